# Optimizing an MI355X kernel written in HIP

```python
import jax, jax.numpy as jnp
from jax import lax
import numpy as np


D_MODEL = 2048
BATCH = 8
SEQ = 2048
DEPTH = 2

HG_HEADS = 8
HG_DIM = 128
HG_WIDTH = HG_HEADS * HG_DIM
HG_CHUNK = 64
ATT_GROUPS = ((128, 1), (512, 4), (2048, 16))
ATT_HEADS_PER_GROUP = 4
ATT_HEAD_DIM = 128
ATT_WIDTH = 3 * ATT_HEADS_PER_GROUP * ATT_HEAD_DIM
ATT_OUT_WIDTH = ATT_HEADS_PER_GROUP * ATT_HEAD_DIM
ROPE_THETA = 10000.0
N_EXPERTS = 64
N_GROUPS = 8
TOPK_GROUPS = 4
TOP_K = 8
EXPERT_FF = 512
SHARED_FF = 512
ROUTED_SCALE = 2.5
DN_ALPHA = (2 * DEPTH) ** 0.25
DN_BETA = (8 * DEPTH) ** -0.25
LN_EPS = 1e-5
NORM_EPS = 1e-6
IN_SPLITS = (HG_WIDTH, HG_WIDTH, HG_WIDTH, HG_WIDTH, ATT_WIDTH, ATT_WIDTH, ATT_WIDTH, D_MODEL, D_MODEL)
IN_WIDTH = 4 * HG_WIDTH + 3 * ATT_WIDTH + 2 * D_MODEL

kernel_name = "hgrn2_dilated_attn_moe_hybrid"


def layer_norm(x, g, b):
    xf = x.astype(jnp.float32)
    mu = jnp.mean(xf, -1, keepdims=True)
    var = jnp.mean(jnp.square(xf - mu), -1, keepdims=True)
    return ((xf - mu) * lax.rsqrt(var + LN_EPS) * g + b).astype(x.dtype)


def hgrn2_lower_bounds(lb_logits):
    p = jax.nn.softmax(lb_logits.astype(jnp.float32), axis=0)
    c = jnp.cumsum(p, axis=0)
    return c - c[:1]


def rope(x, positions):
    dh = x.shape[-1]
    half = dh // 2
    inv = ROPE_THETA ** (-jnp.arange(half, dtype=jnp.float32) * 2.0 / dh)
    ang = positions.astype(jnp.float32)[..., None] * inv
    cos = jnp.cos(ang)[:, :, None, :]
    sin = jnp.sin(ang)[:, :, None, :]
    xf = x.astype(jnp.float32)
    x1, x2 = xf[..., :half], xf[..., half:]
    return jnp.concatenate([x1 * cos - x2 * sin, x2 * cos + x1 * sin], axis=-1)


def banded_attention(q, k, v, n_back):
    n, h, length, dh = q.shape
    blk = n_back
    nb = -(-length // blk)
    pad = nb * blk - length
    def blocks(t):
        t = jnp.pad(t.astype(jnp.float32), ((0, 0), (0, 0), (0, pad), (0, 0)))
        return t.reshape(n, h, nb, blk, dh)
    def with_prev(t):
        prev = jnp.concatenate([jnp.zeros_like(t[:, :, :1]), t[:, :, :-1]], axis=2)
        return jnp.concatenate([prev, t], axis=3)
    qb = blocks(q) * (dh ** -0.5)
    kk = with_prev(blocks(k))
    vv = with_prev(blocks(v))
    s = jnp.einsum('nhbqd,nhbkd->nhbqk', qb, kk)
    qi = jnp.arange(blk)[:, None]
    kj = jnp.arange(2 * blk)[None, :]
    dist = blk + qi - kj
    key_pos = (jnp.arange(nb)[:, None, None] - 1) * blk + kj[None]
    valid = (dist >= 0) & (dist <= n_back) & (key_pos >= 0)
    s = jnp.where(valid, s, -jnp.inf)
    m = jnp.max(s, -1, keepdims=True)
    p = jnp.exp(s - m)
    den = jnp.sum(p, -1, keepdims=True)
    o = jnp.einsum('nhbqk,nhbkd->nhbqd', p, vv) / den
    lse = (m + jnp.log(den))[..., 0]
    o = o.reshape(n, h, nb * blk, dh)[:, :, :length]
    lse = lse.reshape(n, h, nb * blk)[:, :, :length]
    return o, lse


def dilated_group(q, k, v, window, dil):
    b, s, h, dh = q.shape
    length = s // dil
    def gather(t):
        return t.reshape(b, length, dil, h, dh).transpose(0, 2, 3, 1, 4).reshape(b * dil, h, length, dh)
    o, lse = banded_attention(gather(q), gather(k), gather(v), window // dil)
    o = o.reshape(b, dil, h, length, dh).transpose(0, 3, 1, 2, 4).reshape(b, s, h, dh)
    lse = lse.reshape(b, dil, h, length).transpose(0, 3, 1, 2).reshape(b, s, h)
    return o, lse


def dilated_attention_branch(aq, ak, av, positions):
    b, s, _ = aq.shape
    g, hg, dh = len(ATT_GROUPS), ATT_HEADS_PER_GROUP, ATT_HEAD_DIM
    q = rope(aq.reshape(b, s, g * hg, dh), positions).reshape(b, s, g, hg, dh)
    k = rope(ak.reshape(b, s, g * hg, dh), positions).reshape(b, s, g, hg, dh)
    v = av.astype(jnp.float32).reshape(b, s, g, hg, dh)
    outs, lses = [], []
    for gi, (window, dil) in enumerate(ATT_GROUPS):
        o, lse = dilated_group(q[:, :, gi], k[:, :, gi], v[:, :, gi], window, dil)
        outs.append(o)
        lses.append(lse)
    w = jax.nn.softmax(jnp.stack(lses, 0), axis=0)
    o = jnp.sum(w[..., None] * jnp.stack(outs, 0), axis=0)
    return o.reshape(b, s, ATT_OUT_WIDTH).astype(aq.dtype)


def hgrn2_chunk_scan(q, log_f, k, v):
    b, h, s, dk = q.shape
    dv = v.shape[-1]
    c = HG_CHUNK
    n = s // c
    def chunks(t):
        return t.reshape(b, h, n, c, t.shape[-1]).transpose(2, 0, 1, 3, 4)
    causal = jnp.tril(jnp.ones((c, c), dtype=bool))
    def step(state, inp):
        qc, gc, kc, vc = inp
        cum = jnp.cumsum(gc, axis=-2)
        inter = jnp.einsum('bhtk,bhkv->bhtv', qc * jnp.exp(cum), state)
        diff = cum[..., :, None, :] - cum[..., None, :, :]
        decay = jnp.exp(jnp.where(causal[:, :, None], diff, -jnp.inf))
        att = jnp.einsum('bhtsk,bhsk->bhts', qc[..., :, None, :] * decay, kc)
        intra = jnp.einsum('bhts,bhsv->bhtv', att, vc)
        end = cum[..., -1:, :]
        new_state = jnp.exp(end[..., 0, :])[..., None] * state + jnp.einsum('bhsk,bhsv->bhkv', kc * jnp.exp(end - cum), vc)
        return new_state, inter + intra
    init = jnp.zeros((b, h, dk, dv), jnp.float32)
    _, out = lax.scan(step, init, (chunks(q), chunks(log_f), chunks(k), chunks(v)))
    return out.transpose(1, 2, 0, 3, 4).reshape(b, h, s, dv)


def hgrn2_branch(hq, hf, hi, hg, lb, norm_g):
    b, s, _ = hq.shape
    def heads(t):
        return t.astype(jnp.float32).reshape(b, s, HG_HEADS, HG_DIM).transpose(0, 2, 1, 3)
    lb_h = lb.reshape(HG_HEADS, 1, HG_DIM)
    z = heads(hf)
    q = jax.nn.silu(heads(hq))
    log_f = jnp.logaddexp(jnp.log(lb_h), jnp.log1p(-lb_h) + jax.nn.log_sigmoid(z))
    k = (1.0 - lb_h) * jax.nn.sigmoid(-z)
    v = heads(hi)
    o = hgrn2_chunk_scan(q, log_f, k, v)
    o = o * lax.rsqrt(jnp.mean(jnp.square(o), -1, keepdims=True) + NORM_EPS) * norm_g.reshape(HG_HEADS, 1, HG_DIM)
    o = o.transpose(0, 2, 1, 3).reshape(b, s, HG_WIDTH)
    return (o * jax.nn.sigmoid(hg.astype(jnp.float32))).astype(hq.dtype)


def token_mixer(x, positions, w_in, lb, hg_norm_g, w_hg_proj, w_att_proj, w_out):
    h = x @ w_in
    offsets = [int(o) for o in np.cumsum(IN_SPLITS)[:-1]]
    hq, hf, hi, hg, aq, ak, av, gate_h, gate_a = jnp.split(h, offsets, axis=-1)
    y_h = hgrn2_branch(hq, hf, hi, hg, lb, hg_norm_g) @ w_hg_proj
    y_a = dilated_attention_branch(aq, ak, av, positions) @ w_att_proj
    merged = jax.nn.sigmoid(gate_h) * y_h + jax.nn.sigmoid(gate_a) * y_a
    return merged @ w_out


def moe_ffn(x, w_router, router_bias, w_e_gate, w_e_up, w_e_down, w_s_gate, w_s_up, w_s_down):
    b, s, d = x.shape
    t = b * s
    xt = x.reshape(t, d)
    scores = jax.nn.sigmoid(jnp.matmul(xt.astype(jnp.float32), w_router.astype(jnp.float32)))
    sel = scores + router_bias.astype(jnp.float32)
    grp = sel.reshape(t, N_GROUPS, N_EXPERTS // N_GROUPS)
    grp_score = jnp.sum(lax.top_k(grp, 2)[0], axis=-1)
    _, gidx = lax.top_k(grp_score, TOPK_GROUPS)
    rows = jnp.arange(t)[:, None]
    gmask = jnp.zeros((t, N_GROUPS), dtype=bool).at[rows, gidx].set(True)
    sel = jnp.where(gmask[:, :, None], grp, -jnp.inf).reshape(t, N_EXPERTS)
    _, eidx = lax.top_k(sel, TOP_K)
    w = jnp.take_along_axis(scores, eidx, axis=-1)
    w = w / jnp.sum(w, -1, keepdims=True) * ROUTED_SCALE
    gates = jnp.zeros((t, N_EXPERTS), jnp.float32).at[rows, eidx].set(w)
    def expert(acc, params):
        wg, wu, wd, g = params
        hid = jax.nn.silu(xt @ wg) * (xt @ wu)
        return acc + g[:, None] * (hid @ wd).astype(jnp.float32), None
    routed, _ = lax.scan(expert, jnp.zeros((t, d), jnp.float32), (w_e_gate, w_e_up, w_e_down, gates.T))
    shared = (jax.nn.silu(xt @ w_s_gate) * (xt @ w_s_up)) @ w_s_down
    return (routed + shared.astype(jnp.float32)).reshape(b, s, d).astype(x.dtype)


def setup_inputs(seed: int = 0) -> dict:
    key = jax.random.key(seed)
    ks = jax.random.split(key, 20)
    f32 = jnp.float32
    def nrm(k, shape, scale):
        return jax.random.normal(k, shape, f32) * scale
    return {
        "x": nrm(ks[0], (BATCH, SEQ, D_MODEL), 1.0),
        "positions": jnp.broadcast_to(jnp.arange(SEQ, dtype=jnp.int32), (BATCH, SEQ)),
        "w_in": nrm(ks[1], (DEPTH, D_MODEL, IN_WIDTH), D_MODEL ** -0.5),
        "lb_logits": nrm(ks[2], (DEPTH, HG_WIDTH), 0.5),
        "hg_norm_g": 1.0 + nrm(ks[3], (DEPTH, HG_WIDTH), 0.02),
        "w_hg_proj": nrm(ks[4], (DEPTH, HG_WIDTH, D_MODEL), HG_WIDTH ** -0.5),
        "w_att_proj": nrm(ks[5], (DEPTH, ATT_OUT_WIDTH, D_MODEL), ATT_OUT_WIDTH ** -0.5),
        "w_out": nrm(ks[6], (DEPTH, D_MODEL, D_MODEL), DN_BETA * D_MODEL ** -0.5),
        "ln1_g": 1.0 + nrm(ks[7], (DEPTH, D_MODEL), 0.02),
        "ln1_b": nrm(ks[8], (DEPTH, D_MODEL), 0.02),
        "w_router": nrm(ks[9], (DEPTH, D_MODEL, N_EXPERTS), D_MODEL ** -0.5),
        "router_bias": nrm(ks[10], (DEPTH, N_EXPERTS), 0.01),
        "w_e_gate": nrm(ks[11], (DEPTH, N_EXPERTS, D_MODEL, EXPERT_FF), D_MODEL ** -0.5),
        "w_e_up": nrm(ks[12], (DEPTH, N_EXPERTS, D_MODEL, EXPERT_FF), D_MODEL ** -0.5),
        "w_e_down": nrm(ks[13], (DEPTH, N_EXPERTS, EXPERT_FF, D_MODEL), DN_BETA * EXPERT_FF ** -0.5),
        "w_s_gate": nrm(ks[14], (DEPTH, D_MODEL, SHARED_FF), D_MODEL ** -0.5),
        "w_s_up": nrm(ks[15], (DEPTH, D_MODEL, SHARED_FF), D_MODEL ** -0.5),
        "w_s_down": nrm(ks[16], (DEPTH, SHARED_FF, D_MODEL), DN_BETA * SHARED_FF ** -0.5),
        "ln2_g": 1.0 + nrm(ks[17], (DEPTH, D_MODEL), 0.02),
        "ln2_b": nrm(ks[18], (DEPTH, D_MODEL), 0.02),
    }


def reference(x, positions, w_in, lb_logits, hg_norm_g, w_hg_proj, w_att_proj, w_out, ln1_g, ln1_b,
              w_router, router_bias, w_e_gate, w_e_up, w_e_down, w_s_gate, w_s_up, w_s_down, ln2_g, ln2_b):
    lower_bounds = hgrn2_lower_bounds(lb_logits)
    for layer in range(DEPTH):
        mix = token_mixer(x, positions, w_in[layer], lower_bounds[layer], hg_norm_g[layer],
                          w_hg_proj[layer], w_att_proj[layer], w_out[layer])
        x = layer_norm(DN_ALPHA * x + mix, ln1_g[layer], ln1_b[layer])
        ffn = moe_ffn(x, w_router[layer], router_bias[layer], w_e_gate[layer], w_e_up[layer], w_e_down[layer],
                      w_s_gate[layer], w_s_up[layer], w_s_down[layer])
        x = layer_norm(DN_ALPHA * x + ffn, ln2_g[layer], ln2_b[layer])
    return x
```

```cpp
#include <hip/hip_runtime.h>
#include <cstdio>
#include <cstdint>

#ifndef MK_LAUNCH_PER_PHASE
#define MK_LAUNCH_PER_PHASE 1
#endif

#define GAS __attribute__((address_space(1)))
#define LAS __attribute__((address_space(3)))
typedef unsigned short bf16_t;
typedef short bf16x8 __attribute__((ext_vector_type(8)));
typedef short s16x4 __attribute__((ext_vector_type(4)));
typedef float f32x4 __attribute__((ext_vector_type(4)));
typedef float f32x2 __attribute__((ext_vector_type(2)));
typedef unsigned u32x4 __attribute__((ext_vector_type(4)));
typedef unsigned u32x2 __attribute__((ext_vector_type(2)));

constexpr int D_MODEL = 2048, BATCH = 8, SEQ = 2048, DEPTH = 2, T = BATCH * SEQ;
constexpr int HG_HEADS = 8, HG_DIM = 128, HG_WIDTH = 1024, HG_CHUNK = 64, NCHUNK = T / HG_CHUNK;
constexpr int ATT_HEADS = 12, ATT_DIM = 128, ATT_WIDTH = 1536, ATT_OUT = 512;
constexpr int N_EXPERTS = 64, N_GROUPS = 8, TOPK_GROUPS = 4, TOP_K = 8, EXPERT_FF = 512;
constexpr int IN_WIDTH = 12800;
constexpr int C_HQ = 0, C_HF = 1024, C_HI = 2048, C_HGATE = 3072, C_AQ = 4096, C_AK = 5632, C_AV = 7168, C_GH = 8704, C_GA = 10752;
constexpr float ROUTED_SCALE = 2.5f, LN_EPS = 1e-5f, NORM_EPS = 1e-6f;
constexpr float DN_ALPHA = 1.41421356237309515f;
constexpr int NEXP1 = N_EXPERTS + 1;
constexpr int MAXROWS = 163840;

constexpr size_t MiB = 1u << 20;
constexpr size_t WS_CTL = 0, CTL_ZERO_BYTES = 1 * MiB;
constexpr size_t WS_WIN = 4 * MiB;
constexpr size_t WS_WHG = 54 * MiB;
constexpr size_t WS_WATT = 58 * MiB;
constexpr size_t WS_WOUT = 60 * MiB;
constexpr size_t WS_WGU = 68 * MiB;
constexpr size_t WS_WDN = 328 * MiB;
constexpr size_t WS_ROPE = 458 * MiB;
constexpr size_t WS_LB = 466 * MiB;
constexpr size_t WS_R = 467 * MiB;
constexpr size_t WS_X1 = 595 * MiB;
constexpr size_t WS_XB = 723 * MiB;
constexpr size_t WS_X1B = 787 * MiB;
constexpr size_t WS_PE = 851 * MiB;
constexpr size_t WS_PP = 852 * MiB;
constexpr size_t WS_PG = 853 * MiB;
constexpr size_t WS_RM = 854 * MiB;
constexpr size_t WS_HID = 859 * MiB;
constexpr size_t WS_BIG = 1019 * MiB;
constexpr size_t WS_H = WS_BIG;
constexpr size_t WS_LF = WS_BIG + 400 * MiB;
constexpr size_t WS_UT = WS_BIG + 464 * MiB;
constexpr size_t WS_SPT = WS_BIG + 592 * MiB;
constexpr size_t WS_DEC = WS_BIG + 656 * MiB;
constexpr size_t WS_LSE = WS_BIG + 657 * MiB;
constexpr size_t WS_HGO = WS_BIG + 658 * MiB;
constexpr size_t WS_ATTO = WS_BIG + 690 * MiB;
constexpr size_t WS_MRG = WS_BIG + 706 * MiB;
constexpr size_t WS_Y = WS_BIG;
constexpr size_t WS_END = WS_BIG + 770 * MiB;
constexpr int CW_TMO = 0;
constexpr int CW_CNT = 1024;
constexpr int CW_BAR = 4096;

constexpr int LDS_BYTES = 159744;
constexpr int LDS_TAB = 147456;
constexpr int LDS_MISC = LDS_TAB + 2048;

#define RLX_AGENT __ATOMIC_RELAXED, __HIP_MEMORY_SCOPE_AGENT
#define LDS_WAIT() asm volatile("s_waitcnt lgkmcnt(0)" ::: "memory")
#define VM_WAIT() asm volatile("s_waitcnt vmcnt(0)" ::: "memory")
__device__ __forceinline__ unsigned f2bf(float f) { unsigned u = __builtin_bit_cast(unsigned, f); return (u + 0x7fffu + ((u >> 16) & 1u)) >> 16; }
__device__ __forceinline__ unsigned pk2(float lo, float hi) { return f2bf(lo) | (f2bf(hi) << 16); }
__device__ __forceinline__ float bf2f(unsigned short b) { return __builtin_bit_cast(float, ((unsigned)b) << 16); }
__device__ __forceinline__ float bflo(unsigned w) { return __builtin_bit_cast(float, w << 16); }
__device__ __forceinline__ float bfhi(unsigned w) { return __builtin_bit_cast(float, w & 0xffff0000u); }
__device__ __forceinline__ unsigned cvt_pk_bf16(float lo, float hi) { unsigned r; asm volatile("v_cvt_pk_bf16_f32 %0, %1, %2" : "=v"(r) : "v"(lo), "v"(hi)); return r; }
__device__ __forceinline__ float fsigmoid(float x) { return __fdividef(1.0f, 1.0f + __expf(-x)); }
__device__ __forceinline__ float wave_sum(float v) {
#pragma unroll
    for (int o = 1; o < 64; o <<= 1) v += __shfl_xor(v, o);
    return v;
}
__device__ __forceinline__ f32x4 mfma16(bf16x8 a, bf16x8 b, f32x4 c) { return __builtin_amdgcn_mfma_f32_16x16x32_bf16(a, b, c, 0, 0, 0); }
__device__ __forceinline__ s16x4 tr_read(unsigned lds_addr) { s16x4 r; asm volatile("ds_read_b64_tr_b16 %0, %1\n\ts_waitcnt lgkmcnt(0)" : "=&v"(r) : "v"(lds_addr) : "memory"); return r; }

#define XB_TMO      128
#define XB_XCNT(j)  (256  + 64 * (j))
#define XB_XSUB(j)  (1280 + 64 * (j))
#define XB_XGEN(j)  (2304 + 64 * (j))
#define XB_TOP      3328
#define XB_TOPGEN   3392
#define XCD_BAR_WORDS 3456
#define XB_SPIN_CAP (1u << 18)
__device__ __forceinline__ unsigned xb_ld(unsigned* p)              { return __hip_atomic_load(p, __ATOMIC_RELAXED, __HIP_MEMORY_SCOPE_AGENT); }
__device__ __forceinline__ unsigned xb_add(unsigned* p, unsigned v) { return __hip_atomic_fetch_add(p, v, __ATOMIC_RELAXED, __HIP_MEMORY_SCOPE_AGENT); }
__device__ __forceinline__ unsigned xb_xcc_id() { return (unsigned)__builtin_amdgcn_s_getreg((3 << 11) | 20) & 0xFu; }
#define XB_SPIN(cond, bar) do { unsigned _sp = 0; while (cond) { __builtin_amdgcn_s_sleep(1); \
    if ((++_sp & 255u) == 0u) { if (xb_ld(&(bar)[XB_TMO])) break; if (_sp > XB_SPIN_CAP) { atomicAdd(&(bar)[XB_TMO], 1u); break; } } } } while (0)
struct XcdBarrier { unsigned* bar; unsigned x; volatile LAS unsigned* st; };
__device__ __forceinline__ XcdBarrier xcd_barrier_post(unsigned* bar, volatile LAS unsigned* st) {
    XcdBarrier b; b.bar = bar; b.x = xb_xcc_id(); b.st = st;
    if (threadIdx.x == 0) (void)xb_add(&bar[XB_XCNT(b.x)], 1u);
    return b;
}
__device__ __forceinline__ void xcd_barrier_complete(unsigned* bar, unsigned x, unsigned& nloc, unsigned& nx) {
    const unsigned G = gridDim.x * gridDim.y * gridDim.z;
    unsigned sum, cnt, mine, sp = 0u;
    for (;;) {
        sum = 0u; cnt = 0u; mine = 0u;
#pragma unroll
        for (unsigned j = 0; j < 16; ++j) { const unsigned c = xb_ld(&bar[XB_XCNT(j)]); sum += c; cnt += (c > 0u) ? 1u : 0u; mine = (j == x) ? c : mine; }
        if (sum == G) break;
        __builtin_amdgcn_s_sleep(1);
        if ((++sp & 255u) == 0u) { if (xb_ld(&bar[XB_TMO])) break; if (sp > XB_SPIN_CAP) { atomicAdd(&bar[XB_TMO], 1u); break; } }
    }
    nloc = mine > 0u ? mine : 1u; nx = cnt > 0u ? cnt : 1u;
}
__device__ __forceinline__ void xcd_barrier(const XcdBarrier& b) {
    asm volatile("s_waitcnt vmcnt(0)" ::: "memory");
    __syncthreads();
    if (threadIdx.x == 0) {
        unsigned* bar = b.bar;
        __builtin_amdgcn_s_waitcnt(0);
        unsigned nloc = b.st[0], nx = b.st[1];
        if (nloc == 0u) { xcd_barrier_complete(bar, b.x, nloc, nx); b.st[0] = nloc; b.st[1] = nx; }
        const unsigned old = xb_add(&bar[XB_XSUB(b.x)], 1u);
        const unsigned gen = old / nloc;
        if (old + 1u == (gen + 1u) * nloc) {
            __builtin_amdgcn_fence(__ATOMIC_RELEASE, "agent");
            asm volatile("s_waitcnt vmcnt(0)" ::: "memory");
            const unsigned og = xb_add(&bar[XB_TOP], 1u);
            const unsigned tg = og / nx;
            if (og + 1u == (tg + 1u) * nx) xb_add(&bar[XB_TOPGEN], 1u);
            else XB_SPIN(xb_ld(&bar[XB_TOPGEN]) == tg, bar);
            __builtin_amdgcn_fence(__ATOMIC_ACQUIRE, "agent");
            xb_add(&bar[XB_XGEN(b.x)], 1u);
            asm volatile("s_waitcnt vmcnt(0)" ::: "memory");
        } else {
            XB_SPIN(xb_ld(&bar[XB_XGEN(b.x)]) == gen, bar);
            __builtin_amdgcn_fence(__ATOMIC_ACQUIRE, "agent");
            asm volatile("s_waitcnt vmcnt(0)" ::: "memory");
        }
    }
    __syncthreads();
}

namespace pg8 {
constexpr int BM = 256, BK = 64, HALF = 128, HTB = HALF * BK * 2, STAGE_BYTES = 8 * HTB, NXCD = 8, WGM = 8;
__host__ __device__ __forceinline__ int lds_byte(int r, int c) { const int st = (r >> 4) * 2 + (c >> 5), rr = r & 15, cc = c & 31, ob = rr * 64 + cc * 2; return st * 1024 + (ob ^ (((ob >> 9) & 1) << 5)); }
__host__ __device__ __forceinline__ void stage_rc(int b, int& R, int& C) { const int st = b / 1024, sb = b % 1024, swz = sb ^ (((sb >> 9) & 1) << 5); R = (st >> 1) * 16 + swz / 64; C = (st & 1) * 32 + (swz % 64) / 2; }
__host__ __device__ __forceinline__ int perm32(int rho) { const int n = rho >> 4, i = rho & 15; return 8 * (i >> 2) + 4 * n + (i & 3); }

struct Unit {
    const char* a; const char* b; int lda, ldb, nt;
    int row0, col0, aux;
    const int* gidx; int gcnt;
};

__device__ __forceinline__ void tile_of(int L, int nM, int nN, int& pm, int& pn) {
    const int nwg = nM * nN; int wgid = L;
    { const int q = nwg / NXCD, r = nwg % NXCD, xcd = wgid % NXCD, off = wgid / NXCD; wgid = (xcd < r ? xcd * (q + 1) : r * (q + 1) + (xcd - r) * q) + off; }
    const int nig = WGM * nN, gid = wgid / nig, fm = gid * WGM, gsz = (nM - fm) < WGM ? (nM - fm) : WGM;
    pm = fm + ((wgid % nig) % gsz); pn = (wgid % nig) / gsz;
}

template <class Epi, class Sched, bool GATHER>
__device__ __forceinline__ void gemm_phase(LAS unsigned char* lds, const Sched& S, const Epi& E) {
    int tid = threadIdx.x; asm volatile("" : "+v"(tid));
    const int wid = __builtin_amdgcn_readfirstlane(tid >> 6), lane = tid & 63, wr = wid >> 2, wc = wid & 3, fr = lane & 15, fq = lane >> 4;
    int sR[2], sC2[2], sRb[2];
#pragma unroll
    for (int i = 0; i < 2; ++i) { int R, C; stage_rc(tid * 16 + i * 8192, R, C); sR[i] = R; sC2[i] = C * 2; sRb[i] = Epi::PERM ? ((R & ~31) + perm32(R & 31)) : R; }
    const unsigned ldsw = (unsigned)wid * 1024u;
    const int aoff = lds_byte(wr * 64 + fr, fq * 8), boff = lds_byte(wc * 32 + fr, fq * 8);
#define PG8_SA(b, h) (((b) * 2 + (h)) * HTB)
#define PG8_SB(b, h) ((4 + (b) * 2 + (h)) * HTB)
#define PG8_STAGE(bufoff, gbase, voff) do { _Pragma("unroll") for (int _i = 0; _i < 2; ++_i) \
        __builtin_amdgcn_global_load_lds((const unsigned*)((const char*)(gbase) + (voff)[_i]), (LAS unsigned*)(lds + (bufoff) + ldsw + _i * 8192), 16, 0, 0); } while (0)
#define PG8_LDA(dst, b, h) do { _Pragma("unroll") for (int m = 0; m < 4; ++m) _Pragma("unroll") for (int k = 0; k < 2; ++k) dst[m][k] = *(const LAS bf16x8*)(lds + PG8_SA(b, h) + aoff + m * 2048 + k * 1024); } while (0)
#define PG8_LDB(dst, b, h) do { _Pragma("unroll") for (int n = 0; n < 2; ++n) _Pragma("unroll") for (int k = 0; k < 2; ++k) dst[n][k] = *(const LAS bf16x8*)(lds + PG8_SB(b, h) + boff + n * 2048 + k * 1024); } while (0)
#define PG8_MMA(ai, bj, At, Bt) do { __builtin_amdgcn_s_setprio(1); _Pragma("unroll") for (int m = 0; m < 4; ++m) _Pragma("unroll") for (int n = 0; n < 2; ++n) _Pragma("unroll") for (int k = 0; k < 2; ++k) \
        acc[ai][bj][m][n] = __builtin_amdgcn_mfma_f32_16x16x32_bf16(Bt[n][k], At[m][k], acc[ai][bj][m][n], 0, 0, 0); __builtin_amdgcn_s_setprio(0); } while (0)
#define PG8_WAIT_V(n) asm volatile("s_waitcnt vmcnt(" #n ")" ::: "memory")
#define PG8_WAIT_L(n) asm volatile("s_waitcnt lgkmcnt(" #n ")" ::: "memory")
#define PG8_BAR __builtin_amdgcn_s_barrier()
#define PG8_SCHED __builtin_amdgcn_sched_barrier(0)
#define PG8_OFFS(u, ao, bo) do { _Pragma("unroll") for (int _i = 0; _i < 2; ++_i) { (bo)[_i] = (unsigned)(sRb[_i] * (u).ldb + sC2[_i]); \
        _Pragma("unroll") for (int _h = 0; _h < 2; ++_h) { int _r = _h * HALF + sR[_i]; if (GATHER) { _r = (_r < (u).gcnt) ? (u).gidx[_r] : 0; } (ao)[_h][_i] = (unsigned)(_r * (u).lda + sC2[_i]); } } } while (0)
    Unit cur, nxt; int ui = 0;
    if (!S.next(0, cur)) return;
    f32x4 acc[2][2][4][2];
#pragma unroll
    for (int a = 0; a < 2; ++a)
#pragma unroll
        for (int b = 0; b < 2; ++b)
#pragma unroll
            for (int m = 0; m < 4; ++m)
#pragma unroll
                for (int n = 0; n < 2; ++n) acc[a][b][m][n] = (f32x4){0.f, 0.f, 0.f, 0.f};
    bf16x8 At[4][2], B0[2][2], B1[2][2];
    unsigned aoc[2][2], boc[2], aon[2][2], bon[2];
    PG8_OFFS(cur, aoc, boc);
    {
        const char* cA = cur.a; const char* cB = cur.b; const size_t hB = (size_t)HALF * cur.ldb;
        PG8_STAGE(PG8_SB(0, 0), cB, boc); PG8_STAGE(PG8_SB(0, 1), cB + hB, boc); PG8_STAGE(PG8_SA(0, 0), cA, aoc[0]); PG8_STAGE(PG8_SA(0, 1), cA, aoc[1]);
        if (wr == 1) PG8_BAR;
        PG8_WAIT_V(2); PG8_BAR;
        PG8_STAGE(PG8_SB(1, 0), cB + 128, boc); PG8_STAGE(PG8_SA(1, 0), cA + 128, aoc[0]); PG8_STAGE(PG8_SB(1, 1), cB + hB + 128, boc);
        PG8_WAIT_V(6); PG8_BAR;
    }
    for (;;) {
        const bool has_next = S.next(ui + 1, nxt);
        if (has_next) { PG8_OFFS(nxt, aon, bon); }
        else { nxt = cur;
#pragma unroll
            for (int i = 0; i < 2; ++i) { bon[i] = boc[i]; aon[0][i] = aoc[0][i]; aon[1][i] = aoc[1][i]; } }
        const char* cA = cur.a; const char* cB = cur.b; const char* nA = nxt.a; const char* nB = nxt.b;
        const size_t hBc = (size_t)HALF * cur.ldb, hBn = (size_t)HALF * nxt.ldb;
        const int nt = cur.nt;
        for (int t = 0; t < nt; t += 2) {
            const bool last = (t == nt - 2);
            const char* a1 = cA + (size_t)(t + 1) * 128;
            const char* a2 = last ? nA : cA + (size_t)(t + 2) * 128; const char* b2 = last ? nB : cB + (size_t)(t + 2) * 128;
            const char* a3 = a2 + 128; const char* b3 = b2 + 128;
            const size_t hB2 = last ? hBn : hBc;
            unsigned oa0[2], oa1[2], ob[2];
#pragma unroll
            for (int i = 0; i < 2; ++i) { oa0[i] = last ? aon[0][i] : aoc[0][i]; oa1[i] = last ? aon[1][i] : aoc[1][i]; ob[i] = last ? bon[i] : boc[i]; }
            PG8_LDB(B0, 0, 0); PG8_LDB(B1, 0, 1); PG8_SCHED; PG8_LDA(At, 0, 0); PG8_STAGE(PG8_SA(1, 1), a1, aoc[1]);
            PG8_WAIT_V(8); PG8_WAIT_L(0); PG8_BAR; PG8_MMA(0, 0, At, B0); PG8_MMA(0, 1, At, B1); PG8_BAR; PG8_SCHED;
            PG8_LDA(At, 0, 1); PG8_STAGE(PG8_SB(0, 0), b2, ob); PG8_STAGE(PG8_SB(0, 1), b2 + hB2, ob); PG8_STAGE(PG8_SA(0, 0), a2, oa0);
            PG8_WAIT_V(8); PG8_WAIT_L(0); PG8_BAR; PG8_MMA(1, 0, At, B0); PG8_MMA(1, 1, At, B1); PG8_BAR; PG8_SCHED;
            PG8_LDB(B0, 1, 0); PG8_LDB(B1, 1, 1); PG8_SCHED; PG8_LDA(At, 1, 0); PG8_STAGE(PG8_SA(0, 1), a2, oa1);
            PG8_WAIT_V(8); PG8_WAIT_L(0); PG8_BAR; PG8_MMA(0, 0, At, B0); PG8_MMA(0, 1, At, B1); PG8_BAR; PG8_SCHED;
            PG8_LDA(At, 1, 1); PG8_STAGE(PG8_SB(1, 0), b3, ob); PG8_STAGE(PG8_SB(1, 1), b3 + hB2, ob); PG8_STAGE(PG8_SA(1, 0), a3, oa0);
            PG8_WAIT_V(8); PG8_WAIT_L(0); PG8_BAR; PG8_MMA(1, 0, At, B0); PG8_MMA(1, 1, At, B1); PG8_BAR; PG8_SCHED;
        }
        if (wr == 0) PG8_BAR;
        const bool keep = E(acc, cur, wr, wc, fr, fq);
        if (!has_next) break;
        if (!keep) {
#pragma unroll
            for (int a = 0; a < 2; ++a)
#pragma unroll
                for (int b = 0; b < 2; ++b)
#pragma unroll
                    for (int m = 0; m < 4; ++m)
#pragma unroll
                        for (int n = 0; n < 2; ++n) acc[a][b][m][n] = (f32x4){0.f, 0.f, 0.f, 0.f};
        }
        cur = nxt;
#pragma unroll
        for (int i = 0; i < 2; ++i) { boc[i] = bon[i]; aoc[0][i] = aon[0][i]; aoc[1][i] = aon[1][i]; }
        ++ui;
        if (wr == 1) PG8_BAR;
    }
    PG8_WAIT_V(0);
    PG8_BAR;
#undef PG8_OFFS
#undef PG8_SA
#undef PG8_SB
#undef PG8_STAGE
#undef PG8_LDA
#undef PG8_LDB
#undef PG8_MMA
#undef PG8_WAIT_V
#undef PG8_WAIT_L
#undef PG8_BAR
#undef PG8_SCHED
}
}
using pg8::Unit;

struct DenseSched {
    const char* A; const char* Bt; int lda, ldb, nt, nM, nN, G, c;
    __device__ __forceinline__ bool next(int i, Unit& u) const {
        const long L = (long)i * G + c; if (L >= (long)nM * nN) return false;
        int pm, pn; pg8::tile_of((int)L, nM, nN, pm, pn);
        u.a = A + (size_t)pm * 256 * lda; u.b = Bt + (size_t)pn * 256 * ldb; u.lda = lda; u.ldb = ldb; u.nt = nt;
        u.row0 = pm * 256; u.col0 = pn * 256; u.aux = 0; u.gidx = nullptr; u.gcnt = 256; return true;
    }
};
struct MergeSched {
    const char* A0; const char* B0; const char* A1; const char* B1; int nM, nN, G, c;
    __device__ __forceinline__ bool next(int i, Unit& u) const {
        const long L = (long)(i >> 1) * G + c; if (L >= (long)nM * nN) return false;
        int pm, pn; pg8::tile_of((int)L, nM, nN, pm, pn);
        const int seg = i & 1;
        const int ld = seg ? ATT_OUT * 2 : HG_WIDTH * 2;
        u.a = (seg ? A1 : A0) + (size_t)pm * 256 * ld; u.b = (seg ? B1 : B0) + (size_t)pn * 256 * ld; u.lda = ld; u.ldb = ld; u.nt = seg ? ATT_OUT / 64 : HG_WIDTH / 64;
        u.row0 = pm * 256; u.col0 = pn * 256; u.aux = seg; u.gidx = nullptr; u.gcnt = 256; return true;
    }
};
template <int NT, bool UP>
struct MoeSched {
    const LAS int* toff; const unsigned* cnt;
    const char* A; const char* W; const int* rowmap;
    int G, c;
    __device__ __forceinline__ bool next(int i, Unit& u) const {
        const int total = toff[NEXP1];
        const long L = (long)i * G + c; if (L >= (long)total * NT) return false;
        const int mtg = (int)(L / NT), pn = (int)(L % NT);
        int lo = 0, hi = NEXP1;
        while (hi - lo > 1) { const int mid = (lo + hi) >> 1; if (toff[mid] <= mtg) lo = mid; else hi = mid; }
        const int e = lo, mt = mtg - toff[e];
        if (UP) {
            u.a = A; u.lda = D_MODEL * 2; u.nt = D_MODEL / 64;
            u.b = W + ((size_t)e * 1024 + (size_t)pn * 256) * (D_MODEL * 2); u.ldb = D_MODEL * 2;
            if (e < N_EXPERTS) { u.gidx = rowmap + (size_t)e * T + mt * 256; const int n = (int)cnt[e] - mt * 256; u.gcnt = n < 256 ? n : 256; }
            else { u.gidx = rowmap + (size_t)N_EXPERTS * T + mt * 256; u.gcnt = 256; }
            u.col0 = pn * 128;
        } else {
            u.a = A + (size_t)mtg * 256 * (EXPERT_FF * 2); u.lda = EXPERT_FF * 2; u.nt = EXPERT_FF / 64;
            u.b = W + ((size_t)e * D_MODEL + (size_t)pn * 256) * (EXPERT_FF * 2); u.ldb = EXPERT_FF * 2;
            u.gidx = nullptr; u.gcnt = 256; u.col0 = pn * 256;
        }
        u.row0 = mtg * 256; u.aux = e; return true;
    }
};

struct EpiIn {
    static constexpr bool PERM = true;
    bf16_t* H; float* LF; const float* lb; const f32x4* rope;
    __device__ __forceinline__ bool operator()(f32x4 (&acc)[2][2][4][2], const Unit& u, int wr, int wc, int fr, int fq) const {
        const int row0 = u.row0 + wr * 64 + fr, colt = u.col0, cl = wc * 32 + 8 * fq;
        int mode;
        if (colt < C_HF) mode = 1; else if (colt < C_HI) mode = 3; else if (colt < C_HGATE) mode = 0; else if (colt < C_AQ) mode = 2;
        else if (colt < C_AK) mode = 4; else if (colt < C_AV) mode = 5; else if (colt < C_GH) mode = 0; else mode = 2;
        if (mode == 3) {
            f32x4 lbv[2][2];
#pragma unroll
            for (int bj = 0; bj < 2; ++bj)
#pragma unroll
                for (int n = 0; n < 2; ++n) lbv[bj][n] = *(const f32x4*)(lb + (colt - C_HF) + bj * 128 + cl + 4 * n);
#pragma unroll
            for (int ai = 0; ai < 2; ++ai)
#pragma unroll
                for (int m = 0; m < 4; ++m) { float* rowp = LF + (size_t)(row0 + ai * 128 + m * 16) * HG_WIDTH + (colt - C_HF) + cl;
#pragma unroll
                    for (int bj = 0; bj < 2; ++bj)
#pragma unroll
                        for (int n = 0; n < 2; ++n) { f32x4 z = acc[ai][bj][m][n], o;
#pragma unroll
                            for (int j = 0; j < 4; ++j) { const float zz = fmaxf(z[j], -80.f), l = lbv[bj][n][j]; const float f = l + (1.0f - l) * __fdividef(1.0f, 1.0f + __expf(-zz)); o[j] = __logf(f); }
                            *(f32x4*)(rowp + bj * 128 + 4 * n) = o; } }
            return false;
        }
        if (mode >= 4) {
            const float sc = (mode == 4) ? 0.08838834764831845f : 1.0f;
            const int i0 = 16 * wc + 4 * fq;
#pragma unroll
            for (int ai = 0; ai < 2; ++ai)
#pragma unroll
                for (int m = 0; m < 4; ++m) { const int row = row0 + ai * 128 + m * 16; bf16_t* rowp = H + (size_t)row * IN_WIDTH + colt + cl;
                    const f32x4 cs0 = rope[(size_t)row * 32 + (i0 >> 1)], cs1 = rope[(size_t)row * 32 + (i0 >> 1) + 1];
#pragma unroll
                    for (int bj = 0; bj < 2; ++bj) { const f32x4 v0 = acc[ai][bj][m][0], v1 = acc[ai][bj][m][1]; u32x4 w;
                        w.x = cvt_pk_bf16((v0[0] * cs0[0] - v0[1] * cs0[1]) * sc, (v0[1] * cs0[0] + v0[0] * cs0[1]) * sc);
                        w.y = cvt_pk_bf16((v0[2] * cs0[2] - v0[3] * cs0[3]) * sc, (v0[3] * cs0[2] + v0[2] * cs0[3]) * sc);
                        w.z = cvt_pk_bf16((v1[0] * cs1[0] - v1[1] * cs1[1]) * sc, (v1[1] * cs1[0] + v1[0] * cs1[1]) * sc);
                        w.w = cvt_pk_bf16((v1[2] * cs1[2] - v1[3] * cs1[3]) * sc, (v1[3] * cs1[2] + v1[2] * cs1[3]) * sc);
                        *(u32x4*)(rowp + bj * 128) = w; } }
            return false;
        }
#pragma unroll
        for (int ai = 0; ai < 2; ++ai)
#pragma unroll
            for (int m = 0; m < 4; ++m) { bf16_t* rowp = H + (size_t)(row0 + ai * 128 + m * 16) * IN_WIDTH + colt + cl;
#pragma unroll
                for (int bj = 0; bj < 2; ++bj) { f32x4 v0 = acc[ai][bj][m][0], v1 = acc[ai][bj][m][1];
                    if (mode != 0) {
#pragma unroll
                        for (int j = 0; j < 4; ++j) { const float s0 = fsigmoid(v0[j]), s1 = fsigmoid(v1[j]); v0[j] = (mode == 1) ? v0[j] * s0 : s0; v1[j] = (mode == 1) ? v1[j] * s1 : s1; } }
                    u32x4 w; w.x = cvt_pk_bf16(v0[0], v0[1]); w.y = cvt_pk_bf16(v0[2], v0[3]); w.z = cvt_pk_bf16(v1[0], v1[1]); w.w = cvt_pk_bf16(v1[2], v1[3]);
                    *(u32x4*)(rowp + bj * 128) = w; } }
        return false;
    }
};
struct EpiMerge {
    static constexpr bool PERM = true;
    const bf16_t* H; bf16_t* O;
    __device__ __forceinline__ bool operator()(f32x4 (&acc)[2][2][4][2], const Unit& u, int wr, int wc, int fr, int fq) const {
        const int row0 = u.row0 + wr * 64 + fr, col0 = u.col0 + wc * 32 + 8 * fq;
#pragma unroll
        for (int ai = 0; ai < 2; ++ai)
#pragma unroll
            for (int m = 0; m < 4; ++m) { const size_t row = (size_t)(row0 + ai * 128 + m * 16);
#pragma unroll
                for (int bj = 0; bj < 2; ++bj) {
                    const u32x4 ga = *(const u32x4*)(H + row * IN_WIDTH + C_GA + col0 + bj * 128);
                    float a[8] = {bflo(ga.x), bfhi(ga.x), bflo(ga.y), bfhi(ga.y), bflo(ga.z), bfhi(ga.z), bflo(ga.w), bfhi(ga.w)};
                    if (u.aux == 0) {
                        const u32x4 gh = *(const u32x4*)(H + row * IN_WIDTH + C_GH + col0 + bj * 128);
                        float h[8] = {bflo(gh.x), bfhi(gh.x), bflo(gh.y), bfhi(gh.y), bflo(gh.z), bfhi(gh.z), bflo(gh.w), bfhi(gh.w)};
#pragma unroll
                        for (int j = 0; j < 4; ++j) { acc[ai][bj][m][0][j] *= __fdividef(h[j], a[j]); acc[ai][bj][m][1][j] *= __fdividef(h[4 + j], a[4 + j]); }
                    } else {
                        f32x4 v0 = acc[ai][bj][m][0], v1 = acc[ai][bj][m][1];
#pragma unroll
                        for (int j = 0; j < 4; ++j) { v0[j] *= a[j]; v1[j] *= a[4 + j]; }
                        u32x4 w; w.x = cvt_pk_bf16(v0[0], v0[1]); w.y = cvt_pk_bf16(v0[2], v0[3]); w.z = cvt_pk_bf16(v1[0], v1[1]); w.w = cvt_pk_bf16(v1[2], v1[3]);
                        *(u32x4*)(O + row * D_MODEL + col0 + bj * 128) = w;
                    } } }
        return u.aux == 0;
    }
};
struct EpiResid {
    static constexpr bool PERM = false;
    const float* X; float* R;
    __device__ __forceinline__ bool operator()(f32x4 (&acc)[2][2][4][2], const Unit& u, int wr, int wc, int fr, int fq) const {
        const int row0 = u.row0 + wr * 64 + fr, col0 = u.col0 + wc * 32 + 4 * fq;
#pragma unroll
        for (int ai = 0; ai < 2; ++ai)
#pragma unroll
            for (int m = 0; m < 4; ++m) { const size_t off = (size_t)(row0 + ai * 128 + m * 16) * D_MODEL + col0;
#pragma unroll
                for (int bj = 0; bj < 2; ++bj)
#pragma unroll
                    for (int n = 0; n < 2; ++n) { const f32x4 xv = *(const f32x4*)(X + off + bj * 128 + n * 16); *(f32x4*)(R + off + bj * 128 + n * 16) = xv * DN_ALPHA + acc[ai][bj][m][n]; } }
        return false;
    }
};
struct EpiGateUp {
    static constexpr bool PERM = true;
    bf16_t* HID;
    __device__ __forceinline__ bool operator()(f32x4 (&acc)[2][2][4][2], const Unit& u, int wr, int wc, int fr, int fq) const {
        const int row0 = u.row0 + wr * 64 + fr, col0 = u.col0 + wc * 32 + 8 * fq;
#pragma unroll
        for (int ai = 0; ai < 2; ++ai)
#pragma unroll
            for (int m = 0; m < 4; ++m) { bf16_t* rowp = HID + (size_t)(row0 + ai * 128 + m * 16) * EXPERT_FF + col0;
                f32x4 g0 = acc[ai][0][m][0], g1 = acc[ai][0][m][1]; const f32x4 u0 = acc[ai][1][m][0], u1 = acc[ai][1][m][1];
#pragma unroll
                for (int j = 0; j < 4; ++j) { g0[j] = g0[j] * fsigmoid(g0[j]) * u0[j]; g1[j] = g1[j] * fsigmoid(g1[j]) * u1[j]; }
                u32x4 w; w.x = cvt_pk_bf16(g0[0], g0[1]); w.y = cvt_pk_bf16(g0[2], g0[3]); w.z = cvt_pk_bf16(g1[0], g1[1]); w.w = cvt_pk_bf16(g1[2], g1[3]);
                *(u32x4*)rowp = w; }
        return false;
    }
};
struct EpiDown {
    static constexpr bool PERM = true;
    bf16_t* Y;
    __device__ __forceinline__ bool operator()(f32x4 (&acc)[2][2][4][2], const Unit& u, int wr, int wc, int fr, int fq) const {
        const int row0 = u.row0 + wr * 64 + fr, col0 = u.col0 + wc * 32 + 8 * fq;
#pragma unroll
        for (int ai = 0; ai < 2; ++ai)
#pragma unroll
            for (int m = 0; m < 4; ++m) { bf16_t* rowp = Y + (size_t)(row0 + ai * 128 + m * 16) * D_MODEL + col0;
#pragma unroll
                for (int bj = 0; bj < 2; ++bj) { const f32x4 v0 = acc[ai][bj][m][0], v1 = acc[ai][bj][m][1];
                    u32x4 w; w.x = cvt_pk_bf16(v0[0], v0[1]); w.y = cvt_pk_bf16(v0[2], v0[3]); w.z = cvt_pk_bf16(v1[0], v1[1]); w.w = cvt_pk_bf16(v1[2], v1[3]);
                    *(u32x4*)(rowp + bj * 128) = w; } }
        return false;
    }
};

struct Args { const float* in[20]; float* out; unsigned char* ws; int ph_lo, ph_hi; };
typedef const __attribute__((address_space(4))) Args* CArgsP;
#define PHASE_ARGS() CArgsP ap = (CArgsP)__builtin_amdgcn_kernarg_segment_ptr(); asm volatile("" : "+s"(ap))
struct Frame {
    LAS unsigned char* lds;
    unsigned* ctl;
    unsigned char* ws;
    int G, bid;
};
#define PHASE_IDS() int tid = threadIdx.x; asm volatile("" : "+v"(tid)); const int lane = tid & 63, w = __builtin_amdgcn_readfirstlane(tid >> 6); (void)lane; (void)w

__device__ __forceinline__ int conv_src_col(int mode, int p) {
    if (mode == 1 && p >= C_AQ && p < C_AV) { const int hb = p & ~127, q = p & 127; return hb + (q >> 1) + 64 * (q & 1); }
    return p;
}
__device__ __forceinline__ int conv_dst_row(int mode, int n) {
    if (mode == 2) return (n >> 7) * 256 + (n & 127);
    if (mode == 3) return (n >> 7) * 256 + 128 + (n & 127);
    return n;
}
__device__ __forceinline__ void conv_item(const float* W, int K, int N, bf16_t* WT, int mode, LAS float* scr, int item, int lane) {
    const int nblk = N / 64, kb = item / nblk, nb = item % nblk, k0 = 64 * kb, n0 = 64 * nb;
    const int n4 = (lane & 15) * 4, kq = lane >> 4;
    if (mode == 1 && n0 >= C_AQ && n0 < C_AV) {
#pragma unroll 4
        for (int ii = 0; ii < 16; ++ii) { const int k = 4 * ii + kq; const float* src = W + (size_t)(k0 + k) * N;
#pragma unroll
            for (int j = 0; j < 4; ++j) scr[k * 65 + n4 + j] = src[conv_src_col(1, n0 + n4 + j)]; }
    } else {
#pragma unroll 8
        for (int ii = 0; ii < 16; ++ii) { const int k = 4 * ii + kq; const f32x4 v = *(const f32x4*)(W + (size_t)(k0 + k) * N + n0 + n4);
            scr[k * 65 + n4 + 0] = v[0]; scr[k * 65 + n4 + 1] = v[1]; scr[k * 65 + n4 + 2] = v[2]; scr[k * 65 + n4 + 3] = v[3]; }
    }
    LDS_WAIT(); asm volatile("" ::: "memory");
    const int c = lane & 7, nl = lane >> 3;
#pragma unroll
    for (int j = 0; j < 8; ++j) { const int n = nl + 8 * j; const LAS float* s = scr + (8 * c) * 65 + n;
        u32x4 o; o.x = pk2(s[0 * 65], s[1 * 65]); o.y = pk2(s[2 * 65], s[3 * 65]); o.z = pk2(s[4 * 65], s[5 * 65]); o.w = pk2(s[6 * 65], s[7 * 65]);
        *(u32x4*)(WT + (size_t)conv_dst_row(mode, n0 + n) * K + k0 + 8 * c) = o; }
    LDS_WAIT(); asm volatile("" ::: "memory");
}
__device__ __forceinline__ void p0_convert(Frame& F, int layer) {
    PHASE_IDS(); PHASE_ARGS();
    LAS float* scr = (LAS float*)(F.lds + w * 16640);
    const int gw = F.bid * 8 + w, NGW = F.G * 8;
    unsigned char* ws = F.ws;
    const float* w_in = ap->in[2] + (size_t)layer * D_MODEL * IN_WIDTH;
    const float* w_hg = ap->in[5] + (size_t)layer * HG_WIDTH * D_MODEL;
    const float* w_att = ap->in[6] + (size_t)layer * ATT_OUT * D_MODEL;
    const float* w_out = ap->in[7] + (size_t)layer * D_MODEL * D_MODEL;
    const float* w_eg = ap->in[12] + (size_t)layer * N_EXPERTS * D_MODEL * EXPERT_FF;
    const float* w_eu = ap->in[13] + (size_t)layer * N_EXPERTS * D_MODEL * EXPERT_FF;
    const float* w_ed = ap->in[14] + (size_t)layer * N_EXPERTS * EXPERT_FF * D_MODEL;
    const float* w_sg = ap->in[15] + (size_t)layer * D_MODEL * EXPERT_FF;
    const float* w_su = ap->in[16] + (size_t)layer * D_MODEL * EXPERT_FF;
    const float* w_sd = ap->in[17] + (size_t)layer * EXPERT_FF * D_MODEL;
    constexpr int I_IN = (D_MODEL / 64) * (IN_WIDTH / 64), I_HG = (HG_WIDTH / 64) * (D_MODEL / 64), I_ATT = (ATT_OUT / 64) * (D_MODEL / 64), I_OUT = (D_MODEL / 64) * (D_MODEL / 64);
    constexpr int I_E = (D_MODEL / 64) * (EXPERT_FF / 64);
    constexpr int NITEMS = I_IN + I_HG + I_ATT + I_OUT + 3 * NEXP1 * I_E;
    for (int it = gw; it < NITEMS; it += NGW) {
        int r = it;
        if (r < I_IN) { conv_item(w_in, D_MODEL, IN_WIDTH, (bf16_t*)(ws + WS_WIN), 1, scr, r, lane); continue; } r -= I_IN;
        if (r < I_HG) { conv_item(w_hg, HG_WIDTH, D_MODEL, (bf16_t*)(ws + WS_WHG), 0, scr, r, lane); continue; } r -= I_HG;
        if (r < I_ATT) { conv_item(w_att, ATT_OUT, D_MODEL, (bf16_t*)(ws + WS_WATT), 0, scr, r, lane); continue; } r -= I_ATT;
        if (r < I_OUT) { conv_item(w_out, D_MODEL, D_MODEL, (bf16_t*)(ws + WS_WOUT), 0, scr, r, lane); continue; } r -= I_OUT;
        const int which = r / (NEXP1 * I_E); r -= which * (NEXP1 * I_E);
        const int e = r / I_E, ri = r % I_E;
        if (which == 0) { const float* src = (e < N_EXPERTS) ? w_eg + (size_t)e * D_MODEL * EXPERT_FF : w_sg;
            conv_item(src, D_MODEL, EXPERT_FF, (bf16_t*)(ws + WS_WGU) + (size_t)e * 1024 * D_MODEL, 2, scr, ri, lane); }
        else if (which == 1) { const float* src = (e < N_EXPERTS) ? w_eu + (size_t)e * D_MODEL * EXPERT_FF : w_su;
            conv_item(src, D_MODEL, EXPERT_FF, (bf16_t*)(ws + WS_WGU) + (size_t)e * 1024 * D_MODEL, 3, scr, ri, lane); }
        else { const float* src = (e < N_EXPERTS) ? w_ed + (size_t)e * EXPERT_FF * D_MODEL : w_sd;
            conv_item(src, EXPERT_FF, D_MODEL, (bf16_t*)(ws + WS_WDN) + (size_t)e * D_MODEL * EXPERT_FF, 0, scr, ri, lane); }
    }
    if (layer == 0) {
        const f32x4* x4 = (const f32x4*)ap->in[0]; u32x2* xb = (u32x2*)(ws + WS_XB);
        for (size_t i = (size_t)F.bid * 512 + tid; i < (size_t)T * D_MODEL / 4; i += (size_t)F.G * 512) { const f32x4 v = x4[i]; u32x2 o; o.x = pk2(v[0], v[1]); o.y = pk2(v[2], v[3]); xb[i] = o; }
        const int* pos = (const int*)ap->in[1]; f32x2* rt = (f32x2*)(ws + WS_ROPE);
        for (int i = F.bid * 512 + tid; i < T * 64; i += F.G * 512) { const int tk = i >> 6, fi = i & 63;
            const double inv = exp2(-(double)fi * (13.287712379549449 / 64.0));
            const double ang = (double)pos[tk] * inv; const double red = ang - rint(ang * 0.15915494309189535) * 6.283185307179586;
            const float rf = (float)red; rt[i] = (f32x2){cosf(rf), sinf(rf)}; }
        const float* lbl = ap->in[3]; float* lb = (float*)(ws + WS_LB);
        for (int c = F.bid * 512 + tid; c < HG_WIDTH; c += F.G * 512) {
            float mx = -1e30f; for (int l = 0; l < DEPTH; ++l) mx = fmaxf(mx, lbl[l * HG_WIDTH + c]);
            float den = 0.f; for (int l = 0; l < DEPTH; ++l) den += expf(lbl[l * HG_WIDTH + c] - mx);
            float cum = 0.f, c0 = 0.f; for (int l = 0; l < DEPTH; ++l) { cum += expf(lbl[l * HG_WIDTH + c] - mx) / den; if (l == 0) c0 = cum; lb[l * HG_WIDTH + c] = cum - c0; }
        }
    }
}

constexpr int TROW = 272;
__device__ __forceinline__ void h1_item(Frame& F, int chunk) {
    const bf16_t* H = (const bf16_t*)(F.ws + WS_H); const float* LF = (const float*)(F.ws + WS_LF);
    float* UT = (float*)(F.ws + WS_UT); float* DEC = (float*)(F.ws + WS_DEC);
    const int bh = chunk >> 5, n = chunk & 31, b = bh >> 3, head = bh & 7, tok0 = b * SEQ + n * 64;
    LAS unsigned char* KT = F.lds; LAS unsigned char* VT = F.lds + 17408; LAS float* TOT = (LAS float*)(F.lds + 34816);
    PHASE_IDS();
    const int kk = tid & 127, part = tid >> 7, g = lane >> 4, i = lane & 15;
    float lf[16], cum[16];
    { const float* p = LF + (size_t)(tok0 + part * 16) * HG_WIDTH + head * 128 + kk;
#pragma unroll
      for (int j = 0; j < 16; ++j) lf[j] = p[(size_t)j * HG_WIDTH]; }
#pragma unroll
    for (int j = 0; j < 2; ++j) { const int c = tid + 512 * j, row = c >> 4, ch = c & 15;
        const u32x4 v = *(const u32x4*)(H + (size_t)(tok0 + row) * IN_WIDTH + C_HI + head * 128 + ch * 8);
        *(LAS u32x4*)(VT + row * TROW + ch * 16) = v; }
    float run = 0.f;
#pragma unroll
    for (int j = 0; j < 16; ++j) { run += lf[j]; cum[j] = run; }
    TOT[part * 128 + kk] = run;
    __syncthreads();
    float off = 0.f, end = 0.f;
#pragma unroll
    for (int p = 0; p < 4; ++p) { const float t = TOT[p * 128 + kk]; if (p < part) off += t; end += t; }
#pragma unroll
    for (int j = 0; j < 16; ++j) { const float c = cum[j] + off; const float kt = -expm1f(lf[j]) * __expf(end - c);
        *(LAS unsigned short*)(KT + (part * 16 + j) * TROW + kk * 2) = (unsigned short)f2bf(kt); }
    if (part == 0) DEC[(size_t)chunk * 128 + kk] = __expf(end);
    __syncthreads();
    const unsigned ktb = (unsigned)(size_t)KT, vtb = (unsigned)(size_t)VT;
    const int q = i >> 2, p4 = i & 3;
    bf16x8 af[2];
#pragma unroll
    for (int ks = 0; ks < 2; ++ks) { const s16x4 lo = tr_read(ktb + (32 * ks + 8 * g + q) * TROW + (16 * w + 4 * p4) * 2), hi = tr_read(ktb + (32 * ks + 8 * g + 4 + q) * TROW + (16 * w + 4 * p4) * 2);
        af[ks] = (bf16x8){lo[0], lo[1], lo[2], lo[3], hi[0], hi[1], hi[2], hi[3]}; }
#pragma unroll
    for (int vb = 0; vb < 8; ++vb) { f32x4 acc = {0.f, 0.f, 0.f, 0.f};
#pragma unroll
        for (int ks = 0; ks < 2; ++ks) { const s16x4 lo = tr_read(vtb + (32 * ks + 8 * g + q) * TROW + (16 * vb + 4 * p4) * 2), hi = tr_read(vtb + (32 * ks + 8 * g + 4 + q) * TROW + (16 * vb + 4 * p4) * 2);
            const bf16x8 bfr = (bf16x8){lo[0], lo[1], lo[2], lo[3], hi[0], hi[1], hi[2], hi[3]};
            acc = mfma16(af[ks], bfr, acc); }
        *(f32x4*)(UT + (size_t)chunk * 16384 + (16 * vb + i) * 128 + 16 * w + 4 * g) = acc; }
    __syncthreads();
}

__device__ __forceinline__ void attn_item(Frame& F, int it) {
    bf16_t* H = (bf16_t*)(F.ws + WS_H); float* LSE = (float*)(F.ws + WS_LSE);
    const int b = it / 192, rem = it % 192, h = rem >> 4, j = rem & 15, grp = h >> 2, dsh = 2 * grp, d = 1 << dsh, r = j & (d - 1), qb = j >> dsh;
    const int lbase = 128 * (qb - 1);
    bf16_t* Hb = H + (size_t)b * SEQ * IN_WIDTH;
    LAS unsigned char* KT = F.lds; LAS unsigned char* VT = F.lds + 256 * TROW;
    PHASE_IDS();
    const int g = lane >> 4, i = lane & 15;
#pragma unroll
    for (int jj = 0; jj < 8; ++jj) { const int c = tid + 512 * jj, row = c >> 4, ch = c & 15; int l = lbase + row; l = l < 0 ? 0 : l; const size_t tok = (size_t)(l * d + r);
        const u32x4 kv = *(const u32x4*)(Hb + tok * IN_WIDTH + C_AK + h * 128 + ch * 8), vv = *(const u32x4*)(Hb + tok * IN_WIDTH + C_AV + h * 128 + ch * 8);
        *(LAS u32x4*)(KT + row * TROW + ch * 16) = kv; *(LAS u32x4*)(VT + row * TROW + ch * 16) = vv; }
    const size_t tokq = (size_t)((128 * qb + 16 * w + i) * d + r);
    bf16x8 qf[4];
#pragma unroll
    for (int ks = 0; ks < 4; ++ks) qf[ks] = *(const bf16x8*)(Hb + tokq * IN_WIDTH + C_AQ + h * 128 + 32 * ks + 8 * g);
    __syncthreads();
    f32x4 s[9];
#pragma unroll
    for (int jb = 0; jb < 9; ++jb) { f32x4 a4 = {0.f, 0.f, 0.f, 0.f};
#pragma unroll
        for (int ks = 0; ks < 4; ++ks) { const bf16x8 a = *(const LAS bf16x8*)(KT + (16 * (w + jb) + i) * TROW + (32 * ks + 8 * g) * 2); a4 = mfma16(a, qf[ks], a4); }
        s[jb] = a4; }
    float mx = -1e30f;
#pragma unroll
    for (int jb = 0; jb < 9; ++jb)
#pragma unroll
        for (int rg = 0; rg < 4; ++rg) { const int kin = 4 * g + rg, dist = 128 - 16 * jb + i - kin, lk = lbase + 16 * (w + jb) + kin;
            const bool valid = ((unsigned)dist <= 128u) && (lk >= 0);
            const float v = valid ? s[jb][rg] : -INFINITY; s[jb][rg] = v; mx = fmaxf(mx, v); }
    mx = fmaxf(mx, __shfl_xor(mx, 16)); mx = fmaxf(mx, __shfl_xor(mx, 32));
    float den = 0.f;
#pragma unroll
    for (int jb = 0; jb < 9; ++jb)
#pragma unroll
        for (int rg = 0; rg < 4; ++rg) { const float p = __expf(s[jb][rg] - mx); s[jb][rg] = p; den += p; }
    den += __shfl_xor(den, 16); den += __shfl_xor(den, 32);
    f32x4 o[8];
#pragma unroll
    for (int db = 0; db < 8; ++db) o[db] = (f32x4){0.f, 0.f, 0.f, 0.f};
    const unsigned vtb = (unsigned)(size_t)VT; const int q = i >> 2, p4 = i & 3;
#pragma unroll
    for (int kp = 0; kp < 5; ++kp) {
        bf16x8 pb; { const unsigned a0 = cvt_pk_bf16(s[2 * kp][0], s[2 * kp][1]), a1 = cvt_pk_bf16(s[2 * kp][2], s[2 * kp][3]);
            unsigned b0 = 0u, b1 = 0u; if (kp < 4) { b0 = cvt_pk_bf16(s[2 * kp + 1][0], s[2 * kp + 1][1]); b1 = cvt_pk_bf16(s[2 * kp + 1][2], s[2 * kp + 1][3]); }
            const u32x4 t4 = {a0, a1, b0, b1}; pb = __builtin_bit_cast(bf16x8, t4); }
        const int r0 = 16 * (w + 2 * kp) + 4 * g + q, r1 = (kp < 4) ? r0 + 16 : r0;
#pragma unroll
        for (int db = 0; db < 8; ++db) { const s16x4 lo = tr_read(vtb + r0 * TROW + (16 * db + 4 * p4) * 2), hi = tr_read(vtb + r1 * TROW + (16 * db + 4 * p4) * 2);
            const bf16x8 a = (bf16x8){lo[0], lo[1], lo[2], lo[3], hi[0], hi[1], hi[2], hi[3]};
            o[db] = mfma16(a, pb, o[db]); }
    }
    const float rden = __fdividef(1.0f, den);
#pragma unroll
    for (int db = 0; db < 8; ++db) { u32x2 wv; wv.x = cvt_pk_bf16(o[db][0] * rden, o[db][1] * rden); wv.y = cvt_pk_bf16(o[db][2] * rden, o[db][3] * rden);
        *(u32x2*)(Hb + tokq * IN_WIDTH + C_AQ + h * 128 + 16 * db + 4 * g) = wv; }
    if (g == 0) LSE[((size_t)b * SEQ + tokq) * ATT_HEADS + h] = mx + __logf(den);
    __syncthreads();
}

__device__ __forceinline__ void scan_item(Frame& F, int item) {
    const float* UT = (const float*)(F.ws + WS_UT); const float* DEC = (const float*)(F.ws + WS_DEC); bf16_t* SPT = (bf16_t*)(F.ws + WS_SPT);
    PHASE_IDS();
    const int bh = item >> 2, q4 = item & 3, vv = q4 * 32 + (tid >> 4), kk0 = (tid & 15) * 8;
    f32x4 s0 = {0.f, 0.f, 0.f, 0.f}, s1 = {0.f, 0.f, 0.f, 0.f};
#pragma unroll 4
    for (int n = 0; n < 32; ++n) { const size_t chunk = (size_t)bh * 32 + n; const size_t eo = chunk * 16384 + (size_t)vv * 128 + kk0;
        const f32x4 u0 = *(const f32x4*)(UT + eo), u1 = *(const f32x4*)(UT + eo + 4), d0 = *(const f32x4*)(DEC + chunk * 128 + kk0), d1 = *(const f32x4*)(DEC + chunk * 128 + kk0 + 4);
        u32x4 wv; wv.x = cvt_pk_bf16(s0[0], s0[1]); wv.y = cvt_pk_bf16(s0[2], s0[3]); wv.z = cvt_pk_bf16(s1[0], s1[1]); wv.w = cvt_pk_bf16(s1[2], s1[3]);
        *(u32x4*)(SPT + eo) = wv;
        s0 = d0 * s0 + u0; s1 = d1 * s1 + u1; }
}
__device__ __forceinline__ void attn_merge(Frame& F) {
    const bf16_t* H = (const bf16_t*)(F.ws + WS_H); const float* LSE = (const float*)(F.ws + WS_LSE); bf16_t* ATTO = (bf16_t*)(F.ws + WS_ATTO);
    PHASE_IDS();
    const int gw = F.bid * 8 + w, NGW = F.G * 8, hg = lane >> 4, d0 = (lane & 15) * 8;
    for (int t = gw; t < T; t += NGW) {
        const float l0 = LSE[(size_t)t * ATT_HEADS + hg], l1 = LSE[(size_t)t * ATT_HEADS + 4 + hg], l2 = LSE[(size_t)t * ATT_HEADS + 8 + hg];
        const float mx = fmaxf(l0, fmaxf(l1, l2)); float w0 = __expf(l0 - mx), w1 = __expf(l1 - mx), w2 = __expf(l2 - mx); const float rs = __fdividef(1.0f, w0 + w1 + w2); w0 *= rs; w1 *= rs; w2 *= rs;
        const bf16_t* base = H + (size_t)t * IN_WIDTH + C_AQ + hg * 128 + d0;
        const u32x4 a = *(const u32x4*)base, bq = *(const u32x4*)(base + 512), c = *(const u32x4*)(base + 1024);
        u32x4 wv;
        wv.x = cvt_pk_bf16(w0 * bflo(a.x) + w1 * bflo(bq.x) + w2 * bflo(c.x), w0 * bfhi(a.x) + w1 * bfhi(bq.x) + w2 * bfhi(c.x));
        wv.y = cvt_pk_bf16(w0 * bflo(a.y) + w1 * bflo(bq.y) + w2 * bflo(c.y), w0 * bfhi(a.y) + w1 * bfhi(bq.y) + w2 * bfhi(c.y));
        wv.z = cvt_pk_bf16(w0 * bflo(a.z) + w1 * bflo(bq.z) + w2 * bflo(c.z), w0 * bfhi(a.z) + w1 * bfhi(bq.z) + w2 * bfhi(c.z));
        wv.w = cvt_pk_bf16(w0 * bflo(a.w) + w1 * bflo(bq.w) + w2 * bflo(c.w), w0 * bfhi(a.w) + w1 * bfhi(bq.w) + w2 * bfhi(c.w));
        *(u32x4*)(ATTO + (size_t)t * ATT_OUT + hg * 128 + d0) = wv;
    }
}

__device__ __forceinline__ void h3_item(Frame& F, int chunk, const float* normg) {
    const bf16_t* H = (const bf16_t*)(F.ws + WS_H); const float* LF = (const float*)(F.ws + WS_LF); const bf16_t* SPT = (const bf16_t*)(F.ws + WS_SPT); bf16_t* HGO = (bf16_t*)(F.ws + WS_HGO);
    const int bh = chunk >> 5, n = chunk & 31, b = bh >> 3, head = bh & 7, tok0 = b * SEQ + n * 64;
    LAS unsigned char* QT = F.lds; LAS unsigned char* QH = F.lds + 17408; LAS unsigned char* KH = F.lds + 34816; LAS unsigned char* VT = F.lds + 52224; LAS unsigned char* SP = F.lds + 69632;
    LAS float* TOT = (LAS float*)(F.lds + 104448); LAS float* RS = (LAS float*)(F.lds + 106496);
    PHASE_IDS();
    const int kk = tid & 127, part = tid >> 7, g = lane >> 4, i = lane & 15;
    float lf[16], cum[16], qv[16];
    { const float* p = LF + (size_t)(tok0 + part * 16) * HG_WIDTH + head * 128 + kk; const bf16_t* pq = H + (size_t)(tok0 + part * 16) * IN_WIDTH + C_HQ + head * 128 + kk;
#pragma unroll
      for (int j = 0; j < 16; ++j) { lf[j] = p[(size_t)j * HG_WIDTH]; qv[j] = bf2f(pq[(size_t)j * IN_WIDTH]); } }
#pragma unroll
    for (int j = 0; j < 2; ++j) { const int c = tid + 512 * j, row = c >> 4, ch = c & 15;
        const u32x4 v = *(const u32x4*)(H + (size_t)(tok0 + row) * IN_WIDTH + C_HI + head * 128 + ch * 8);
        *(LAS u32x4*)(VT + row * TROW + ch * 16) = v; }
#pragma unroll
    for (int j = 0; j < 4; ++j) { const int c = tid + 512 * j, row = c >> 4, ch = c & 15;
        const u32x4 v = *(const u32x4*)(SPT + (size_t)chunk * 16384 + row * 128 + ch * 8);
        *(LAS u32x4*)(SP + row * TROW + ch * 16) = v; }
    float run = 0.f;
#pragma unroll
    for (int j = 0; j < 16; ++j) { run += lf[j]; cum[j] = run; }
    TOT[part * 128 + kk] = run;
    __syncthreads();
    float off = 0.f;
#pragma unroll
    for (int p = 0; p < 4; ++p) { const float t = TOT[p * 128 + kk]; if (p < part) off += t; }
    const float cmid = TOT[kk] + TOT[128 + kk];
#pragma unroll
    for (int j = 0; j < 16; ++j) { const float c = cum[j] + off; const int t = part * 16 + j; const float kq = -expm1f(lf[j]);
        *(LAS unsigned short*)(QT + t * TROW + kk * 2) = (unsigned short)f2bf(qv[j] * __expf(c));
        *(LAS unsigned short*)(QH + t * TROW + kk * 2) = (unsigned short)f2bf(qv[j] * __expf(fminf(c - cmid, 60.f)));
        *(LAS unsigned short*)(KH + t * TROW + kk * 2) = (unsigned short)f2bf(kq * __expf(fminf(cmid - c, 60.f))); }
    __syncthreads();
    const int tb = w & 3, vh = w >> 2;
    f32x4 at[4];
#pragma unroll
    for (int sb = 0; sb < 4; ++sb) { f32x4 a4 = {0.f, 0.f, 0.f, 0.f};
        if (sb <= tb) {
#pragma unroll
            for (int ks = 0; ks < 4; ++ks) { const bf16x8 a = *(const LAS bf16x8*)(KH + (16 * sb + i) * TROW + (32 * ks + 8 * g) * 2), bq = *(const LAS bf16x8*)(QH + (16 * tb + i) * TROW + (32 * ks + 8 * g) * 2);
                a4 = mfma16(a, bq, a4); }
            if (sb == tb) {
#pragma unroll
                for (int rg = 0; rg < 4; ++rg) a4[rg] = (4 * g + rg <= i) ? a4[rg] : 0.f; }
        }
        at[sb] = a4; }
    bf16x8 pb[2];
#pragma unroll
    for (int kp = 0; kp < 2; ++kp) { const u32x4 t4 = {cvt_pk_bf16(at[2 * kp][0], at[2 * kp][1]), cvt_pk_bf16(at[2 * kp][2], at[2 * kp][3]), cvt_pk_bf16(at[2 * kp + 1][0], at[2 * kp + 1][1]), cvt_pk_bf16(at[2 * kp + 1][2], at[2 * kp + 1][3])};
        pb[kp] = __builtin_bit_cast(bf16x8, t4); }
    const unsigned vtb = (unsigned)(size_t)VT; const int q = i >> 2, p4 = i & 3;
    f32x4 o[4]; float ss = 0.f;
#pragma unroll
    for (int vb = 0; vb < 4; ++vb) { const int vblk = 4 * vh + vb; f32x4 acc = {0.f, 0.f, 0.f, 0.f};
#pragma unroll
        for (int ks = 0; ks < 4; ++ks) { const bf16x8 a = *(const LAS bf16x8*)(SP + (16 * vblk + i) * TROW + (32 * ks + 8 * g) * 2), bq = *(const LAS bf16x8*)(QT + (16 * tb + i) * TROW + (32 * ks + 8 * g) * 2);
            acc = mfma16(a, bq, acc); }
#pragma unroll
        for (int kp = 0; kp < 2; ++kp) { const s16x4 lo = tr_read(vtb + (32 * kp + 4 * g + q) * TROW + (16 * vblk + 4 * p4) * 2), hi = tr_read(vtb + (32 * kp + 16 + 4 * g + q) * TROW + (16 * vblk + 4 * p4) * 2);
            const bf16x8 a = (bf16x8){lo[0], lo[1], lo[2], lo[3], hi[0], hi[1], hi[2], hi[3]};
            acc = mfma16(a, pb[kp], acc); }
        o[vb] = acc; ss += (acc[0] * acc[0] + acc[1] * acc[1]) + (acc[2] * acc[2] + acc[3] * acc[3]); }
    ss += __shfl_xor(ss, 16); ss += __shfl_xor(ss, 32);
    if (g == 0) RS[vh * 64 + 16 * tb + i] = ss;
    __syncthreads();
    const float tot = RS[16 * tb + i] + RS[64 + 16 * tb + i];
    const float rinv = rsqrtf(tot * (1.0f / 128.0f) + NORM_EPS);
    const size_t tok = (size_t)(tok0 + 16 * tb + i);
#pragma unroll
    for (int vb = 0; vb < 4; ++vb) { const int vv = 16 * (4 * vh + vb) + 4 * g;
        const f32x4 ng = *(const f32x4*)(normg + head * 128 + vv); const u32x2 gt = *(const u32x2*)(H + tok * IN_WIDTH + C_HGATE + head * 128 + vv);
        u32x2 wv; wv.x = cvt_pk_bf16(o[vb][0] * rinv * ng[0] * bflo(gt.x), o[vb][1] * rinv * ng[1] * bfhi(gt.x)); wv.y = cvt_pk_bf16(o[vb][2] * rinv * ng[2] * bflo(gt.y), o[vb][3] * rinv * ng[3] * bfhi(gt.y));
        *(u32x2*)(HGO + tok * HG_WIDTH + head * 128 + vv) = wv; }
    __syncthreads();
}

__device__ __forceinline__ void ln_router_phase(Frame& F, int layer) {
    PHASE_ARGS();
    const float* R = (const float*)(F.ws + WS_R); float* X1 = (float*)(F.ws + WS_X1); bf16_t* X1B = (bf16_t*)(F.ws + WS_X1B);
    const float* g1 = ap->in[8] + (size_t)layer * D_MODEL; const float* b1 = ap->in[9] + (size_t)layer * D_MODEL;
    const float* wrt = ap->in[10] + (size_t)layer * D_MODEL * N_EXPERTS; const float* rbias = ap->in[11] + (size_t)layer * N_EXPERTS;
    int* PE = (int*)(F.ws + WS_PE); int* PP = (int*)(F.ws + WS_PP); float* PG = (float*)(F.ws + WS_PG); int* RM = (int*)(F.ws + WS_RM);
    unsigned* cnt = F.ctl + CW_CNT + layer * 64;
    constexpr int XSLD = 1028;
    LAS float* XS = (LAS float*)F.lds; LAS float* PART = (LAS float*)(F.lds + 16 * XSLD * 4); LAS float* LG = (LAS float*)(F.lds + 16 * XSLD * 4 + 32768);
    PHASE_IDS();
    const int g = lane >> 4, i = lane & 15;
    for (int tile = F.bid; tile < T / 16; tile += F.G) {
        const int tok0 = tile * 16;
        f32x4 ys[2][8];
#pragma unroll
        for (int tt = 0; tt < 2; ++tt) { const size_t token = (size_t)(tok0 + 2 * w + tt);
            const f32x4* rp = (const f32x4*)(R + token * D_MODEL) + lane; float s = 0.f;
#pragma unroll
            for (int j = 0; j < 8; ++j) { ys[tt][j] = rp[64 * j]; s += (ys[tt][j][0] + ys[tt][j][1]) + (ys[tt][j][2] + ys[tt][j][3]); }
            const float mean = wave_sum(s) * (1.0f / D_MODEL); float s2 = 0.f;
#pragma unroll
            for (int j = 0; j < 8; ++j) { ys[tt][j] = ys[tt][j] - mean; s2 += (ys[tt][j][0] * ys[tt][j][0] + ys[tt][j][1] * ys[tt][j][1]) + (ys[tt][j][2] * ys[tt][j][2] + ys[tt][j][3] * ys[tt][j][3]); }
            const float rstd = rsqrtf(wave_sum(s2) * (1.0f / D_MODEL) + LN_EPS);
#pragma unroll
            for (int j = 0; j < 8; ++j) { const f32x4 gg = *((const f32x4*)g1 + lane + 64 * j), bb = *((const f32x4*)b1 + lane + 64 * j);
                const f32x4 y = ys[tt][j] * rstd * gg + bb; ys[tt][j] = y;
                *((f32x4*)(X1 + token * D_MODEL) + lane + 64 * j) = y;
                u32x2 o; o.x = cvt_pk_bf16(y[0], y[1]); o.y = cvt_pk_bf16(y[2], y[3]); *((u32x2*)(X1B + token * D_MODEL) + lane + 64 * j) = o; }
        }
        f32x4 dacc[4];
#pragma unroll
        for (int nb = 0; nb < 4; ++nb) dacc[nb] = (f32x4){0.f, 0.f, 0.f, 0.f};
#pragma unroll
        for (int half = 0; half < 2; ++half) {
#pragma unroll
            for (int tt = 0; tt < 2; ++tt)
#pragma unroll
                for (int j = 0; j < 4; ++j) *(LAS f32x4*)(XS + (2 * w + tt) * XSLD + 4 * lane + 256 * j) = ys[tt][4 * half + j];
            __syncthreads();
#pragma unroll 2
            for (int kg = 0; kg < 8; ++kg) { const int kb = 128 * w + 16 * kg; const f32x4 a4 = *(const LAS f32x4*)(XS + i * XSLD + kb + 4 * g);
#pragma unroll
                for (int s = 0; s < 4; ++s) { const f32x4 b4 = *(const f32x4*)(wrt + (size_t)(half * 1024 + kb + 4 * g + s) * N_EXPERTS + 4 * i);
#pragma unroll
                    for (int nb = 0; nb < 4; ++nb) dacc[nb] = __builtin_amdgcn_mfma_f32_16x16x4f32(a4[s], b4[nb], dacc[nb], 0, 0, 0); } }
            __syncthreads();
        }
#pragma unroll
        for (int rg = 0; rg < 4; ++rg) *(LAS f32x4*)(PART + ((w * 16 + 4 * g + rg) * 64 + 4 * i)) = (f32x4){dacc[0][rg], dacc[1][rg], dacc[2][rg], dacc[3][rg]};
        __syncthreads();
        { const int tk = tid >> 5, e2 = (tid & 31) * 2; float a = 0.f, b = 0.f;
#pragma unroll
          for (int ww = 0; ww < 8; ++ww) { a += PART[(ww * 16 + tk) * 64 + e2]; b += PART[(ww * 16 + tk) * 64 + e2 + 1]; }
          LG[tk * 64 + e2] = a; LG[tk * 64 + e2 + 1] = b; }
        if (tid < 16) RM[(size_t)N_EXPERTS * T + tok0 + tid] = tok0 + tid;
        __syncthreads();
#pragma unroll 1
        for (int tt = 0; tt < 2; ++tt) { const int tk = 2 * w + tt, token = tok0 + tk, e = lane;
            const float sc = 1.0f / (1.0f + expf(-LG[tk * 64 + e])); const float sel = sc + rbias[e];
            float m1 = sel; m1 = fmaxf(m1, __shfl_xor(m1, 1)); m1 = fmaxf(m1, __shfl_xor(m1, 2)); m1 = fmaxf(m1, __shfl_xor(m1, 4));
            const unsigned long long bal = __ballot(sel == m1) & (0xFFull << (8 * (e >> 3)));
            const int first = __builtin_ctzll(bal);
            float v2 = (e == first) ? -INFINITY : sel; v2 = fmaxf(v2, __shfl_xor(v2, 1)); v2 = fmaxf(v2, __shfl_xor(v2, 2)); v2 = fmaxf(v2, __shfl_xor(v2, 4));
            const float gs = m1 + v2; int grank = 0;
#pragma unroll
            for (int gp = 0; gp < 8; ++gp) { const float o = __builtin_bit_cast(float, __builtin_amdgcn_readlane(__builtin_bit_cast(int, gs), 8 * gp)); grank += (o > gs || (o == gs && gp < (e >> 3))) ? 1 : 0; }
            const float sel2 = (grank < TOPK_GROUPS) ? sel : -INFINITY; int rank = 0;
#pragma unroll
            for (int ep = 0; ep < 64; ++ep) { const float o = __builtin_bit_cast(float, __builtin_amdgcn_readlane(__builtin_bit_cast(int, sel2), ep)); rank += (o > sel2 || (o == sel2 && ep < e)) ? 1 : 0; }
            const bool chosen = rank < TOP_K;
            const float wsum = wave_sum(chosen ? sc : 0.f);
            if (chosen) { const int pos = (int)atomicAdd(cnt + e, 1u);
                PE[(size_t)token * 8 + rank] = e; PP[(size_t)token * 8 + rank] = pos; PG[(size_t)token * 8 + rank] = sc / wsum * ROUTED_SCALE; RM[(size_t)e * T + pos] = token; }
        }
        __syncthreads();
    }
}

__device__ __forceinline__ void build_toff(Frame& F, int layer) {
    LAS int* toff = (LAS int*)(F.lds + LDS_TAB);
    if (threadIdx.x == 0) { const unsigned* cnt = F.ctl + CW_CNT + layer * 64; int acc = 0;
        for (int e = 0; e < N_EXPERTS; ++e) { toff[e] = acc; acc += ((int)__hip_atomic_load(cnt + e, RLX_AGENT) + 255) >> 8; }
        toff[N_EXPERTS] = acc; toff[NEXP1] = acc + T / 256; }
    __syncthreads();
}

__device__ __forceinline__ void combine_ln2_phase(Frame& F, int layer) {
    PHASE_ARGS(); float* OUT = ap->out;
    const bf16_t* Y = (const bf16_t*)(F.ws + WS_Y); const float* X1 = (const float*)(F.ws + WS_X1); bf16_t* XB = (bf16_t*)(F.ws + WS_XB);
    const float* g2 = ap->in[18] + (size_t)layer * D_MODEL; const float* b2 = ap->in[19] + (size_t)layer * D_MODEL;
    const int* PE = (const int*)(F.ws + WS_PE); const int* PP = (const int*)(F.ws + WS_PP); const float* PG = (const float*)(F.ws + WS_PG);
    const LAS int* toff = (const LAS int*)(F.lds + LDS_TAB);
    PHASE_IDS();
    const int gw = F.bid * 8 + w, NGW = F.G * 8;
    for (int t = gw; t < T; t += NGW) {
        f32x4 a[4][2];
#pragma unroll
        for (int j = 0; j < 4; ++j) { a[j][0] = (f32x4){0.f, 0.f, 0.f, 0.f}; a[j][1] = (f32x4){0.f, 0.f, 0.f, 0.f}; }
#pragma unroll
        for (int k = 0; k < 9; ++k) { size_t row; float gt;
            if (k < 8) { const int e = PE[(size_t)t * 8 + k]; row = (size_t)toff[e] * 256 + PP[(size_t)t * 8 + k]; gt = PG[(size_t)t * 8 + k]; }
            else { row = (size_t)toff[N_EXPERTS] * 256 + t; gt = 1.0f; }
            const u32x4* yp = (const u32x4*)(Y + row * D_MODEL) + lane;
#pragma unroll
            for (int j = 0; j < 4; ++j) { const u32x4 y = yp[64 * j];
                a[j][0] += (f32x4){bflo(y.x), bfhi(y.x), bflo(y.y), bfhi(y.y)} * gt; a[j][1] += (f32x4){bflo(y.z), bfhi(y.z), bflo(y.w), bfhi(y.w)} * gt; } }
        float s = 0.f;
#pragma unroll
        for (int j = 0; j < 4; ++j) { const f32x4* xp = (const f32x4*)(X1 + (size_t)t * D_MODEL + 8 * lane + 512 * j);
            a[j][0] += xp[0] * DN_ALPHA; a[j][1] += xp[1] * DN_ALPHA;
            s += (a[j][0][0] + a[j][0][1]) + (a[j][0][2] + a[j][0][3]) + (a[j][1][0] + a[j][1][1]) + (a[j][1][2] + a[j][1][3]); }
        const float mean = wave_sum(s) * (1.0f / D_MODEL); float s2 = 0.f;
#pragma unroll
        for (int j = 0; j < 4; ++j) { a[j][0] = a[j][0] - mean; a[j][1] = a[j][1] - mean;
            s2 += (a[j][0][0] * a[j][0][0] + a[j][0][1] * a[j][0][1]) + (a[j][0][2] * a[j][0][2] + a[j][0][3] * a[j][0][3]) + (a[j][1][0] * a[j][1][0] + a[j][1][1] * a[j][1][1]) + (a[j][1][2] * a[j][1][2] + a[j][1][3] * a[j][1][3]); }
        const float rstd = rsqrtf(wave_sum(s2) * (1.0f / D_MODEL) + LN_EPS);
#pragma unroll
        for (int j = 0; j < 4; ++j) { const int c = 8 * lane + 512 * j;
            const f32x4 o0 = a[j][0] * rstd * *(const f32x4*)(g2 + c) + *(const f32x4*)(b2 + c), o1 = a[j][1] * rstd * *(const f32x4*)(g2 + c + 4) + *(const f32x4*)(b2 + c + 4);
            *(f32x4*)(OUT + (size_t)t * D_MODEL + c) = o0; *(f32x4*)(OUT + (size_t)t * D_MODEL + c + 4) = o1;
            u32x4 wv; wv.x = cvt_pk_bf16(o0[0], o0[1]); wv.y = cvt_pk_bf16(o0[2], o0[3]); wv.z = cvt_pk_bf16(o1[0], o1[1]); wv.w = cvt_pk_bf16(o1[2], o1[3]);
            *(u32x4*)(XB + (size_t)t * D_MODEL + c) = wv; }
    }
}

constexpr int PH_PER_LAYER = 11, N_PHASES = DEPTH * PH_PER_LAYER;
#ifndef PH_MASK
#define PH_MASK 0x7ff
#endif
#define IN(k) (((PH_MASK >> ((k) % PH_PER_LAYER)) & 1) && lo <= (k) && (k) < hi)
#define SEAM(k) do { if (IN(k) && IN((k) + 1)) xcd_barrier(bar); } while (0)
#define PHASE_FRAME() Frame F = F0; asm volatile("" : "+s"(F.ws), "+s"(F.ctl), "+s"(F.G), "+s"(F.bid), "+s"(F.lds)); unsigned char* ws = F.ws; (void)ws
template <int layer>
__device__ __forceinline__ void run_layer(const Frame& F0, const XcdBarrier& bar, const int lo, const int hi) {
        const int pb = layer * PH_PER_LAYER;
        if (IN(pb + 0)) { PHASE_FRAME(); p0_convert(F, layer); }
        SEAM(pb + 0);
        if (IN(pb + 1)) { PHASE_FRAME();
            DenseSched S{(const char*)(ws + WS_XB), (const char*)(ws + WS_WIN), D_MODEL * 2, D_MODEL * 2, D_MODEL / 64, T / 256, IN_WIDTH / 256, F.G, F.bid};
            EpiIn E{(bf16_t*)(ws + WS_H), (float*)(ws + WS_LF), (const float*)(ws + WS_LB) + layer * HG_WIDTH, (const f32x4*)(ws + WS_ROPE)};
            pg8::gemm_phase<EpiIn, DenseSched, false>(F.lds, S, E);
        }
        SEAM(pb + 1);
        if (IN(pb + 2)) { PHASE_FRAME();
            for (int it = F.bid; it < NCHUNK * HG_HEADS; it += F.G) h1_item(F, it);
            for (int it = F.bid; it < BATCH * ATT_HEADS * 16; it += F.G) attn_item(F, it);
        }
        SEAM(pb + 2);
        if (IN(pb + 3)) { PHASE_FRAME();
            for (int it = F.bid; it < BATCH * HG_HEADS * 4; it += F.G) scan_item(F, it);
            attn_merge(F);
        }
        SEAM(pb + 3);
        if (IN(pb + 4)) { PHASE_FRAME();
            PHASE_ARGS(); const float* normg = ap->in[4] + (size_t)layer * HG_WIDTH;
            for (int it = F.bid; it < NCHUNK * HG_HEADS; it += F.G) h3_item(F, it, normg);
        }
        SEAM(pb + 4);
        if (IN(pb + 5)) { PHASE_FRAME();
            MergeSched S{(const char*)(ws + WS_HGO), (const char*)(ws + WS_WHG), (const char*)(ws + WS_ATTO), (const char*)(ws + WS_WATT), T / 256, D_MODEL / 256, F.G, F.bid};
            EpiMerge E{(const bf16_t*)(ws + WS_H), (bf16_t*)(ws + WS_MRG)};
            pg8::gemm_phase<EpiMerge, MergeSched, false>(F.lds, S, E);
        }
        SEAM(pb + 5);
        if (IN(pb + 6)) { PHASE_FRAME();
            DenseSched S{(const char*)(ws + WS_MRG), (const char*)(ws + WS_WOUT), D_MODEL * 2, D_MODEL * 2, D_MODEL / 64, T / 256, D_MODEL / 256, F.G, F.bid};
            PHASE_ARGS(); EpiResid E{layer == 0 ? ap->in[0] : (const float*)ap->out, (float*)(ws + WS_R)};
            pg8::gemm_phase<EpiResid, DenseSched, false>(F.lds, S, E);
        }
        SEAM(pb + 6);
        if (IN(pb + 7)) { PHASE_FRAME(); ln_router_phase(F, layer); }
        SEAM(pb + 7);
        if (IN(pb + 8)) { PHASE_FRAME();
            build_toff(F, layer);
            MoeSched<4, true> S{(const LAS int*)(F.lds + LDS_TAB), F.ctl + CW_CNT + layer * 64, (const char*)(ws + WS_X1B), (const char*)(ws + WS_WGU), (const int*)(ws + WS_RM), F.G, F.bid};
            EpiGateUp E{(bf16_t*)(ws + WS_HID)};
            pg8::gemm_phase<EpiGateUp, MoeSched<4, true>, true>(F.lds, S, E);
        }
        SEAM(pb + 8);
        if (IN(pb + 9)) { PHASE_FRAME();
            build_toff(F, layer);
            MoeSched<8, false> S{(const LAS int*)(F.lds + LDS_TAB), F.ctl + CW_CNT + layer * 64, (const char*)(ws + WS_HID), (const char*)(ws + WS_WDN), nullptr, F.G, F.bid};
            EpiDown E{(bf16_t*)(ws + WS_Y)};
            pg8::gemm_phase<EpiDown, MoeSched<8, false>, false>(F.lds, S, E);
        }
        SEAM(pb + 9);
        if (IN(pb + 10)) { PHASE_FRAME(); build_toff(F, layer); combine_ln2_phase(F, layer); }
        SEAM(pb + 10);
}
#undef IN
#undef SEAM
__global__ void __launch_bounds__(512, 2) kfwd(Args args) {
    extern __shared__ __attribute__((aligned(16))) unsigned char lds_raw[];
    Frame F0;
    F0.lds = (LAS unsigned char*)lds_raw;
    F0.G = gridDim.x; F0.bid = blockIdx.x; F0.ws = args.ws; F0.ctl = (unsigned*)(args.ws + WS_CTL);
    for (int u = threadIdx.x; u < (LDS_BYTES - LDS_TAB) / 4; u += 512) ((LAS unsigned*)(F0.lds + LDS_TAB))[u] = 0u;
    __syncthreads();
    XcdBarrier bar = xcd_barrier_post(F0.ctl + CW_BAR, (volatile LAS unsigned*)(F0.lds + LDS_MISC));
    const int lo = args.ph_lo, hi = args.ph_hi;
    run_layer<0>(F0, bar, lo, hi);
    run_layer<1>(F0, bar, lo, hi);
}

extern "C" void kernel_launch(void* const* d_in, const int* in_sizes, int n_in, void* d_out, int out_size, void* d_ws, size_t ws_size, hipStream_t stream) {
    static int grid = 0;
    if (grid == 0) {
        if (n_in != 20 || out_size != T * D_MODEL || ws_size < WS_END) { fprintf(stderr, "kernel_launch: unexpected shapes (n_in %d, out %d, ws %zu < %zu)\n", n_in, out_size, ws_size, (size_t)WS_END); grid = -1; return; }
        int dev = 0, cus = 0, per_cu = 0;
        if (hipGetDevice(&dev) != hipSuccess || hipDeviceGetAttribute(&cus, hipDeviceAttributeMultiprocessorCount, dev) != hipSuccess) { grid = -1; return; }
        if (hipFuncSetAttribute((const void*)kfwd, hipFuncAttributeMaxDynamicSharedMemorySize, LDS_BYTES) != hipSuccess) { fprintf(stderr, "kernel_launch: hipFuncSetAttribute failed\n"); grid = -1; return; }
        if (hipOccupancyMaxActiveBlocksPerMultiprocessor(&per_cu, (const void*)kfwd, 512, LDS_BYTES) != hipSuccess || per_cu < 1) fprintf(stderr, "kernel_launch: occupancy query says %d\n", per_cu);
        (void)hipGetLastError();
        grid = cus;
    }
    if (grid < 0) return;
    if (hipMemsetAsync((char*)d_ws + WS_CTL, 0, CTL_ZERO_BYTES, stream) != hipSuccess) return;
    Args a{};
    for (int i = 0; i < 20; ++i) a.in[i] = (const float*)d_in[i];
    a.out = (float*)d_out; a.ws = (unsigned char*)d_ws;
#if MK_LAUNCH_PER_PHASE
    for (int p = 0; p < N_PHASES; ++p) { a.ph_lo = p; a.ph_hi = p + 1; hipLaunchKernelGGL(kfwd, dim3(grid), dim3(512), LDS_BYTES, stream, a); }
#else
    a.ph_lo = 0; a.ph_hi = N_PHASES; hipLaunchKernelGGL(kfwd, dim3(grid), dim3(512), LDS_BYTES, stream, a);
#endif
}
```

```cpp
#include <hip/hip_runtime.h>
#include <cstdio>
#include <cstdint>

#ifndef MK_LAUNCH_PER_PHASE
#define MK_LAUNCH_PER_PHASE 0
#endif

#define GAS __attribute__((address_space(1)))
#define LAS __attribute__((address_space(3)))
typedef unsigned short bf16_t;
typedef short bf16x8 __attribute__((ext_vector_type(8)));
typedef short s16x4 __attribute__((ext_vector_type(4)));
typedef float f32x4 __attribute__((ext_vector_type(4)));
typedef float f32x2 __attribute__((ext_vector_type(2)));
typedef unsigned u32x4 __attribute__((ext_vector_type(4)));
typedef unsigned u32x2 __attribute__((ext_vector_type(2)));

constexpr int D_MODEL = 2048, BATCH = 8, SEQ = 2048, DEPTH = 2, T = BATCH * SEQ;
constexpr int HG_HEADS = 8, HG_DIM = 128, HG_WIDTH = 1024, HG_CHUNK = 64, NCHUNK = T / HG_CHUNK;
constexpr int ATT_HEADS = 12, ATT_DIM = 128, ATT_WIDTH = 1536, ATT_OUT = 512;
constexpr int N_EXPERTS = 64, N_GROUPS = 8, TOPK_GROUPS = 4, TOP_K = 8, EXPERT_FF = 512;
constexpr int IN_WIDTH = 12800;
constexpr int C_HQ = 0, C_HF = 1024, C_HI = 2048, C_HGATE = 3072, C_AQ = 4096, C_AK = 5632, C_AV = 7168, C_GH = 8704, C_GA = 10752;
constexpr float ROUTED_SCALE = 2.5f, LN_EPS = 1e-5f, NORM_EPS = 1e-6f;
constexpr float DN_ALPHA = 1.41421356237309515f;
constexpr int NEXP1 = N_EXPERTS + 1;
constexpr int MAXROWS = 163840;

constexpr size_t MiB = 1u << 20;
constexpr size_t WS_CTL = 0, CTL_ZERO_BYTES = 1 * MiB;
constexpr size_t WS_WIN = 4 * MiB;
constexpr size_t WS_WHG = 54 * MiB;
constexpr size_t WS_WATT = 58 * MiB;
constexpr size_t WS_WOUT = 60 * MiB;
constexpr size_t WS_WGU = 68 * MiB;
constexpr size_t WS_WDN = 328 * MiB;
constexpr size_t WS_ROPE = 458 * MiB;
constexpr size_t WS_LB = 466 * MiB;
constexpr size_t WS_R = 467 * MiB;
constexpr size_t WS_X1 = 595 * MiB;
constexpr size_t WS_XB = 723 * MiB;
constexpr size_t WS_X1B = 787 * MiB;
constexpr size_t WS_PE = 851 * MiB;
constexpr size_t WS_PP = 852 * MiB;
constexpr size_t WS_PG = 853 * MiB;
constexpr size_t WS_RM = 854 * MiB;
constexpr size_t WS_HID = 859 * MiB;
constexpr size_t WS_BIG = 1019 * MiB;
constexpr size_t WS_H = WS_BIG;
constexpr size_t WS_LF = WS_BIG + 400 * MiB;
constexpr size_t WS_UT = WS_BIG + 464 * MiB;
constexpr size_t WS_SPT = WS_BIG + 592 * MiB;
constexpr size_t WS_DEC = WS_BIG + 656 * MiB;
constexpr size_t WS_LSE = WS_BIG + 657 * MiB;
constexpr size_t WS_HGO = WS_BIG + 658 * MiB;
constexpr size_t WS_ATTO = WS_BIG + 690 * MiB;
constexpr size_t WS_MRG = WS_BIG + 706 * MiB;
constexpr size_t WS_Y = WS_BIG;
constexpr size_t WS_END = WS_BIG + 770 * MiB;
constexpr int CW_TMO = 0;
constexpr int CW_CNT = 1024;
constexpr int CW_BAR = 4096;

constexpr int LDS_BYTES = 159744;
constexpr int LDS_TAB = 147456;
constexpr int LDS_MISC = LDS_TAB + 2048;

#define RLX_AGENT __ATOMIC_RELAXED, __HIP_MEMORY_SCOPE_AGENT
#define LDS_WAIT() asm volatile("s_waitcnt lgkmcnt(0)" ::: "memory")
#define VM_WAIT() asm volatile("s_waitcnt vmcnt(0)" ::: "memory")
__device__ __forceinline__ unsigned f2bf(float f) { unsigned u = __builtin_bit_cast(unsigned, f); return (u + 0x7fffu + ((u >> 16) & 1u)) >> 16; }
__device__ __forceinline__ unsigned pk2(float lo, float hi) { return f2bf(lo) | (f2bf(hi) << 16); }
__device__ __forceinline__ float bf2f(unsigned short b) { return __builtin_bit_cast(float, ((unsigned)b) << 16); }
__device__ __forceinline__ float bflo(unsigned w) { return __builtin_bit_cast(float, w << 16); }
__device__ __forceinline__ float bfhi(unsigned w) { return __builtin_bit_cast(float, w & 0xffff0000u); }
__device__ __forceinline__ unsigned cvt_pk_bf16(float lo, float hi) { unsigned r; asm volatile("v_cvt_pk_bf16_f32 %0, %1, %2" : "=v"(r) : "v"(lo), "v"(hi)); return r; }
__device__ __forceinline__ float fsigmoid(float x) { return __fdividef(1.0f, 1.0f + __expf(-x)); }
__device__ __forceinline__ float wave_sum(float v) {
#pragma unroll
    for (int o = 1; o < 64; o <<= 1) v += __shfl_xor(v, o);
    return v;
}
__device__ __forceinline__ f32x4 mfma16(bf16x8 a, bf16x8 b, f32x4 c) { return __builtin_amdgcn_mfma_f32_16x16x32_bf16(a, b, c, 0, 0, 0); }
__device__ __forceinline__ s16x4 tr_read(unsigned lds_addr) { s16x4 r; asm volatile("ds_read_b64_tr_b16 %0, %1\n\ts_waitcnt lgkmcnt(0)" : "=&v"(r) : "v"(lds_addr) : "memory"); return r; }

#define XB_TMO      128
#define XB_XCNT(j)  (256  + 64 * (j))
#define XB_XSUB(j)  (1280 + 64 * (j))
#define XB_XGEN(j)  (2304 + 64 * (j))
#define XB_TOP      3328
#define XB_TOPGEN   3392
#define XCD_BAR_WORDS 3456
#define XB_SPIN_CAP (1u << 18)
__device__ __forceinline__ unsigned xb_ld(unsigned* p)              { return __hip_atomic_load(p, __ATOMIC_RELAXED, __HIP_MEMORY_SCOPE_AGENT); }
__device__ __forceinline__ unsigned xb_add(unsigned* p, unsigned v) { return __hip_atomic_fetch_add(p, v, __ATOMIC_RELAXED, __HIP_MEMORY_SCOPE_AGENT); }
__device__ __forceinline__ unsigned xb_xcc_id() { return (unsigned)__builtin_amdgcn_s_getreg((3 << 11) | 20) & 0xFu; }
#define XB_SPIN(cond, bar) do { unsigned _sp = 0; while (cond) { __builtin_amdgcn_s_sleep(1); \
    if ((++_sp & 255u) == 0u) { if (xb_ld(&(bar)[XB_TMO])) break; if (_sp > XB_SPIN_CAP) { atomicAdd(&(bar)[XB_TMO], 1u); break; } } } } while (0)
struct XcdBarrier { unsigned* bar; unsigned x; volatile LAS unsigned* st; };
__device__ __forceinline__ XcdBarrier xcd_barrier_post(unsigned* bar, volatile LAS unsigned* st) {
    XcdBarrier b; b.bar = bar; b.x = xb_xcc_id(); b.st = st;
    if (threadIdx.x == 0) (void)xb_add(&bar[XB_XCNT(b.x)], 1u);
    return b;
}
__device__ __forceinline__ void xcd_barrier_complete(unsigned* bar, unsigned x, unsigned& nloc, unsigned& nx) {
    const unsigned G = gridDim.x * gridDim.y * gridDim.z;
    unsigned sum, cnt, mine, sp = 0u;
    for (;;) {
        sum = 0u; cnt = 0u; mine = 0u;
#pragma unroll
        for (unsigned j = 0; j < 16; ++j) { const unsigned c = xb_ld(&bar[XB_XCNT(j)]); sum += c; cnt += (c > 0u) ? 1u : 0u; mine = (j == x) ? c : mine; }
        if (sum == G) break;
        __builtin_amdgcn_s_sleep(1);
        if ((++sp & 255u) == 0u) { if (xb_ld(&bar[XB_TMO])) break; if (sp > XB_SPIN_CAP) { atomicAdd(&bar[XB_TMO], 1u); break; } }
    }
    nloc = mine > 0u ? mine : 1u; nx = cnt > 0u ? cnt : 1u;
}
__device__ __forceinline__ void xcd_barrier(const XcdBarrier& b) {
    asm volatile("s_waitcnt vmcnt(0)" ::: "memory");
    __syncthreads();
    if (threadIdx.x == 0) {
        unsigned* bar = b.bar;
        __builtin_amdgcn_s_waitcnt(0);
        unsigned nloc = b.st[0], nx = b.st[1];
        if (nloc == 0u) { xcd_barrier_complete(bar, b.x, nloc, nx); b.st[0] = nloc; b.st[1] = nx; }
        const unsigned old = xb_add(&bar[XB_XSUB(b.x)], 1u);
        const unsigned gen = old / nloc;
        if (old + 1u == (gen + 1u) * nloc) {
            __builtin_amdgcn_fence(__ATOMIC_RELEASE, "agent");
            asm volatile("s_waitcnt vmcnt(0)" ::: "memory");
            const unsigned og = xb_add(&bar[XB_TOP], 1u);
            const unsigned tg = og / nx;
            if (og + 1u == (tg + 1u) * nx) xb_add(&bar[XB_TOPGEN], 1u);
            else XB_SPIN(xb_ld(&bar[XB_TOPGEN]) == tg, bar);
            __builtin_amdgcn_fence(__ATOMIC_ACQUIRE, "agent");
            xb_add(&bar[XB_XGEN(b.x)], 1u);
            asm volatile("s_waitcnt vmcnt(0)" ::: "memory");
        } else {
            XB_SPIN(xb_ld(&bar[XB_XGEN(b.x)]) == gen, bar);
            __builtin_amdgcn_fence(__ATOMIC_ACQUIRE, "agent");
            asm volatile("s_waitcnt vmcnt(0)" ::: "memory");
        }
    }
    __syncthreads();
}

namespace pg8 {
constexpr int BM = 256, BK = 64, HALF = 128, HTB = HALF * BK * 2, STAGE_BYTES = 8 * HTB, NXCD = 8, WGM = 8;
__host__ __device__ __forceinline__ int lds_byte(int r, int c) { const int st = (r >> 4) * 2 + (c >> 5), rr = r & 15, cc = c & 31, ob = rr * 64 + cc * 2; return st * 1024 + (ob ^ (((ob >> 9) & 1) << 5)); }
__host__ __device__ __forceinline__ void stage_rc(int b, int& R, int& C) { const int st = b / 1024, sb = b % 1024, swz = sb ^ (((sb >> 9) & 1) << 5); R = (st >> 1) * 16 + swz / 64; C = (st & 1) * 32 + (swz % 64) / 2; }
__host__ __device__ __forceinline__ int perm32(int rho) { const int n = rho >> 4, i = rho & 15; return 8 * (i >> 2) + 4 * n + (i & 3); }

struct Unit {
    const char* a; const char* b; int lda, ldb, nt;
    int row0, col0, aux;
    const int* gidx; int gcnt;
};

__device__ __forceinline__ void tile_of(int L, int nM, int nN, int& pm, int& pn) {
    const int nwg = nM * nN; int wgid = L;
    { const int q = nwg / NXCD, r = nwg % NXCD, xcd = wgid % NXCD, off = wgid / NXCD; wgid = (xcd < r ? xcd * (q + 1) : r * (q + 1) + (xcd - r) * q) + off; }
    const int nig = WGM * nN, gid = wgid / nig, fm = gid * WGM, gsz = (nM - fm) < WGM ? (nM - fm) : WGM;
    pm = fm + ((wgid % nig) % gsz); pn = (wgid % nig) / gsz;
}

template <class Epi, class Sched, bool GATHER>
__device__ __forceinline__ void gemm_phase(LAS unsigned char* lds, const Sched& S, const Epi& E) {
    int tid = threadIdx.x; asm volatile("" : "+v"(tid));
    const int wid = __builtin_amdgcn_readfirstlane(tid >> 6), lane = tid & 63, wr = wid >> 2, wc = wid & 3, fr = lane & 15, fq = lane >> 4;
    int sR[2], sC2[2], sRb[2];
#pragma unroll
    for (int i = 0; i < 2; ++i) { int R, C; stage_rc(tid * 16 + i * 8192, R, C); sR[i] = R; sC2[i] = C * 2; sRb[i] = Epi::PERM ? ((R & ~31) + perm32(R & 31)) : R; }
    const unsigned ldsw = (unsigned)wid * 1024u;
    const int aoff = lds_byte(wr * 64 + fr, fq * 8), boff = lds_byte(wc * 32 + fr, fq * 8);
#define PG8_SA(b, h) (((b) * 2 + (h)) * HTB)
#define PG8_SB(b, h) ((4 + (b) * 2 + (h)) * HTB)
#define PG8_STAGE(bufoff, gbase, voff) do { _Pragma("unroll") for (int _i = 0; _i < 2; ++_i) \
        __builtin_amdgcn_global_load_lds((const unsigned*)((const char*)(gbase) + (voff)[_i]), (LAS unsigned*)(lds + (bufoff) + ldsw + _i * 8192), 16, 0, 0); } while (0)
#define PG8_LDA(dst, b, h) do { _Pragma("unroll") for (int m = 0; m < 4; ++m) _Pragma("unroll") for (int k = 0; k < 2; ++k) dst[m][k] = *(const LAS bf16x8*)(lds + PG8_SA(b, h) + aoff + m * 2048 + k * 1024); } while (0)
#define PG8_LDB(dst, b, h) do { _Pragma("unroll") for (int n = 0; n < 2; ++n) _Pragma("unroll") for (int k = 0; k < 2; ++k) dst[n][k] = *(const LAS bf16x8*)(lds + PG8_SB(b, h) + boff + n * 2048 + k * 1024); } while (0)
#define PG8_MMA(ai, bj, At, Bt) do { __builtin_amdgcn_s_setprio(1); _Pragma("unroll") for (int m = 0; m < 4; ++m) _Pragma("unroll") for (int n = 0; n < 2; ++n) _Pragma("unroll") for (int k = 0; k < 2; ++k) \
        acc[ai][bj][m][n] = __builtin_amdgcn_mfma_f32_16x16x32_bf16(Bt[n][k], At[m][k], acc[ai][bj][m][n], 0, 0, 0); __builtin_amdgcn_s_setprio(0); } while (0)
#define PG8_WAIT_V(n) asm volatile("s_waitcnt vmcnt(" #n ")" ::: "memory")
#define PG8_WAIT_L(n) asm volatile("s_waitcnt lgkmcnt(" #n ")" ::: "memory")
#define PG8_BAR __builtin_amdgcn_s_barrier()
#define PG8_SCHED __builtin_amdgcn_sched_barrier(0)
#define PG8_OFFS(u, ao, bo) do { _Pragma("unroll") for (int _i = 0; _i < 2; ++_i) { (bo)[_i] = (unsigned)(sRb[_i] * (u).ldb + sC2[_i]); \
        _Pragma("unroll") for (int _h = 0; _h < 2; ++_h) { int _r = _h * HALF + sR[_i]; if (GATHER) { _r = (_r < (u).gcnt) ? (u).gidx[_r] : 0; } (ao)[_h][_i] = (unsigned)(_r * (u).lda + sC2[_i]); } } } while (0)
    Unit cur, nxt; int ui = 0;
    if (!S.next(0, cur)) return;
    f32x4 acc[2][2][4][2];
#pragma unroll
    for (int a = 0; a < 2; ++a)
#pragma unroll
        for (int b = 0; b < 2; ++b)
#pragma unroll
            for (int m = 0; m < 4; ++m)
#pragma unroll
                for (int n = 0; n < 2; ++n) acc[a][b][m][n] = (f32x4){0.f, 0.f, 0.f, 0.f};
    bf16x8 At[4][2], B0[2][2], B1[2][2];
    unsigned aoc[2][2], boc[2], aon[2][2], bon[2];
    PG8_OFFS(cur, aoc, boc);
    {
        const char* cA = cur.a; const char* cB = cur.b; const size_t hB = (size_t)HALF * cur.ldb;
        PG8_STAGE(PG8_SB(0, 0), cB, boc); PG8_STAGE(PG8_SB(0, 1), cB + hB, boc); PG8_STAGE(PG8_SA(0, 0), cA, aoc[0]); PG8_STAGE(PG8_SA(0, 1), cA, aoc[1]);
        if (wr == 1) PG8_BAR;
        PG8_WAIT_V(2); PG8_BAR;
        PG8_STAGE(PG8_SB(1, 0), cB + 128, boc); PG8_STAGE(PG8_SA(1, 0), cA + 128, aoc[0]); PG8_STAGE(PG8_SB(1, 1), cB + hB + 128, boc);
        PG8_WAIT_V(6); PG8_BAR;
    }
    for (;;) {
        const bool has_next = S.next(ui + 1, nxt);
        if (has_next) { PG8_OFFS(nxt, aon, bon); }
        else { nxt = cur;
#pragma unroll
            for (int i = 0; i < 2; ++i) { bon[i] = boc[i]; aon[0][i] = aoc[0][i]; aon[1][i] = aoc[1][i]; } }
        const char* cA = cur.a; const char* cB = cur.b; const char* nA = nxt.a; const char* nB = nxt.b;
        const size_t hBc = (size_t)HALF * cur.ldb, hBn = (size_t)HALF * nxt.ldb;
        const int nt = cur.nt;
        for (int t = 0; t < nt; t += 2) {
            const bool last = (t == nt - 2);
            const char* a1 = cA + (size_t)(t + 1) * 128;
            const char* a2 = last ? nA : cA + (size_t)(t + 2) * 128; const char* b2 = last ? nB : cB + (size_t)(t + 2) * 128;
            const char* a3 = a2 + 128; const char* b3 = b2 + 128;
            const size_t hB2 = last ? hBn : hBc;
            unsigned oa0[2], oa1[2], ob[2];
#pragma unroll
            for (int i = 0; i < 2; ++i) { oa0[i] = last ? aon[0][i] : aoc[0][i]; oa1[i] = last ? aon[1][i] : aoc[1][i]; ob[i] = last ? bon[i] : boc[i]; }
            PG8_LDB(B0, 0, 0); PG8_LDB(B1, 0, 1); PG8_SCHED; PG8_LDA(At, 0, 0); PG8_STAGE(PG8_SA(1, 1), a1, aoc[1]);
            PG8_WAIT_V(8); PG8_WAIT_L(0); PG8_BAR; PG8_MMA(0, 0, At, B0); PG8_MMA(0, 1, At, B1); PG8_BAR; PG8_SCHED;
            PG8_LDA(At, 0, 1); PG8_STAGE(PG8_SB(0, 0), b2, ob); PG8_STAGE(PG8_SB(0, 1), b2 + hB2, ob); PG8_STAGE(PG8_SA(0, 0), a2, oa0);
            PG8_WAIT_V(8); PG8_WAIT_L(0); PG8_BAR; PG8_MMA(1, 0, At, B0); PG8_MMA(1, 1, At, B1); PG8_BAR; PG8_SCHED;
            PG8_LDB(B0, 1, 0); PG8_LDB(B1, 1, 1); PG8_SCHED; PG8_LDA(At, 1, 0); PG8_STAGE(PG8_SA(0, 1), a2, oa1);
            PG8_WAIT_V(8); PG8_WAIT_L(0); PG8_BAR; PG8_MMA(0, 0, At, B0); PG8_MMA(0, 1, At, B1); PG8_BAR; PG8_SCHED;
            PG8_LDA(At, 1, 1); PG8_STAGE(PG8_SB(1, 0), b3, ob); PG8_STAGE(PG8_SB(1, 1), b3 + hB2, ob); PG8_STAGE(PG8_SA(1, 0), a3, oa0);
            PG8_WAIT_V(8); PG8_WAIT_L(0); PG8_BAR; PG8_MMA(1, 0, At, B0); PG8_MMA(1, 1, At, B1); PG8_BAR; PG8_SCHED;
        }
        if (wr == 0) PG8_BAR;
        const bool keep = E(acc, cur, wr, wc, fr, fq);
        if (!has_next) break;
        if (!keep) {
#pragma unroll
            for (int a = 0; a < 2; ++a)
#pragma unroll
                for (int b = 0; b < 2; ++b)
#pragma unroll
                    for (int m = 0; m < 4; ++m)
#pragma unroll
                        for (int n = 0; n < 2; ++n) acc[a][b][m][n] = (f32x4){0.f, 0.f, 0.f, 0.f};
        }
        cur = nxt;
#pragma unroll
        for (int i = 0; i < 2; ++i) { boc[i] = bon[i]; aoc[0][i] = aon[0][i]; aoc[1][i] = aon[1][i]; }
        ++ui;
        if (wr == 1) PG8_BAR;
    }
    PG8_WAIT_V(0);
    PG8_BAR;
#undef PG8_OFFS
#undef PG8_SA
#undef PG8_SB
#undef PG8_STAGE
#undef PG8_LDA
#undef PG8_LDB
#undef PG8_MMA
#undef PG8_WAIT_V
#undef PG8_WAIT_L
#undef PG8_BAR
#undef PG8_SCHED
}
}
using pg8::Unit;

struct DenseSched {
    const char* A; const char* Bt; int lda, ldb, nt, nM, nN, G, c;
    __device__ __forceinline__ bool next(int i, Unit& u) const {
        const long L = (long)i * G + c; if (L >= (long)nM * nN) return false;
        int pm, pn; pg8::tile_of((int)L, nM, nN, pm, pn);
        u.a = A + (size_t)pm * 256 * lda; u.b = Bt + (size_t)pn * 256 * ldb; u.lda = lda; u.ldb = ldb; u.nt = nt;
        u.row0 = pm * 256; u.col0 = pn * 256; u.aux = 0; u.gidx = nullptr; u.gcnt = 256; return true;
    }
};
struct MergeSched {
    const char* A0; const char* B0; const char* A1; const char* B1; int nM, nN, G, c;
    __device__ __forceinline__ bool next(int i, Unit& u) const {
        const long L = (long)(i >> 1) * G + c; if (L >= (long)nM * nN) return false;
        int pm, pn; pg8::tile_of((int)L, nM, nN, pm, pn);
        const int seg = i & 1;
        const int ld = seg ? ATT_OUT * 2 : HG_WIDTH * 2;
        u.a = (seg ? A1 : A0) + (size_t)pm * 256 * ld; u.b = (seg ? B1 : B0) + (size_t)pn * 256 * ld; u.lda = ld; u.ldb = ld; u.nt = seg ? ATT_OUT / 64 : HG_WIDTH / 64;
        u.row0 = pm * 256; u.col0 = pn * 256; u.aux = seg; u.gidx = nullptr; u.gcnt = 256; return true;
    }
};
template <int NT, bool UP>
struct MoeSched {
    const LAS int* toff; const unsigned* cnt;
    const char* A; const char* W; const int* rowmap;
    int G, c;
    __device__ __forceinline__ bool next(int i, Unit& u) const {
        const int total = toff[NEXP1];
        const long L = (long)i * G + c; if (L >= (long)total * NT) return false;
        const int mtg = (int)(L / NT), pn = (int)(L % NT);
        int lo = 0, hi = NEXP1;
        while (hi - lo > 1) { const int mid = (lo + hi) >> 1; if (toff[mid] <= mtg) lo = mid; else hi = mid; }
        const int e = lo, mt = mtg - toff[e];
        if (UP) {
            u.a = A; u.lda = D_MODEL * 2; u.nt = D_MODEL / 64;
            u.b = W + ((size_t)e * 1024 + (size_t)pn * 256) * (D_MODEL * 2); u.ldb = D_MODEL * 2;
            if (e < N_EXPERTS) { u.gidx = rowmap + (size_t)e * T + mt * 256; const int n = (int)cnt[e] - mt * 256; u.gcnt = n < 256 ? n : 256; }
            else { u.gidx = rowmap + (size_t)N_EXPERTS * T + mt * 256; u.gcnt = 256; }
            u.col0 = pn * 128;
        } else {
            u.a = A + (size_t)mtg * 256 * (EXPERT_FF * 2); u.lda = EXPERT_FF * 2; u.nt = EXPERT_FF / 64;
            u.b = W + ((size_t)e * D_MODEL + (size_t)pn * 256) * (EXPERT_FF * 2); u.ldb = EXPERT_FF * 2;
            u.gidx = nullptr; u.gcnt = 256; u.col0 = pn * 256;
        }
        u.row0 = mtg * 256; u.aux = e; return true;
    }
};

struct EpiIn {
    static constexpr bool PERM = true;
    bf16_t* H; float* LF; const float* lb; const f32x4* rope;
    __device__ __forceinline__ bool operator()(f32x4 (&acc)[2][2][4][2], const Unit& u, int wr, int wc, int fr, int fq) const {
        const int row0 = u.row0 + wr * 64 + fr, colt = u.col0, cl = wc * 32 + 8 * fq;
        int mode;
        if (colt < C_HF) mode = 1; else if (colt < C_HI) mode = 3; else if (colt < C_HGATE) mode = 0; else if (colt < C_AQ) mode = 2;
        else if (colt < C_AK) mode = 4; else if (colt < C_AV) mode = 5; else if (colt < C_GH) mode = 0; else mode = 2;
        if (mode == 3) {
            f32x4 lbv[2][2];
#pragma unroll
            for (int bj = 0; bj < 2; ++bj)
#pragma unroll
                for (int n = 0; n < 2; ++n) lbv[bj][n] = *(const f32x4*)(lb + (colt - C_HF) + bj * 128 + cl + 4 * n);
#pragma unroll
            for (int ai = 0; ai < 2; ++ai)
#pragma unroll
                for (int m = 0; m < 4; ++m) { float* rowp = LF + (size_t)(row0 + ai * 128 + m * 16) * HG_WIDTH + (colt - C_HF) + cl;
#pragma unroll
                    for (int bj = 0; bj < 2; ++bj)
#pragma unroll
                        for (int n = 0; n < 2; ++n) { f32x4 z = acc[ai][bj][m][n], o;
#pragma unroll
                            for (int j = 0; j < 4; ++j) { const float zz = fmaxf(z[j], -80.f), l = lbv[bj][n][j]; const float f = l + (1.0f - l) * __fdividef(1.0f, 1.0f + __expf(-zz)); o[j] = __logf(f); }
                            *(f32x4*)(rowp + bj * 128 + 4 * n) = o; } }
            return false;
        }
        if (mode >= 4) {
            const float sc = (mode == 4) ? 0.08838834764831845f : 1.0f;
            const int i0 = 16 * wc + 4 * fq;
#pragma unroll
            for (int ai = 0; ai < 2; ++ai)
#pragma unroll
                for (int m = 0; m < 4; ++m) { const int row = row0 + ai * 128 + m * 16; bf16_t* rowp = H + (size_t)row * IN_WIDTH + colt + cl;
                    const f32x4 cs0 = rope[(size_t)row * 32 + (i0 >> 1)], cs1 = rope[(size_t)row * 32 + (i0 >> 1) + 1];
#pragma unroll
                    for (int bj = 0; bj < 2; ++bj) { const f32x4 v0 = acc[ai][bj][m][0], v1 = acc[ai][bj][m][1]; u32x4 w;
                        w.x = cvt_pk_bf16((v0[0] * cs0[0] - v0[1] * cs0[1]) * sc, (v0[1] * cs0[0] + v0[0] * cs0[1]) * sc);
                        w.y = cvt_pk_bf16((v0[2] * cs0[2] - v0[3] * cs0[3]) * sc, (v0[3] * cs0[2] + v0[2] * cs0[3]) * sc);
                        w.z = cvt_pk_bf16((v1[0] * cs1[0] - v1[1] * cs1[1]) * sc, (v1[1] * cs1[0] + v1[0] * cs1[1]) * sc);
                        w.w = cvt_pk_bf16((v1[2] * cs1[2] - v1[3] * cs1[3]) * sc, (v1[3] * cs1[2] + v1[2] * cs1[3]) * sc);
                        *(u32x4*)(rowp + bj * 128) = w; } }
            return false;
        }
#pragma unroll
        for (int ai = 0; ai < 2; ++ai)
#pragma unroll
            for (int m = 0; m < 4; ++m) { bf16_t* rowp = H + (size_t)(row0 + ai * 128 + m * 16) * IN_WIDTH + colt + cl;
#pragma unroll
                for (int bj = 0; bj < 2; ++bj) { f32x4 v0 = acc[ai][bj][m][0], v1 = acc[ai][bj][m][1];
                    if (mode != 0) {
#pragma unroll
                        for (int j = 0; j < 4; ++j) { const float s0 = fsigmoid(v0[j]), s1 = fsigmoid(v1[j]); v0[j] = (mode == 1) ? v0[j] * s0 : s0; v1[j] = (mode == 1) ? v1[j] * s1 : s1; } }
                    u32x4 w; w.x = cvt_pk_bf16(v0[0], v0[1]); w.y = cvt_pk_bf16(v0[2], v0[3]); w.z = cvt_pk_bf16(v1[0], v1[1]); w.w = cvt_pk_bf16(v1[2], v1[3]);
                    *(u32x4*)(rowp + bj * 128) = w; } }
        return false;
    }
};
struct EpiMerge {
    static constexpr bool PERM = true;
    const bf16_t* H; bf16_t* O;
    __device__ __forceinline__ bool operator()(f32x4 (&acc)[2][2][4][2], const Unit& u, int wr, int wc, int fr, int fq) const {
        const int row0 = u.row0 + wr * 64 + fr, col0 = u.col0 + wc * 32 + 8 * fq;
#pragma unroll
        for (int ai = 0; ai < 2; ++ai)
#pragma unroll
            for (int m = 0; m < 4; ++m) { const size_t row = (size_t)(row0 + ai * 128 + m * 16);
#pragma unroll
                for (int bj = 0; bj < 2; ++bj) {
                    const u32x4 ga = *(const u32x4*)(H + row * IN_WIDTH + C_GA + col0 + bj * 128);
                    float a[8] = {bflo(ga.x), bfhi(ga.x), bflo(ga.y), bfhi(ga.y), bflo(ga.z), bfhi(ga.z), bflo(ga.w), bfhi(ga.w)};
                    if (u.aux == 0) {
                        const u32x4 gh = *(const u32x4*)(H + row * IN_WIDTH + C_GH + col0 + bj * 128);
                        float h[8] = {bflo(gh.x), bfhi(gh.x), bflo(gh.y), bfhi(gh.y), bflo(gh.z), bfhi(gh.z), bflo(gh.w), bfhi(gh.w)};
#pragma unroll
                        for (int j = 0; j < 4; ++j) { acc[ai][bj][m][0][j] *= __fdividef(h[j], a[j]); acc[ai][bj][m][1][j] *= __fdividef(h[4 + j], a[4 + j]); }
                    } else {
                        f32x4 v0 = acc[ai][bj][m][0], v1 = acc[ai][bj][m][1];
#pragma unroll
                        for (int j = 0; j < 4; ++j) { v0[j] *= a[j]; v1[j] *= a[4 + j]; }
                        u32x4 w; w.x = cvt_pk_bf16(v0[0], v0[1]); w.y = cvt_pk_bf16(v0[2], v0[3]); w.z = cvt_pk_bf16(v1[0], v1[1]); w.w = cvt_pk_bf16(v1[2], v1[3]);
                        *(u32x4*)(O + row * D_MODEL + col0 + bj * 128) = w;
                    } } }
        return u.aux == 0;
    }
};
struct EpiResid {
    static constexpr bool PERM = false;
    const float* X; float* R;
    __device__ __forceinline__ bool operator()(f32x4 (&acc)[2][2][4][2], const Unit& u, int wr, int wc, int fr, int fq) const {
        const int row0 = u.row0 + wr * 64 + fr, col0 = u.col0 + wc * 32 + 4 * fq;
#pragma unroll
        for (int ai = 0; ai < 2; ++ai)
#pragma unroll
            for (int m = 0; m < 4; ++m) { const size_t off = (size_t)(row0 + ai * 128 + m * 16) * D_MODEL + col0;
#pragma unroll
                for (int bj = 0; bj < 2; ++bj)
#pragma unroll
                    for (int n = 0; n < 2; ++n) { const f32x4 xv = *(const f32x4*)(X + off + bj * 128 + n * 16); *(f32x4*)(R + off + bj * 128 + n * 16) = xv * DN_ALPHA + acc[ai][bj][m][n]; } }
        return false;
    }
};
struct EpiGateUp {
    static constexpr bool PERM = true;
    bf16_t* HID;
    __device__ __forceinline__ bool operator()(f32x4 (&acc)[2][2][4][2], const Unit& u, int wr, int wc, int fr, int fq) const {
        const int row0 = u.row0 + wr * 64 + fr, col0 = u.col0 + wc * 32 + 8 * fq;
#pragma unroll
        for (int ai = 0; ai < 2; ++ai)
#pragma unroll
            for (int m = 0; m < 4; ++m) { bf16_t* rowp = HID + (size_t)(row0 + ai * 128 + m * 16) * EXPERT_FF + col0;
                f32x4 g0 = acc[ai][0][m][0], g1 = acc[ai][0][m][1]; const f32x4 u0 = acc[ai][1][m][0], u1 = acc[ai][1][m][1];
#pragma unroll
                for (int j = 0; j < 4; ++j) { g0[j] = g0[j] * fsigmoid(g0[j]) * u0[j]; g1[j] = g1[j] * fsigmoid(g1[j]) * u1[j]; }
                u32x4 w; w.x = cvt_pk_bf16(g0[0], g0[1]); w.y = cvt_pk_bf16(g0[2], g0[3]); w.z = cvt_pk_bf16(g1[0], g1[1]); w.w = cvt_pk_bf16(g1[2], g1[3]);
                *(u32x4*)rowp = w; }
        return false;
    }
};
struct EpiDown {
    static constexpr bool PERM = true;
    bf16_t* Y;
    __device__ __forceinline__ bool operator()(f32x4 (&acc)[2][2][4][2], const Unit& u, int wr, int wc, int fr, int fq) const {
        const int row0 = u.row0 + wr * 64 + fr, col0 = u.col0 + wc * 32 + 8 * fq;
#pragma unroll
        for (int ai = 0; ai < 2; ++ai)
#pragma unroll
            for (int m = 0; m < 4; ++m) { bf16_t* rowp = Y + (size_t)(row0 + ai * 128 + m * 16) * D_MODEL + col0;
#pragma unroll
                for (int bj = 0; bj < 2; ++bj) { const f32x4 v0 = acc[ai][bj][m][0], v1 = acc[ai][bj][m][1];
                    u32x4 w; w.x = cvt_pk_bf16(v0[0], v0[1]); w.y = cvt_pk_bf16(v0[2], v0[3]); w.z = cvt_pk_bf16(v1[0], v1[1]); w.w = cvt_pk_bf16(v1[2], v1[3]);
                    *(u32x4*)(rowp + bj * 128) = w; } }
        return false;
    }
};

struct Args { const float* in[20]; float* out; unsigned char* ws; int ph_lo, ph_hi; };
typedef const __attribute__((address_space(4))) Args* CArgsP;
#define PHASE_ARGS() CArgsP ap = (CArgsP)__builtin_amdgcn_kernarg_segment_ptr(); asm volatile("" : "+s"(ap))
struct Frame {
    LAS unsigned char* lds;
    unsigned* ctl;
    unsigned char* ws;
    int G, bid;
};
#define PHASE_IDS() int tid = threadIdx.x; asm volatile("" : "+v"(tid)); const int lane = tid & 63, w = __builtin_amdgcn_readfirstlane(tid >> 6); (void)lane; (void)w

__device__ __forceinline__ int conv_src_col(int mode, int p) {
    if (mode == 1 && p >= C_AQ && p < C_AV) { const int hb = p & ~127, q = p & 127; return hb + (q >> 1) + 64 * (q & 1); }
    return p;
}
__device__ __forceinline__ int conv_dst_row(int mode, int n) {
    if (mode == 2) return (n >> 7) * 256 + (n & 127);
    if (mode == 3) return (n >> 7) * 256 + 128 + (n & 127);
    return n;
}
__device__ __forceinline__ void conv_item(const float* W, int K, int N, bf16_t* WT, int mode, LAS float* scr, int item, int lane) {
    const int nblk = N / 64, kb = item / nblk, nb = item % nblk, k0 = 64 * kb, n0 = 64 * nb;
    const int n4 = (lane & 15) * 4, kq = lane >> 4;
    if (mode == 1 && n0 >= C_AQ && n0 < C_AV) {
#pragma unroll 4
        for (int ii = 0; ii < 16; ++ii) { const int k = 4 * ii + kq; const float* src = W + (size_t)(k0 + k) * N;
#pragma unroll
            for (int j = 0; j < 4; ++j) scr[k * 65 + n4 + j] = src[conv_src_col(1, n0 + n4 + j)]; }
    } else {
#pragma unroll 8
        for (int ii = 0; ii < 16; ++ii) { const int k = 4 * ii + kq; const f32x4 v = *(const f32x4*)(W + (size_t)(k0 + k) * N + n0 + n4);
            scr[k * 65 + n4 + 0] = v[0]; scr[k * 65 + n4 + 1] = v[1]; scr[k * 65 + n4 + 2] = v[2]; scr[k * 65 + n4 + 3] = v[3]; }
    }
    LDS_WAIT(); asm volatile("" ::: "memory");
    const int c = lane & 7, nl = lane >> 3;
#pragma unroll
    for (int j = 0; j < 8; ++j) { const int n = nl + 8 * j; const LAS float* s = scr + (8 * c) * 65 + n;
        u32x4 o; o.x = pk2(s[0 * 65], s[1 * 65]); o.y = pk2(s[2 * 65], s[3 * 65]); o.z = pk2(s[4 * 65], s[5 * 65]); o.w = pk2(s[6 * 65], s[7 * 65]);
        *(u32x4*)(WT + (size_t)conv_dst_row(mode, n0 + n) * K + k0 + 8 * c) = o; }
    LDS_WAIT(); asm volatile("" ::: "memory");
}
__device__ __forceinline__ void p0_convert(Frame& F, int layer) {
    PHASE_IDS(); PHASE_ARGS();
    LAS float* scr = (LAS float*)(F.lds + w * 16640);
    const int gw = F.bid * 8 + w, NGW = F.G * 8;
    unsigned char* ws = F.ws;
    const float* w_in = ap->in[2] + (size_t)layer * D_MODEL * IN_WIDTH;
    const float* w_hg = ap->in[5] + (size_t)layer * HG_WIDTH * D_MODEL;
    const float* w_att = ap->in[6] + (size_t)layer * ATT_OUT * D_MODEL;
    const float* w_out = ap->in[7] + (size_t)layer * D_MODEL * D_MODEL;
    const float* w_eg = ap->in[12] + (size_t)layer * N_EXPERTS * D_MODEL * EXPERT_FF;
    const float* w_eu = ap->in[13] + (size_t)layer * N_EXPERTS * D_MODEL * EXPERT_FF;
    const float* w_ed = ap->in[14] + (size_t)layer * N_EXPERTS * EXPERT_FF * D_MODEL;
    const float* w_sg = ap->in[15] + (size_t)layer * D_MODEL * EXPERT_FF;
    const float* w_su = ap->in[16] + (size_t)layer * D_MODEL * EXPERT_FF;
    const float* w_sd = ap->in[17] + (size_t)layer * EXPERT_FF * D_MODEL;
    constexpr int I_IN = (D_MODEL / 64) * (IN_WIDTH / 64), I_HG = (HG_WIDTH / 64) * (D_MODEL / 64), I_ATT = (ATT_OUT / 64) * (D_MODEL / 64), I_OUT = (D_MODEL / 64) * (D_MODEL / 64);
    constexpr int I_E = (D_MODEL / 64) * (EXPERT_FF / 64);
    constexpr int NITEMS = I_IN + I_HG + I_ATT + I_OUT + 3 * NEXP1 * I_E;
    for (int it = gw; it < NITEMS; it += NGW) {
        int r = it;
        if (r < I_IN) { conv_item(w_in, D_MODEL, IN_WIDTH, (bf16_t*)(ws + WS_WIN), 1, scr, r, lane); continue; } r -= I_IN;
        if (r < I_HG) { conv_item(w_hg, HG_WIDTH, D_MODEL, (bf16_t*)(ws + WS_WHG), 0, scr, r, lane); continue; } r -= I_HG;
        if (r < I_ATT) { conv_item(w_att, ATT_OUT, D_MODEL, (bf16_t*)(ws + WS_WATT), 0, scr, r, lane); continue; } r -= I_ATT;
        if (r < I_OUT) { conv_item(w_out, D_MODEL, D_MODEL, (bf16_t*)(ws + WS_WOUT), 0, scr, r, lane); continue; } r -= I_OUT;
        const int which = r / (NEXP1 * I_E); r -= which * (NEXP1 * I_E);
        const int e = r / I_E, ri = r % I_E;
        if (which == 0) { const float* src = (e < N_EXPERTS) ? w_eg + (size_t)e * D_MODEL * EXPERT_FF : w_sg;
            conv_item(src, D_MODEL, EXPERT_FF, (bf16_t*)(ws + WS_WGU) + (size_t)e * 1024 * D_MODEL, 2, scr, ri, lane); }
        else if (which == 1) { const float* src = (e < N_EXPERTS) ? w_eu + (size_t)e * D_MODEL * EXPERT_FF : w_su;
            conv_item(src, D_MODEL, EXPERT_FF, (bf16_t*)(ws + WS_WGU) + (size_t)e * 1024 * D_MODEL, 3, scr, ri, lane); }
        else { const float* src = (e < N_EXPERTS) ? w_ed + (size_t)e * EXPERT_FF * D_MODEL : w_sd;
            conv_item(src, EXPERT_FF, D_MODEL, (bf16_t*)(ws + WS_WDN) + (size_t)e * D_MODEL * EXPERT_FF, 0, scr, ri, lane); }
    }
    if (layer == 0) {
        const f32x4* x4 = (const f32x4*)ap->in[0]; u32x2* xb = (u32x2*)(ws + WS_XB);
        for (size_t i = (size_t)F.bid * 512 + tid; i < (size_t)T * D_MODEL / 4; i += (size_t)F.G * 512) { const f32x4 v = x4[i]; u32x2 o; o.x = pk2(v[0], v[1]); o.y = pk2(v[2], v[3]); xb[i] = o; }
        const int* pos = (const int*)ap->in[1]; f32x2* rt = (f32x2*)(ws + WS_ROPE);
        for (int i = F.bid * 512 + tid; i < T * 64; i += F.G * 512) { const int tk = i >> 6, fi = i & 63;
            const double inv = exp2(-(double)fi * (13.287712379549449 / 64.0));
            const double ang = (double)pos[tk] * inv; const double red = ang - rint(ang * 0.15915494309189535) * 6.283185307179586;
            const float rf = (float)red; rt[i] = (f32x2){cosf(rf), sinf(rf)}; }
        const float* lbl = ap->in[3]; float* lb = (float*)(ws + WS_LB);
        for (int c = F.bid * 512 + tid; c < HG_WIDTH; c += F.G * 512) {
            float mx = -1e30f; for (int l = 0; l < DEPTH; ++l) mx = fmaxf(mx, lbl[l * HG_WIDTH + c]);
            float den = 0.f; for (int l = 0; l < DEPTH; ++l) den += expf(lbl[l * HG_WIDTH + c] - mx);
            float cum = 0.f, c0 = 0.f; for (int l = 0; l < DEPTH; ++l) { cum += expf(lbl[l * HG_WIDTH + c] - mx) / den; if (l == 0) c0 = cum; lb[l * HG_WIDTH + c] = cum - c0; }
        }
    }
}

constexpr int TROW = 272;
__device__ __forceinline__ void h1_item(Frame& F, int chunk) {
    const bf16_t* H = (const bf16_t*)(F.ws + WS_H); const float* LF = (const float*)(F.ws + WS_LF);
    float* UT = (float*)(F.ws + WS_UT); float* DEC = (float*)(F.ws + WS_DEC);
    const int bh = chunk >> 5, n = chunk & 31, b = bh >> 3, head = bh & 7, tok0 = b * SEQ + n * 64;
    LAS unsigned char* KT = F.lds; LAS unsigned char* VT = F.lds + 17408; LAS float* TOT = (LAS float*)(F.lds + 34816);
    PHASE_IDS();
    const int kk = tid & 127, part = tid >> 7, g = lane >> 4, i = lane & 15;
    float lf[16], cum[16];
    { const float* p = LF + (size_t)(tok0 + part * 16) * HG_WIDTH + head * 128 + kk;
#pragma unroll
      for (int j = 0; j < 16; ++j) lf[j] = p[(size_t)j * HG_WIDTH]; }
#pragma unroll
    for (int j = 0; j < 2; ++j) { const int c = tid + 512 * j, row = c >> 4, ch = c & 15;
        const u32x4 v = *(const u32x4*)(H + (size_t)(tok0 + row) * IN_WIDTH + C_HI + head * 128 + ch * 8);
        *(LAS u32x4*)(VT + row * TROW + ch * 16) = v; }
    float run = 0.f;
#pragma unroll
    for (int j = 0; j < 16; ++j) { run += lf[j]; cum[j] = run; }
    TOT[part * 128 + kk] = run;
    __syncthreads();
    float off = 0.f, end = 0.f;
#pragma unroll
    for (int p = 0; p < 4; ++p) { const float t = TOT[p * 128 + kk]; if (p < part) off += t; end += t; }
#pragma unroll
    for (int j = 0; j < 16; ++j) { const float c = cum[j] + off; const float kt = -expm1f(lf[j]) * __expf(end - c);
        *(LAS unsigned short*)(KT + (part * 16 + j) * TROW + kk * 2) = (unsigned short)f2bf(kt); }
    if (part == 0) DEC[(size_t)chunk * 128 + kk] = __expf(end);
    __syncthreads();
    const unsigned ktb = (unsigned)(size_t)KT, vtb = (unsigned)(size_t)VT;
    const int q = i >> 2, p4 = i & 3;
    bf16x8 af[2];
#pragma unroll
    for (int ks = 0; ks < 2; ++ks) { const s16x4 lo = tr_read(ktb + (32 * ks + 8 * g + q) * TROW + (16 * w + 4 * p4) * 2), hi = tr_read(ktb + (32 * ks + 8 * g + 4 + q) * TROW + (16 * w + 4 * p4) * 2);
        af[ks] = (bf16x8){lo[0], lo[1], lo[2], lo[3], hi[0], hi[1], hi[2], hi[3]}; }
#pragma unroll
    for (int vb = 0; vb < 8; ++vb) { f32x4 acc = {0.f, 0.f, 0.f, 0.f};
#pragma unroll
        for (int ks = 0; ks < 2; ++ks) { const s16x4 lo = tr_read(vtb + (32 * ks + 8 * g + q) * TROW + (16 * vb + 4 * p4) * 2), hi = tr_read(vtb + (32 * ks + 8 * g + 4 + q) * TROW + (16 * vb + 4 * p4) * 2);
            const bf16x8 bfr = (bf16x8){lo[0], lo[1], lo[2], lo[3], hi[0], hi[1], hi[2], hi[3]};
            acc = mfma16(af[ks], bfr, acc); }
        *(f32x4*)(UT + (size_t)chunk * 16384 + (16 * vb + i) * 128 + 16 * w + 4 * g) = acc; }
    __syncthreads();
}

__device__ __forceinline__ void attn_item(Frame& F, int it) {
    bf16_t* H = (bf16_t*)(F.ws + WS_H); float* LSE = (float*)(F.ws + WS_LSE);
    const int b = it / 192, rem = it % 192, h = rem >> 4, j = rem & 15, grp = h >> 2, dsh = 2 * grp, d = 1 << dsh, r = j & (d - 1), qb = j >> dsh;
    const int lbase = 128 * (qb - 1);
    bf16_t* Hb = H + (size_t)b * SEQ * IN_WIDTH;
    LAS unsigned char* KT = F.lds; LAS unsigned char* VT = F.lds + 256 * TROW;
    PHASE_IDS();
    const int g = lane >> 4, i = lane & 15;
#pragma unroll
    for (int jj = 0; jj < 8; ++jj) { const int c = tid + 512 * jj, row = c >> 4, ch = c & 15; int l = lbase + row; l = l < 0 ? 0 : l; const size_t tok = (size_t)(l * d + r);
        const u32x4 kv = *(const u32x4*)(Hb + tok * IN_WIDTH + C_AK + h * 128 + ch * 8), vv = *(const u32x4*)(Hb + tok * IN_WIDTH + C_AV + h * 128 + ch * 8);
        *(LAS u32x4*)(KT + row * TROW + ch * 16) = kv; *(LAS u32x4*)(VT + row * TROW + ch * 16) = vv; }
    const size_t tokq = (size_t)((128 * qb + 16 * w + i) * d + r);
    bf16x8 qf[4];
#pragma unroll
    for (int ks = 0; ks < 4; ++ks) qf[ks] = *(const bf16x8*)(Hb + tokq * IN_WIDTH + C_AQ + h * 128 + 32 * ks + 8 * g);
    __syncthreads();
    f32x4 s[9];
#pragma unroll
    for (int jb = 0; jb < 9; ++jb) { f32x4 a4 = {0.f, 0.f, 0.f, 0.f};
#pragma unroll
        for (int ks = 0; ks < 4; ++ks) { const bf16x8 a = *(const LAS bf16x8*)(KT + (16 * (w + jb) + i) * TROW + (32 * ks + 8 * g) * 2); a4 = mfma16(a, qf[ks], a4); }
        s[jb] = a4; }
    float mx = -1e30f;
#pragma unroll
    for (int jb = 0; jb < 9; ++jb)
#pragma unroll
        for (int rg = 0; rg < 4; ++rg) { const int kin = 4 * g + rg, dist = 128 - 16 * jb + i - kin, lk = lbase + 16 * (w + jb) + kin;
            const bool valid = ((unsigned)dist <= 128u) && (lk >= 0);
            const float v = valid ? s[jb][rg] : -INFINITY; s[jb][rg] = v; mx = fmaxf(mx, v); }
    mx = fmaxf(mx, __shfl_xor(mx, 16)); mx = fmaxf(mx, __shfl_xor(mx, 32));
    float den = 0.f;
#pragma unroll
    for (int jb = 0; jb < 9; ++jb)
#pragma unroll
        for (int rg = 0; rg < 4; ++rg) { const float p = __expf(s[jb][rg] - mx); s[jb][rg] = p; den += p; }
    den += __shfl_xor(den, 16); den += __shfl_xor(den, 32);
    f32x4 o[8];
#pragma unroll
    for (int db = 0; db < 8; ++db) o[db] = (f32x4){0.f, 0.f, 0.f, 0.f};
    const unsigned vtb = (unsigned)(size_t)VT; const int q = i >> 2, p4 = i & 3;
#pragma unroll
    for (int kp = 0; kp < 5; ++kp) {
        bf16x8 pb; { const unsigned a0 = cvt_pk_bf16(s[2 * kp][0], s[2 * kp][1]), a1 = cvt_pk_bf16(s[2 * kp][2], s[2 * kp][3]);
            unsigned b0 = 0u, b1 = 0u; if (kp < 4) { b0 = cvt_pk_bf16(s[2 * kp + 1][0], s[2 * kp + 1][1]); b1 = cvt_pk_bf16(s[2 * kp + 1][2], s[2 * kp + 1][3]); }
            const u32x4 t4 = {a0, a1, b0, b1}; pb = __builtin_bit_cast(bf16x8, t4); }
        const int r0 = 16 * (w + 2 * kp) + 4 * g + q, r1 = (kp < 4) ? r0 + 16 : r0;
#pragma unroll
        for (int db = 0; db < 8; ++db) { const s16x4 lo = tr_read(vtb + r0 * TROW + (16 * db + 4 * p4) * 2), hi = tr_read(vtb + r1 * TROW + (16 * db + 4 * p4) * 2);
            const bf16x8 a = (bf16x8){lo[0], lo[1], lo[2], lo[3], hi[0], hi[1], hi[2], hi[3]};
            o[db] = mfma16(a, pb, o[db]); }
    }
    const float rden = __fdividef(1.0f, den);
#pragma unroll
    for (int db = 0; db < 8; ++db) { u32x2 wv; wv.x = cvt_pk_bf16(o[db][0] * rden, o[db][1] * rden); wv.y = cvt_pk_bf16(o[db][2] * rden, o[db][3] * rden);
        *(u32x2*)(Hb + tokq * IN_WIDTH + C_AQ + h * 128 + 16 * db + 4 * g) = wv; }
    if (g == 0) LSE[((size_t)b * SEQ + tokq) * ATT_HEADS + h] = mx + __logf(den);
    __syncthreads();
}

__device__ __forceinline__ void scan_item(Frame& F, int item) {
    const float* UT = (const float*)(F.ws + WS_UT); const float* DEC = (const float*)(F.ws + WS_DEC); bf16_t* SPT = (bf16_t*)(F.ws + WS_SPT);
    PHASE_IDS();
    const int bh = item >> 2, q4 = item & 3, vv = q4 * 32 + (tid >> 4), kk0 = (tid & 15) * 8;
    f32x4 s0 = {0.f, 0.f, 0.f, 0.f}, s1 = {0.f, 0.f, 0.f, 0.f};
#pragma unroll 4
    for (int n = 0; n < 32; ++n) { const size_t chunk = (size_t)bh * 32 + n; const size_t eo = chunk * 16384 + (size_t)vv * 128 + kk0;
        const f32x4 u0 = *(const f32x4*)(UT + eo), u1 = *(const f32x4*)(UT + eo + 4), d0 = *(const f32x4*)(DEC + chunk * 128 + kk0), d1 = *(const f32x4*)(DEC + chunk * 128 + kk0 + 4);
        u32x4 wv; wv.x = cvt_pk_bf16(s0[0], s0[1]); wv.y = cvt_pk_bf16(s0[2], s0[3]); wv.z = cvt_pk_bf16(s1[0], s1[1]); wv.w = cvt_pk_bf16(s1[2], s1[3]);
        *(u32x4*)(SPT + eo) = wv;
        s0 = d0 * s0 + u0; s1 = d1 * s1 + u1; }
}
__device__ __forceinline__ void attn_merge(Frame& F) {
    const bf16_t* H = (const bf16_t*)(F.ws + WS_H); const float* LSE = (const float*)(F.ws + WS_LSE); bf16_t* ATTO = (bf16_t*)(F.ws + WS_ATTO);
    PHASE_IDS();
    const int gw = F.bid * 8 + w, NGW = F.G * 8, hg = lane >> 4, d0 = (lane & 15) * 8;
    for (int t = gw; t < T; t += NGW) {
        const float l0 = LSE[(size_t)t * ATT_HEADS + hg], l1 = LSE[(size_t)t * ATT_HEADS + 4 + hg], l2 = LSE[(size_t)t * ATT_HEADS + 8 + hg];
        const float mx = fmaxf(l0, fmaxf(l1, l2)); float w0 = __expf(l0 - mx), w1 = __expf(l1 - mx), w2 = __expf(l2 - mx); const float rs = __fdividef(1.0f, w0 + w1 + w2); w0 *= rs; w1 *= rs; w2 *= rs;
        const bf16_t* base = H + (size_t)t * IN_WIDTH + C_AQ + hg * 128 + d0;
        const u32x4 a = *(const u32x4*)base, bq = *(const u32x4*)(base + 512), c = *(const u32x4*)(base + 1024);
        u32x4 wv;
        wv.x = cvt_pk_bf16(w0 * bflo(a.x) + w1 * bflo(bq.x) + w2 * bflo(c.x), w0 * bfhi(a.x) + w1 * bfhi(bq.x) + w2 * bfhi(c.x));
        wv.y = cvt_pk_bf16(w0 * bflo(a.y) + w1 * bflo(bq.y) + w2 * bflo(c.y), w0 * bfhi(a.y) + w1 * bfhi(bq.y) + w2 * bfhi(c.y));
        wv.z = cvt_pk_bf16(w0 * bflo(a.z) + w1 * bflo(bq.z) + w2 * bflo(c.z), w0 * bfhi(a.z) + w1 * bfhi(bq.z) + w2 * bfhi(c.z));
        wv.w = cvt_pk_bf16(w0 * bflo(a.w) + w1 * bflo(bq.w) + w2 * bflo(c.w), w0 * bfhi(a.w) + w1 * bfhi(bq.w) + w2 * bfhi(c.w));
        *(u32x4*)(ATTO + (size_t)t * ATT_OUT + hg * 128 + d0) = wv;
    }
}

__device__ __forceinline__ void h3_item(Frame& F, int chunk, const float* normg) {
    const bf16_t* H = (const bf16_t*)(F.ws + WS_H); const float* LF = (const float*)(F.ws + WS_LF); const bf16_t* SPT = (const bf16_t*)(F.ws + WS_SPT); bf16_t* HGO = (bf16_t*)(F.ws + WS_HGO);
    const int bh = chunk >> 5, n = chunk & 31, b = bh >> 3, head = bh & 7, tok0 = b * SEQ + n * 64;
    LAS unsigned char* QT = F.lds; LAS unsigned char* QH = F.lds + 17408; LAS unsigned char* KH = F.lds + 34816; LAS unsigned char* VT = F.lds + 52224; LAS unsigned char* SP = F.lds + 69632;
    LAS float* TOT = (LAS float*)(F.lds + 104448); LAS float* RS = (LAS float*)(F.lds + 106496);
    PHASE_IDS();
    const int kk = tid & 127, part = tid >> 7, g = lane >> 4, i = lane & 15;
    float lf[16], cum[16], qv[16];
    { const float* p = LF + (size_t)(tok0 + part * 16) * HG_WIDTH + head * 128 + kk; const bf16_t* pq = H + (size_t)(tok0 + part * 16) * IN_WIDTH + C_HQ + head * 128 + kk;
#pragma unroll
      for (int j = 0; j < 16; ++j) { lf[j] = p[(size_t)j * HG_WIDTH]; qv[j] = bf2f(pq[(size_t)j * IN_WIDTH]); } }
#pragma unroll
    for (int j = 0; j < 2; ++j) { const int c = tid + 512 * j, row = c >> 4, ch = c & 15;
        const u32x4 v = *(const u32x4*)(H + (size_t)(tok0 + row) * IN_WIDTH + C_HI + head * 128 + ch * 8);
        *(LAS u32x4*)(VT + row * TROW + ch * 16) = v; }
#pragma unroll
    for (int j = 0; j < 4; ++j) { const int c = tid + 512 * j, row = c >> 4, ch = c & 15;
        const u32x4 v = *(const u32x4*)(SPT + (size_t)chunk * 16384 + row * 128 + ch * 8);
        *(LAS u32x4*)(SP + row * TROW + ch * 16) = v; }
    float run = 0.f;
#pragma unroll
    for (int j = 0; j < 16; ++j) { run += lf[j]; cum[j] = run; }
    TOT[part * 128 + kk] = run;
    __syncthreads();
    float off = 0.f;
#pragma unroll
    for (int p = 0; p < 4; ++p) { const float t = TOT[p * 128 + kk]; if (p < part) off += t; }
    const float cmid = TOT[kk] + TOT[128 + kk];
#pragma unroll
    for (int j = 0; j < 16; ++j) { const float c = cum[j] + off; const int t = part * 16 + j; const float kq = -expm1f(lf[j]);
        *(LAS unsigned short*)(QT + t * TROW + kk * 2) = (unsigned short)f2bf(qv[j] * __expf(c));
        *(LAS unsigned short*)(QH + t * TROW + kk * 2) = (unsigned short)f2bf(qv[j] * __expf(fminf(c - cmid, 60.f)));
        *(LAS unsigned short*)(KH + t * TROW + kk * 2) = (unsigned short)f2bf(kq * __expf(fminf(cmid - c, 60.f))); }
    __syncthreads();
    const int tb = w & 3, vh = w >> 2;
    f32x4 at[4];
#pragma unroll
    for (int sb = 0; sb < 4; ++sb) { f32x4 a4 = {0.f, 0.f, 0.f, 0.f};
        if (sb <= tb) {
#pragma unroll
            for (int ks = 0; ks < 4; ++ks) { const bf16x8 a = *(const LAS bf16x8*)(KH + (16 * sb + i) * TROW + (32 * ks + 8 * g) * 2), bq = *(const LAS bf16x8*)(QH + (16 * tb + i) * TROW + (32 * ks + 8 * g) * 2);
                a4 = mfma16(a, bq, a4); }
            if (sb == tb) {
#pragma unroll
                for (int rg = 0; rg < 4; ++rg) a4[rg] = (4 * g + rg <= i) ? a4[rg] : 0.f; }
        }
        at[sb] = a4; }
    bf16x8 pb[2];
#pragma unroll
    for (int kp = 0; kp < 2; ++kp) { const u32x4 t4 = {cvt_pk_bf16(at[2 * kp][0], at[2 * kp][1]), cvt_pk_bf16(at[2 * kp][2], at[2 * kp][3]), cvt_pk_bf16(at[2 * kp + 1][0], at[2 * kp + 1][1]), cvt_pk_bf16(at[2 * kp + 1][2], at[2 * kp + 1][3])};
        pb[kp] = __builtin_bit_cast(bf16x8, t4); }
    const unsigned vtb = (unsigned)(size_t)VT; const int q = i >> 2, p4 = i & 3;
    f32x4 o[4]; float ss = 0.f;
#pragma unroll
    for (int vb = 0; vb < 4; ++vb) { const int vblk = 4 * vh + vb; f32x4 acc = {0.f, 0.f, 0.f, 0.f};
#pragma unroll
        for (int ks = 0; ks < 4; ++ks) { const bf16x8 a = *(const LAS bf16x8*)(SP + (16 * vblk + i) * TROW + (32 * ks + 8 * g) * 2), bq = *(const LAS bf16x8*)(QT + (16 * tb + i) * TROW + (32 * ks + 8 * g) * 2);
            acc = mfma16(a, bq, acc); }
#pragma unroll
        for (int kp = 0; kp < 2; ++kp) { const s16x4 lo = tr_read(vtb + (32 * kp + 4 * g + q) * TROW + (16 * vblk + 4 * p4) * 2), hi = tr_read(vtb + (32 * kp + 16 + 4 * g + q) * TROW + (16 * vblk + 4 * p4) * 2);
            const bf16x8 a = (bf16x8){lo[0], lo[1], lo[2], lo[3], hi[0], hi[1], hi[2], hi[3]};
            acc = mfma16(a, pb[kp], acc); }
        o[vb] = acc; ss += (acc[0] * acc[0] + acc[1] * acc[1]) + (acc[2] * acc[2] + acc[3] * acc[3]); }
    ss += __shfl_xor(ss, 16); ss += __shfl_xor(ss, 32);
    if (g == 0) RS[vh * 64 + 16 * tb + i] = ss;
    __syncthreads();
    const float tot = RS[16 * tb + i] + RS[64 + 16 * tb + i];
    const float rinv = rsqrtf(tot * (1.0f / 128.0f) + NORM_EPS);
    const size_t tok = (size_t)(tok0 + 16 * tb + i);
#pragma unroll
    for (int vb = 0; vb < 4; ++vb) { const int vv = 16 * (4 * vh + vb) + 4 * g;
        const f32x4 ng = *(const f32x4*)(normg + head * 128 + vv); const u32x2 gt = *(const u32x2*)(H + tok * IN_WIDTH + C_HGATE + head * 128 + vv);
        u32x2 wv; wv.x = cvt_pk_bf16(o[vb][0] * rinv * ng[0] * bflo(gt.x), o[vb][1] * rinv * ng[1] * bfhi(gt.x)); wv.y = cvt_pk_bf16(o[vb][2] * rinv * ng[2] * bflo(gt.y), o[vb][3] * rinv * ng[3] * bfhi(gt.y));
        *(u32x2*)(HGO + tok * HG_WIDTH + head * 128 + vv) = wv; }
    __syncthreads();
}

__device__ __forceinline__ void ln_router_phase(Frame& F, int layer) {
    PHASE_ARGS();
    const float* R = (const float*)(F.ws + WS_R); float* X1 = (float*)(F.ws + WS_X1); bf16_t* X1B = (bf16_t*)(F.ws + WS_X1B);
    const float* g1 = ap->in[8] + (size_t)layer * D_MODEL; const float* b1 = ap->in[9] + (size_t)layer * D_MODEL;
    const float* wrt = ap->in[10] + (size_t)layer * D_MODEL * N_EXPERTS; const float* rbias = ap->in[11] + (size_t)layer * N_EXPERTS;
    int* PE = (int*)(F.ws + WS_PE); int* PP = (int*)(F.ws + WS_PP); float* PG = (float*)(F.ws + WS_PG); int* RM = (int*)(F.ws + WS_RM);
    unsigned* cnt = F.ctl + CW_CNT + layer * 64;
    constexpr int XSLD = 1028;
    LAS float* XS = (LAS float*)F.lds; LAS float* PART = (LAS float*)(F.lds + 16 * XSLD * 4); LAS float* LG = (LAS float*)(F.lds + 16 * XSLD * 4 + 32768);
    PHASE_IDS();
    const int g = lane >> 4, i = lane & 15;
    for (int tile = F.bid; tile < T / 16; tile += F.G) {
        const int tok0 = tile * 16;
        f32x4 ys[2][8];
#pragma unroll
        for (int tt = 0; tt < 2; ++tt) { const size_t token = (size_t)(tok0 + 2 * w + tt);
            const f32x4* rp = (const f32x4*)(R + token * D_MODEL) + lane; float s = 0.f;
#pragma unroll
            for (int j = 0; j < 8; ++j) { ys[tt][j] = rp[64 * j]; s += (ys[tt][j][0] + ys[tt][j][1]) + (ys[tt][j][2] + ys[tt][j][3]); }
            const float mean = wave_sum(s) * (1.0f / D_MODEL); float s2 = 0.f;
#pragma unroll
            for (int j = 0; j < 8; ++j) { ys[tt][j] = ys[tt][j] - mean; s2 += (ys[tt][j][0] * ys[tt][j][0] + ys[tt][j][1] * ys[tt][j][1]) + (ys[tt][j][2] * ys[tt][j][2] + ys[tt][j][3] * ys[tt][j][3]); }
            const float rstd = rsqrtf(wave_sum(s2) * (1.0f / D_MODEL) + LN_EPS);
#pragma unroll
            for (int j = 0; j < 8; ++j) { const f32x4 gg = *((const f32x4*)g1 + lane + 64 * j), bb = *((const f32x4*)b1 + lane + 64 * j);
                const f32x4 y = ys[tt][j] * rstd * gg + bb; ys[tt][j] = y;
                *((f32x4*)(X1 + token * D_MODEL) + lane + 64 * j) = y;
                u32x2 o; o.x = cvt_pk_bf16(y[0], y[1]); o.y = cvt_pk_bf16(y[2], y[3]); *((u32x2*)(X1B + token * D_MODEL) + lane + 64 * j) = o; }
        }
        f32x4 dacc[4];
#pragma unroll
        for (int nb = 0; nb < 4; ++nb) dacc[nb] = (f32x4){0.f, 0.f, 0.f, 0.f};
#pragma unroll
        for (int half = 0; half < 2; ++half) {
#pragma unroll
            for (int tt = 0; tt < 2; ++tt)
#pragma unroll
                for (int j = 0; j < 4; ++j) *(LAS f32x4*)(XS + (2 * w + tt) * XSLD + 4 * lane + 256 * j) = ys[tt][4 * half + j];
            __syncthreads();
#pragma unroll 2
            for (int kg = 0; kg < 8; ++kg) { const int kb = 128 * w + 16 * kg; const f32x4 a4 = *(const LAS f32x4*)(XS + i * XSLD + kb + 4 * g);
#pragma unroll
                for (int s = 0; s < 4; ++s) { const f32x4 b4 = *(const f32x4*)(wrt + (size_t)(half * 1024 + kb + 4 * g + s) * N_EXPERTS + 4 * i);
#pragma unroll
                    for (int nb = 0; nb < 4; ++nb) dacc[nb] = __builtin_amdgcn_mfma_f32_16x16x4f32(a4[s], b4[nb], dacc[nb], 0, 0, 0); } }
            __syncthreads();
        }
#pragma unroll
        for (int rg = 0; rg < 4; ++rg) *(LAS f32x4*)(PART + ((w * 16 + 4 * g + rg) * 64 + 4 * i)) = (f32x4){dacc[0][rg], dacc[1][rg], dacc[2][rg], dacc[3][rg]};
        __syncthreads();
        { const int tk = tid >> 5, e2 = (tid & 31) * 2; float a = 0.f, b = 0.f;
#pragma unroll
          for (int ww = 0; ww < 8; ++ww) { a += PART[(ww * 16 + tk) * 64 + e2]; b += PART[(ww * 16 + tk) * 64 + e2 + 1]; }
          LG[tk * 64 + e2] = a; LG[tk * 64 + e2 + 1] = b; }
        if (tid < 16) RM[(size_t)N_EXPERTS * T + tok0 + tid] = tok0 + tid;
        __syncthreads();
#pragma unroll 1
        for (int tt = 0; tt < 2; ++tt) { const int tk = 2 * w + tt, token = tok0 + tk, e = lane;
            const float sc = 1.0f / (1.0f + expf(-LG[tk * 64 + e])); const float sel = sc + rbias[e];
            float m1 = sel; m1 = fmaxf(m1, __shfl_xor(m1, 1)); m1 = fmaxf(m1, __shfl_xor(m1, 2)); m1 = fmaxf(m1, __shfl_xor(m1, 4));
            const unsigned long long bal = __ballot(sel == m1) & (0xFFull << (8 * (e >> 3)));
            const int first = __builtin_ctzll(bal);
            float v2 = (e == first) ? -INFINITY : sel; v2 = fmaxf(v2, __shfl_xor(v2, 1)); v2 = fmaxf(v2, __shfl_xor(v2, 2)); v2 = fmaxf(v2, __shfl_xor(v2, 4));
            const float gs = m1 + v2; int grank = 0;
#pragma unroll
            for (int gp = 0; gp < 8; ++gp) { const float o = __builtin_bit_cast(float, __builtin_amdgcn_readlane(__builtin_bit_cast(int, gs), 8 * gp)); grank += (o > gs || (o == gs && gp < (e >> 3))) ? 1 : 0; }
            const float sel2 = (grank < TOPK_GROUPS) ? sel : -INFINITY; int rank = 0;
#pragma unroll
            for (int ep = 0; ep < 64; ++ep) { const float o = __builtin_bit_cast(float, __builtin_amdgcn_readlane(__builtin_bit_cast(int, sel2), ep)); rank += (o > sel2 || (o == sel2 && ep < e)) ? 1 : 0; }
            const bool chosen = rank < TOP_K;
            const float wsum = wave_sum(chosen ? sc : 0.f);
            if (chosen) { const int pos = (int)atomicAdd(cnt + e, 1u);
                PE[(size_t)token * 8 + rank] = e; PP[(size_t)token * 8 + rank] = pos; PG[(size_t)token * 8 + rank] = sc / wsum * ROUTED_SCALE; RM[(size_t)e * T + pos] = token; }
        }
        __syncthreads();
    }
}

__device__ __forceinline__ void build_toff(Frame& F, int layer) {
    LAS int* toff = (LAS int*)(F.lds + LDS_TAB);
    if (threadIdx.x == 0) { const unsigned* cnt = F.ctl + CW_CNT + layer * 64; int acc = 0;
        for (int e = 0; e < N_EXPERTS; ++e) { toff[e] = acc; acc += ((int)__hip_atomic_load(cnt + e, RLX_AGENT) + 255) >> 8; }
        toff[N_EXPERTS] = acc; toff[NEXP1] = acc + T / 256; }
    __syncthreads();
}

__device__ __forceinline__ void combine_ln2_phase(Frame& F, int layer) {
    PHASE_ARGS(); float* OUT = ap->out;
    const bf16_t* Y = (const bf16_t*)(F.ws + WS_Y); const float* X1 = (const float*)(F.ws + WS_X1); bf16_t* XB = (bf16_t*)(F.ws + WS_XB);
    const float* g2 = ap->in[18] + (size_t)layer * D_MODEL; const float* b2 = ap->in[19] + (size_t)layer * D_MODEL;
    const int* PE = (const int*)(F.ws + WS_PE); const int* PP = (const int*)(F.ws + WS_PP); const float* PG = (const float*)(F.ws + WS_PG);
    const LAS int* toff = (const LAS int*)(F.lds + LDS_TAB);
    PHASE_IDS();
    const int gw = F.bid * 8 + w, NGW = F.G * 8;
    for (int t = gw; t < T; t += NGW) {
        f32x4 a[4][2];
#pragma unroll
        for (int j = 0; j < 4; ++j) { a[j][0] = (f32x4){0.f, 0.f, 0.f, 0.f}; a[j][1] = (f32x4){0.f, 0.f, 0.f, 0.f}; }
#pragma unroll
        for (int k = 0; k < 9; ++k) { size_t row; float gt;
            if (k < 8) { const int e = PE[(size_t)t * 8 + k]; row = (size_t)toff[e] * 256 + PP[(size_t)t * 8 + k]; gt = PG[(size_t)t * 8 + k]; }
            else { row = (size_t)toff[N_EXPERTS] * 256 + t; gt = 1.0f; }
            const u32x4* yp = (const u32x4*)(Y + row * D_MODEL) + lane;
#pragma unroll
            for (int j = 0; j < 4; ++j) { const u32x4 y = yp[64 * j];
                a[j][0] += (f32x4){bflo(y.x), bfhi(y.x), bflo(y.y), bfhi(y.y)} * gt; a[j][1] += (f32x4){bflo(y.z), bfhi(y.z), bflo(y.w), bfhi(y.w)} * gt; } }
        float s = 0.f;
#pragma unroll
        for (int j = 0; j < 4; ++j) { const f32x4* xp = (const f32x4*)(X1 + (size_t)t * D_MODEL + 8 * lane + 512 * j);
            a[j][0] += xp[0] * DN_ALPHA; a[j][1] += xp[1] * DN_ALPHA;
            s += (a[j][0][0] + a[j][0][1]) + (a[j][0][2] + a[j][0][3]) + (a[j][1][0] + a[j][1][1]) + (a[j][1][2] + a[j][1][3]); }
        const float mean = wave_sum(s) * (1.0f / D_MODEL); float s2 = 0.f;
#pragma unroll
        for (int j = 0; j < 4; ++j) { a[j][0] = a[j][0] - mean; a[j][1] = a[j][1] - mean;
            s2 += (a[j][0][0] * a[j][0][0] + a[j][0][1] * a[j][0][1]) + (a[j][0][2] * a[j][0][2] + a[j][0][3] * a[j][0][3]) + (a[j][1][0] * a[j][1][0] + a[j][1][1] * a[j][1][1]) + (a[j][1][2] * a[j][1][2] + a[j][1][3] * a[j][1][3]); }
        const float rstd = rsqrtf(wave_sum(s2) * (1.0f / D_MODEL) + LN_EPS);
#pragma unroll
        for (int j = 0; j < 4; ++j) { const int c = 8 * lane + 512 * j;
            const f32x4 o0 = a[j][0] * rstd * *(const f32x4*)(g2 + c) + *(const f32x4*)(b2 + c), o1 = a[j][1] * rstd * *(const f32x4*)(g2 + c + 4) + *(const f32x4*)(b2 + c + 4);
            *(f32x4*)(OUT + (size_t)t * D_MODEL + c) = o0; *(f32x4*)(OUT + (size_t)t * D_MODEL + c + 4) = o1;
            u32x4 wv; wv.x = cvt_pk_bf16(o0[0], o0[1]); wv.y = cvt_pk_bf16(o0[2], o0[3]); wv.z = cvt_pk_bf16(o1[0], o1[1]); wv.w = cvt_pk_bf16(o1[2], o1[3]);
            *(u32x4*)(XB + (size_t)t * D_MODEL + c) = wv; }
    }
}

constexpr int PH_PER_LAYER = 11, N_PHASES = DEPTH * PH_PER_LAYER;
#ifndef PH_MASK
#define PH_MASK 0x7ff
#endif
#define IN(k) (((PH_MASK >> ((k) % PH_PER_LAYER)) & 1) && lo <= (k) && (k) < hi)
#define SEAM(k) do { if (IN(k) && IN((k) + 1)) xcd_barrier(bar); } while (0)
#define PHASE_FRAME() Frame F = F0; asm volatile("" : "+s"(F.ws), "+s"(F.ctl), "+s"(F.G), "+s"(F.bid), "+s"(F.lds)); unsigned char* ws = F.ws; (void)ws
template <int layer>
__device__ __forceinline__ void run_layer(const Frame& F0, const XcdBarrier& bar, const int lo, const int hi) {
        const int pb = layer * PH_PER_LAYER;
        if (IN(pb + 0)) { PHASE_FRAME(); p0_convert(F, layer); }
        SEAM(pb + 0);
        if (IN(pb + 1)) { PHASE_FRAME();
            DenseSched S{(const char*)(ws + WS_XB), (const char*)(ws + WS_WIN), D_MODEL * 2, D_MODEL * 2, D_MODEL / 64, T / 256, IN_WIDTH / 256, F.G, F.bid};
            EpiIn E{(bf16_t*)(ws + WS_H), (float*)(ws + WS_LF), (const float*)(ws + WS_LB) + layer * HG_WIDTH, (const f32x4*)(ws + WS_ROPE)};
            pg8::gemm_phase<EpiIn, DenseSched, false>(F.lds, S, E);
        }
        SEAM(pb + 1);
        if (IN(pb + 2)) { PHASE_FRAME();
            for (int it = F.bid; it < NCHUNK * HG_HEADS; it += F.G) h1_item(F, it);
            for (int it = F.bid; it < BATCH * ATT_HEADS * 16; it += F.G) attn_item(F, it);
        }
        SEAM(pb + 2);
        if (IN(pb + 3)) { PHASE_FRAME();
            for (int it = F.bid; it < BATCH * HG_HEADS * 4; it += F.G) scan_item(F, it);
            attn_merge(F);
        }
        SEAM(pb + 3);
        if (IN(pb + 4)) { PHASE_FRAME();
            PHASE_ARGS(); const float* normg = ap->in[4] + (size_t)layer * HG_WIDTH;
            for (int it = F.bid; it < NCHUNK * HG_HEADS; it += F.G) h3_item(F, it, normg);
        }
        SEAM(pb + 4);
        if (IN(pb + 5)) { PHASE_FRAME();
            MergeSched S{(const char*)(ws + WS_HGO), (const char*)(ws + WS_WHG), (const char*)(ws + WS_ATTO), (const char*)(ws + WS_WATT), T / 256, D_MODEL / 256, F.G, F.bid};
            EpiMerge E{(const bf16_t*)(ws + WS_H), (bf16_t*)(ws + WS_MRG)};
            pg8::gemm_phase<EpiMerge, MergeSched, false>(F.lds, S, E);
        }
        SEAM(pb + 5);
        if (IN(pb + 6)) { PHASE_FRAME();
            DenseSched S{(const char*)(ws + WS_MRG), (const char*)(ws + WS_WOUT), D_MODEL * 2, D_MODEL * 2, D_MODEL / 64, T / 256, D_MODEL / 256, F.G, F.bid};
            PHASE_ARGS(); EpiResid E{layer == 0 ? ap->in[0] : (const float*)ap->out, (float*)(ws + WS_R)};
            pg8::gemm_phase<EpiResid, DenseSched, false>(F.lds, S, E);
        }
        SEAM(pb + 6);
        if (IN(pb + 7)) { PHASE_FRAME(); ln_router_phase(F, layer); }
        SEAM(pb + 7);
        if (IN(pb + 8)) { PHASE_FRAME();
            build_toff(F, layer);
            MoeSched<4, true> S{(const LAS int*)(F.lds + LDS_TAB), F.ctl + CW_CNT + layer * 64, (const char*)(ws + WS_X1B), (const char*)(ws + WS_WGU), (const int*)(ws + WS_RM), F.G, F.bid};
            EpiGateUp E{(bf16_t*)(ws + WS_HID)};
            pg8::gemm_phase<EpiGateUp, MoeSched<4, true>, true>(F.lds, S, E);
        }
        SEAM(pb + 8);
        if (IN(pb + 9)) { PHASE_FRAME();
            build_toff(F, layer);
            MoeSched<8, false> S{(const LAS int*)(F.lds + LDS_TAB), F.ctl + CW_CNT + layer * 64, (const char*)(ws + WS_HID), (const char*)(ws + WS_WDN), nullptr, F.G, F.bid};
            EpiDown E{(bf16_t*)(ws + WS_Y)};
            pg8::gemm_phase<EpiDown, MoeSched<8, false>, false>(F.lds, S, E);
        }
        SEAM(pb + 9);
        if (IN(pb + 10)) { PHASE_FRAME(); build_toff(F, layer); combine_ln2_phase(F, layer); }
        SEAM(pb + 10);
}
#undef IN
#undef SEAM
__global__ void __launch_bounds__(512, 2) kfwd(Args args) {
    extern __shared__ __attribute__((aligned(16))) unsigned char lds_raw[];
    Frame F0;
    F0.lds = (LAS unsigned char*)lds_raw;
    F0.G = gridDim.x; F0.bid = blockIdx.x; F0.ws = args.ws; F0.ctl = (unsigned*)(args.ws + WS_CTL);
    for (int u = threadIdx.x; u < (LDS_BYTES - LDS_TAB) / 4; u += 512) ((LAS unsigned*)(F0.lds + LDS_TAB))[u] = 0u;
    __syncthreads();
    XcdBarrier bar = xcd_barrier_post(F0.ctl + CW_BAR, (volatile LAS unsigned*)(F0.lds + LDS_MISC));
    const int lo = args.ph_lo, hi = args.ph_hi;
    run_layer<0>(F0, bar, lo, hi);
    run_layer<1>(F0, bar, lo, hi);
}

extern "C" void kernel_launch(void* const* d_in, const int* in_sizes, int n_in, void* d_out, int out_size, void* d_ws, size_t ws_size, hipStream_t stream) {
    static int grid = 0;
    if (grid == 0) {
        if (n_in != 20 || out_size != T * D_MODEL || ws_size < WS_END) { fprintf(stderr, "kernel_launch: unexpected shapes (n_in %d, out %d, ws %zu < %zu)\n", n_in, out_size, ws_size, (size_t)WS_END); grid = -1; return; }
        int dev = 0, cus = 0, per_cu = 0;
        if (hipGetDevice(&dev) != hipSuccess || hipDeviceGetAttribute(&cus, hipDeviceAttributeMultiprocessorCount, dev) != hipSuccess) { grid = -1; return; }
        if (hipFuncSetAttribute((const void*)kfwd, hipFuncAttributeMaxDynamicSharedMemorySize, LDS_BYTES) != hipSuccess) { fprintf(stderr, "kernel_launch: hipFuncSetAttribute failed\n"); grid = -1; return; }
        if (hipOccupancyMaxActiveBlocksPerMultiprocessor(&per_cu, (const void*)kfwd, 512, LDS_BYTES) != hipSuccess || per_cu < 1) fprintf(stderr, "kernel_launch: occupancy query says %d\n", per_cu);
        (void)hipGetLastError();
        grid = cus;
    }
    if (grid < 0) return;
    if (hipMemsetAsync((char*)d_ws + WS_CTL, 0, CTL_ZERO_BYTES, stream) != hipSuccess) return;
    Args a{};
    for (int i = 0; i < 20; ++i) a.in[i] = (const float*)d_in[i];
    a.out = (float*)d_out; a.ws = (unsigned char*)d_ws;
#if MK_LAUNCH_PER_PHASE
    for (int p = 0; p < N_PHASES; ++p) { a.ph_lo = p; a.ph_hi = p + 1; hipLaunchKernelGGL(kfwd, dim3(grid), dim3(512), LDS_BYTES, stream, a); }
#else
    a.ph_lo = 0; a.ph_hi = N_PHASES; hipLaunchKernelGGL(kfwd, dim3(grid), dim3(512), LDS_BYTES, stream, a);
#endif
}
```

```cpp
#include <hip/hip_runtime.h>
#include <cstdio>
#include <cstdint>

#ifndef MK_LAUNCH_PER_PHASE
#define MK_LAUNCH_PER_PHASE 0
#endif

#define GAS __attribute__((address_space(1)))
#define LAS __attribute__((address_space(3)))
typedef unsigned short bf16_t;
typedef short bf16x8 __attribute__((ext_vector_type(8)));
typedef short s16x4 __attribute__((ext_vector_type(4)));
typedef float f32x4 __attribute__((ext_vector_type(4)));
typedef float f32x2 __attribute__((ext_vector_type(2)));
typedef unsigned u32x4 __attribute__((ext_vector_type(4)));
typedef unsigned u32x2 __attribute__((ext_vector_type(2)));
typedef _Float16 f16x8 __attribute__((ext_vector_type(8)));

constexpr int D_MODEL = 2048, BATCH = 8, SEQ = 2048, DEPTH = 2, T = BATCH * SEQ;
constexpr int HG_HEADS = 8, HG_DIM = 128, HG_WIDTH = 1024, HG_CHUNK = 64, NCHUNK = T / HG_CHUNK;
constexpr int ATT_HEADS = 12, ATT_DIM = 128, ATT_WIDTH = 1536, ATT_OUT = 512;
constexpr int N_EXPERTS = 64, N_GROUPS = 8, TOPK_GROUPS = 4, TOP_K = 8, EXPERT_FF = 512;
constexpr int IN_WIDTH = 12800;
constexpr int C_HQ = 0, C_HF = 1024, C_HI = 2048, C_HGATE = 3072, C_AQ = 4096, C_AK = 5632, C_AV = 7168, C_GH = 8704, C_GA = 10752;
constexpr float ROUTED_SCALE = 2.5f, LN_EPS = 1e-5f, NORM_EPS = 1e-6f;
constexpr float DN_ALPHA = 1.41421356237309515f;
#define HOFF(c, row) (((size_t)((c) >> 7) * T + (size_t)(row)) * 128 + ((c) & 127))
constexpr int NEXP1 = N_EXPERTS + 1;
constexpr int MAXROWS = 163840;

constexpr size_t MiB = 1u << 20;
constexpr size_t WS_CTL = 0, CTL_ZERO_BYTES = 1 * MiB;
constexpr size_t WS_WIN = 4 * MiB;
constexpr size_t WS_WHG = 54 * MiB;
constexpr size_t WS_WATT = 58 * MiB;
constexpr size_t WS_WOUT = 60 * MiB;
constexpr size_t WS_WGU = 68 * MiB;
constexpr size_t WS_WDN = 328 * MiB;
constexpr size_t WS_ROPE = 458 * MiB;
constexpr size_t WS_LB = 466 * MiB;
constexpr size_t WS_R = 467 * MiB;
constexpr size_t WS_X1 = 595 * MiB;
constexpr size_t WS_XB = 723 * MiB;
constexpr size_t WS_X1B = 787 * MiB;
constexpr size_t WS_PE = 851 * MiB;
constexpr size_t WS_PP = 852 * MiB;
constexpr size_t WS_PG = 853 * MiB;
constexpr size_t WS_RM = 854 * MiB;
constexpr size_t WS_HID = 859 * MiB;
constexpr size_t WS_BIG = 1019 * MiB;
constexpr size_t WS_H = WS_BIG;
constexpr size_t WS_LF = WS_BIG + 400 * MiB;
constexpr size_t WS_UT = WS_BIG + 464 * MiB;
constexpr size_t WS_SPT = WS_BIG + 592 * MiB;
constexpr size_t WS_DEC = WS_BIG + 656 * MiB;
constexpr size_t WS_LSE = WS_BIG + 657 * MiB;
constexpr size_t WS_HGO = WS_BIG + 658 * MiB;
constexpr size_t WS_ATTO = WS_BIG + 690 * MiB;
constexpr size_t WS_MRG = WS_BIG + 706 * MiB;
constexpr size_t WS_Y = WS_BIG;
constexpr size_t WS_XB8 = WS_BIG + 772 * MiB;
constexpr size_t WS_WINF = WS_WIN + 30 * MiB;
constexpr size_t WS_X1B8 = WS_BIG + 804 * MiB;
constexpr size_t WS_WGU8 = 531 * MiB;
constexpr size_t WS_WDN8 = WS_BIG + 836 * MiB;
constexpr size_t WS_END = WS_BIG + 901 * MiB;
constexpr int CW_TMO = 0;
constexpr int CW_CNT = 1024;
constexpr int CW_CQ = 2048;
constexpr int CW_BAR = 4096;

constexpr int LDS_BYTES = 159744;
constexpr int LDS_EPI = 131072;
constexpr int LDS_TAB = 147456;
constexpr int LDS_MISC = LDS_TAB + 2048;

#define RLX_AGENT __ATOMIC_RELAXED, __HIP_MEMORY_SCOPE_AGENT
#define LDS_WAIT() asm volatile("s_waitcnt lgkmcnt(0)" ::: "memory")
#define VM_WAIT() asm volatile("s_waitcnt vmcnt(0)" ::: "memory")
#define LDS_BARRIER() asm volatile("s_waitcnt lgkmcnt(0)\n\ts_barrier" ::: "memory")
__device__ __forceinline__ unsigned f2bf(float f) { unsigned u = __builtin_bit_cast(unsigned, f); return (u + 0x7fffu + ((u >> 16) & 1u)) >> 16; }
__device__ __forceinline__ unsigned pk2(float lo, float hi) { return f2bf(lo) | (f2bf(hi) << 16); }
__device__ __forceinline__ float bf2f(unsigned short b) { return __builtin_bit_cast(float, ((unsigned)b) << 16); }
__device__ __forceinline__ float bflo(unsigned w) { return __builtin_bit_cast(float, w << 16); }
__device__ __forceinline__ float bfhi(unsigned w) { return __builtin_bit_cast(float, w & 0xffff0000u); }
__device__ __forceinline__ unsigned cvt_pk_bf16(float lo, float hi) { unsigned r; asm volatile("v_cvt_pk_bf16_f32 %0, %1, %2" : "=v"(r) : "v"(lo), "v"(hi)); return r; }
__device__ __forceinline__ float fdiv(float a, float b) { return a * __builtin_amdgcn_rcpf(b); }
__device__ __forceinline__ float fsigmoid(float x) { return __builtin_amdgcn_rcpf(1.0f + __expf(-x)); }
__device__ __forceinline__ float wave_sum(float v) {
#pragma unroll
    for (int o = 1; o < 64; o <<= 1) v += __shfl_xor(v, o);
    return v;
}
__device__ __forceinline__ float max8_dpp(float v) {
    v = fmaxf(v, __builtin_bit_cast(float, __builtin_amdgcn_update_dpp(0, __builtin_bit_cast(int, v), 0xB1, 0xF, 0xF, false)));
    v = fmaxf(v, __builtin_bit_cast(float, __builtin_amdgcn_update_dpp(0, __builtin_bit_cast(int, v), 0x4E, 0xF, 0xF, false)));
    v = fmaxf(v, __builtin_bit_cast(float, __builtin_amdgcn_update_dpp(0, __builtin_bit_cast(int, v), 0x141, 0xF, 0xF, false)));
    return v;
}
__device__ __forceinline__ f32x4 mfma16(bf16x8 a, bf16x8 b, f32x4 c) { return __builtin_amdgcn_mfma_f32_16x16x32_bf16(a, b, c, 0, 0, 0); }
__device__ __forceinline__ s16x4 tr_read(unsigned lds_addr) { s16x4 r; asm volatile("ds_read_b64_tr_b16 %0, %1\n\ts_waitcnt lgkmcnt(0)" : "=&v"(r) : "v"(lds_addr) : "memory"); return r; }

template <int STRIDE> __device__ __forceinline__ void tr_read8(s16x4 (&r)[8], unsigned a) {
    asm volatile("ds_read_b64_tr_b16 %0, %8\n\tds_read_b64_tr_b16 %1, %8 offset:%9\n\tds_read_b64_tr_b16 %2, %8 offset:%10\n\tds_read_b64_tr_b16 %3, %8 offset:%11\n\t"
                 "ds_read_b64_tr_b16 %4, %8 offset:%12\n\tds_read_b64_tr_b16 %5, %8 offset:%13\n\tds_read_b64_tr_b16 %6, %8 offset:%14\n\tds_read_b64_tr_b16 %7, %8 offset:%15\n\ts_waitcnt lgkmcnt(0)"
                 : "=&v"(r[0]), "=&v"(r[1]), "=&v"(r[2]), "=&v"(r[3]), "=&v"(r[4]), "=&v"(r[5]), "=&v"(r[6]), "=&v"(r[7])
                 : "v"(a), "i"(STRIDE), "i"(2 * STRIDE), "i"(3 * STRIDE), "i"(4 * STRIDE), "i"(5 * STRIDE), "i"(6 * STRIDE), "i"(7 * STRIDE) : "memory");
}
template <int STRIDE> __device__ __forceinline__ void tr_read4x2(s16x4 (&r0)[4], s16x4 (&r1)[4], unsigned a0, unsigned a1) {
    asm volatile("ds_read_b64_tr_b16 %0, %8\n\tds_read_b64_tr_b16 %1, %8 offset:%10\n\tds_read_b64_tr_b16 %2, %8 offset:%11\n\tds_read_b64_tr_b16 %3, %8 offset:%12\n\t"
                 "ds_read_b64_tr_b16 %4, %9\n\tds_read_b64_tr_b16 %5, %9 offset:%10\n\tds_read_b64_tr_b16 %6, %9 offset:%11\n\tds_read_b64_tr_b16 %7, %9 offset:%12\n\ts_waitcnt lgkmcnt(0)"
                 : "=&v"(r0[0]), "=&v"(r0[1]), "=&v"(r0[2]), "=&v"(r0[3]), "=&v"(r1[0]), "=&v"(r1[1]), "=&v"(r1[2]), "=&v"(r1[3])
                 : "v"(a0), "v"(a1), "i"(STRIDE), "i"(2 * STRIDE), "i"(3 * STRIDE) : "memory");
}
#define TRCAT(lo, hi) ((bf16x8){(lo)[0], (lo)[1], (lo)[2], (lo)[3], (hi)[0], (hi)[1], (hi)[2], (hi)[3]})
#define XB_TMO      128
#define XB_XCNT(j)  (256  + 64 * (j))
#define XB_XSUB(j)  (1280 + 64 * (j))
#define XB_XGEN(j)  (2304 + 64 * (j))
#define XB_TOP      3328
#define XB_TOPGEN   3392
#define XCD_BAR_WORDS 3456
#define XB_SPIN_CAP (1u << 18)
__device__ __forceinline__ unsigned xb_ld(unsigned* p)              { return __hip_atomic_load(p, __ATOMIC_RELAXED, __HIP_MEMORY_SCOPE_AGENT); }
__device__ __forceinline__ unsigned xb_add(unsigned* p, unsigned v) { return __hip_atomic_fetch_add(p, v, __ATOMIC_RELAXED, __HIP_MEMORY_SCOPE_AGENT); }
__device__ __forceinline__ unsigned xb_xcc_id() { return (unsigned)__builtin_amdgcn_s_getreg((3 << 11) | 20) & 0xFu; }
#define XB_SPIN(cond, bar) do { unsigned _sp = 0; while (cond) { __builtin_amdgcn_s_sleep(1); \
    if ((++_sp & 255u) == 0u) { if (xb_ld(&(bar)[XB_TMO])) break; if (_sp > XB_SPIN_CAP) { atomicAdd(&(bar)[XB_TMO], 1u); break; } } } } while (0)
struct XcdBarrier { unsigned* bar; unsigned x; volatile LAS unsigned* st; };
__device__ __forceinline__ XcdBarrier xcd_barrier_post(unsigned* bar, volatile LAS unsigned* st) {
    XcdBarrier b; b.bar = bar; b.x = xb_xcc_id(); b.st = st;
    if (threadIdx.x == 0) (void)xb_add(&bar[XB_XCNT(b.x)], 1u);
    return b;
}
__device__ __forceinline__ void xcd_barrier_complete(unsigned* bar, unsigned x, unsigned& nloc, unsigned& nx) {
    const unsigned G = gridDim.x * gridDim.y * gridDim.z;
    unsigned sum, cnt, mine, sp = 0u;
    for (;;) {
        sum = 0u; cnt = 0u; mine = 0u;
#pragma unroll
        for (unsigned j = 0; j < 16; ++j) { const unsigned c = xb_ld(&bar[XB_XCNT(j)]); sum += c; cnt += (c > 0u) ? 1u : 0u; mine = (j == x) ? c : mine; }
        if (sum == G) break;
        __builtin_amdgcn_s_sleep(1);
        if ((++sp & 255u) == 0u) { if (xb_ld(&bar[XB_TMO])) break; if (sp > XB_SPIN_CAP) { atomicAdd(&bar[XB_TMO], 1u); break; } }
    }
    nloc = mine > 0u ? mine : 1u; nx = cnt > 0u ? cnt : 1u;
}
__device__ __forceinline__ void xcd_barrier(const XcdBarrier& b) {
    asm volatile("s_waitcnt vmcnt(0)" ::: "memory");
    __syncthreads();
    if (threadIdx.x == 0) {
        unsigned* bar = b.bar;
        __builtin_amdgcn_s_waitcnt(0);
        unsigned nloc = b.st[0], nx = b.st[1];
        if (nloc == 0u) { xcd_barrier_complete(bar, b.x, nloc, nx); b.st[0] = nloc; b.st[1] = nx; }
        const unsigned old = xb_add(&bar[XB_XSUB(b.x)], 1u);
        const unsigned gen = old / nloc;
        if (old + 1u == (gen + 1u) * nloc) {
            __builtin_amdgcn_fence(__ATOMIC_RELEASE, "agent");
            asm volatile("s_waitcnt vmcnt(0)" ::: "memory");
            const unsigned og = xb_add(&bar[XB_TOP], 1u);
            const unsigned tg = og / nx;
            if (og + 1u == (tg + 1u) * nx) xb_add(&bar[XB_TOPGEN], 1u);
            else XB_SPIN(xb_ld(&bar[XB_TOPGEN]) == tg, bar);
            __builtin_amdgcn_fence(__ATOMIC_ACQUIRE, "agent");
            xb_add(&bar[XB_XGEN(b.x)], 1u);
            asm volatile("s_waitcnt vmcnt(0)" ::: "memory");
        } else {
            XB_SPIN(xb_ld(&bar[XB_XGEN(b.x)]) == gen, bar);
            __builtin_amdgcn_fence(__ATOMIC_ACQUIRE, "agent");
            asm volatile("s_waitcnt vmcnt(0)" ::: "memory");
        }
    }
    __syncthreads();
}

namespace pg8 {
constexpr int BM = 256, BK = 64, HALF = 128, HTB = HALF * BK * 2, STAGE_BYTES = 8 * HTB, NXCD = 8, WGM = 8;
__host__ __device__ __forceinline__ int lds_byte(int r, int c) { const int st = (r >> 4) * 2 + (c >> 5), rr = r & 15, cc = c & 31, ob = rr * 64 + cc * 2; return st * 1024 + (ob ^ (((ob >> 9) & 1) << 5)); }
__host__ __device__ __forceinline__ void stage_rc(int b, int& R, int& C) { const int st = b / 1024, sb = b % 1024, swz = sb ^ (((sb >> 9) & 1) << 5); R = (st >> 1) * 16 + swz / 64; C = (st & 1) * 32 + (swz % 64) / 2; }
__host__ __device__ __forceinline__ int perm32(int rho) { const int n = rho >> 4, i = rho & 15; return 8 * (i >> 2) + 4 * n + (i & 3); }

struct Unit {
    const GAS char* a; const GAS char* b; int lda, ldb, nt;
    int row0, col0, aux;
    const GAS int* gidx; int gcnt;
    const LAS int* gl;
};

template <class S> struct RangeSched { const S& s; int lo, hi; __device__ __forceinline__ bool next(int i, Unit& u) const { return (lo + i < hi) && s.next(lo + i, u); } };

__device__ __forceinline__ void tile_of(int L, int nM, int nN, int& pm, int& pn) {
    const int nwg = nM * nN; int wgid = L;
    { const int q = nwg / NXCD, r = nwg % NXCD, xcd = wgid % NXCD, off = wgid / NXCD; wgid = (xcd < r ? xcd * (q + 1) : r * (q + 1) + (xcd - r) * q) + off; }
    const int nig = WGM * nN, gid = wgid / nig, fm = gid * WGM, gsz = (nM - fm) < WGM ? (nM - fm) : WGM;
    pm = fm + ((wgid % nig) % gsz); pn = (wgid % nig) / gsz;
}

typedef int i32x8 __attribute__((ext_vector_type(8)));
typedef int i32x4v __attribute__((ext_vector_type(4)));
template <class Epi, class Sched, bool GATHER, bool FP8 = false, bool UNI = false>
__device__ __forceinline__ void gemm_phase(LAS unsigned char* lds, const Sched& S, const Epi& E) {
    int tid = threadIdx.x; asm volatile("" : "+v"(tid));
    const int wid = __builtin_amdgcn_readfirstlane(tid >> 6), lane = tid & 63, wr = wid >> 2, wc = wid & 3, fr = lane & 15, fq = lane >> 4;
    int sR[2], sC2[2], sRb[2];
#pragma unroll
    for (int i = 0; i < 2; ++i) { int R, C; stage_rc(tid * 16 + i * 8192, R, C); sR[i] = R; sC2[i] = C * 2; sRb[i] = Epi::WIDE ? (64 * (R >> 5) + perm32(R & 31)) : (Epi::PERM ? ((R & ~31) + perm32(R & 31)) : R); }
    const unsigned ldsw = (unsigned)wid * 1024u;
    const int aoff = lds_byte(wr * 64 + fr, fq * 8), boff = lds_byte(wc * 32 + fr, fq * 8);
    const int sclw = 0x79, scla = 0x7f;
    const int aoff8[2] = {lds_byte(wr * 64 + fr, fq * 16), lds_byte(wr * 64 + fr, fq * 16 + 8)}, boff8[2] = {lds_byte(wc * 32 + fr, fq * 16), lds_byte(wc * 32 + fr, fq * 16 + 8)};
#define PG8_SA(b, h) (((b) * 2 + (h)) * HTB)
#define PG8_SB(b, h) ((4 + (b) * 2 + (h)) * HTB)
#define PG8_STAGE(bufoff, gbase, voff) do { _Pragma("unroll") for (int _i = 0; _i < 2; ++_i) \
        __builtin_amdgcn_global_load_lds((const GAS unsigned*)((const GAS char*)(gbase) + (voff)[_i]), (LAS unsigned*)(lds + (bufoff) + ldsw + _i * 8192), 16, 0, 0); } while (0)
#define PG8_LDA(dst, b, h) do { _Pragma("unroll") for (int m = 0; m < 4; ++m) { dst[m].lo = *(const LAS i32x4v*)(lds + PG8_SA(b, h) + (FP8 ? aoff8[0] : aoff) + m * 2048); dst[m].hi = *(const LAS i32x4v*)(lds + PG8_SA(b, h) + (FP8 ? aoff8[1] : aoff + 1024) + m * 2048); } } while (0)
#define PG8_LDB(dst, b, h) do { _Pragma("unroll") for (int n = 0; n < 2; ++n) { dst[n].lo = *(const LAS i32x4v*)(lds + PG8_SB(b, h) + (FP8 ? boff8[0] : boff) + n * 2048); dst[n].hi = *(const LAS i32x4v*)(lds + PG8_SB(b, h) + (FP8 ? boff8[1] : boff + 1024) + n * 2048); } } while (0)
#define PG8_BF(x) __builtin_bit_cast(bf16x8, (i32x4v)(x))
#define PG8_MMA(ai, bj, At, Bt) do { __builtin_amdgcn_s_setprio(1); _Pragma("unroll") for (int m = 0; m < 4; ++m) _Pragma("unroll") for (int n = 0; n < 2; ++n) { \
        if constexpr (FP8) { asm volatile("v_mfma_scale_f32_16x16x128_f8f6f4 %0, %1, %2, %0, %3, %4 op_sel_hi:[0,0,0]" : "+v"(acc[ai][bj][m][n]) : "v"(Bt[n]), "v"(At[m]), "v"(sclw), "v"(scla)); } \
        else { acc[ai][bj][m][n] = __builtin_amdgcn_mfma_f32_16x16x32_bf16(PG8_BF(Bt[n].lo), PG8_BF(At[m].lo), acc[ai][bj][m][n], 0, 0, 0); \
               acc[ai][bj][m][n] = __builtin_amdgcn_mfma_f32_16x16x32_bf16(PG8_BF(Bt[n].hi), PG8_BF(At[m].hi), acc[ai][bj][m][n], 0, 0, 0); } } \
        __builtin_amdgcn_s_setprio(0); } while (0)
#define PG8_WAIT_V(n) asm volatile("s_waitcnt vmcnt(" #n ")" ::: "memory")
#define PG8_WAIT_L(n) asm volatile("s_waitcnt lgkmcnt(" #n ")" ::: "memory")
#define PG8_BAR __builtin_amdgcn_s_barrier()
#define PG8_SCHED __builtin_amdgcn_sched_barrier(0)
#define PG8_OFFS(u, ao, bo) do { _Pragma("unroll") for (int _i = 0; _i < 2; ++_i) { (bo)[_i] = (unsigned)(sRb[_i] * (u).ldb + sC2[_i]); \
        _Pragma("unroll") for (int _h = 0; _h < 2; ++_h) { int _r = _h * HALF + sR[_i]; if (GATHER) { _r = (u).gl ? (u).gl[_r] : ((_r < (u).gcnt) ? (u).gidx[_r] : 0); } (ao)[_h][_i] = (unsigned)(_r * (u).lda + sC2[_i]); } } } while (0)
    Unit cur, nxt; int ui = 0;
    if (!S.next(0, cur)) return;
    f32x4 acc[2][2][4][2];
#pragma unroll
    for (int a = 0; a < 2; ++a)
#pragma unroll
        for (int b = 0; b < 2; ++b)
#pragma unroll
            for (int m = 0; m < 4; ++m)
#pragma unroll
                for (int n = 0; n < 2; ++n) acc[a][b][m][n] = (f32x4){0.f, 0.f, 0.f, 0.f};
    i32x8 At[4], B0[2], B1[2];
    unsigned aoc[2][2], boc[2], aon[2][2], bon[2];
    PG8_OFFS(cur, aoc, boc);
    {
        const GAS char* cA = cur.a; const GAS char* cB = cur.b; const size_t hB = (size_t)(Epi::WIDE ? 32 : HALF) * cur.ldb;
        PG8_STAGE(PG8_SB(0, 0), cB, boc); PG8_STAGE(PG8_SB(0, 1), cB + hB, boc); PG8_STAGE(PG8_SA(0, 0), cA, aoc[0]); PG8_STAGE(PG8_SA(0, 1), cA, aoc[1]);
        if (wr == 1) PG8_BAR;
        PG8_WAIT_V(2); PG8_BAR;
        PG8_STAGE(PG8_SB(1, 0), cB + 128, boc); PG8_STAGE(PG8_SA(1, 0), cA + 128, aoc[0]); PG8_STAGE(PG8_SB(1, 1), cB + hB + 128, boc);
        PG8_WAIT_V(6); PG8_BAR;
    }
    for (;;) {
        const bool has_next = S.next(ui + 1, nxt);
        if constexpr (UNI) { if (!has_next) nxt = cur; }
        else { if (has_next) { PG8_OFFS(nxt, aon, bon); }
          else { nxt = cur;
#pragma unroll
            for (int i = 0; i < 2; ++i) { bon[i] = boc[i]; aon[0][i] = aoc[0][i]; aon[1][i] = aoc[1][i]; } } }
        const GAS char* cA = cur.a; const GAS char* cB = cur.b; const GAS char* nA = nxt.a; const GAS char* nB = nxt.b;
        const size_t hBc = (size_t)(Epi::WIDE ? 32 : HALF) * cur.ldb, hBn = (size_t)(Epi::WIDE ? 32 : HALF) * nxt.ldb;
        const int nt = cur.nt;
        for (int t = 0; t < nt; t += 2) {
            const bool last = (t == nt - 2);
            const GAS char* a1 = cA + (size_t)(t + 1) * 128;
            const GAS char* a2 = last ? nA : cA + (size_t)(t + 2) * 128; const GAS char* b2 = last ? nB : cB + (size_t)(t + 2) * 128;
            const GAS char* a3 = a2 + 128; const GAS char* b3 = b2 + 128;
            const size_t hB2 = last ? hBn : hBc;
            unsigned oa0[2], oa1[2], ob[2];
#pragma unroll
            for (int i = 0; i < 2; ++i) { if constexpr (UNI) { oa0[i] = aoc[0][i]; oa1[i] = aoc[1][i]; ob[i] = boc[i]; } else { oa0[i] = last ? aon[0][i] : aoc[0][i]; oa1[i] = last ? aon[1][i] : aoc[1][i]; ob[i] = last ? bon[i] : boc[i]; } }
            PG8_LDB(B0, 0, 0); PG8_LDB(B1, 0, 1); PG8_SCHED; PG8_LDA(At, 0, 0); PG8_STAGE(PG8_SA(1, 1), a1, aoc[1]);
            PG8_WAIT_V(8); PG8_WAIT_L(0); PG8_BAR; PG8_MMA(0, 0, At, B0); PG8_MMA(0, 1, At, B1); PG8_BAR; PG8_SCHED;
            PG8_LDA(At, 0, 1); PG8_STAGE(PG8_SB(0, 0), b2, ob); PG8_STAGE(PG8_SB(0, 1), b2 + hB2, ob); PG8_STAGE(PG8_SA(0, 0), a2, oa0);
            PG8_WAIT_V(8); PG8_WAIT_L(0); PG8_BAR; PG8_MMA(1, 0, At, B0); PG8_MMA(1, 1, At, B1); PG8_BAR; PG8_SCHED;
            PG8_LDB(B0, 1, 0); PG8_LDB(B1, 1, 1); PG8_SCHED; PG8_LDA(At, 1, 0); PG8_STAGE(PG8_SA(0, 1), a2, oa1);
            PG8_WAIT_V(8); PG8_WAIT_L(0); PG8_BAR; PG8_MMA(0, 0, At, B0); PG8_MMA(0, 1, At, B1); PG8_BAR; PG8_SCHED;
            PG8_LDA(At, 1, 1); PG8_STAGE(PG8_SB(1, 0), b3, ob); PG8_STAGE(PG8_SB(1, 1), b3 + hB2, ob); PG8_STAGE(PG8_SA(1, 0), a3, oa0);
            PG8_WAIT_V(8); PG8_WAIT_L(0); PG8_BAR; PG8_MMA(1, 0, At, B0); PG8_MMA(1, 1, At, B1); PG8_BAR; PG8_SCHED;
        }
        if (wr == 0) PG8_BAR;
        const bool keep = E(acc, cur, wr, wc, fr, fq, lds + LDS_EPI + wid * 2048);
        if (!has_next) break;
        if (!keep) {
#pragma unroll
            for (int a = 0; a < 2; ++a)
#pragma unroll
                for (int b = 0; b < 2; ++b)
#pragma unroll
                    for (int m = 0; m < 4; ++m)
#pragma unroll
                        for (int n = 0; n < 2; ++n) acc[a][b][m][n] = (f32x4){0.f, 0.f, 0.f, 0.f};
        }
        cur = nxt;
        if constexpr (!UNI) {
#pragma unroll
            for (int i = 0; i < 2; ++i) { boc[i] = bon[i]; aoc[0][i] = aon[0][i]; aoc[1][i] = aon[1][i]; } }
        ++ui;
        if (wr == 1) PG8_BAR;
    }
    PG8_WAIT_V(0);
    PG8_BAR;
#undef PG8_OFFS
#undef PG8_SA
#undef PG8_SB
#undef PG8_STAGE
#undef PG8_LDA
#undef PG8_LDB
#undef PG8_MMA
#undef PG8_BF
#undef PG8_WAIT_V
#undef PG8_WAIT_L
#undef PG8_BAR
#undef PG8_SCHED
}
}
using pg8::Unit;

struct DenseSched {
    const GAS char* A; const GAS char* Bt; int lda, ldb, nt, nM, nN, G, c;
    int skip_from, skip_n;
    __device__ __forceinline__ bool next(int i, Unit& u) const {
        const long L = (long)i * G + c; if (L >= (long)nM * nN) return false;
        int pm, pn; pg8::tile_of((int)L, nM, nN, pm, pn);
        if (pn >= skip_from) pn += skip_n;
        u.a = A + (size_t)pm * 256 * lda; u.b = Bt + (size_t)pn * 256 * ldb; u.lda = lda; u.ldb = ldb; u.nt = nt;
        u.row0 = pm * 256; u.col0 = pn * 256; u.aux = 0; u.gidx = nullptr; u.gcnt = 256; u.gl = nullptr; return true;
    }
};
struct MergeSched {
    const GAS char* A0; const GAS char* B0; const GAS char* A1; const GAS char* B1; int nM, nN, G, c;
    __device__ __forceinline__ bool next(int i, Unit& u) const {
        const long L = (long)(i >> 1) * G + c; if (L >= (long)nM * nN) return false;
        int pm, pn; pg8::tile_of((int)L, nM, nN, pm, pn);
        const int seg = i & 1;
        const int ld = seg ? ATT_OUT * 2 : HG_WIDTH * 2;
        u.a = (seg ? A1 : A0) + (size_t)pm * 256 * ld; u.b = (seg ? B1 : B0) + (size_t)pn * 256 * ld; u.lda = ld; u.ldb = ld; u.nt = seg ? ATT_OUT / 64 : HG_WIDTH / 64;
        u.row0 = pm * 256; u.col0 = pn * 256; u.aux = seg; u.gidx = nullptr; u.gcnt = 256; u.gl = nullptr; return true;
    }
};
template <int NT, bool UP, int ES = 2>
struct MoeSched {
    const LAS int* toff; const GAS unsigned* cnt;
    const GAS char* A; const GAS char* W; const GAS int* rowmap;
    int G, c;
    const LAS int* gtab;
    const LAS int* utab;
    __device__ __forceinline__ bool decode(int i, int& mtg, int& pn, int& e) const {
        const int total = toff[NEXP1];
        const int nb = G >> 3, x = c & 7, lb = c >> 3;
        const int tpx = (total + 7) >> 3, t0 = x * tpx; int nx = total - t0; nx = nx > tpx ? tpx : nx;
        const int jj = i * nb + lb;
        if (nx <= 0 || lb >= nb || jj >= nx * NT) return false;
        const int nig = 8 * NT, gid = jj / nig, fm = gid * 8, gsz = (nx - fm) < 8 ? (nx - fm) : 8;
        mtg = t0 + fm + ((jj % nig) % gsz); pn = (jj % nig) / gsz;
        int lo = 0, hi = NEXP1;
        while (hi - lo > 1) { const int mid = (lo + hi) >> 1; if (toff[mid] <= mtg) lo = mid; else hi = mid; }
        e = lo; return true;
    }
    __device__ __forceinline__ void build_units(LAS int* tab) const {
        if (threadIdx.x < 32) { int mtg = 0, pn = 0, e = 0; const bool ok = decode((int)threadIdx.x, mtg, pn, e);
            tab[threadIdx.x * 4 + 0] = mtg; tab[threadIdx.x * 4 + 1] = pn; tab[threadIdx.x * 4 + 2] = e; tab[threadIdx.x * 4 + 3] = ok ? 1 : 0; }
        __syncthreads();
        if (UP && gtab != nullptr) {
            LAS int* gt = (LAS int*)gtab;
            for (int i0 = 0; i0 < 16; i0 += 2) { const int i = i0 + (int)(threadIdx.x >> 8), r = (int)threadIdx.x & 255;
                if (tab[i * 4 + 3]) { const int mtg = tab[i * 4 + 0], e = tab[i * 4 + 2], mt = mtg - toff[e];
                    int v; if (e < N_EXPERTS) { const int n = (int)cnt[e] - mt * 256; v = (r < n) ? rowmap[(size_t)e * T + mt * 256 + r] : 0; } else v = mt * 256 + r;
                    gt[i * 256 + r] = v; } }
            __syncthreads(); }
    }
    __device__ __forceinline__ bool next(int i, Unit& u) const {
        int mtg, pn, e;
        if (i < 32) { const int ok = utab[i * 4 + 3]; if (!ok) return false; mtg = utab[i * 4 + 0]; pn = utab[i * 4 + 1]; e = utab[i * 4 + 2]; }
        else if (!decode(i, mtg, pn, e)) return false;
        mtg = __builtin_amdgcn_readfirstlane(mtg); pn = __builtin_amdgcn_readfirstlane(pn); e = __builtin_amdgcn_readfirstlane(e);
        const int mt = mtg - toff[e];
        if (UP) {
            u.a = A; u.lda = D_MODEL * ES; u.nt = D_MODEL * ES / 128;
            u.b = W + ((size_t)e * 1024 + (size_t)pn * 256) * (D_MODEL * ES); u.ldb = D_MODEL * ES;
            if (gtab != nullptr && i < 16) { u.gl = gtab + i * 256; u.gidx = nullptr; u.gcnt = 256; }
            else { u.gl = nullptr;
                if (e < N_EXPERTS) { u.gidx = rowmap + (size_t)e * T + mt * 256; const int n = (int)cnt[e] - mt * 256; u.gcnt = n < 256 ? n : 256; }
                else { u.gidx = rowmap + (size_t)N_EXPERTS * T + mt * 256; u.gcnt = 256; } }
            u.col0 = pn * 128;
        } else {
            u.a = A + (size_t)mtg * 256 * (EXPERT_FF * ES); u.lda = EXPERT_FF * ES; u.nt = EXPERT_FF * ES / 128;
            u.b = W + ((size_t)e * D_MODEL + (size_t)pn * 256) * (EXPERT_FF * ES); u.ldb = EXPERT_FF * ES;
            u.gidx = nullptr; u.gcnt = 256; u.gl = nullptr; u.col0 = pn * 256;
        }
        u.row0 = mtg * 256; u.aux = e; return true;
    }
};

struct EpiIn {
    static constexpr bool PERM = true, WIDE = false;
    GAS bf16_t* H; GAS _Float16* LF; const GAS float* lb; const GAS f32x4* rope;
    __device__ __forceinline__ bool operator()(f32x4 (&acc)[2][2][4][2], const Unit& u, int wr, int wc, int fr, int fq, LAS unsigned char* scr) const {
        const int row0 = u.row0 + wr * 64 + fr, colt = u.col0, cl = wc * 32 + 8 * fq;
        int mode;
        if (colt < C_HF) mode = 1; else if (colt < C_HI) mode = 3; else if (colt < C_HGATE) mode = 0; else if (colt < C_AQ) mode = 2;
        else if (colt < C_AK) mode = 4; else if (colt < C_AV) mode = 5; else if (colt < C_GH) mode = 0; else mode = 2;
        if (mode == 3) {
            f32x4 lbv[2][2];
#pragma unroll
            for (int bj = 0; bj < 2; ++bj)
#pragma unroll
                for (int n = 0; n < 2; ++n) lbv[bj][n] = *(const GAS f32x4*)(lb + (colt - C_HF) + bj * 128 + cl + 4 * n);
#pragma unroll
            for (int ai = 0; ai < 2; ++ai)
#pragma unroll
                for (int m = 0; m < 4; ++m) { GAS _Float16* rowp = LF + HOFF(colt - C_HF, row0 + ai * 128 + m * 16) + cl;
#pragma unroll
                    for (int bj = 0; bj < 2; ++bj) { f16x8 o8;
#pragma unroll
                        for (int n = 0; n < 2; ++n) { const f32x4 z = acc[ai][bj][m][n];
#pragma unroll
                            for (int j = 0; j < 4; ++j) { const float zz = fmaxf(z[j], -80.f), l = lbv[bj][n][j]; const float f = l + (1.0f - l) * fdiv(1.0f, 1.0f + __expf(-zz)); o8[4 * n + j] = (_Float16)__logf(f); } }
                        *(GAS f16x8*)(rowp + (size_t)bj * T * 128) = o8; } }
            return false;
        }
        if (mode >= 4) {
            const float sc = (mode == 4) ? 0.08838834764831845f : 1.0f;
            const int i0 = 16 * wc + 4 * fq;
#pragma unroll
            for (int ai = 0; ai < 2; ++ai)
#pragma unroll
                for (int m = 0; m < 4; ++m) { const int row = row0 + ai * 128 + m * 16; GAS bf16_t* rowp = H + HOFF(colt, row) + cl;
                    const f32x4 cs0 = rope[(size_t)row * 32 + (i0 >> 1)], cs1 = rope[(size_t)row * 32 + (i0 >> 1) + 1];
#pragma unroll
                    for (int bj = 0; bj < 2; ++bj) { const f32x4 v0 = acc[ai][bj][m][0], v1 = acc[ai][bj][m][1]; u32x4 w;
                        w.x = cvt_pk_bf16((v0[0] * cs0[0] - v0[1] * cs0[1]) * sc, (v0[1] * cs0[0] + v0[0] * cs0[1]) * sc);
                        w.y = cvt_pk_bf16((v0[2] * cs0[2] - v0[3] * cs0[3]) * sc, (v0[3] * cs0[2] + v0[2] * cs0[3]) * sc);
                        w.z = cvt_pk_bf16((v1[0] * cs1[0] - v1[1] * cs1[1]) * sc, (v1[1] * cs1[0] + v1[0] * cs1[1]) * sc);
                        w.w = cvt_pk_bf16((v1[2] * cs1[2] - v1[3] * cs1[3]) * sc, (v1[3] * cs1[2] + v1[2] * cs1[3]) * sc);
                        *(GAS u32x4*)(rowp + (size_t)bj * T * 128) = w; } }
            return false;
        }
#pragma unroll
        for (int ai = 0; ai < 2; ++ai)
#pragma unroll
            for (int m = 0; m < 4; ++m) { GAS bf16_t* rowp = H + HOFF(colt, row0 + ai * 128 + m * 16) + cl;
#pragma unroll
                for (int bj = 0; bj < 2; ++bj) { f32x4 v0 = acc[ai][bj][m][0], v1 = acc[ai][bj][m][1];
                    if (mode != 0) {
#pragma unroll
                        for (int j = 0; j < 4; ++j) { const float s0 = fsigmoid(v0[j]), s1 = fsigmoid(v1[j]); v0[j] = (mode == 1) ? v0[j] * s0 : s0; v1[j] = (mode == 1) ? v1[j] * s1 : s1; } }
                    u32x4 w; w.x = cvt_pk_bf16(v0[0], v0[1]); w.y = cvt_pk_bf16(v0[2], v0[3]); w.z = cvt_pk_bf16(v1[0], v1[1]); w.w = cvt_pk_bf16(v1[2], v1[3]);
                    *(GAS u32x4*)(rowp + (size_t)bj * T * 128) = w; } }
        return false;
    }
};
struct EpiMerge {
    static constexpr bool PERM = true, WIDE = true;
    const GAS bf16_t* H; GAS bf16_t* O;
    __device__ __forceinline__ bool operator()(f32x4 (&acc)[2][2][4][2], const Unit& u, int wr, int wc, int fr, int fq, LAS unsigned char* scr) const {
        const int lane = fq * 16 + fr, rowb = u.row0 + wr * 64, colb = u.col0 + wc * 64;
        const int lr = lane >> 3, lch = lane & 7;
        const int wo = lr * 128 + ((lch ^ (lr & 7)) * 16);
        const bool seg0 = (u.aux == 0);
#pragma unroll
        for (int ai = 0; ai < 2; ++ai)
#pragma unroll
            for (int m = 0; m < 4; ++m) { const size_t rg = (size_t)(rowb + ai * 128 + m * 16);
                const GAS bf16_t* gpa = H + HOFF(C_GA + colb, rg + lr) + lch * 8; const GAS bf16_t* gph = H + HOFF(C_GH + colb, rg + lr) + lch * 8;
                const u32x4 ga0 = *(const GAS u32x4*)gpa, ga1 = *(const GAS u32x4*)(gpa + 8 * 128);
                u32x4 gh0 = ga0, gh1 = ga1; if (seg0) { gh0 = *(const GAS u32x4*)gph; gh1 = *(const GAS u32x4*)(gph + 8 * 128); }
                *(LAS u32x4*)(scr + wo) = ga0; *(LAS u32x4*)(scr + wo + 1024) = ga1;
                LDS_WAIT();
                u32x4 gaf[2], ghf[2];
#pragma unroll
                for (int bj = 0; bj < 2; ++bj) gaf[bj] = *(const LAS u32x4*)(scr + fr * 128 + (((bj * 4 + fq) ^ (fr & 7)) * 16));
                LDS_WAIT();
                if (seg0) { *(LAS u32x4*)(scr + wo) = gh0; *(LAS u32x4*)(scr + wo + 1024) = gh1;
                    LDS_WAIT();
#pragma unroll
                    for (int bj = 0; bj < 2; ++bj) ghf[bj] = *(const LAS u32x4*)(scr + fr * 128 + (((bj * 4 + fq) ^ (fr & 7)) * 16));
                    LDS_WAIT(); }
#pragma unroll
                for (int bj = 0; bj < 2; ++bj) { const u32x4 ga = gaf[bj];
                    float a[8] = {bflo(ga.x), bfhi(ga.x), bflo(ga.y), bfhi(ga.y), bflo(ga.z), bfhi(ga.z), bflo(ga.w), bfhi(ga.w)};
                    if (seg0) { const u32x4 gh = ghf[bj];
                        float h[8] = {bflo(gh.x), bfhi(gh.x), bflo(gh.y), bfhi(gh.y), bflo(gh.z), bfhi(gh.z), bflo(gh.w), bfhi(gh.w)};
#pragma unroll
                        for (int j = 0; j < 4; ++j) { acc[ai][bj][m][0][j] *= fdiv(h[j], a[j]); acc[ai][bj][m][1][j] *= fdiv(h[4 + j], a[4 + j]); }
                    } else {
                        f32x4 v0 = acc[ai][bj][m][0], v1 = acc[ai][bj][m][1];
#pragma unroll
                        for (int j = 0; j < 4; ++j) { v0[j] *= a[j]; v1[j] *= a[4 + j]; }
                        u32x2 w8; int q = __builtin_amdgcn_cvt_pk_fp8_f32(v0[0], v0[1], 0, false); q = __builtin_amdgcn_cvt_pk_fp8_f32(v0[2], v0[3], q, true); w8.x = (unsigned)q;
                        q = __builtin_amdgcn_cvt_pk_fp8_f32(v1[0], v1[1], 0, false); q = __builtin_amdgcn_cvt_pk_fp8_f32(v1[2], v1[3], q, true); w8.y = (unsigned)q;
                        *(LAS u32x2*)(scr + fr * 64 + bj * 32 + fq * 8) = w8; } }
                if (!seg0) { LDS_WAIT();
                    const int r = lane >> 2, ch = lane & 3; const u32x4 o = *(const LAS u32x4*)(scr + r * 64 + ch * 16);
                    *(GAS u32x4*)((GAS unsigned char*)O + (rg + r) * D_MODEL + colb + ch * 16) = o;
                    LDS_WAIT(); }
            }
        return seg0;
    }
};
struct EpiResid {
    static constexpr bool PERM = false, WIDE = false;
    const GAS bf16_t* X; GAS bf16_t* R;
    __device__ __forceinline__ bool operator()(f32x4 (&acc)[2][2][4][2], const Unit& u, int wr, int wc, int fr, int fq, LAS unsigned char* scr) const {
        const int row0 = u.row0 + wr * 64 + fr, col0 = u.col0 + wc * 32 + 4 * fq;
#pragma unroll
        for (int ai = 0; ai < 2; ++ai)
#pragma unroll
            for (int m = 0; m < 4; ++m) { const size_t off = (size_t)(row0 + ai * 128 + m * 16) * D_MODEL + col0;
#pragma unroll
                for (int bj = 0; bj < 2; ++bj)
#pragma unroll
                    for (int n = 0; n < 2; ++n) { const u32x2 xv = *(const GAS u32x2*)(X + off + bj * 128 + n * 16); const f32x4 a = acc[ai][bj][m][n];
                        u32x2 o; o.x = cvt_pk_bf16(bflo(xv.x) * DN_ALPHA + a[0], bfhi(xv.x) * DN_ALPHA + a[1]); o.y = cvt_pk_bf16(bflo(xv.y) * DN_ALPHA + a[2], bfhi(xv.y) * DN_ALPHA + a[3]);
                        *(GAS u32x2*)(R + off + bj * 128 + n * 16) = o; } }
        return false;
    }
};
template <bool F8OUT>
struct EpiGateUp {
    static constexpr bool PERM = true, WIDE = false;
    GAS bf16_t* HID;
    __device__ __forceinline__ bool operator()(f32x4 (&acc)[2][2][4][2], const Unit& u, int wr, int wc, int fr, int fq, LAS unsigned char* scr) const {
        const int row0 = u.row0 + wr * 64 + fr, col0 = u.col0 + wc * 32 + 8 * fq;
#pragma unroll
        for (int ai = 0; ai < 2; ++ai)
#pragma unroll
            for (int m = 0; m < 4; ++m) { GAS bf16_t* rowp = HID + (size_t)(row0 + ai * 128 + m * 16) * EXPERT_FF + col0;
                f32x4 g0 = acc[ai][0][m][0], g1 = acc[ai][0][m][1]; const f32x4 u0 = acc[ai][1][m][0], u1 = acc[ai][1][m][1];
#pragma unroll
                for (int j = 0; j < 4; ++j) { g0[j] = g0[j] * fsigmoid(g0[j]) * u0[j]; g1[j] = g1[j] * fsigmoid(g1[j]) * u1[j]; }
                if constexpr (F8OUT) { u32x2 w8; int q = __builtin_amdgcn_cvt_pk_fp8_f32(g0[0], g0[1], 0, false); q = __builtin_amdgcn_cvt_pk_fp8_f32(g0[2], g0[3], q, true); w8.x = (unsigned)q;
                    q = __builtin_amdgcn_cvt_pk_fp8_f32(g1[0], g1[1], 0, false); q = __builtin_amdgcn_cvt_pk_fp8_f32(g1[2], g1[3], q, true); w8.y = (unsigned)q;
                    *(GAS u32x2*)((GAS unsigned char*)HID + (size_t)(row0 + ai * 128 + m * 16) * EXPERT_FF + col0) = w8; }
                else { u32x4 w; w.x = cvt_pk_bf16(g0[0], g0[1]); w.y = cvt_pk_bf16(g0[2], g0[3]); w.z = cvt_pk_bf16(g1[0], g1[1]); w.w = cvt_pk_bf16(g1[2], g1[3]);
                    *(GAS u32x4*)rowp = w; } }
        return false;
    }
};
template <bool F8OUT>
struct EpiDown {
    static constexpr bool PERM = true, WIDE = true;
    GAS bf16_t* Y;
    __device__ __forceinline__ bool operator()(f32x4 (&acc)[2][2][4][2], const Unit& u, int wr, int wc, int fr, int fq, LAS unsigned char* scr) const {
        const int lane = fq * 16 + fr, rowb = u.row0 + wr * 64, colb = u.col0 + wc * 64;
#pragma unroll
        for (int ai = 0; ai < 2; ++ai)
#pragma unroll
            for (int m = 0; m < 4; ++m) { const size_t rg = (size_t)(rowb + ai * 128 + m * 16);
                if constexpr (F8OUT) {
#pragma unroll
                    for (int bj = 0; bj < 2; ++bj) { const f32x4 v0 = acc[ai][bj][m][0], v1 = acc[ai][bj][m][1]; u32x2 w8;
                        int q = __builtin_amdgcn_cvt_pk_fp8_f32(v0[0], v0[1], 0, false); q = __builtin_amdgcn_cvt_pk_fp8_f32(v0[2], v0[3], q, true); w8.x = (unsigned)q;
                        q = __builtin_amdgcn_cvt_pk_fp8_f32(v1[0], v1[1], 0, false); q = __builtin_amdgcn_cvt_pk_fp8_f32(v1[2], v1[3], q, true); w8.y = (unsigned)q;
                        *(LAS u32x2*)(scr + fr * 64 + bj * 32 + fq * 8) = w8; }
                    LDS_WAIT();
                    const int r = lane >> 2, ch = lane & 3; const u32x4 o = *(const LAS u32x4*)(scr + r * 64 + ch * 16);
                    *(GAS u32x4*)((GAS unsigned char*)Y + (rg + r) * D_MODEL + colb + ch * 16) = o;
                } else {
#pragma unroll
                    for (int bj = 0; bj < 2; ++bj) { const f32x4 v0 = acc[ai][bj][m][0], v1 = acc[ai][bj][m][1];
                        u32x4 w; w.x = cvt_pk_bf16(v0[0], v0[1]); w.y = cvt_pk_bf16(v0[2], v0[3]); w.z = cvt_pk_bf16(v1[0], v1[1]); w.w = cvt_pk_bf16(v1[2], v1[3]);
                        *(LAS u32x4*)(scr + fr * 128 + (((bj * 4 + fq) ^ (fr & 7)) * 16)) = w; }
                    LDS_WAIT();
                    const int r = lane >> 3, ch = lane & 7;
                    const u32x4 o0 = *(const LAS u32x4*)(scr + r * 128 + ((ch ^ (r & 7)) * 16)), o1 = *(const LAS u32x4*)(scr + (r + 8) * 128 + ((ch ^ (r & 7)) * 16));
                    *(GAS u32x4*)(Y + (rg + r) * D_MODEL + colb + ch * 8) = o0; *(GAS u32x4*)(Y + (rg + r + 8) * D_MODEL + colb + ch * 8) = o1;
                }
                LDS_WAIT(); }
        return false;
    }
};

struct Args { const float* in[20]; float* out; unsigned char* ws; int ph_lo, ph_hi; };
typedef const __attribute__((address_space(4))) Args* CArgsP;
#define GIN(k) ((const GAS float*)(GAS const float*)ap->in[k])
#define PHASE_ARGS() CArgsP ap = (CArgsP)__builtin_amdgcn_kernarg_segment_ptr(); asm volatile("" : "+s"(ap))
struct Frame {
    LAS unsigned char* lds;
    GAS unsigned* ctl;
    GAS unsigned char* ws;
    int G, bid;
};
#define PHASE_IDS() int tid = threadIdx.x; asm volatile("" : "+v"(tid)); const int lane = tid & 63, w = __builtin_amdgcn_readfirstlane(tid >> 6); (void)lane; (void)w

__device__ __forceinline__ int conv_src_col(int mode, int p) {
    if (mode == 1 && p >= C_AQ && p < C_AV) { const int hb = p & ~127, q = p & 127; return hb + (q >> 1) + 64 * (q & 1); }
    return p;
}
__device__ __forceinline__ int conv_dst_row(int mode, int n) {
    if (mode == 1) { if (n >= C_AQ && n < C_AV) { const int hb = n & ~127, dd = n & 127; return hb + (dd < 64 ? 2 * dd : 2 * (dd - 64) + 1); } return n; }
    if (mode == 2) return (n >> 7) * 256 + (n & 127);
    if (mode == 3) return (n >> 7) * 256 + 128 + (n & 127);
    return n;
}
struct ConvJob { const GAS float* W; GAS unsigned char* WT; int K, N, mode, item, ncol0, ncols, f8; float sc8; };
__device__ __forceinline__ void conv_load(const ConvJob& J, int tid, f32x4 (&v)[16]) {
    const int nblk = J.ncols / 256, k0 = 128 * (J.item / nblk), n0 = J.ncol0 + 256 * (J.item % nblk);
    {
#pragma unroll
        for (int ii = 0; ii < 16; ++ii) { const int idx = tid + 512 * ii, k = idx >> 6, c4 = idx & 63; v[ii] = *(const GAS f32x4*)(J.W + (size_t)(k0 + k) * J.N + n0 + 4 * c4); }
    }
}
__device__ __forceinline__ void conv_to_lds(const ConvJob& J, int tid, const f32x4 (&v)[16], LAS float* T) {
#pragma unroll
    for (int ii = 0; ii < 16; ++ii) { const int idx = tid + 512 * ii, k = idx >> 6, c4 = idx & 63; const int g = J.f8 ? ((k >> 4) & 7) : ((k >> 3) & 15);
        *(LAS f32x4*)(T + k * 256 + 4 * (c4 ^ g)) = v[ii]; }
}
__device__ __forceinline__ void conv_from_lds(const ConvJob& J, int tid, const LAS float* T) {
    const int nblk = J.ncols / 256, k0 = 128 * (J.item / nblk), n0 = J.ncol0 + 256 * (J.item % nblk);
    const int lane = tid & 63, w = tid >> 6, j = lane & 3;
    if (J.f8) {
        const int c = (lane >> 2) & 7; const float sc8 = J.sc8;
#pragma unroll
        for (int it = 0; it < 4; ++it) { const int c4n = w * 8 + it * 2 + (lane >> 5), n = 4 * c4n + j; const LAS float* base = T + 4 * (c4n ^ c) + j; u32x4 o;
#pragma unroll
            for (int d = 0; d < 4; ++d) { const int kk = 16 * c + 4 * d;
                int wv = __builtin_amdgcn_cvt_pk_fp8_f32(base[(kk + 0) * 256] * sc8, base[(kk + 1) * 256] * sc8, 0, false);
                wv = __builtin_amdgcn_cvt_pk_fp8_f32(base[(kk + 2) * 256] * sc8, base[(kk + 3) * 256] * sc8, wv, true); o[d] = (unsigned)wv; }
            *(GAS u32x4*)(J.WT + (size_t)conv_dst_row(J.mode, n0 - J.ncol0 + n) * J.K + k0 + 16 * c) = o; }
    } else {
        const int c = ((lane >> 2) & 7) + 8 * (lane >> 5);
#pragma unroll
        for (int it = 0; it < 8; ++it) { const int c4n = w * 8 + it, n = 4 * c4n + j; const LAS float* base = T + 4 * (c4n ^ c) + j + (8 * c) * 256;
            u32x4 o; o.x = cvt_pk_bf16(base[0 * 256], base[1 * 256]); o.y = cvt_pk_bf16(base[2 * 256], base[3 * 256]); o.z = cvt_pk_bf16(base[4 * 256], base[5 * 256]); o.w = cvt_pk_bf16(base[6 * 256], base[7 * 256]);
            *(GAS u32x4*)(J.WT + ((size_t)conv_dst_row(J.mode, n0 - J.ncol0 + n) * J.K + k0 + 8 * c) * 2) = o; }
    }
}
__device__ __forceinline__ void conv8_load(const ConvJob& J, int tid, f32x4 (&v)[16]) {
    const int nblk = J.ncols / 256, k0 = 128 * (J.item / nblk), n0 = J.ncol0 + 256 * (J.item % nblk);
    const int lane = tid & 63, w = tid >> 6, kg = lane & 7, nq = lane >> 3;
    const GAS float* p = J.W + (size_t)(k0 + 16 * kg) * J.N + n0 + 32 * w + 4 * nq;
#pragma unroll
    for (int j = 0; j < 16; ++j) v[j] = *(const GAS f32x4*)(p + (size_t)j * J.N);
}
__device__ __forceinline__ void conv8_store(const ConvJob& J, int tid, const f32x4 (&v)[16]) {
    const int nblk = J.ncols / 256, k0 = 128 * (J.item / nblk), n0 = J.ncol0 + 256 * (J.item % nblk);
    const int lane = tid & 63, w = tid >> 6, kg = lane & 7, nq = lane >> 3; const float sc8 = J.sc8;
#pragma unroll
    for (int c = 0; c < 4; ++c) { u32x4 o;
#pragma unroll
        for (int d = 0; d < 4; ++d) { int wv = __builtin_amdgcn_cvt_pk_fp8_f32(v[4 * d][c] * sc8, v[4 * d + 1][c] * sc8, 0, false);
            wv = __builtin_amdgcn_cvt_pk_fp8_f32(v[4 * d + 2][c] * sc8, v[4 * d + 3][c] * sc8, wv, true); o[d] = (unsigned)wv; }
        *(GAS u32x4*)(J.WT + (size_t)conv_dst_row(J.mode, n0 - J.ncol0 + 32 * w + 4 * nq + c) * J.K + k0 + 16 * kg) = o; }
}
__device__ __forceinline__ void p0_convert(Frame& F, int layer, bool gu8, bool moe8, int part = 0, int tail = 0, GAS unsigned* ctr = nullptr, int seg_lo = 0, int seg_n = -1) {
    PHASE_IDS(); PHASE_ARGS();
    LAS float* TL = (LAS float*)F.lds;
    GAS unsigned char* ws = F.ws;
    const GAS float* w_in = GIN(2) + (size_t)layer * D_MODEL * IN_WIDTH;
    const GAS float* w_hg = GIN(5) + (size_t)layer * HG_WIDTH * D_MODEL;
    const GAS float* w_att = GIN(6) + (size_t)layer * ATT_OUT * D_MODEL;
    const GAS float* w_out = GIN(7) + (size_t)layer * D_MODEL * D_MODEL;
    const GAS float* w_eg = GIN(12) + (size_t)layer * N_EXPERTS * D_MODEL * EXPERT_FF;
    const GAS float* w_eu = GIN(13) + (size_t)layer * N_EXPERTS * D_MODEL * EXPERT_FF;
    const GAS float* w_ed = GIN(14) + (size_t)layer * N_EXPERTS * EXPERT_FF * D_MODEL;
    const GAS float* w_sg = GIN(15) + (size_t)layer * D_MODEL * EXPERT_FF;
    const GAS float* w_su = GIN(16) + (size_t)layer * D_MODEL * EXPERT_FF;
    const GAS float* w_sd = GIN(17) + (size_t)layer * EXPERT_FF * D_MODEL;
    constexpr int I_IN = (D_MODEL / 128) * (IN_WIDTH / 256), I_INF = (D_MODEL / 128) * (HG_WIDTH / 256), I_HG = (HG_WIDTH / 128) * (D_MODEL / 256), I_ATT = (ATT_OUT / 128) * (D_MODEL / 256), I_OUT = (D_MODEL / 128) * (D_MODEL / 256);
    constexpr int I_E = (D_MODEL / 128) * (EXPERT_FF / 256);
    static_assert((EXPERT_FF / 128) * (D_MODEL / 256) == I_E, "item count of the down matrices");
    constexpr int NITEMS = I_IN + I_INF + I_HG + I_ATT + I_OUT + 3 * NEXP1 * I_E;
    auto decode = [&](int it) -> ConvJob {
        int r = it;
        if (r < I_IN) return ConvJob{w_in, ws + WS_WIN, D_MODEL, IN_WIDTH, 1, r, 0, IN_WIDTH, 1, 64.f}; r -= I_IN;
        if (r < I_INF) return ConvJob{w_in, ws + WS_WINF, D_MODEL, IN_WIDTH, 0, r, C_HF, HG_WIDTH, 0, 1.f}; r -= I_INF;
        if (r < I_HG) return ConvJob{w_hg, ws + WS_WHG, HG_WIDTH, D_MODEL, 0, r, 0, D_MODEL, 0, 1.f}; r -= I_HG;
        if (r < I_ATT) return ConvJob{w_att, ws + WS_WATT, ATT_OUT, D_MODEL, 0, r, 0, D_MODEL, 0, 1.f}; r -= I_ATT;
        if (r < I_OUT) return ConvJob{w_out, ws + WS_WOUT, D_MODEL, D_MODEL, 0, r, 0, D_MODEL, 1, 64.f}; r -= I_OUT;
        const int which = r / (NEXP1 * I_E); r -= which * (NEXP1 * I_E);
        const int e = r / I_E, ri = r % I_E; const int es = gu8 ? 1 : 2;
        if (which == 0) return ConvJob{(e < N_EXPERTS) ? w_eg + (size_t)e * D_MODEL * EXPERT_FF : w_sg, ws + (moe8 ? WS_WGU8 : WS_WGU) + (size_t)e * 1024 * D_MODEL * es, D_MODEL, EXPERT_FF, 2, ri, 0, EXPERT_FF, gu8 ? 1 : 0, 64.f};
        if (which == 1) return ConvJob{(e < N_EXPERTS) ? w_eu + (size_t)e * D_MODEL * EXPERT_FF : w_su, ws + (moe8 ? WS_WGU8 : WS_WGU) + (size_t)e * 1024 * D_MODEL * es, D_MODEL, EXPERT_FF, 3, ri, 0, EXPERT_FF, gu8 ? 1 : 0, 64.f};
        return ConvJob{(e < N_EXPERTS) ? w_ed + (size_t)e * EXPERT_FF * D_MODEL : w_sd, ws + (moe8 ? WS_WDN8 : WS_WDN) + (size_t)e * D_MODEL * EXPERT_FF, EXPERT_FF, D_MODEL, 0, ri, 0, D_MODEL, 1, 64.f};
    };
    constexpr int N_NONEXP = I_IN + I_INF + I_HG + I_ATT + I_OUT, NB16 = I_INF + I_HG + I_ATT;
    if (gu8) {
        constexpr int NF8 = NITEMS - NB16, NF8_NONEXP = I_IN + I_OUT;
        const int q_lo = (part == 2) ? NF8_NONEXP : 0, q_end = (part == 1) ? NF8_NONEXP : NF8, q_hi = q_end - tail;
        if (ctr != nullptr) {
            LAS unsigned* qw = (LAS unsigned*)(F.lds + LDS_TAB + 1536);
            for (;;) {
                if (tid == 0) *qw = __hip_atomic_fetch_add(ctr, 1u, RLX_AGENT);
                LDS_BARRIER();
                const int qd = q_hi + seg_lo + __builtin_amdgcn_readfirstlane((int)*qw);
                LDS_BARRIER();
                if (qd >= (seg_n < 0 ? q_end : q_hi + seg_lo + seg_n)) break;
                const ConvJob j = decode(qd < I_IN ? qd : qd + NB16); f32x4 v[16]; conv8_load(j, tid, v); conv8_store(j, tid, v); }
            return;
        }
        int q = q_lo + F.bid;
        if (q < q_hi) {
            f32x4 va[16], vb[16];
            conv8_load(decode(q < I_IN ? q : q + NB16), tid, va);
            for (;;) {
                const int q1 = q + F.G; const bool m1 = q1 < q_hi;
                if (m1) conv8_load(decode(q1 < I_IN ? q1 : q1 + NB16), tid, vb);
                conv8_store(decode(q < I_IN ? q : q + NB16), tid, va);
                if (!m1) break;
                const int q2 = q1 + F.G; const bool m2 = q2 < q_hi;
                if (m2) conv8_load(decode(q2 < I_IN ? q2 : q2 + NB16), tid, va);
                conv8_store(decode(q1 < I_IN ? q1 : q1 + NB16), tid, vb);
                if (!m2) break;
                q = q2; }
        }
        if (part != 2) {
            for (int it = I_IN + (F.G - 1 - F.bid); it < I_IN + NB16; it += F.G) { const ConvJob j = decode(it); f32x4 v[16];
                conv_load(j, tid, v); conv_to_lds(j, tid, v, TL); LDS_BARRIER(); conv_from_lds(j, tid, TL); LDS_BARRIER(); }
        }
    } else {
    const int it_lo = (part == 2) ? N_NONEXP : 0, it_hi = (part == 1) ? N_NONEXP : NITEMS;
    if (it_lo + F.bid < it_hi) {
        f32x4 va[16]; int it = it_lo + F.bid; ConvJob jc = decode(it);
        conv_load(jc, tid, va);
        for (;;) { const int itn = it + F.G; const bool more = itn < it_hi;
            conv_to_lds(jc, tid, va, TL);
            LDS_BARRIER();
            ConvJob jn = jc; if (more) { jn = decode(itn); conv_load(jn, tid, va); }
            conv_from_lds(jc, tid, TL);
            LDS_BARRIER();
            if (!more) break;
            jc = jn; it = itn; }
    }
    }
    if (layer == 0 && part != 2) {
        const GAS f32x4* x4 = (const GAS f32x4*)GIN(0); GAS u32x2* xb = (GAS u32x2*)(ws + WS_XB); GAS unsigned* xb8 = (GAS unsigned*)(ws + WS_XB8);
        for (size_t i = (size_t)F.bid * 512 + tid; i < (size_t)T * D_MODEL / 4; i += (size_t)F.G * 512) { const f32x4 v = x4[i]; u32x2 o; o.x = pk2(v[0], v[1]); o.y = pk2(v[2], v[3]); xb[i] = o;
            int w8 = __builtin_amdgcn_cvt_pk_fp8_f32(v[0], v[1], 0, false); w8 = __builtin_amdgcn_cvt_pk_fp8_f32(v[2], v[3], w8, true); xb8[i] = (unsigned)w8; }
        const GAS int* pos = (const GAS int*)GIN(1); GAS f32x2* rt = (GAS f32x2*)(ws + WS_ROPE);
        for (int i = F.bid * 512 + tid; i < T * 64; i += F.G * 512) { const int tk = i >> 6, fi = i & 63;
            const double inv = exp2(-(double)fi * (13.287712379549449 / 64.0));
            const double ang = (double)pos[tk] * inv; const double red = ang - rint(ang * 0.15915494309189535) * 6.283185307179586;
            const float rf = (float)red; rt[i] = (f32x2){cosf(rf), sinf(rf)}; }
        const GAS float* lbl = GIN(3); GAS float* lb = (GAS float*)(ws + WS_LB);
        for (int c = F.bid * 512 + tid; c < HG_WIDTH; c += F.G * 512) {
            float mx = -1e30f; for (int l = 0; l < DEPTH; ++l) mx = fmaxf(mx, lbl[l * HG_WIDTH + c]);
            float den = 0.f; for (int l = 0; l < DEPTH; ++l) den += expf(lbl[l * HG_WIDTH + c] - mx);
            float cum = 0.f, c0 = 0.f; for (int l = 0; l < DEPTH; ++l) { cum += expf(lbl[l * HG_WIDTH + c] - mx) / den; if (l == 0) c0 = cum; lb[l * HG_WIDTH + c] = cum - c0; }
        }
    }
}

constexpr int TROW = 272;
struct H1Regs { float lf[16]; u32x4 v[2]; };
__device__ __forceinline__ void h1_load(Frame& F, int chunk, int tid, H1Regs& R) {
    const GAS bf16_t* H = (const GAS bf16_t*)(F.ws + WS_H); const GAS _Float16* LF = (const GAS _Float16*)(F.ws + WS_LF);
    const int bh = chunk >> 5, n = chunk & 31, b = bh >> 3, head = bh & 7, tok0 = b * SEQ + n * 64, kk = tid & 127, part = tid >> 7;
    const GAS _Float16* p = LF + HOFF(head * 128, tok0 + part * 16) + kk;
#pragma unroll
    for (int j = 0; j < 16; ++j) R.lf[j] = (float)p[(size_t)j * 128];
#pragma unroll
    for (int j = 0; j < 2; ++j) { const int c = tid + 512 * j, row = c >> 4, ch = c & 15;
        R.v[j] = *(const GAS u32x4*)(H + HOFF(C_HI + head * 128, tok0 + row) + ch * 8); }
}
__device__ __forceinline__ void h1_item(Frame& F, int chunk, int tid, const H1Regs& R) {
    GAS float* UT = (GAS float*)(F.ws + WS_UT); GAS float* DEC = (GAS float*)(F.ws + WS_DEC);
    LAS unsigned char* KT = F.lds; LAS unsigned char* VT = F.lds + 17408; LAS float* TOT = (LAS float*)(F.lds + 34816);
    const int lane = tid & 63, w = __builtin_amdgcn_readfirstlane(tid >> 6);
    const int kk = tid & 127, part = tid >> 7, g = lane >> 4, i = lane & 15;
    float lf[16], cum[16];
#pragma unroll
    for (int j = 0; j < 16; ++j) lf[j] = R.lf[j];
#pragma unroll
    for (int j = 0; j < 2; ++j) { const int c = tid + 512 * j, row = c >> 4, ch = c & 15; *(LAS u32x4*)(VT + row * TROW + ch * 16) = R.v[j]; }
    float run = 0.f;
#pragma unroll
    for (int j = 0; j < 16; ++j) { run += lf[j]; cum[j] = run; }
    TOT[part * 128 + kk] = run;
    LDS_BARRIER();
    float off = 0.f, end = 0.f;
#pragma unroll
    for (int p = 0; p < 4; ++p) { const float t = TOT[p * 128 + kk]; if (p < part) off += t; end += t; }
#pragma unroll
    for (int j = 0; j < 16; ++j) { const float c = cum[j] + off; const float kt = (1.0f - __expf(lf[j])) * __expf(end - c);
        *(LAS unsigned short*)(KT + (part * 16 + j) * TROW + kk * 2) = (unsigned short)cvt_pk_bf16(kt, 0.f); }
    if (part == 0) DEC[(size_t)chunk * 128 + kk] = __expf(end);
    LDS_BARRIER();
    const unsigned ktb = (unsigned)(size_t)KT, vtb = (unsigned)(size_t)VT;
    const int q = i >> 2, p4 = i & 3;
    bf16x8 af[2];
#pragma unroll
    for (int ks = 0; ks < 2; ++ks) { const s16x4 lo = tr_read(ktb + (32 * ks + 8 * g + q) * TROW + (16 * w + 4 * p4) * 2), hi = tr_read(ktb + (32 * ks + 8 * g + 4 + q) * TROW + (16 * w + 4 * p4) * 2);
        af[ks] = (bf16x8){lo[0], lo[1], lo[2], lo[3], hi[0], hi[1], hi[2], hi[3]}; }
    f32x4 uacc[8];
#pragma unroll
    for (int vb = 0; vb < 8; ++vb) uacc[vb] = (f32x4){0.f, 0.f, 0.f, 0.f};
#pragma unroll
    for (int ks = 0; ks < 2; ++ks) { s16x4 lo[8], hi[8];
        tr_read8<32>(lo, vtb + (32 * ks + 8 * g + q) * TROW + 8 * p4); tr_read8<32>(hi, vtb + (32 * ks + 8 * g + 4 + q) * TROW + 8 * p4);
#pragma unroll
        for (int vb = 0; vb < 8; ++vb) uacc[vb] = mfma16(af[ks], TRCAT(lo[vb], hi[vb]), uacc[vb]); }
#pragma unroll
    for (int vb = 0; vb < 8; ++vb) { u32x2 wv; wv.x = pk2(uacc[vb][0], uacc[vb][1]); wv.y = pk2(uacc[vb][2], uacc[vb][3]);
        *(GAS u32x2*)((GAS bf16_t*)UT + (size_t)chunk * 16384 + (16 * vb + i) * 128 + 16 * w + 4 * g) = wv; }
    LDS_BARRIER();
}

__device__ __forceinline__ void attn_item(Frame& F, int it) {
    GAS bf16_t* H = (GAS bf16_t*)(F.ws + WS_H); GAS float* LSE = (GAS float*)(F.ws + WS_LSE);
    const int b = it / 192, rem = it % 192, h = rem >> 4, j = rem & 15, grp = h >> 2, dsh = 2 * grp, d = 1 << dsh, r = j & (d - 1), qb = j >> dsh;
    const int lbase = 128 * (qb - 1);
    GAS bf16_t* HbQ = H + HOFF(C_AQ + h * 128, b * SEQ); GAS bf16_t* HbK = H + HOFF(C_AK + h * 128, b * SEQ); GAS bf16_t* HbV = H + HOFF(C_AV + h * 128, b * SEQ);
    LAS unsigned char* KT = F.lds; LAS unsigned char* VT = F.lds + 256 * TROW;
    PHASE_IDS();
    const int g = lane >> 4, i = lane & 15;
    const int jb0 = (qb == 0) ? (8 - w) : 0;
#pragma unroll
    for (int jj = 0; jj < 8; ++jj) { if (qb == 0 && jj < 4) continue;
        const int c = tid + 512 * jj, row = c >> 4, ch = c & 15; int l = lbase + row; l = l < 0 ? 0 : l; const size_t tok = (size_t)(l * d + r);
        const u32x4 kv = *(const GAS u32x4*)(HbK + tok * 128 + ch * 8), vv = *(const GAS u32x4*)(HbV + tok * 128 + ch * 8);
        *(LAS u32x4*)(KT + row * TROW + ch * 16) = kv; *(LAS u32x4*)(VT + row * TROW + ch * 16) = vv; }
    const size_t tokq = (size_t)((128 * qb + 16 * w + i) * d + r);
    bf16x8 qf[4];
#pragma unroll
    for (int ks = 0; ks < 4; ++ks) qf[ks] = *(const GAS bf16x8*)(HbQ + tokq * 128 + 32 * ks + 8 * g);
    LDS_BARRIER();
    f32x4 s[9];
#pragma unroll
    for (int jb = 0; jb < 9; ++jb) { f32x4 a4 = {0.f, 0.f, 0.f, 0.f};
        if (jb >= jb0) {
#pragma unroll
            for (int ks = 0; ks < 4; ++ks) { const bf16x8 a = *(const LAS bf16x8*)(KT + (16 * (w + jb) + i) * TROW + (32 * ks + 8 * g) * 2); a4 = mfma16(a, qf[ks], a4); } }
        s[jb] = a4; }
    float mx = -1e30f;
#pragma unroll
    for (int jb = 0; jb < 9; ++jb)
#pragma unroll
        for (int rg = 0; rg < 4; ++rg) { const int kin = 4 * g + rg, dist = 128 - 16 * jb + i - kin, lk = lbase + 16 * (w + jb) + kin;
            const bool valid = ((unsigned)dist <= 128u) && (lk >= 0) && (jb >= jb0);
            const float v = valid ? s[jb][rg] : -INFINITY; s[jb][rg] = v; mx = fmaxf(mx, v); }
    mx = fmaxf(mx, __shfl_xor(mx, 16)); mx = fmaxf(mx, __shfl_xor(mx, 32));
    float den = 0.f;
#pragma unroll
    for (int jb = 0; jb < 9; ++jb)
#pragma unroll
        for (int rg = 0; rg < 4; ++rg) { const float p = __expf(s[jb][rg] - mx); s[jb][rg] = p; den += p; }
    den += __shfl_xor(den, 16); den += __shfl_xor(den, 32);
    f32x4 o[8];
#pragma unroll
    for (int db = 0; db < 8; ++db) o[db] = (f32x4){0.f, 0.f, 0.f, 0.f};
    const unsigned vtb = (unsigned)(size_t)VT; const int q = i >> 2, p4 = i & 3;
#pragma unroll
    for (int kp = 0; kp < 5; ++kp) {
        bf16x8 pb; { const unsigned a0 = cvt_pk_bf16(s[2 * kp][0], s[2 * kp][1]), a1 = cvt_pk_bf16(s[2 * kp][2], s[2 * kp][3]);
            unsigned b0 = 0u, b1 = 0u; if (kp < 4) { b0 = cvt_pk_bf16(s[2 * kp + 1][0], s[2 * kp + 1][1]); b1 = cvt_pk_bf16(s[2 * kp + 1][2], s[2 * kp + 1][3]); }
            const u32x4 t4 = {a0, a1, b0, b1}; pb = __builtin_bit_cast(bf16x8, t4); }
        if (2 * kp + 1 < jb0) continue;
        int r0 = 16 * (w + 2 * kp) + 4 * g + q; const int r1 = (kp < 4) ? r0 + 16 : r0;
        if (2 * kp < jb0) r0 = r1;
        s16x4 lo[8], hi[8];
        tr_read8<32>(lo, vtb + r0 * TROW + 8 * p4); tr_read8<32>(hi, vtb + r1 * TROW + 8 * p4);
#pragma unroll
        for (int db = 0; db < 8; ++db) o[db] = mfma16(TRCAT(lo[db], hi[db]), pb, o[db]);
    }
    const float rden = fdiv(1.0f, den);
#pragma unroll
    for (int db = 0; db < 8; ++db) { u32x2 wv; wv.x = cvt_pk_bf16(o[db][0] * rden, o[db][1] * rden); wv.y = cvt_pk_bf16(o[db][2] * rden, o[db][3] * rden);
        *(GAS u32x2*)(HbQ + tokq * 128 + 16 * db + 4 * g) = wv; }
    if (g == 0) LSE[(size_t)h * T + (size_t)b * SEQ + tokq] = mx + __logf(den);
    LDS_BARRIER();
}

__device__ __forceinline__ void scan_item(Frame& F, int item) {
    const GAS float* UT = (const GAS float*)(F.ws + WS_UT); const GAS float* DEC = (const GAS float*)(F.ws + WS_DEC); GAS bf16_t* SPT = (GAS bf16_t*)(F.ws + WS_SPT);
    PHASE_IDS();
    const int bh = item >> 2, q4 = item & 3, vv = q4 * 32 + (tid >> 4), kk0 = (tid & 15) * 8;
    f32x4 s0 = {0.f, 0.f, 0.f, 0.f}, s1 = {0.f, 0.f, 0.f, 0.f};
#pragma unroll 8
    for (int n = 0; n < 32; ++n) { const size_t chunk = (size_t)bh * 32 + n; const size_t eo = chunk * 16384 + (size_t)vv * 128 + kk0;
        const u32x4 ub = *(const GAS u32x4*)((const GAS bf16_t*)UT + eo); const f32x4 u0 = {bflo(ub.x), bfhi(ub.x), bflo(ub.y), bfhi(ub.y)}, u1 = {bflo(ub.z), bfhi(ub.z), bflo(ub.w), bfhi(ub.w)}, d0 = *(const GAS f32x4*)(DEC + chunk * 128 + kk0), d1 = *(const GAS f32x4*)(DEC + chunk * 128 + kk0 + 4);
        u32x4 wv; wv.x = cvt_pk_bf16(s0[0], s0[1]); wv.y = cvt_pk_bf16(s0[2], s0[3]); wv.z = cvt_pk_bf16(s1[0], s1[1]); wv.w = cvt_pk_bf16(s1[2], s1[3]);
        *(GAS u32x4*)(SPT + eo) = wv;
        s0 = d0 * s0 + u0; s1 = d1 * s1 + u1; }
}
__device__ __forceinline__ void attn_merge(Frame& F) {
    const GAS bf16_t* H = (const GAS bf16_t*)(F.ws + WS_H); const GAS float* LSE = (const GAS float*)(F.ws + WS_LSE); GAS bf16_t* ATTO = (GAS bf16_t*)(F.ws + WS_ATTO);
    PHASE_IDS();
    const int gw = F.bid * 8 + w, NGW = F.G * 8, hg = lane >> 4, d0 = (lane & 15) * 8;
    for (int t = gw; t < T; t += NGW) {
        const float l0 = LSE[(size_t)hg * T + t], l1 = LSE[(size_t)(4 + hg) * T + t], l2 = LSE[(size_t)(8 + hg) * T + t];
        const float mx = fmaxf(l0, fmaxf(l1, l2)); float w0 = __expf(l0 - mx), w1 = __expf(l1 - mx), w2 = __expf(l2 - mx); const float rs = fdiv(1.0f, w0 + w1 + w2); w0 *= rs; w1 *= rs; w2 *= rs;
        const GAS bf16_t* base = H + HOFF(C_AQ + hg * 128, t) + d0;
        const u32x4 a = *(const GAS u32x4*)base, bq = *(const GAS u32x4*)(base + (size_t)4 * T * 128), c = *(const GAS u32x4*)(base + (size_t)8 * T * 128);
        u32x4 wv;
        wv.x = cvt_pk_bf16(w0 * bflo(a.x) + w1 * bflo(bq.x) + w2 * bflo(c.x), w0 * bfhi(a.x) + w1 * bfhi(bq.x) + w2 * bfhi(c.x));
        wv.y = cvt_pk_bf16(w0 * bflo(a.y) + w1 * bflo(bq.y) + w2 * bflo(c.y), w0 * bfhi(a.y) + w1 * bfhi(bq.y) + w2 * bfhi(c.y));
        wv.z = cvt_pk_bf16(w0 * bflo(a.z) + w1 * bflo(bq.z) + w2 * bflo(c.z), w0 * bfhi(a.z) + w1 * bfhi(bq.z) + w2 * bfhi(c.z));
        wv.w = cvt_pk_bf16(w0 * bflo(a.w) + w1 * bflo(bq.w) + w2 * bflo(c.w), w0 * bfhi(a.w) + w1 * bfhi(bq.w) + w2 * bfhi(c.w));
        *(GAS u32x4*)(ATTO + (size_t)t * ATT_OUT + hg * 128 + d0) = wv;
    }
}

struct H3Regs { float lf[16]; unsigned short q[16]; u32x4 v[2]; u32x4 sp[4]; };
__device__ __forceinline__ void h3_load(Frame& F, int chunk, int tid, H3Regs& R) {
    const GAS bf16_t* H = (const GAS bf16_t*)(F.ws + WS_H); const GAS _Float16* LF = (const GAS _Float16*)(F.ws + WS_LF); const GAS bf16_t* SPT = (const GAS bf16_t*)(F.ws + WS_SPT);
    const int bh = chunk >> 5, n = chunk & 31, b = bh >> 3, head = bh & 7, tok0 = b * SEQ + n * 64, kk = tid & 127, part = tid >> 7;
    const GAS _Float16* p = LF + HOFF(head * 128, tok0 + part * 16) + kk; const GAS bf16_t* pq = H + HOFF(C_HQ + head * 128, tok0 + part * 16) + kk;
#pragma unroll
    for (int j = 0; j < 16; ++j) { R.lf[j] = (float)p[(size_t)j * 128]; R.q[j] = pq[(size_t)j * 128]; }
#pragma unroll
    for (int j = 0; j < 2; ++j) { const int c = tid + 512 * j, row = c >> 4, ch = c & 15; R.v[j] = *(const GAS u32x4*)(H + HOFF(C_HI + head * 128, tok0 + row) + ch * 8); }
#pragma unroll
    for (int j = 0; j < 4; ++j) { const int c = tid + 512 * j, row = c >> 4, ch = c & 15; R.sp[j] = *(const GAS u32x4*)(SPT + (size_t)chunk * 16384 + row * 128 + ch * 8); }
}
__device__ __forceinline__ void h3_item(Frame& F, int chunk, const GAS float* normg, int tid, const H3Regs& R) {
    const GAS bf16_t* H = (const GAS bf16_t*)(F.ws + WS_H); GAS bf16_t* HGO = (GAS bf16_t*)(F.ws + WS_HGO);
    const int bh = chunk >> 5, n = chunk & 31, b = bh >> 3, head = bh & 7, tok0 = b * SEQ + n * 64;
    LAS unsigned char* QT = F.lds; LAS unsigned char* QH = F.lds + 17408; LAS unsigned char* KH = F.lds + 34816; LAS unsigned char* VT = F.lds + 52224; LAS unsigned char* SP = F.lds + 69632;
    LAS float* TOT = (LAS float*)(F.lds + 104448); LAS float* RS = (LAS float*)(F.lds + 106496);
    const int lane = tid & 63, w = __builtin_amdgcn_readfirstlane(tid >> 6);
    const int kk = tid & 127, part = tid >> 7, g = lane >> 4, i = lane & 15;
    float lf[16], cum[16], qv[16];
#pragma unroll
    for (int j = 0; j < 16; ++j) { lf[j] = R.lf[j]; qv[j] = bf2f(R.q[j]); }
#pragma unroll
    for (int j = 0; j < 2; ++j) { const int c = tid + 512 * j, row = c >> 4, ch = c & 15; *(LAS u32x4*)(VT + row * TROW + ch * 16) = R.v[j]; }
#pragma unroll
    for (int j = 0; j < 4; ++j) { const int c = tid + 512 * j, row = c >> 4, ch = c & 15; *(LAS u32x4*)(SP + row * TROW + ch * 16) = R.sp[j]; }
    float run = 0.f;
#pragma unroll
    for (int j = 0; j < 16; ++j) { run += lf[j]; cum[j] = run; }
    TOT[part * 128 + kk] = run;
    LDS_BARRIER();
    float off = 0.f;
#pragma unroll
    for (int p = 0; p < 4; ++p) { const float t = TOT[p * 128 + kk]; if (p < part) off += t; }
    const float cmid = TOT[kk] + TOT[128 + kk];
#pragma unroll
    for (int j = 0; j < 16; ++j) { const float c = cum[j] + off; const int t = part * 16 + j; const float kq = 1.0f - __expf(lf[j]);
        const unsigned w01 = cvt_pk_bf16(qv[j] * __expf(c), qv[j] * __expf(fminf(c - cmid, 60.f)));
        *(LAS unsigned short*)(QT + t * TROW + kk * 2) = (unsigned short)w01;
        *(LAS unsigned short*)(QH + t * TROW + kk * 2) = (unsigned short)(w01 >> 16);
        *(LAS unsigned short*)(KH + t * TROW + kk * 2) = (unsigned short)cvt_pk_bf16(kq * __expf(fminf(cmid - c, 60.f)), 0.f); }
    LDS_BARRIER();
    const int tb = w & 3, vh = w >> 2;
    f32x4 at[4];
#pragma unroll
    for (int sb = 0; sb < 4; ++sb) { f32x4 a4 = {0.f, 0.f, 0.f, 0.f};
        if (sb <= tb) {
#pragma unroll
            for (int ks = 0; ks < 4; ++ks) { const bf16x8 a = *(const LAS bf16x8*)(KH + (16 * sb + i) * TROW + (32 * ks + 8 * g) * 2), bq = *(const LAS bf16x8*)(QH + (16 * tb + i) * TROW + (32 * ks + 8 * g) * 2);
                a4 = mfma16(a, bq, a4); }
            if (sb == tb) {
#pragma unroll
                for (int rg = 0; rg < 4; ++rg) a4[rg] = (4 * g + rg <= i) ? a4[rg] : 0.f; }
        }
        at[sb] = a4; }
    bf16x8 pb[2];
#pragma unroll
    for (int kp = 0; kp < 2; ++kp) { const u32x4 t4 = {pk2(at[2 * kp][0], at[2 * kp][1]), pk2(at[2 * kp][2], at[2 * kp][3]), pk2(at[2 * kp + 1][0], at[2 * kp + 1][1]), pk2(at[2 * kp + 1][2], at[2 * kp + 1][3])};
        pb[kp] = __builtin_bit_cast(bf16x8, t4); }
    const unsigned vtb = (unsigned)(size_t)VT; const int q = i >> 2, p4 = i & 3;
    f32x4 o[4]; float ss = 0.f;
    s16x4 vlo[2][4], vhi[2][4];
#pragma unroll
    for (int kp = 0; kp < 2; ++kp) tr_read4x2<32>(vlo[kp], vhi[kp], vtb + (32 * kp + 4 * g + q) * TROW + (64 * vh + 4 * p4) * 2, vtb + (32 * kp + 16 + 4 * g + q) * TROW + (64 * vh + 4 * p4) * 2);
#pragma unroll
    for (int vb = 0; vb < 4; ++vb) { const int vblk = 4 * vh + vb; f32x4 acc = {0.f, 0.f, 0.f, 0.f};
#pragma unroll
        for (int ks = 0; ks < 4; ++ks) { const bf16x8 a = *(const LAS bf16x8*)(SP + (16 * vblk + i) * TROW + (32 * ks + 8 * g) * 2), bq = *(const LAS bf16x8*)(QT + (16 * tb + i) * TROW + (32 * ks + 8 * g) * 2);
            acc = mfma16(a, bq, acc); }
#pragma unroll
        for (int kp = 0; kp < 2; ++kp) acc = mfma16(TRCAT(vlo[kp][vb], vhi[kp][vb]), pb[kp], acc);
        o[vb] = acc; ss += (acc[0] * acc[0] + acc[1] * acc[1]) + (acc[2] * acc[2] + acc[3] * acc[3]); }
    ss += __shfl_xor(ss, 16); ss += __shfl_xor(ss, 32);
    if (g == 0) RS[vh * 64 + 16 * tb + i] = ss;
    LDS_BARRIER();
    const float tot = RS[16 * tb + i] + RS[64 + 16 * tb + i];
    const float rinv = rsqrtf(tot * (1.0f / 128.0f) + NORM_EPS);
    const size_t tok = (size_t)(tok0 + 16 * tb + i);
#pragma unroll
    for (int vb = 0; vb < 4; ++vb) { const int vv = 16 * (4 * vh + vb) + 4 * g;
        const f32x4 ng = *(const GAS f32x4*)(normg + head * 128 + vv); const u32x2 gt = *(const GAS u32x2*)(H + HOFF(C_HGATE + head * 128, tok) + vv);
        u32x2 wv; wv.x = cvt_pk_bf16(o[vb][0] * rinv * ng[0] * bflo(gt.x), o[vb][1] * rinv * ng[1] * bfhi(gt.x)); wv.y = cvt_pk_bf16(o[vb][2] * rinv * ng[2] * bflo(gt.y), o[vb][3] * rinv * ng[3] * bfhi(gt.y));
        *(GAS u32x2*)(HGO + tok * HG_WIDTH + head * 128 + vv) = wv; }
    LDS_BARRIER();
}

template <bool X8>
__device__ __forceinline__ void ln_router_phase(Frame& F, int layer) {
    PHASE_ARGS();
    const GAS bf16_t* R = (const GAS bf16_t*)(F.ws + WS_R); GAS bf16_t* X1B = (GAS bf16_t*)(F.ws + WS_X1B); GAS unsigned char* X1B8 = F.ws + WS_X1B8;
    const GAS float* g1 = GIN(8) + (size_t)layer * D_MODEL; const GAS float* b1 = GIN(9) + (size_t)layer * D_MODEL;
    const GAS float* wrt = GIN(10) + (size_t)layer * D_MODEL * N_EXPERTS; const GAS float* rbias = GIN(11) + (size_t)layer * N_EXPERTS;
    GAS int* PE = (GAS int*)(F.ws + WS_PE); GAS int* PP = (GAS int*)(F.ws + WS_PP); GAS float* PG = (GAS float*)(F.ws + WS_PG); GAS int* RM = (GAS int*)(F.ws + WS_RM);
    GAS unsigned* cnt = F.ctl + CW_CNT + layer * 64;
    constexpr int XROW = 528, WROW = 144;
    LAS unsigned char* XSb = F.lds; LAS unsigned char* WSb = F.lds + 64 * XROW; LAS float* PART = (LAS float*)F.lds; LAS float* LG = (LAS float*)(F.lds + 32768);
    LAS int* LCNT = (LAS int*)(F.lds + 49152); LAS int* BASE = (LAS int*)(F.lds + 49408); LAS int* PEL = (LAS int*)(F.lds + 49664); LAS int* PLL = (LAS int*)(F.lds + 51712);
    PHASE_IDS();
    const int g = lane >> 4, i = lane & 15;
    for (int bt = F.bid; bt < T / 64; bt += F.G) {
        const int tok0 = bt * 64;
#pragma unroll 1
        for (int pr = 0; pr < 4; ++pr) {
            f32x4 ys[2][4][2];
#pragma unroll
            for (int tt = 0; tt < 2; ++tt) { const size_t token = (size_t)(tok0 + 8 * w + 2 * pr + tt);
                const GAS u32x4* rp = (const GAS u32x4*)(R + token * D_MODEL) + lane;
#pragma unroll
                for (int j = 0; j < 4; ++j) { const u32x4 r = rp[64 * j]; ys[tt][j][0] = (f32x4){bflo(r.x), bfhi(r.x), bflo(r.y), bfhi(r.y)}; ys[tt][j][1] = (f32x4){bflo(r.z), bfhi(r.z), bflo(r.w), bfhi(r.w)}; } }
#pragma unroll
            for (int tt = 0; tt < 2; ++tt) { const size_t token = (size_t)(tok0 + 8 * w + 2 * pr + tt); float s = 0.f;
#pragma unroll
                for (int j = 0; j < 4; ++j)
#pragma unroll
                    for (int h = 0; h < 2; ++h) s += (ys[tt][j][h][0] + ys[tt][j][h][1]) + (ys[tt][j][h][2] + ys[tt][j][h][3]);
                const float mean = wave_sum(s) * (1.0f / D_MODEL); float s2 = 0.f;
#pragma unroll
                for (int j = 0; j < 4; ++j)
#pragma unroll
                    for (int h = 0; h < 2; ++h) { ys[tt][j][h] = ys[tt][j][h] - mean; s2 += (ys[tt][j][h][0] * ys[tt][j][h][0] + ys[tt][j][h][1] * ys[tt][j][h][1]) + (ys[tt][j][h][2] * ys[tt][j][h][2] + ys[tt][j][h][3] * ys[tt][j][h][3]); }
                const float rstd = rsqrtf(wave_sum(s2) * (1.0f / D_MODEL) + LN_EPS);
#pragma unroll
                for (int j = 0; j < 4; ++j) { const int c = 8 * lane + 512 * j;
                    const f32x4 y0 = ys[tt][j][0] * rstd * *(const GAS f32x4*)(g1 + c) + *(const GAS f32x4*)(b1 + c), y1 = ys[tt][j][1] * rstd * *(const GAS f32x4*)(g1 + c + 4) + *(const GAS f32x4*)(b1 + c + 4);
                    u32x4 o; o.x = cvt_pk_bf16(y0[0], y0[1]); o.y = cvt_pk_bf16(y0[2], y0[3]); o.z = cvt_pk_bf16(y1[0], y1[1]); o.w = cvt_pk_bf16(y1[2], y1[3]);
                    *(GAS u32x4*)(X1B + token * D_MODEL + c) = o;
                    if constexpr (X8) { u32x2 w8; int q8 = __builtin_amdgcn_cvt_pk_fp8_f32(y0[0], y0[1], 0, false); q8 = __builtin_amdgcn_cvt_pk_fp8_f32(y0[2], y0[3], q8, true); w8.x = (unsigned)q8;
                        q8 = __builtin_amdgcn_cvt_pk_fp8_f32(y1[0], y1[1], 0, false); q8 = __builtin_amdgcn_cvt_pk_fp8_f32(y1[2], y1[3], q8, true); w8.y = (unsigned)q8;
                        *(GAS u32x2*)(X1B8 + token * D_MODEL + c) = w8; } }
            }
        }
        VM_WAIT(); __syncthreads();
        f32x4 dacc[4];
#pragma unroll
        for (int nb = 0; nb < 4; ++nb) dacc[nb] = (f32x4){0.f, 0.f, 0.f, 0.f};
        const int tt4 = w & 3, kh = w >> 2;
        u32x4 xr[4];
#pragma unroll
        for (int j = 0; j < 4; ++j) { const int idx = tid + 512 * j, row = idx >> 5, c8 = idx & 31; xr[j] = *(const GAS u32x4*)(X1B + (size_t)(tok0 + row) * D_MODEL + 8 * c8); }
#pragma unroll 1
        for (int ke = 0; ke < 8; ++ke) { const int k1 = 256 * (ke + 1);
#pragma unroll
            for (int j = 0; j < 4; ++j) { const int idx = tid + 512 * j, row = idx >> 5, c8 = idx & 31; *(LAS u32x4*)(XSb + row * XROW + c8 * 16) = xr[j]; }
#pragma unroll
            for (int j = 0; j < 8; ++j) { const int idx = tid + 512 * j, row = idx >> 4, c4 = idx & 15; const f32x4 v = *(const GAS f32x4*)(wrt + (size_t)(k1 - 256 + row) * N_EXPERTS + 4 * c4);
                u32x2 o; o.x = cvt_pk_bf16(v[0], v[1]); o.y = cvt_pk_bf16(v[2], v[3]); *(LAS u32x2*)(WSb + row * WROW + c4 * 8) = o; }
            LDS_BARRIER();
            if (ke < 7) {
#pragma unroll
                for (int j = 0; j < 4; ++j) { const int idx = tid + 512 * j, row = idx >> 5, c8 = idx & 31; xr[j] = *(const GAS u32x4*)(X1B + (size_t)(tok0 + row) * D_MODEL + k1 + 8 * c8); }
            }
            { const unsigned wsb = (unsigned)(size_t)WSb; const int q = i >> 2, p4 = i & 3;
#pragma unroll
              for (int ks = 0; ks < 4; ++ks) { const int kk0 = 128 * kh + 32 * ks;
                const bf16x8 a = *(const LAS bf16x8*)(XSb + (tt4 * 16 + i) * XROW + (kk0 + 8 * g) * 2);
                s16x4 lo4[4], hi4[4];
                tr_read4x2<32>(lo4, hi4, wsb + (kk0 + 8 * g + q) * WROW + 8 * p4, wsb + (kk0 + 8 * g + 4 + q) * WROW + 8 * p4);
#pragma unroll
                for (int nb = 0; nb < 4; ++nb) dacc[nb] = mfma16(a, TRCAT(lo4[nb], hi4[nb]), dacc[nb]); } }
            LDS_BARRIER();
        }
#pragma unroll
        for (int nb = 0; nb < 4; ++nb)
#pragma unroll
            for (int rg = 0; rg < 4; ++rg) PART[(kh * 64 + tt4 * 16 + 4 * g + rg) * 64 + 16 * nb + i] = dacc[nb][rg];
        __syncthreads();
        { const f32x4 a0 = *(const LAS f32x4*)(PART + tid * 8), a1 = *(const LAS f32x4*)(PART + tid * 8 + 4), c0 = *(const LAS f32x4*)(PART + 4096 + tid * 8), c1 = *(const LAS f32x4*)(PART + 4096 + tid * 8 + 4);
          __syncthreads();
          *(LAS f32x4*)(LG + tid * 8) = a0 + c0; *(LAS f32x4*)(LG + tid * 8 + 4) = a1 + c1; }
        if (tid < 64) { RM[(size_t)N_EXPERTS * T + tok0 + tid] = tok0 + tid; LCNT[tid] = 0; }
        __syncthreads();
#pragma unroll 1
        for (int tt = 0; tt < 8; ++tt) { const int tk = 8 * w + tt, token = tok0 + tk, e = lane;
            const float sc = 1.0f / (1.0f + expf(-LG[tk * 64 + e])); const float sel = sc + rbias[e];
            const float m1 = max8_dpp(sel);
            const unsigned long long bal = __ballot(sel == m1) & (0xFFull << (8 * (e >> 3)));
            const int first = __builtin_ctzll(bal);
            const float v2 = max8_dpp((e == first) ? -INFINITY : sel);
            const float gs = m1 + v2; int grank = 0;
#pragma unroll
            for (int gp = 0; gp < 8; ++gp) { const float o = __builtin_bit_cast(float, __builtin_amdgcn_readlane(__builtin_bit_cast(int, gs), 8 * gp)); grank += (o > gs || (o == gs && gp < (e >> 3))) ? 1 : 0; }
            const bool gsel = grank < TOPK_GROUPS; const float sel2 = gsel ? sel : -INFINITY; int rank = 0;
            const unsigned long long gbal = __ballot(gsel);
#pragma unroll 1
            for (int gp = 0; gp < 8; ++gp) { if (((gbal >> (8 * gp)) & 1ull) == 0ull) continue;
#pragma unroll
                for (int q = 0; q < 8; ++q) { const int ep = 8 * gp + q; const float o = __builtin_bit_cast(float, __builtin_amdgcn_readlane(__builtin_bit_cast(int, sel2), ep)); rank += (o > sel2 || (o == sel2 && ep < e)) ? 1 : 0; } }
            const bool chosen = gsel && rank < TOP_K;
            float wsum = 0.f; { unsigned long long cb = __ballot(chosen);
                while (cb) { const int l = __builtin_ctzll(cb); wsum += __builtin_bit_cast(float, __builtin_amdgcn_readlane(__builtin_bit_cast(int, sc), l)); cb &= cb - 1ull; } }
            if (chosen) { const int lpos = __hip_atomic_fetch_add(LCNT + e, 1, __ATOMIC_RELAXED, __HIP_MEMORY_SCOPE_WORKGROUP);
                PEL[tk * 8 + rank] = e; PLL[tk * 8 + rank] = lpos;
                PE[(size_t)token * 8 + rank] = e; PG[(size_t)token * 8 + rank] = sc / wsum * ROUTED_SCALE; }
        }
        __syncthreads();
        if (tid < 64) BASE[tid] = (int)__hip_atomic_fetch_add(cnt + tid, (unsigned)LCNT[tid], __ATOMIC_RELAXED, __HIP_MEMORY_SCOPE_AGENT);
        __syncthreads();
        { const int e = PEL[tid], pos = BASE[e] + PLL[tid], token = tok0 + (tid >> 3);
          PP[(size_t)token * 8 + (tid & 7)] = pos; RM[(size_t)e * T + pos] = token; }
        __syncthreads();
    }
}

__device__ __forceinline__ void build_toff(Frame& F, int layer) {
    LAS int* toff = (LAS int*)(F.lds + LDS_TAB);
    if (threadIdx.x < 64) {
        const GAS unsigned* cnt = F.ctl + CW_CNT + layer * 64; const int e = (int)threadIdx.x;
        const int tiles = ((int)__hip_atomic_load(cnt + e, RLX_AGENT) + 255) >> 8; int incl = tiles;
#pragma unroll
        for (int o = 1; o < 64; o <<= 1) { const int up = __shfl_up(incl, o); if (e >= o) incl += up; }
        toff[e] = incl - tiles;
        if (e == 63) { toff[N_EXPERTS] = incl; toff[NEXP1] = incl + T / 256; } }
    __syncthreads();
}

template <bool Y8, bool LAST>
__device__ __forceinline__ void combine_ln2_phase(Frame& F, int layer) {
    PHASE_ARGS(); GAS float* OUT = (GAS float*)(GAS float*)ap->out;
    const GAS bf16_t* Y = (const GAS bf16_t*)(F.ws + WS_Y); const GAS bf16_t* X1B = (const GAS bf16_t*)(F.ws + WS_X1B); GAS bf16_t* XB = (GAS bf16_t*)(F.ws + WS_XB); GAS unsigned char* XB8 = F.ws + WS_XB8;
    const GAS float* g2 = GIN(18) + (size_t)layer * D_MODEL; const GAS float* b2 = GIN(19) + (size_t)layer * D_MODEL;
    const GAS int* PE = (const GAS int*)(F.ws + WS_PE); const GAS int* PP = (const GAS int*)(F.ws + WS_PP); const GAS float* PG = (const GAS float*)(F.ws + WS_PG);
    const LAS int* toff = (const LAS int*)(F.lds + LDS_TAB);
    PHASE_IDS();
    const int gw = F.bid * 8 + w, NGW = F.G * 8;
    for (int tb = gw; tb < T; tb += 8 * NGW) {
        int myrow = 0; float mygate = 0.f;
        { const int tl = tb + (lane >> 3) * NGW; if (tl < T) { const int e = PE[(size_t)tl * 8 + (lane & 7)]; myrow = toff[e] * 256 + PP[(size_t)tl * 8 + (lane & 7)]; mygate = PG[(size_t)tl * 8 + (lane & 7)]; } }
#pragma unroll 1
      for (int tj = 0; tj < 8; ++tj) { const int t = tb + tj * NGW; if (t >= T) break;
        f32x4 a[4][2];
#pragma unroll
        for (int j = 0; j < 4; ++j) { a[j][0] = (f32x4){0.f, 0.f, 0.f, 0.f}; a[j][1] = (f32x4){0.f, 0.f, 0.f, 0.f}; }
#pragma unroll
        for (int k = 0; k < 9; ++k) { size_t row; float gt;
            if (k < 8) { row = (size_t)__shfl(myrow, tj * 8 + k); gt = __shfl(mygate, tj * 8 + k); }
            else { row = (size_t)toff[N_EXPERTS] * 256 + t; gt = 1.0f; }
            if constexpr (Y8) {
                const GAS u32x2* yp = (const GAS u32x2*)((const GAS unsigned char*)Y + row * D_MODEL) + lane;
#pragma unroll
                for (int j = 0; j < 4; ++j) { const u32x2 y = yp[64 * j];
                    const f32x2 p0 = __builtin_amdgcn_cvt_pk_f32_fp8((int)y.x, false), p1 = __builtin_amdgcn_cvt_pk_f32_fp8((int)y.x, true), p2 = __builtin_amdgcn_cvt_pk_f32_fp8((int)y.y, false), p3 = __builtin_amdgcn_cvt_pk_f32_fp8((int)y.y, true);
                    a[j][0] += (f32x4){p0[0], p0[1], p1[0], p1[1]} * gt; a[j][1] += (f32x4){p2[0], p2[1], p3[0], p3[1]} * gt; }
            } else {
            const GAS u32x4* yp = (const GAS u32x4*)(Y + row * D_MODEL) + lane;
#pragma unroll
            for (int j = 0; j < 4; ++j) { const u32x4 y = yp[64 * j];
                a[j][0] += (f32x4){bflo(y.x), bfhi(y.x), bflo(y.y), bfhi(y.y)} * gt; a[j][1] += (f32x4){bflo(y.z), bfhi(y.z), bflo(y.w), bfhi(y.w)} * gt; } } }
        float s = 0.f;
#pragma unroll
        for (int j = 0; j < 4; ++j) { const u32x4 xv = *(const GAS u32x4*)(X1B + (size_t)t * D_MODEL + 8 * lane + 512 * j);
            a[j][0] += (f32x4){bflo(xv.x), bfhi(xv.x), bflo(xv.y), bfhi(xv.y)} * DN_ALPHA; a[j][1] += (f32x4){bflo(xv.z), bfhi(xv.z), bflo(xv.w), bfhi(xv.w)} * DN_ALPHA;
            s += (a[j][0][0] + a[j][0][1]) + (a[j][0][2] + a[j][0][3]) + (a[j][1][0] + a[j][1][1]) + (a[j][1][2] + a[j][1][3]); }
        const float mean = wave_sum(s) * (1.0f / D_MODEL); float s2 = 0.f;
#pragma unroll
        for (int j = 0; j < 4; ++j) { a[j][0] = a[j][0] - mean; a[j][1] = a[j][1] - mean;
            s2 += (a[j][0][0] * a[j][0][0] + a[j][0][1] * a[j][0][1]) + (a[j][0][2] * a[j][0][2] + a[j][0][3] * a[j][0][3]) + (a[j][1][0] * a[j][1][0] + a[j][1][1] * a[j][1][1]) + (a[j][1][2] * a[j][1][2] + a[j][1][3] * a[j][1][3]); }
        const float rstd = rsqrtf(wave_sum(s2) * (1.0f / D_MODEL) + LN_EPS);
#pragma unroll
        for (int j = 0; j < 4; ++j) { const int c = 8 * lane + 512 * j;
            const f32x4 o0 = a[j][0] * rstd * *(const GAS f32x4*)(g2 + c) + *(const GAS f32x4*)(b2 + c), o1 = a[j][1] * rstd * *(const GAS f32x4*)(g2 + c + 4) + *(const GAS f32x4*)(b2 + c + 4);
            if constexpr (LAST) { *(GAS f32x4*)(OUT + (size_t)t * D_MODEL + c) = o0; *(GAS f32x4*)(OUT + (size_t)t * D_MODEL + c + 4) = o1; }
            else {
            u32x4 wv; wv.x = cvt_pk_bf16(o0[0], o0[1]); wv.y = cvt_pk_bf16(o0[2], o0[3]); wv.z = cvt_pk_bf16(o1[0], o1[1]); wv.w = cvt_pk_bf16(o1[2], o1[3]);
            *(GAS u32x4*)(XB + (size_t)t * D_MODEL + c) = wv;
            u32x2 w8; { int q = __builtin_amdgcn_cvt_pk_fp8_f32(o0[0], o0[1], 0, false); q = __builtin_amdgcn_cvt_pk_fp8_f32(o0[2], o0[3], q, true); w8.x = (unsigned)q;
                        q = __builtin_amdgcn_cvt_pk_fp8_f32(o1[0], o1[1], 0, false); q = __builtin_amdgcn_cvt_pk_fp8_f32(o1[2], o1[3], q, true); w8.y = (unsigned)q; }
            *(GAS u32x2*)(XB8 + (size_t)t * D_MODEL + c) = w8; } }
      }
    }
}

constexpr int PH_PER_LAYER = 11, N_PHASES = DEPTH * PH_PER_LAYER;
constexpr int CONV_TAIL = 512;
constexpr int CONV_TAIL_P1 = 640, CONV_TAIL_NEXT = CONV_TAIL + CONV_TAIL_P1 + 512;
constexpr bool GU8_ALL = true;
#ifndef PH_MASK
#define PH_MASK 0x7ff
#endif
#define IN(k) (((PH_MASK >> ((k) % PH_PER_LAYER)) & 1) && lo <= (k) && (k) < hi)
#ifndef PROBE_MASK
#define PROBE_MASK 0
#endif
#ifndef PROBE_AMP
#define PROBE_AMP 4
#endif
constexpr int LDS_STAMP = LDS_TAB + 1024;
#define SEAM(k) do { if (IN(k) && IN((k) + 1)) xcd_barrier(bar); \
    if (PROBE_MASK != 0 && threadIdx.x == 0) ((LAS unsigned long long*)(F0.lds + LDS_STAMP))[(k) + 1] = __builtin_amdgcn_s_memrealtime(); } while (0)
#define PHASE_FRAME() Frame F = F0; asm volatile("" : "+s"(F.ws), "+s"(F.ctl), "+s"(F.G), "+s"(F.bid), "+s"(F.lds)); \
    F.ws = (GAS unsigned char*)(GAS unsigned char*)F.ws; F.ctl = (GAS unsigned*)(GAS unsigned*)F.ctl;     \
    GAS unsigned char* ws = F.ws; (void)ws
template <int layer>
__device__ __forceinline__ void run_layer(const Frame& F0, const XcdBarrier& bar, const int lo, const int hi) {
        const int pb = layer * PH_PER_LAYER;
        constexpr bool GU8 = (layer == DEPTH - 1) || GU8_ALL;
        constexpr bool MOE8 = (layer == DEPTH - 1);
        if constexpr (layer == 0) { if (IN(pb + 0)) { PHASE_FRAME(); p0_convert(F, layer, GU8, MOE8, 1); } }
        SEAM(pb + 0);
        if (IN(pb + 1)) { PHASE_FRAME();
            EpiIn E{(GAS bf16_t*)(ws + WS_H), (GAS _Float16*)(ws + WS_LF), (const GAS float*)(ws + WS_LB) + layer * HG_WIDTH, (const GAS f32x4*)(ws + WS_ROPE)};
            DenseSched Sa{(const GAS char*)(ws + WS_XB), (const GAS char*)(ws + WS_WINF) - (size_t)C_HF * (D_MODEL * 2), D_MODEL * 2, D_MODEL * 2, D_MODEL / 64, T / 256, HG_WIDTH / 256, F.G, F.bid, 0, C_HF / 256};
            pg8::gemm_phase<EpiIn, DenseSched, false, false, true>(F.lds, Sa, E);
            DenseSched Sb{(const GAS char*)(ws + WS_XB8), (const GAS char*)(ws + WS_WIN), D_MODEL, D_MODEL, D_MODEL / 128, T / 256, (IN_WIDTH - HG_WIDTH) / 256, F.G, F.bid, C_HF / 256, HG_WIDTH / 256};
            if constexpr (layer == 0) {
                const long ntile = (long)Sb.nM * Sb.nN; const int nun = (int)((ntile - F.bid + F.G - 1) / F.G);
                const int ks = __builtin_amdgcn_readfirstlane(((F.bid & 7) * (nun + 1)) >> 3);
#pragma unroll 1
                for (int part = 0; part < 2; ++part) {
                    pg8::RangeSched<DenseSched> RS{Sb, part == 0 ? 0 : ks, part == 0 ? ks : (1 << 30)};
                    pg8::gemm_phase<EpiIn, pg8::RangeSched<DenseSched>, false, true, true>(F.lds, RS, E);
                    if (part == 0) p0_convert(F, layer, GU8, MOE8, 2, CONV_TAIL);
                }
                p0_convert(F, layer, GU8, MOE8, 2, CONV_TAIL, F.ctl + CW_CQ);
            } else { pg8::gemm_phase<EpiIn, DenseSched, false, true, true>(F.lds, Sb, E);
                p0_convert(F, layer, GU8, MOE8, 0, CONV_TAIL_NEXT, F.ctl + CW_CQ + 128, CONV_TAIL, CONV_TAIL_P1); }
        }
        SEAM(pb + 1);
        if (IN(pb + 2)) { PHASE_FRAME();
            { PHASE_IDS(); H1Regs ra, rb; int it = F.bid;
              if (it < NCHUNK * HG_HEADS) h1_load(F, it, tid, ra);
              for (; it < NCHUNK * HG_HEADS; it += F.G) { const int itn = it + F.G; if (itn < NCHUNK * HG_HEADS) h1_load(F, itn, tid, rb); h1_item(F, it, tid, ra); ra = rb; } }
            { constexpr int NAI = BATCH * ATT_HEADS * 16; const int nb = F.G >> 3, x = F.bid & 7, lb = F.bid >> 3;
              if ((F.G & 7) == 0 && NAI % 8 == 0) { for (int k = lb; k < NAI / 8; k += nb) { const int hh = k >> 4, jj = ((k & 15) + hh) & 15;
                  attn_item(F, x * (NAI / 8) + hh * 16 + jj); } }
              else { for (int it = F.bid; it < NAI; it += F.G) attn_item(F, it); } }
        }
        SEAM(pb + 2);
        if (IN(pb + 3)) { PHASE_FRAME();
            for (int it = F.bid; it < BATCH * HG_HEADS * 4; it += F.G) scan_item(F, it);
            attn_merge(F);
        }
        SEAM(pb + 3);
        if (IN(pb + 4)) { PHASE_FRAME();
            PHASE_ARGS(); const GAS float* normg = GIN(4) + (size_t)layer * HG_WIDTH;
            { PHASE_IDS(); H3Regs ra, rb; int it = F.bid;
              if (it < NCHUNK * HG_HEADS) h3_load(F, it, tid, ra);
              for (; it < NCHUNK * HG_HEADS; it += F.G) { const int itn = it + F.G; if (itn < NCHUNK * HG_HEADS) h3_load(F, itn, tid, rb); h3_item(F, it, normg, tid, ra); ra = rb; } }
        }
        SEAM(pb + 4);
        if (IN(pb + 5)) { PHASE_FRAME();
            MergeSched S{(const GAS char*)(ws + WS_HGO), (const GAS char*)(ws + WS_WHG), (const GAS char*)(ws + WS_ATTO), (const GAS char*)(ws + WS_WATT), T / 256, D_MODEL / 256, F.G, F.bid};
            EpiMerge E{(const GAS bf16_t*)(ws + WS_H), (GAS bf16_t*)(ws + WS_MRG)};
            pg8::gemm_phase<EpiMerge, MergeSched, false>(F.lds, S, E);
        }
        SEAM(pb + 5);
        if (IN(pb + 6)) { PHASE_FRAME();
            DenseSched S{(const GAS char*)(ws + WS_MRG), (const GAS char*)(ws + WS_WOUT), D_MODEL, D_MODEL, D_MODEL / 128, T / 256, D_MODEL / 256, F.G, F.bid, 1 << 30, 0};
            PHASE_ARGS(); EpiResid E{(const GAS bf16_t*)(ws + WS_XB), (GAS bf16_t*)(ws + WS_R)};
            pg8::gemm_phase<EpiResid, DenseSched, false, true, true>(F.lds, S, E);
        }
        SEAM(pb + 6);
        if (IN(pb + 7)) { PHASE_FRAME(); ln_router_phase<GU8>(F, layer); }
        SEAM(pb + 7);
        if (IN(pb + 8)) { PHASE_FRAME();
            build_toff(F, layer);
            {
                typedef MoeSched<4, true, GU8 ? 1 : 2> SchedT;
                SchedT S{(const LAS int*)(F.lds + LDS_TAB), F.ctl + CW_CNT + layer * 64, (const GAS char*)(ws + (GU8 ? WS_X1B8 : WS_X1B)), (const GAS char*)(ws + (MOE8 ? WS_WGU8 : WS_WGU)), (const GAS int*)(ws + WS_RM), F.G, F.bid, (const LAS int*)(F.lds + LDS_EPI), (const LAS int*)(F.lds + LDS_TAB + 512)}; S.build_units((LAS int*)(F.lds + LDS_TAB + 512));
                EpiGateUp<true> E{(GAS bf16_t*)(ws + WS_HID)};
                if constexpr (layer + 1 < DEPTH) {
                    int nun = 0; { const LAS int* ut = (const LAS int*)(F.lds + LDS_TAB + 512); for (int i = 0; i < 32; ++i) nun += ut[i * 4 + 3]; }
                    const int ks = __builtin_amdgcn_readfirstlane(((F.bid & 7) * (nun + 1)) >> 3);
#pragma unroll 1
                    for (int part = 0; part < 2; ++part) {
                        pg8::RangeSched<SchedT> RS{S, part == 0 ? 0 : ks, part == 0 ? ks : (1 << 30)};
                        pg8::gemm_phase<EpiGateUp<true>, pg8::RangeSched<SchedT>, true, GU8>(F.lds, RS, E);
                        if (part == 0) p0_convert(F, layer + 1, (layer + 1 == DEPTH - 1) || GU8_ALL, layer + 1 == DEPTH - 1, 0, CONV_TAIL_NEXT);
                    }
                    p0_convert(F, layer + 1, (layer + 1 == DEPTH - 1) || GU8_ALL, layer + 1 == DEPTH - 1, 0, CONV_TAIL_NEXT, F.ctl + CW_CQ + 64, 0, CONV_TAIL);
                } else { pg8::gemm_phase<EpiGateUp<true>, SchedT, true, GU8>(F.lds, S, E);
                    p0_convert(F, layer, GU8, MOE8, 0, CONV_TAIL_NEXT, F.ctl + CW_CQ + 192, CONV_TAIL + CONV_TAIL_P1, -1); }
            }
        }
        SEAM(pb + 8);
        if (IN(pb + 9)) { PHASE_FRAME();
            build_toff(F, layer);
            {
                EpiDown<true> E{(GAS bf16_t*)(ws + WS_Y)};
                MoeSched<8, false, 1> S{(const LAS int*)(F.lds + LDS_TAB), F.ctl + CW_CNT + layer * 64, (const GAS char*)(ws + WS_HID), (const GAS char*)(ws + (MOE8 ? WS_WDN8 : WS_WDN)), nullptr, F.G, F.bid, nullptr, (const LAS int*)(F.lds + LDS_TAB + 512)}; S.build_units((LAS int*)(F.lds + LDS_TAB + 512));
                pg8::gemm_phase<EpiDown<true>, MoeSched<8, false, 1>, false, true, true>(F.lds, S, E);
            }
        }
        SEAM(pb + 9);
        if (IN(pb + 10)) { PHASE_FRAME(); build_toff(F, layer); combine_ln2_phase<true, layer == DEPTH - 1>(F, layer); }
        if constexpr (layer == DEPTH - 1) { SEAM(pb + 10); } else { if (PROBE_MASK != 0 && threadIdx.x == 0) ((LAS unsigned long long*)(F0.lds + LDS_STAMP))[pb + 11] = __builtin_amdgcn_s_memrealtime(); }
}
#undef IN
#undef SEAM
__global__ void __launch_bounds__(512, 2) kfwd(Args args) {
    extern __shared__ __attribute__((aligned(16))) unsigned char lds_raw[];
    Frame F0;
    F0.lds = (LAS unsigned char*)lds_raw;
    F0.G = gridDim.x; F0.bid = blockIdx.x; F0.ws = (GAS unsigned char*)args.ws; F0.ctl = (GAS unsigned*)(args.ws + WS_CTL);
    for (int u = threadIdx.x; u < (LDS_BYTES - LDS_TAB) / 4; u += 512) ((LAS unsigned*)(F0.lds + LDS_TAB))[u] = 0u;
    __syncthreads();
    XcdBarrier bar = xcd_barrier_post((unsigned*)(F0.ctl + CW_BAR), (volatile LAS unsigned*)(F0.lds + LDS_MISC));
    const int lo = args.ph_lo, hi = args.ph_hi;
    if (PROBE_MASK != 0 && threadIdx.x == 0) ((LAS unsigned long long*)(F0.lds + LDS_STAMP))[0] = __builtin_amdgcn_s_memrealtime();
    run_layer<0>(F0, bar, lo, hi);
    run_layer<1>(F0, bar, lo, hi);
    if (PROBE_MASK != 0 && blockIdx.x == 0 && threadIdx.x == 0) {
        const LAS unsigned long long* ts = (const LAS unsigned long long*)(F0.lds + LDS_STAMP); unsigned long long tot = 0;
        for (int k = 0; k < N_PHASES; ++k) if ((PROBE_MASK >> (k % PH_PER_LAYER)) & 1) tot += ts[k + 1] - ts[k];
        const unsigned long long t0 = __builtin_amdgcn_s_memrealtime(), lim = tot * PROBE_AMP < 4000000ull ? tot * PROBE_AMP : 4000000ull;
        while (__builtin_amdgcn_s_memrealtime() - t0 < lim) __builtin_amdgcn_s_sleep(32);
    }
}

extern "C" void kernel_launch(void* const* d_in, const int* in_sizes, int n_in, void* d_out, int out_size, void* d_ws, size_t ws_size, hipStream_t stream) {
    static int grid = 0;
    if (grid == 0) {
        if (n_in != 20 || out_size != T * D_MODEL || ws_size < WS_END) { fprintf(stderr, "kernel_launch: unexpected shapes (n_in %d, out %d, ws %zu < %zu)\n", n_in, out_size, ws_size, (size_t)WS_END); grid = -1; return; }
        int dev = 0, cus = 0, per_cu = 0;
        if (hipGetDevice(&dev) != hipSuccess || hipDeviceGetAttribute(&cus, hipDeviceAttributeMultiprocessorCount, dev) != hipSuccess) { grid = -1; return; }
        if (hipFuncSetAttribute((const void*)kfwd, hipFuncAttributeMaxDynamicSharedMemorySize, LDS_BYTES) != hipSuccess) { fprintf(stderr, "kernel_launch: hipFuncSetAttribute failed\n"); grid = -1; return; }
        if (hipOccupancyMaxActiveBlocksPerMultiprocessor(&per_cu, (const void*)kfwd, 512, LDS_BYTES) != hipSuccess || per_cu < 1) fprintf(stderr, "kernel_launch: occupancy query says %d\n", per_cu);
        (void)hipGetLastError();
        grid = cus;
    }
    if (grid < 0) return;
    if (hipMemsetAsync((char*)d_ws + WS_CTL, 0, CTL_ZERO_BYTES, stream) != hipSuccess) return;
    Args a{};
    for (int i = 0; i < 20; ++i) a.in[i] = (const float*)d_in[i];
    a.out = (float*)d_out; a.ws = (unsigned char*)d_ws;
#if MK_LAUNCH_PER_PHASE
    for (int p = 0; p < N_PHASES; ++p) { a.ph_lo = p; a.ph_hi = p + 1; hipLaunchKernelGGL(kfwd, dim3(grid), dim3(512), LDS_BYTES, stream, a); }
#else
    a.ph_lo = 0; a.ph_hi = N_PHASES; hipLaunchKernelGGL(kfwd, dim3(grid), dim3(512), LDS_BYTES, stream, a);
#endif
}
```

```cpp
#include <hip/hip_runtime.h>
#include <cstdio>
#include <cstdint>

#ifndef MK_LAUNCH_PER_PHASE
#define MK_LAUNCH_PER_PHASE 0
#endif

#define GAS __attribute__((address_space(1)))
#define LAS __attribute__((address_space(3)))
typedef unsigned short bf16_t;
typedef short bf16x8 __attribute__((ext_vector_type(8)));
typedef short s16x4 __attribute__((ext_vector_type(4)));
typedef float f32x4 __attribute__((ext_vector_type(4)));
typedef float f32x2 __attribute__((ext_vector_type(2)));
typedef unsigned u32x4 __attribute__((ext_vector_type(4)));
typedef unsigned u32x2 __attribute__((ext_vector_type(2)));
typedef _Float16 f16x8 __attribute__((ext_vector_type(8)));

constexpr int D_MODEL = 2048, BATCH = 8, SEQ = 2048, DEPTH = 2, T = BATCH * SEQ;
constexpr int HG_HEADS = 8, HG_DIM = 128, HG_WIDTH = 1024, HG_CHUNK = 64, NCHUNK = T / HG_CHUNK;
constexpr int ATT_HEADS = 12, ATT_DIM = 128, ATT_WIDTH = 1536, ATT_OUT = 512;
constexpr int N_EXPERTS = 64, N_GROUPS = 8, TOPK_GROUPS = 4, TOP_K = 8, EXPERT_FF = 512;
constexpr int IN_WIDTH = 12800;
constexpr int C_HQ = 0, C_HF = 1024, C_HI = 2048, C_HGATE = 3072, C_AQ = 4096, C_AK = 5632, C_AV = 7168, C_GH = 8704, C_GA = 10752;
constexpr float ROUTED_SCALE = 2.5f, LN_EPS = 1e-5f, NORM_EPS = 1e-6f;
constexpr float DN_ALPHA = 1.41421356237309515f;
#define HOFF(c, row) (((size_t)((c) >> 7) * T + (size_t)(row)) * 128 + ((c) & 127))
constexpr int NEXP1 = N_EXPERTS + 1;
constexpr int MAXROWS = 163840;

constexpr size_t MiB = 1u << 20;
constexpr size_t WS_CTL = 0, CTL_ZERO_BYTES = 1 * MiB;
constexpr size_t WS_WIN = 4 * MiB;
constexpr size_t WS_WHG = 54 * MiB;
constexpr size_t WS_WATT = 58 * MiB;
constexpr size_t WS_WOUT = 60 * MiB;
constexpr size_t WS_WGU = 68 * MiB;
constexpr size_t WS_WDN = 328 * MiB;
constexpr size_t WS_ROPE = 458 * MiB;
constexpr size_t WS_LB = 466 * MiB;
constexpr size_t WS_R = 467 * MiB;
constexpr size_t WS_X1 = 595 * MiB;
constexpr size_t WS_XB = 723 * MiB;
constexpr size_t WS_X1B = 787 * MiB;
constexpr size_t WS_PE = 851 * MiB;
constexpr size_t WS_PP = 852 * MiB;
constexpr size_t WS_PG = 853 * MiB;
constexpr size_t WS_RM = 854 * MiB;
constexpr size_t WS_HID = 859 * MiB;
constexpr size_t WS_BIG = 1019 * MiB;
constexpr size_t WS_H = WS_BIG;
constexpr size_t WS_LF = WS_BIG + 400 * MiB;
constexpr size_t WS_UT = WS_BIG + 464 * MiB;
constexpr size_t WS_SPT = WS_BIG + 592 * MiB;
constexpr size_t WS_DEC = WS_BIG + 656 * MiB;
constexpr size_t WS_LSE = WS_BIG + 657 * MiB;
constexpr size_t WS_HGO = WS_BIG + 658 * MiB;
constexpr size_t WS_ATTO = WS_BIG + 690 * MiB;
constexpr size_t WS_MRG = WS_BIG + 706 * MiB;
constexpr size_t WS_Y = WS_BIG;
constexpr size_t WS_XB8 = WS_BIG + 772 * MiB;
constexpr size_t WS_WINF = WS_WIN + 30 * MiB;
constexpr size_t WS_X1B8 = WS_BIG + 804 * MiB;
constexpr size_t WS_WGU8 = 531 * MiB;
constexpr size_t WS_WDN8 = WS_BIG + 836 * MiB;
constexpr size_t WS_END = WS_BIG + 901 * MiB;
constexpr int CW_TMO = 0;
constexpr int CW_CNT = 1024;
constexpr int CW_CQ = 2048;
constexpr int CW_BAR = 4096;

constexpr int LDS_BYTES = 159744;
constexpr int LDS_EPI = 131072;
constexpr int LDS_TAB = 147456;
constexpr int LDS_MISC = LDS_TAB + 2048;

#define RLX_AGENT __ATOMIC_RELAXED, __HIP_MEMORY_SCOPE_AGENT
#define LDS_WAIT() asm volatile("s_waitcnt lgkmcnt(0)" ::: "memory")
#define VM_WAIT() asm volatile("s_waitcnt vmcnt(0)" ::: "memory")
#define LDS_BARRIER() asm volatile("s_waitcnt lgkmcnt(0)\n\ts_barrier" ::: "memory")
__device__ __forceinline__ unsigned f2bf(float f) { unsigned u = __builtin_bit_cast(unsigned, f); return (u + 0x7fffu + ((u >> 16) & 1u)) >> 16; }
__device__ __forceinline__ unsigned pk2(float lo, float hi) { return f2bf(lo) | (f2bf(hi) << 16); }
__device__ __forceinline__ float bf2f(unsigned short b) { return __builtin_bit_cast(float, ((unsigned)b) << 16); }
__device__ __forceinline__ float bflo(unsigned w) { return __builtin_bit_cast(float, w << 16); }
__device__ __forceinline__ float bfhi(unsigned w) { return __builtin_bit_cast(float, w & 0xffff0000u); }
__device__ __forceinline__ unsigned cvt_pk_bf16(float lo, float hi) { unsigned r; asm volatile("v_cvt_pk_bf16_f32 %0, %1, %2" : "=v"(r) : "v"(lo), "v"(hi)); return r; }
__device__ __forceinline__ float fdiv(float a, float b) { return a * __builtin_amdgcn_rcpf(b); }
__device__ __forceinline__ float fsigmoid(float x) { return __builtin_amdgcn_rcpf(1.0f + __expf(-x)); }
__device__ __forceinline__ float wave_sum(float v) {
#pragma unroll
    for (int o = 1; o < 64; o <<= 1) v += __shfl_xor(v, o);
    return v;
}
__device__ __forceinline__ float max8_dpp(float v) {
    v = fmaxf(v, __builtin_bit_cast(float, __builtin_amdgcn_update_dpp(0, __builtin_bit_cast(int, v), 0xB1, 0xF, 0xF, false)));
    v = fmaxf(v, __builtin_bit_cast(float, __builtin_amdgcn_update_dpp(0, __builtin_bit_cast(int, v), 0x4E, 0xF, 0xF, false)));
    v = fmaxf(v, __builtin_bit_cast(float, __builtin_amdgcn_update_dpp(0, __builtin_bit_cast(int, v), 0x141, 0xF, 0xF, false)));
    return v;
}
__device__ __forceinline__ f32x4 mfma16(bf16x8 a, bf16x8 b, f32x4 c) { return __builtin_amdgcn_mfma_f32_16x16x32_bf16(a, b, c, 0, 0, 0); }
__device__ __forceinline__ s16x4 tr_read(unsigned lds_addr) { s16x4 r; asm volatile("ds_read_b64_tr_b16 %0, %1\n\ts_waitcnt lgkmcnt(0)" : "=&v"(r) : "v"(lds_addr) : "memory"); return r; }

template <int STRIDE> __device__ __forceinline__ void tr_read8(s16x4 (&r)[8], unsigned a) {
    asm volatile("ds_read_b64_tr_b16 %0, %8\n\tds_read_b64_tr_b16 %1, %8 offset:%9\n\tds_read_b64_tr_b16 %2, %8 offset:%10\n\tds_read_b64_tr_b16 %3, %8 offset:%11\n\t"
                 "ds_read_b64_tr_b16 %4, %8 offset:%12\n\tds_read_b64_tr_b16 %5, %8 offset:%13\n\tds_read_b64_tr_b16 %6, %8 offset:%14\n\tds_read_b64_tr_b16 %7, %8 offset:%15\n\ts_waitcnt lgkmcnt(0)"
                 : "=&v"(r[0]), "=&v"(r[1]), "=&v"(r[2]), "=&v"(r[3]), "=&v"(r[4]), "=&v"(r[5]), "=&v"(r[6]), "=&v"(r[7])
                 : "v"(a), "i"(STRIDE), "i"(2 * STRIDE), "i"(3 * STRIDE), "i"(4 * STRIDE), "i"(5 * STRIDE), "i"(6 * STRIDE), "i"(7 * STRIDE) : "memory");
}
template <int STRIDE> __device__ __forceinline__ void tr_read4x2(s16x4 (&r0)[4], s16x4 (&r1)[4], unsigned a0, unsigned a1) {
    asm volatile("ds_read_b64_tr_b16 %0, %8\n\tds_read_b64_tr_b16 %1, %8 offset:%10\n\tds_read_b64_tr_b16 %2, %8 offset:%11\n\tds_read_b64_tr_b16 %3, %8 offset:%12\n\t"
                 "ds_read_b64_tr_b16 %4, %9\n\tds_read_b64_tr_b16 %5, %9 offset:%10\n\tds_read_b64_tr_b16 %6, %9 offset:%11\n\tds_read_b64_tr_b16 %7, %9 offset:%12\n\ts_waitcnt lgkmcnt(0)"
                 : "=&v"(r0[0]), "=&v"(r0[1]), "=&v"(r0[2]), "=&v"(r0[3]), "=&v"(r1[0]), "=&v"(r1[1]), "=&v"(r1[2]), "=&v"(r1[3])
                 : "v"(a0), "v"(a1), "i"(STRIDE), "i"(2 * STRIDE), "i"(3 * STRIDE) : "memory");
}
#define TRCAT(lo, hi) ((bf16x8){(lo)[0], (lo)[1], (lo)[2], (lo)[3], (hi)[0], (hi)[1], (hi)[2], (hi)[3]})
#define XB_TMO      128
#define XB_XCNT(j)  (256  + 64 * (j))
#define XB_XSUB(j)  (1280 + 64 * (j))
#define XB_XGEN(j)  (2304 + 64 * (j))
#define XB_TOP      3328
#define XB_TOPGEN   3392
#define XCD_BAR_WORDS 3456
#define XB_SPIN_CAP (1u << 18)
__device__ __forceinline__ unsigned xb_ld(unsigned* p)              { return __hip_atomic_load(p, __ATOMIC_RELAXED, __HIP_MEMORY_SCOPE_AGENT); }
__device__ __forceinline__ unsigned xb_add(unsigned* p, unsigned v) { return __hip_atomic_fetch_add(p, v, __ATOMIC_RELAXED, __HIP_MEMORY_SCOPE_AGENT); }
__device__ __forceinline__ unsigned xb_xcc_id() { return (unsigned)__builtin_amdgcn_s_getreg((3 << 11) | 20) & 0xFu; }
#define XB_SPIN(cond, bar) do { unsigned _sp = 0; while (cond) { __builtin_amdgcn_s_sleep(1); \
    if ((++_sp & 255u) == 0u) { if (xb_ld(&(bar)[XB_TMO])) break; if (_sp > XB_SPIN_CAP) { atomicAdd(&(bar)[XB_TMO], 1u); break; } } } } while (0)
struct XcdBarrier { unsigned* bar; unsigned x; volatile LAS unsigned* st; };
__device__ __forceinline__ XcdBarrier xcd_barrier_post(unsigned* bar, volatile LAS unsigned* st) {
    XcdBarrier b; b.bar = bar; b.x = xb_xcc_id(); b.st = st;
    if (threadIdx.x == 0) (void)xb_add(&bar[XB_XCNT(b.x)], 1u);
    return b;
}
__device__ __forceinline__ void xcd_barrier_complete(unsigned* bar, unsigned x, unsigned& nloc, unsigned& nx) {
    const unsigned G = gridDim.x * gridDim.y * gridDim.z;
    unsigned sum, cnt, mine, sp = 0u;
    for (;;) {
        sum = 0u; cnt = 0u; mine = 0u;
#pragma unroll
        for (unsigned j = 0; j < 16; ++j) { const unsigned c = xb_ld(&bar[XB_XCNT(j)]); sum += c; cnt += (c > 0u) ? 1u : 0u; mine = (j == x) ? c : mine; }
        if (sum == G) break;
        __builtin_amdgcn_s_sleep(1);
        if ((++sp & 255u) == 0u) { if (xb_ld(&bar[XB_TMO])) break; if (sp > XB_SPIN_CAP) { atomicAdd(&bar[XB_TMO], 1u); break; } }
    }
    nloc = mine > 0u ? mine : 1u; nx = cnt > 0u ? cnt : 1u;
}
__device__ __forceinline__ void xcd_barrier(const XcdBarrier& b) {
    asm volatile("s_waitcnt vmcnt(0)" ::: "memory");
    __syncthreads();
    if (threadIdx.x == 0) {
        unsigned* bar = b.bar;
        __builtin_amdgcn_s_waitcnt(0);
        unsigned nloc = b.st[0], nx = b.st[1];
        if (nloc == 0u) { xcd_barrier_complete(bar, b.x, nloc, nx); b.st[0] = nloc; b.st[1] = nx; }
        const unsigned old = xb_add(&bar[XB_XSUB(b.x)], 1u);
        const unsigned gen = old / nloc;
        if (old + 1u == (gen + 1u) * nloc) {
            __builtin_amdgcn_fence(__ATOMIC_RELEASE, "agent");
            asm volatile("s_waitcnt vmcnt(0)" ::: "memory");
            const unsigned og = xb_add(&bar[XB_TOP], 1u);
            const unsigned tg = og / nx;
            if (og + 1u == (tg + 1u) * nx) xb_add(&bar[XB_TOPGEN], 1u);
            else XB_SPIN(xb_ld(&bar[XB_TOPGEN]) == tg, bar);
            __builtin_amdgcn_fence(__ATOMIC_ACQUIRE, "agent");
            xb_add(&bar[XB_XGEN(b.x)], 1u);
            asm volatile("s_waitcnt vmcnt(0)" ::: "memory");
        } else {
            XB_SPIN(xb_ld(&bar[XB_XGEN(b.x)]) == gen, bar);
            __builtin_amdgcn_fence(__ATOMIC_ACQUIRE, "agent");
            asm volatile("s_waitcnt vmcnt(0)" ::: "memory");
        }
    }
    __syncthreads();
}

namespace pg8 {
constexpr int BM = 256, BK = 64, HALF = 128, HTB = HALF * BK * 2, STAGE_BYTES = 8 * HTB, NXCD = 8, WGM = 8;
__host__ __device__ __forceinline__ int lds_byte(int r, int c) { const int st = (r >> 4) * 2 + (c >> 5), rr = r & 15, cc = c & 31, ob = rr * 64 + cc * 2; return st * 1024 + (ob ^ (((ob >> 9) & 1) << 5)); }
__host__ __device__ __forceinline__ void stage_rc(int b, int& R, int& C) { const int st = b / 1024, sb = b % 1024, swz = sb ^ (((sb >> 9) & 1) << 5); R = (st >> 1) * 16 + swz / 64; C = (st & 1) * 32 + (swz % 64) / 2; }
__host__ __device__ __forceinline__ int perm32(int rho) { const int n = rho >> 4, i = rho & 15; return 8 * (i >> 2) + 4 * n + (i & 3); }

struct Unit {
    const GAS char* a; const GAS char* b; int lda, ldb, nt;
    int row0, col0, aux;
    const GAS int* gidx; int gcnt;
    const LAS int* gl;
};

template <class S> struct RangeSched { const S& s; int lo, hi; __device__ __forceinline__ bool next(int i, Unit& u) const { return (lo + i < hi) && s.next(lo + i, u); } };

__device__ __forceinline__ void tile_of(int L, int nM, int nN, int& pm, int& pn) {
    const int nwg = nM * nN; int wgid = L;
    { const int q = nwg / NXCD, r = nwg % NXCD, xcd = wgid % NXCD, off = wgid / NXCD; wgid = (xcd < r ? xcd * (q + 1) : r * (q + 1) + (xcd - r) * q) + off; }
    const int nig = WGM * nN, gid = wgid / nig, fm = gid * WGM, gsz = (nM - fm) < WGM ? (nM - fm) : WGM;
    pm = fm + ((wgid % nig) % gsz); pn = (wgid % nig) / gsz;
}

typedef int i32x8 __attribute__((ext_vector_type(8)));
typedef int i32x4v __attribute__((ext_vector_type(4)));
template <class Epi, class Sched, bool GATHER, bool FP8 = false, bool UNI = false>
__device__ __forceinline__ void gemm_phase(LAS unsigned char* lds, const Sched& S, const Epi& E) {
    int tid = threadIdx.x; asm volatile("" : "+v"(tid));
    const int wid = __builtin_amdgcn_readfirstlane(tid >> 6), lane = tid & 63, wr = wid >> 2, wc = wid & 3, fr = lane & 15, fq = lane >> 4;
    int sR[2], sC2[2], sRb[2];
#pragma unroll
    for (int i = 0; i < 2; ++i) { int R, C; stage_rc(tid * 16 + i * 8192, R, C); sR[i] = R; sC2[i] = C * 2; sRb[i] = Epi::WIDE ? (64 * (R >> 5) + perm32(R & 31)) : (Epi::PERM ? ((R & ~31) + perm32(R & 31)) : R); }
    const unsigned ldsw = (unsigned)wid * 1024u;
    const int aoff = lds_byte(wr * 64 + fr, fq * 8), boff = lds_byte(wc * 32 + fr, fq * 8);
    const int sclw = 0x79, scla = 0x7f;
    const int aoff8[2] = {lds_byte(wr * 64 + fr, fq * 16), lds_byte(wr * 64 + fr, fq * 16 + 8)}, boff8[2] = {lds_byte(wc * 32 + fr, fq * 16), lds_byte(wc * 32 + fr, fq * 16 + 8)};
#define PG8_SA(b, h) (((b) * 2 + (h)) * HTB)
#define PG8_SB(b, h) ((4 + (b) * 2 + (h)) * HTB)
#define PG8_STAGE(bufoff, gbase, voff) do { _Pragma("unroll") for (int _i = 0; _i < 2; ++_i) \
        __builtin_amdgcn_global_load_lds((const GAS unsigned*)((const GAS char*)(gbase) + (voff)[_i]), (LAS unsigned*)(lds + (bufoff) + ldsw + _i * 8192), 16, 0, 0); } while (0)
#define PG8_LDA(dst, b, h) do { _Pragma("unroll") for (int m = 0; m < 4; ++m) { dst[m].lo = *(const LAS i32x4v*)(lds + PG8_SA(b, h) + (FP8 ? aoff8[0] : aoff) + m * 2048); dst[m].hi = *(const LAS i32x4v*)(lds + PG8_SA(b, h) + (FP8 ? aoff8[1] : aoff + 1024) + m * 2048); } } while (0)
#define PG8_LDB(dst, b, h) do { _Pragma("unroll") for (int n = 0; n < 2; ++n) { dst[n].lo = *(const LAS i32x4v*)(lds + PG8_SB(b, h) + (FP8 ? boff8[0] : boff) + n * 2048); dst[n].hi = *(const LAS i32x4v*)(lds + PG8_SB(b, h) + (FP8 ? boff8[1] : boff + 1024) + n * 2048); } } while (0)
#define PG8_BF(x) __builtin_bit_cast(bf16x8, (i32x4v)(x))
#define PG8_MMA(ai, bj, At, Bt) do { __builtin_amdgcn_s_setprio(1); _Pragma("unroll") for (int m = 0; m < 4; ++m) _Pragma("unroll") for (int n = 0; n < 2; ++n) { \
        if constexpr (FP8) { asm volatile("v_mfma_scale_f32_16x16x128_f8f6f4 %0, %1, %2, %0, %3, %4 op_sel_hi:[0,0,0]" : "+v"(acc[ai][bj][m][n]) : "v"(Bt[n]), "v"(At[m]), "v"(sclw), "v"(scla)); } \
        else { acc[ai][bj][m][n] = __builtin_amdgcn_mfma_f32_16x16x32_bf16(PG8_BF(Bt[n].lo), PG8_BF(At[m].lo), acc[ai][bj][m][n], 0, 0, 0); \
               acc[ai][bj][m][n] = __builtin_amdgcn_mfma_f32_16x16x32_bf16(PG8_BF(Bt[n].hi), PG8_BF(At[m].hi), acc[ai][bj][m][n], 0, 0, 0); } } \
        __builtin_amdgcn_s_setprio(0); } while (0)
#define PG8_WAIT_V(n) asm volatile("s_waitcnt vmcnt(" #n ")" ::: "memory")
#define PG8_WAIT_L(n) asm volatile("s_waitcnt lgkmcnt(" #n ")" ::: "memory")
#define PG8_BAR __builtin_amdgcn_s_barrier()
#define PG8_SCHED __builtin_amdgcn_sched_barrier(0)
#define PG8_OFFS(u, ao, bo) do { _Pragma("unroll") for (int _i = 0; _i < 2; ++_i) { (bo)[_i] = (unsigned)(sRb[_i] * (u).ldb + sC2[_i]); \
        _Pragma("unroll") for (int _h = 0; _h < 2; ++_h) { int _r = _h * HALF + sR[_i]; if (GATHER) { _r = (u).gl ? (u).gl[_r] : ((_r < (u).gcnt) ? (u).gidx[_r] : 0); } (ao)[_h][_i] = (unsigned)(_r * (u).lda + sC2[_i]); } } } while (0)
    Unit cur, nxt; int ui = 0;
    if (!S.next(0, cur)) return;
    f32x4 acc[2][2][4][2];
#pragma unroll
    for (int a = 0; a < 2; ++a)
#pragma unroll
        for (int b = 0; b < 2; ++b)
#pragma unroll
            for (int m = 0; m < 4; ++m)
#pragma unroll
                for (int n = 0; n < 2; ++n) acc[a][b][m][n] = (f32x4){0.f, 0.f, 0.f, 0.f};
    i32x8 At[4], B0[2], B1[2];
    unsigned aoc[2][2], boc[2], aon[2][2], bon[2];
    PG8_OFFS(cur, aoc, boc);
    {
        const GAS char* cA = cur.a; const GAS char* cB = cur.b; const size_t hB = (size_t)(Epi::WIDE ? 32 : HALF) * cur.ldb;
        PG8_STAGE(PG8_SB(0, 0), cB, boc); PG8_STAGE(PG8_SB(0, 1), cB + hB, boc); PG8_STAGE(PG8_SA(0, 0), cA, aoc[0]); PG8_STAGE(PG8_SA(0, 1), cA, aoc[1]);
        if (wr == 1) PG8_BAR;
        PG8_WAIT_V(2); PG8_BAR;
        PG8_STAGE(PG8_SB(1, 0), cB + 128, boc); PG8_STAGE(PG8_SA(1, 0), cA + 128, aoc[0]); PG8_STAGE(PG8_SB(1, 1), cB + hB + 128, boc);
        PG8_WAIT_V(6); PG8_BAR;
    }
    for (;;) {
        const bool has_next = S.next(ui + 1, nxt);
        if constexpr (UNI) { if (!has_next) nxt = cur; }
        else { if (has_next) { PG8_OFFS(nxt, aon, bon); }
          else { nxt = cur;
#pragma unroll
            for (int i = 0; i < 2; ++i) { bon[i] = boc[i]; aon[0][i] = aoc[0][i]; aon[1][i] = aoc[1][i]; } } }
        const GAS char* cA = cur.a; const GAS char* cB = cur.b; const GAS char* nA = nxt.a; const GAS char* nB = nxt.b;
        const size_t hBc = (size_t)(Epi::WIDE ? 32 : HALF) * cur.ldb, hBn = (size_t)(Epi::WIDE ? 32 : HALF) * nxt.ldb;
        const int nt = cur.nt;
        for (int t = 0; t < nt; t += 2) {
            const bool last = (t == nt - 2);
            const GAS char* a1 = cA + (size_t)(t + 1) * 128;
            const GAS char* a2 = last ? nA : cA + (size_t)(t + 2) * 128; const GAS char* b2 = last ? nB : cB + (size_t)(t + 2) * 128;
            const GAS char* a3 = a2 + 128; const GAS char* b3 = b2 + 128;
            const size_t hB2 = last ? hBn : hBc;
            unsigned oa0[2], oa1[2], ob[2];
#pragma unroll
            for (int i = 0; i < 2; ++i) { if constexpr (UNI) { oa0[i] = aoc[0][i]; oa1[i] = aoc[1][i]; ob[i] = boc[i]; } else { oa0[i] = last ? aon[0][i] : aoc[0][i]; oa1[i] = last ? aon[1][i] : aoc[1][i]; ob[i] = last ? bon[i] : boc[i]; } }
            PG8_LDB(B0, 0, 0); PG8_LDB(B1, 0, 1); PG8_SCHED; PG8_LDA(At, 0, 0); PG8_STAGE(PG8_SA(1, 1), a1, aoc[1]);
            PG8_WAIT_V(8); PG8_WAIT_L(0); PG8_BAR; PG8_MMA(0, 0, At, B0); PG8_MMA(0, 1, At, B1); PG8_BAR; PG8_SCHED;
            PG8_LDA(At, 0, 1); PG8_STAGE(PG8_SB(0, 0), b2, ob); PG8_STAGE(PG8_SB(0, 1), b2 + hB2, ob); PG8_STAGE(PG8_SA(0, 0), a2, oa0);
            PG8_WAIT_V(8); PG8_WAIT_L(0); PG8_BAR; PG8_MMA(1, 0, At, B0); PG8_MMA(1, 1, At, B1); PG8_BAR; PG8_SCHED;
            PG8_LDB(B0, 1, 0); PG8_LDB(B1, 1, 1); PG8_SCHED; PG8_LDA(At, 1, 0); PG8_STAGE(PG8_SA(0, 1), a2, oa1);
            PG8_WAIT_V(8); PG8_WAIT_L(0); PG8_BAR; PG8_MMA(0, 0, At, B0); PG8_MMA(0, 1, At, B1); PG8_BAR; PG8_SCHED;
            PG8_LDA(At, 1, 1); PG8_STAGE(PG8_SB(1, 0), b3, ob); PG8_STAGE(PG8_SB(1, 1), b3 + hB2, ob); PG8_STAGE(PG8_SA(1, 0), a3, oa0);
            PG8_WAIT_V(8); PG8_WAIT_L(0); PG8_BAR; PG8_MMA(1, 0, At, B0); PG8_MMA(1, 1, At, B1); PG8_BAR; PG8_SCHED;
        }
        if (wr == 0) PG8_BAR;
        const bool keep = E(acc, cur, wr, wc, fr, fq, lds + LDS_EPI + wid * 2048);
        if (!has_next) break;
        if (!keep) {
#pragma unroll
            for (int a = 0; a < 2; ++a)
#pragma unroll
                for (int b = 0; b < 2; ++b)
#pragma unroll
                    for (int m = 0; m < 4; ++m)
#pragma unroll
                        for (int n = 0; n < 2; ++n) acc[a][b][m][n] = (f32x4){0.f, 0.f, 0.f, 0.f};
        }
        cur = nxt;
        if constexpr (!UNI) {
#pragma unroll
            for (int i = 0; i < 2; ++i) { boc[i] = bon[i]; aoc[0][i] = aon[0][i]; aoc[1][i] = aon[1][i]; } }
        ++ui;
        if (wr == 1) PG8_BAR;
    }
    PG8_WAIT_V(0);
    PG8_BAR;
#undef PG8_OFFS
#undef PG8_SA
#undef PG8_SB
#undef PG8_STAGE
#undef PG8_LDA
#undef PG8_LDB
#undef PG8_MMA
#undef PG8_BF
#undef PG8_WAIT_V
#undef PG8_WAIT_L
#undef PG8_BAR
#undef PG8_SCHED
}
}
using pg8::Unit;

struct DenseSched {
    const GAS char* A; const GAS char* Bt; int lda, ldb, nt, nM, nN, G, c;
    int skip_from, skip_n;
    __device__ __forceinline__ bool next(int i, Unit& u) const {
        const long L = (long)i * G + c; if (L >= (long)nM * nN) return false;
        int pm, pn; pg8::tile_of((int)L, nM, nN, pm, pn);
        if (pn >= skip_from) pn += skip_n;
        u.a = A + (size_t)pm * 256 * lda; u.b = Bt + (size_t)pn * 256 * ldb; u.lda = lda; u.ldb = ldb; u.nt = nt;
        u.row0 = pm * 256; u.col0 = pn * 256; u.aux = 0; u.gidx = nullptr; u.gcnt = 256; u.gl = nullptr; return true;
    }
};
struct MergeSched {
    const GAS char* A0; const GAS char* B0; const GAS char* A1; const GAS char* B1; int nM, nN, G, c;
    __device__ __forceinline__ bool next(int i, Unit& u) const {
        const long L = (long)(i >> 1) * G + c; if (L >= (long)nM * nN) return false;
        int pm, pn; pg8::tile_of((int)L, nM, nN, pm, pn);
        const int seg = i & 1;
        const int ld = seg ? ATT_OUT * 2 : HG_WIDTH * 2;
        u.a = (seg ? A1 : A0) + (size_t)pm * 256 * ld; u.b = (seg ? B1 : B0) + (size_t)pn * 256 * ld; u.lda = ld; u.ldb = ld; u.nt = seg ? ATT_OUT / 64 : HG_WIDTH / 64;
        u.row0 = pm * 256; u.col0 = pn * 256; u.aux = seg; u.gidx = nullptr; u.gcnt = 256; u.gl = nullptr; return true;
    }
};
template <int NT, bool UP, int ES = 2>
struct MoeSched {
    const LAS int* toff; const GAS unsigned* cnt;
    const GAS char* A; const GAS char* W; const GAS int* rowmap;
    int G, c;
    const LAS int* gtab;
    const LAS int* utab;
    __device__ __forceinline__ bool decode(int i, int& mtg, int& pn, int& e) const {
        const int total = toff[NEXP1];
        const int nb = G >> 3, x = c & 7, lb = c >> 3;
        const int tpx = (total + 7) >> 3, t0 = x * tpx; int nx = total - t0; nx = nx > tpx ? tpx : nx;
        const int jj = i * nb + lb;
        if (nx <= 0 || lb >= nb || jj >= nx * NT) return false;
        const int nig = 8 * NT, gid = jj / nig, fm = gid * 8, gsz = (nx - fm) < 8 ? (nx - fm) : 8;
        mtg = t0 + fm + ((jj % nig) % gsz); pn = (jj % nig) / gsz;
        int lo = 0, hi = NEXP1;
        while (hi - lo > 1) { const int mid = (lo + hi) >> 1; if (toff[mid] <= mtg) lo = mid; else hi = mid; }
        e = lo; return true;
    }
    __device__ __forceinline__ void build_units(LAS int* tab) const {
        if (threadIdx.x < 32) { int mtg = 0, pn = 0, e = 0; const bool ok = decode((int)threadIdx.x, mtg, pn, e);
            tab[threadIdx.x * 4 + 0] = mtg; tab[threadIdx.x * 4 + 1] = pn; tab[threadIdx.x * 4 + 2] = e; tab[threadIdx.x * 4 + 3] = ok ? 1 : 0; }
        __syncthreads();
        if (UP && gtab != nullptr) {
            LAS int* gt = (LAS int*)gtab;
            for (int i0 = 0; i0 < 16; i0 += 2) { const int i = i0 + (int)(threadIdx.x >> 8), r = (int)threadIdx.x & 255;
                if (tab[i * 4 + 3]) { const int mtg = tab[i * 4 + 0], e = tab[i * 4 + 2], mt = mtg - toff[e];
                    int v; if (e < N_EXPERTS) { const int n = (int)cnt[e] - mt * 256; v = (r < n) ? rowmap[(size_t)e * T + mt * 256 + r] : 0; } else v = mt * 256 + r;
                    gt[i * 256 + r] = v; } }
            __syncthreads(); }
    }
    __device__ __forceinline__ bool next(int i, Unit& u) const {
        int mtg, pn, e;
        if (i < 32) { const int ok = utab[i * 4 + 3]; if (!ok) return false; mtg = utab[i * 4 + 0]; pn = utab[i * 4 + 1]; e = utab[i * 4 + 2]; }
        else if (!decode(i, mtg, pn, e)) return false;
        mtg = __builtin_amdgcn_readfirstlane(mtg); pn = __builtin_amdgcn_readfirstlane(pn); e = __builtin_amdgcn_readfirstlane(e);
        const int mt = mtg - toff[e];
        if (UP) {
            u.a = A; u.lda = D_MODEL * ES; u.nt = D_MODEL * ES / 128;
            u.b = W + ((size_t)e * 1024 + (size_t)pn * 256) * (D_MODEL * ES); u.ldb = D_MODEL * ES;
            if (gtab != nullptr && i < 16) { u.gl = gtab + i * 256; u.gidx = nullptr; u.gcnt = 256; }
            else { u.gl = nullptr;
                if (e < N_EXPERTS) { u.gidx = rowmap + (size_t)e * T + mt * 256; const int n = (int)cnt[e] - mt * 256; u.gcnt = n < 256 ? n : 256; }
                else { u.gidx = rowmap + (size_t)N_EXPERTS * T + mt * 256; u.gcnt = 256; } }
            u.col0 = pn * 128;
        } else {
            u.a = A + (size_t)mtg * 256 * (EXPERT_FF * ES); u.lda = EXPERT_FF * ES; u.nt = EXPERT_FF * ES / 128;
            u.b = W + ((size_t)e * D_MODEL + (size_t)pn * 256) * (EXPERT_FF * ES); u.ldb = EXPERT_FF * ES;
            u.gidx = nullptr; u.gcnt = 256; u.gl = nullptr; u.col0 = pn * 256;
        }
        u.row0 = mtg * 256; u.aux = e; return true;
    }
};

struct EpiIn {
    static constexpr bool PERM = true, WIDE = false;
    GAS bf16_t* H; GAS _Float16* LF; const GAS float* lb; const GAS f32x4* rope;
    __device__ __forceinline__ bool operator()(f32x4 (&acc)[2][2][4][2], const Unit& u, int wr, int wc, int fr, int fq, LAS unsigned char* scr) const {
        const int row0 = u.row0 + wr * 64 + fr, colt = u.col0, cl = wc * 32 + 8 * fq;
        int mode;
        if (colt < C_HF) mode = 1; else if (colt < C_HI) mode = 3; else if (colt < C_HGATE) mode = 0; else if (colt < C_AQ) mode = 2;
        else if (colt < C_AK) mode = 4; else if (colt < C_AV) mode = 5; else if (colt < C_GH) mode = 0; else mode = 2;
        if (mode == 3) {
            f32x4 lbv[2][2];
#pragma unroll
            for (int bj = 0; bj < 2; ++bj)
#pragma unroll
                for (int n = 0; n < 2; ++n) lbv[bj][n] = *(const GAS f32x4*)(lb + (colt - C_HF) + bj * 128 + cl + 4 * n);
#pragma unroll
            for (int ai = 0; ai < 2; ++ai)
#pragma unroll
                for (int m = 0; m < 4; ++m) { GAS _Float16* rowp = LF + HOFF(colt - C_HF, row0 + ai * 128 + m * 16) + cl;
#pragma unroll
                    for (int bj = 0; bj < 2; ++bj) { f16x8 o8;
#pragma unroll
                        for (int n = 0; n < 2; ++n) { const f32x4 z = acc[ai][bj][m][n];
#pragma unroll
                            for (int j = 0; j < 4; ++j) { const float zz = fmaxf(z[j], -80.f), l = lbv[bj][n][j]; const float f = l + (1.0f - l) * fdiv(1.0f, 1.0f + __expf(-zz)); o8[4 * n + j] = (_Float16)__logf(f); } }
                        *(GAS f16x8*)(rowp + (size_t)bj * T * 128) = o8; } }
            return false;
        }
        if (mode >= 4) {
            const float sc = (mode == 4) ? 0.08838834764831845f : 1.0f;
            const int i0 = 16 * wc + 4 * fq;
#pragma unroll
            for (int ai = 0; ai < 2; ++ai)
#pragma unroll
                for (int m = 0; m < 4; ++m) { const int row = row0 + ai * 128 + m * 16; GAS bf16_t* rowp = H + HOFF(colt, row) + cl;
                    const f32x4 cs0 = rope[(size_t)row * 32 + (i0 >> 1)], cs1 = rope[(size_t)row * 32 + (i0 >> 1) + 1];
#pragma unroll
                    for (int bj = 0; bj < 2; ++bj) { const f32x4 v0 = acc[ai][bj][m][0], v1 = acc[ai][bj][m][1]; u32x4 w;
                        w.x = cvt_pk_bf16((v0[0] * cs0[0] - v0[1] * cs0[1]) * sc, (v0[1] * cs0[0] + v0[0] * cs0[1]) * sc);
                        w.y = cvt_pk_bf16((v0[2] * cs0[2] - v0[3] * cs0[3]) * sc, (v0[3] * cs0[2] + v0[2] * cs0[3]) * sc);
                        w.z = cvt_pk_bf16((v1[0] * cs1[0] - v1[1] * cs1[1]) * sc, (v1[1] * cs1[0] + v1[0] * cs1[1]) * sc);
                        w.w = cvt_pk_bf16((v1[2] * cs1[2] - v1[3] * cs1[3]) * sc, (v1[3] * cs1[2] + v1[2] * cs1[3]) * sc);
                        *(GAS u32x4*)(rowp + (size_t)bj * T * 128) = w; } }
            return false;
        }
#pragma unroll
        for (int ai = 0; ai < 2; ++ai)
#pragma unroll
            for (int m = 0; m < 4; ++m) { GAS bf16_t* rowp = H + HOFF(colt, row0 + ai * 128 + m * 16) + cl;
#pragma unroll
                for (int bj = 0; bj < 2; ++bj) { f32x4 v0 = acc[ai][bj][m][0], v1 = acc[ai][bj][m][1];
                    if (mode != 0) {
#pragma unroll
                        for (int j = 0; j < 4; ++j) { const float s0 = fsigmoid(v0[j]), s1 = fsigmoid(v1[j]); v0[j] = (mode == 1) ? v0[j] * s0 : s0; v1[j] = (mode == 1) ? v1[j] * s1 : s1; } }
                    u32x4 w; w.x = cvt_pk_bf16(v0[0], v0[1]); w.y = cvt_pk_bf16(v0[2], v0[3]); w.z = cvt_pk_bf16(v1[0], v1[1]); w.w = cvt_pk_bf16(v1[2], v1[3]);
                    *(GAS u32x4*)(rowp + (size_t)bj * T * 128) = w; } }
        return false;
    }
};
struct EpiMerge {
    static constexpr bool PERM = true, WIDE = true;
    const GAS bf16_t* H; GAS bf16_t* O;
    __device__ __forceinline__ bool operator()(f32x4 (&acc)[2][2][4][2], const Unit& u, int wr, int wc, int fr, int fq, LAS unsigned char* scr) const {
        const int lane = fq * 16 + fr, rowb = u.row0 + wr * 64, colb = u.col0 + wc * 64;
        const int lr = lane >> 3, lch = lane & 7;
        const int wo = lr * 128 + ((lch ^ (lr & 7)) * 16);
        const bool seg0 = (u.aux == 0);
#pragma unroll
        for (int ai = 0; ai < 2; ++ai)
#pragma unroll
            for (int m = 0; m < 4; ++m) { const size_t rg = (size_t)(rowb + ai * 128 + m * 16);
                const GAS bf16_t* gpa = H + HOFF(C_GA + colb, rg + lr) + lch * 8; const GAS bf16_t* gph = H + HOFF(C_GH + colb, rg + lr) + lch * 8;
                const u32x4 ga0 = *(const GAS u32x4*)gpa, ga1 = *(const GAS u32x4*)(gpa + 8 * 128);
                u32x4 gh0 = ga0, gh1 = ga1; if (seg0) { gh0 = *(const GAS u32x4*)gph; gh1 = *(const GAS u32x4*)(gph + 8 * 128); }
                *(LAS u32x4*)(scr + wo) = ga0; *(LAS u32x4*)(scr + wo + 1024) = ga1;
                LDS_WAIT();
                u32x4 gaf[2], ghf[2];
#pragma unroll
                for (int bj = 0; bj < 2; ++bj) gaf[bj] = *(const LAS u32x4*)(scr + fr * 128 + (((bj * 4 + fq) ^ (fr & 7)) * 16));
                LDS_WAIT();
                if (seg0) { *(LAS u32x4*)(scr + wo) = gh0; *(LAS u32x4*)(scr + wo + 1024) = gh1;
                    LDS_WAIT();
#pragma unroll
                    for (int bj = 0; bj < 2; ++bj) ghf[bj] = *(const LAS u32x4*)(scr + fr * 128 + (((bj * 4 + fq) ^ (fr & 7)) * 16));
                    LDS_WAIT(); }
#pragma unroll
                for (int bj = 0; bj < 2; ++bj) { const u32x4 ga = gaf[bj];
                    float a[8] = {bflo(ga.x), bfhi(ga.x), bflo(ga.y), bfhi(ga.y), bflo(ga.z), bfhi(ga.z), bflo(ga.w), bfhi(ga.w)};
                    if (seg0) { const u32x4 gh = ghf[bj];
                        float h[8] = {bflo(gh.x), bfhi(gh.x), bflo(gh.y), bfhi(gh.y), bflo(gh.z), bfhi(gh.z), bflo(gh.w), bfhi(gh.w)};
#pragma unroll
                        for (int j = 0; j < 4; ++j) { acc[ai][bj][m][0][j] *= fdiv(h[j], a[j]); acc[ai][bj][m][1][j] *= fdiv(h[4 + j], a[4 + j]); }
                    } else {
                        f32x4 v0 = acc[ai][bj][m][0], v1 = acc[ai][bj][m][1];
#pragma unroll
                        for (int j = 0; j < 4; ++j) { v0[j] *= a[j]; v1[j] *= a[4 + j]; }
                        u32x2 w8; int q = __builtin_amdgcn_cvt_pk_fp8_f32(v0[0], v0[1], 0, false); q = __builtin_amdgcn_cvt_pk_fp8_f32(v0[2], v0[3], q, true); w8.x = (unsigned)q;
                        q = __builtin_amdgcn_cvt_pk_fp8_f32(v1[0], v1[1], 0, false); q = __builtin_amdgcn_cvt_pk_fp8_f32(v1[2], v1[3], q, true); w8.y = (unsigned)q;
                        *(LAS u32x2*)(scr + fr * 64 + bj * 32 + fq * 8) = w8; } }
                if (!seg0) { LDS_WAIT();
                    const int r = lane >> 2, ch = lane & 3; const u32x4 o = *(const LAS u32x4*)(scr + r * 64 + ch * 16);
                    *(GAS u32x4*)((GAS unsigned char*)O + (rg + r) * D_MODEL + colb + ch * 16) = o;
                    LDS_WAIT(); }
            }
        return seg0;
    }
};
struct EpiResid {
    static constexpr bool PERM = false, WIDE = false;
    const GAS bf16_t* X; GAS bf16_t* R;
    __device__ __forceinline__ bool operator()(f32x4 (&acc)[2][2][4][2], const Unit& u, int wr, int wc, int fr, int fq, LAS unsigned char* scr) const {
        const int row0 = u.row0 + wr * 64 + fr, col0 = u.col0 + wc * 32 + 4 * fq;
#pragma unroll
        for (int ai = 0; ai < 2; ++ai)
#pragma unroll
            for (int m = 0; m < 4; ++m) { const size_t off = (size_t)(row0 + ai * 128 + m * 16) * D_MODEL + col0;
#pragma unroll
                for (int bj = 0; bj < 2; ++bj)
#pragma unroll
                    for (int n = 0; n < 2; ++n) { const u32x2 xv = *(const GAS u32x2*)(X + off + bj * 128 + n * 16); const f32x4 a = acc[ai][bj][m][n];
                        u32x2 o; o.x = cvt_pk_bf16(bflo(xv.x) * DN_ALPHA + a[0], bfhi(xv.x) * DN_ALPHA + a[1]); o.y = cvt_pk_bf16(bflo(xv.y) * DN_ALPHA + a[2], bfhi(xv.y) * DN_ALPHA + a[3]);
                        *(GAS u32x2*)(R + off + bj * 128 + n * 16) = o; } }
        return false;
    }
};
template <bool F8OUT>
struct EpiGateUp {
    static constexpr bool PERM = true, WIDE = false;
    GAS bf16_t* HID;
    __device__ __forceinline__ bool operator()(f32x4 (&acc)[2][2][4][2], const Unit& u, int wr, int wc, int fr, int fq, LAS unsigned char* scr) const {
        const int row0 = u.row0 + wr * 64 + fr, col0 = u.col0 + wc * 32 + 8 * fq;
#pragma unroll
        for (int ai = 0; ai < 2; ++ai)
#pragma unroll
            for (int m = 0; m < 4; ++m) { GAS bf16_t* rowp = HID + (size_t)(row0 + ai * 128 + m * 16) * EXPERT_FF + col0;
                f32x4 g0 = acc[ai][0][m][0], g1 = acc[ai][0][m][1]; const f32x4 u0 = acc[ai][1][m][0], u1 = acc[ai][1][m][1];
#pragma unroll
                for (int j = 0; j < 4; ++j) { g0[j] = g0[j] * fsigmoid(g0[j]) * u0[j]; g1[j] = g1[j] * fsigmoid(g1[j]) * u1[j]; }
                if constexpr (F8OUT) { u32x2 w8; int q = __builtin_amdgcn_cvt_pk_fp8_f32(g0[0], g0[1], 0, false); q = __builtin_amdgcn_cvt_pk_fp8_f32(g0[2], g0[3], q, true); w8.x = (unsigned)q;
                    q = __builtin_amdgcn_cvt_pk_fp8_f32(g1[0], g1[1], 0, false); q = __builtin_amdgcn_cvt_pk_fp8_f32(g1[2], g1[3], q, true); w8.y = (unsigned)q;
                    *(GAS u32x2*)((GAS unsigned char*)HID + (size_t)(row0 + ai * 128 + m * 16) * EXPERT_FF + col0) = w8; }
                else { u32x4 w; w.x = cvt_pk_bf16(g0[0], g0[1]); w.y = cvt_pk_bf16(g0[2], g0[3]); w.z = cvt_pk_bf16(g1[0], g1[1]); w.w = cvt_pk_bf16(g1[2], g1[3]);
                    *(GAS u32x4*)rowp = w; } }
        return false;
    }
};
template <bool F8OUT>
struct EpiDown {
    static constexpr bool PERM = true, WIDE = true;
    GAS bf16_t* Y;
    __device__ __forceinline__ bool operator()(f32x4 (&acc)[2][2][4][2], const Unit& u, int wr, int wc, int fr, int fq, LAS unsigned char* scr) const {
        const int lane = fq * 16 + fr, rowb = u.row0 + wr * 64, colb = u.col0 + wc * 64;
#pragma unroll
        for (int ai = 0; ai < 2; ++ai)
#pragma unroll
            for (int m = 0; m < 4; ++m) { const size_t rg = (size_t)(rowb + ai * 128 + m * 16);
                if constexpr (F8OUT) {
#pragma unroll
                    for (int bj = 0; bj < 2; ++bj) { const f32x4 v0 = acc[ai][bj][m][0], v1 = acc[ai][bj][m][1]; u32x2 w8;
                        int q = __builtin_amdgcn_cvt_pk_fp8_f32(v0[0], v0[1], 0, false); q = __builtin_amdgcn_cvt_pk_fp8_f32(v0[2], v0[3], q, true); w8.x = (unsigned)q;
                        q = __builtin_amdgcn_cvt_pk_fp8_f32(v1[0], v1[1], 0, false); q = __builtin_amdgcn_cvt_pk_fp8_f32(v1[2], v1[3], q, true); w8.y = (unsigned)q;
                        *(LAS u32x2*)(scr + fr * 64 + bj * 32 + fq * 8) = w8; }
                    LDS_WAIT();
                    const int r = lane >> 2, ch = lane & 3; const u32x4 o = *(const LAS u32x4*)(scr + r * 64 + ch * 16);
                    *(GAS u32x4*)((GAS unsigned char*)Y + (rg + r) * D_MODEL + colb + ch * 16) = o;
                } else {
#pragma unroll
                    for (int bj = 0; bj < 2; ++bj) { const f32x4 v0 = acc[ai][bj][m][0], v1 = acc[ai][bj][m][1];
                        u32x4 w; w.x = cvt_pk_bf16(v0[0], v0[1]); w.y = cvt_pk_bf16(v0[2], v0[3]); w.z = cvt_pk_bf16(v1[0], v1[1]); w.w = cvt_pk_bf16(v1[2], v1[3]);
                        *(LAS u32x4*)(scr + fr * 128 + (((bj * 4 + fq) ^ (fr & 7)) * 16)) = w; }
                    LDS_WAIT();
                    const int r = lane >> 3, ch = lane & 7;
                    const u32x4 o0 = *(const LAS u32x4*)(scr + r * 128 + ((ch ^ (r & 7)) * 16)), o1 = *(const LAS u32x4*)(scr + (r + 8) * 128 + ((ch ^ (r & 7)) * 16));
                    *(GAS u32x4*)(Y + (rg + r) * D_MODEL + colb + ch * 8) = o0; *(GAS u32x4*)(Y + (rg + r + 8) * D_MODEL + colb + ch * 8) = o1;
                }
                LDS_WAIT(); }
        return false;
    }
};

struct Args { const float* in[20]; float* out; unsigned char* ws; int ph_lo, ph_hi; };
typedef const __attribute__((address_space(4))) Args* CArgsP;
#define GIN(k) ((const GAS float*)(GAS const float*)ap->in[k])
#define PHASE_ARGS() CArgsP ap = (CArgsP)__builtin_amdgcn_kernarg_segment_ptr(); asm volatile("" : "+s"(ap))
struct Frame {
    LAS unsigned char* lds;
    GAS unsigned* ctl;
    GAS unsigned char* ws;
    int G, bid;
};
#define PHASE_IDS() int tid = threadIdx.x; asm volatile("" : "+v"(tid)); const int lane = tid & 63, w = __builtin_amdgcn_readfirstlane(tid >> 6); (void)lane; (void)w

__device__ __forceinline__ int conv_src_col(int mode, int p) {
    if (mode == 1 && p >= C_AQ && p < C_AV) { const int hb = p & ~127, q = p & 127; return hb + (q >> 1) + 64 * (q & 1); }
    return p;
}
__device__ __forceinline__ int conv_dst_row(int mode, int n) {
    if (mode == 1) { if (n >= C_AQ && n < C_AV) { const int hb = n & ~127, dd = n & 127; return hb + (dd < 64 ? 2 * dd : 2 * (dd - 64) + 1); } return n; }
    if (mode == 2) return (n >> 7) * 256 + (n & 127);
    if (mode == 3) return (n >> 7) * 256 + 128 + (n & 127);
    return n;
}
struct ConvJob { const GAS float* W; GAS unsigned char* WT; int K, N, mode, item, ncol0, ncols, f8; float sc8; };
__device__ __forceinline__ void conv_load(const ConvJob& J, int tid, f32x4 (&v)[16]) {
    const int nblk = J.ncols / 256, k0 = 128 * (J.item / nblk), n0 = J.ncol0 + 256 * (J.item % nblk);
    {
#pragma unroll
        for (int ii = 0; ii < 16; ++ii) { const int idx = tid + 512 * ii, k = idx >> 6, c4 = idx & 63; v[ii] = *(const GAS f32x4*)(J.W + (size_t)(k0 + k) * J.N + n0 + 4 * c4); }
    }
}
__device__ __forceinline__ void conv_to_lds(const ConvJob& J, int tid, const f32x4 (&v)[16], LAS float* T) {
#pragma unroll
    for (int ii = 0; ii < 16; ++ii) { const int idx = tid + 512 * ii, k = idx >> 6, c4 = idx & 63; const int g = J.f8 ? ((k >> 4) & 7) : ((k >> 3) & 15);
        *(LAS f32x4*)(T + k * 256 + 4 * (c4 ^ g)) = v[ii]; }
}
__device__ __forceinline__ void conv_from_lds(const ConvJob& J, int tid, const LAS float* T) {
    const int nblk = J.ncols / 256, k0 = 128 * (J.item / nblk), n0 = J.ncol0 + 256 * (J.item % nblk);
    const int lane = tid & 63, w = tid >> 6, j = lane & 3;
    if (J.f8) {
        const int c = (lane >> 2) & 7; const float sc8 = J.sc8;
#pragma unroll
        for (int it = 0; it < 4; ++it) { const int c4n = w * 8 + it * 2 + (lane >> 5), n = 4 * c4n + j; const LAS float* base = T + 4 * (c4n ^ c) + j; u32x4 o;
#pragma unroll
            for (int d = 0; d < 4; ++d) { const int kk = 16 * c + 4 * d;
                int wv = __builtin_amdgcn_cvt_pk_fp8_f32(base[(kk + 0) * 256] * sc8, base[(kk + 1) * 256] * sc8, 0, false);
                wv = __builtin_amdgcn_cvt_pk_fp8_f32(base[(kk + 2) * 256] * sc8, base[(kk + 3) * 256] * sc8, wv, true); o[d] = (unsigned)wv; }
            *(GAS u32x4*)(J.WT + (size_t)conv_dst_row(J.mode, n0 - J.ncol0 + n) * J.K + k0 + 16 * c) = o; }
    } else {
        const int c = ((lane >> 2) & 7) + 8 * (lane >> 5);
#pragma unroll
        for (int it = 0; it < 8; ++it) { const int c4n = w * 8 + it, n = 4 * c4n + j; const LAS float* base = T + 4 * (c4n ^ c) + j + (8 * c) * 256;
            u32x4 o; o.x = cvt_pk_bf16(base[0 * 256], base[1 * 256]); o.y = cvt_pk_bf16(base[2 * 256], base[3 * 256]); o.z = cvt_pk_bf16(base[4 * 256], base[5 * 256]); o.w = cvt_pk_bf16(base[6 * 256], base[7 * 256]);
            *(GAS u32x4*)(J.WT + ((size_t)conv_dst_row(J.mode, n0 - J.ncol0 + n) * J.K + k0 + 8 * c) * 2) = o; }
    }
}
__device__ __forceinline__ void conv8_load(const ConvJob& J, int tid, f32x4 (&v)[16]) {
    const int nblk = J.ncols / 256, k0 = 128 * (J.item / nblk), n0 = J.ncol0 + 256 * (J.item % nblk);
    const int lane = tid & 63, w = tid >> 6, kg = lane & 7, nq = lane >> 3;
    const GAS float* p = J.W + (size_t)(k0 + 16 * kg) * J.N + n0 + 32 * w + 4 * nq;
#pragma unroll
    for (int j = 0; j < 16; ++j) v[j] = *(const GAS f32x4*)(p + (size_t)j * J.N);
}
__device__ __forceinline__ void conv8_store(const ConvJob& J, int tid, const f32x4 (&v)[16]) {
    const int nblk = J.ncols / 256, k0 = 128 * (J.item / nblk), n0 = J.ncol0 + 256 * (J.item % nblk);
    const int lane = tid & 63, w = tid >> 6, kg = lane & 7, nq = lane >> 3; const float sc8 = J.sc8;
#pragma unroll
    for (int c = 0; c < 4; ++c) { u32x4 o;
#pragma unroll
        for (int d = 0; d < 4; ++d) { int wv = __builtin_amdgcn_cvt_pk_fp8_f32(v[4 * d][c] * sc8, v[4 * d + 1][c] * sc8, 0, false);
            wv = __builtin_amdgcn_cvt_pk_fp8_f32(v[4 * d + 2][c] * sc8, v[4 * d + 3][c] * sc8, wv, true); o[d] = (unsigned)wv; }
        *(GAS u32x4*)(J.WT + (size_t)conv_dst_row(J.mode, n0 - J.ncol0 + 32 * w + 4 * nq + c) * J.K + k0 + 16 * kg) = o; }
}
__device__ __forceinline__ void p0_convert(Frame& F, int layer, bool gu8, bool moe8, int part = 0, int tail = 0, GAS unsigned* ctr = nullptr) {
    PHASE_IDS(); PHASE_ARGS();
    LAS float* TL = (LAS float*)F.lds;
    GAS unsigned char* ws = F.ws;
    const GAS float* w_in = GIN(2) + (size_t)layer * D_MODEL * IN_WIDTH;
    const GAS float* w_hg = GIN(5) + (size_t)layer * HG_WIDTH * D_MODEL;
    const GAS float* w_att = GIN(6) + (size_t)layer * ATT_OUT * D_MODEL;
    const GAS float* w_out = GIN(7) + (size_t)layer * D_MODEL * D_MODEL;
    const GAS float* w_eg = GIN(12) + (size_t)layer * N_EXPERTS * D_MODEL * EXPERT_FF;
    const GAS float* w_eu = GIN(13) + (size_t)layer * N_EXPERTS * D_MODEL * EXPERT_FF;
    const GAS float* w_ed = GIN(14) + (size_t)layer * N_EXPERTS * EXPERT_FF * D_MODEL;
    const GAS float* w_sg = GIN(15) + (size_t)layer * D_MODEL * EXPERT_FF;
    const GAS float* w_su = GIN(16) + (size_t)layer * D_MODEL * EXPERT_FF;
    const GAS float* w_sd = GIN(17) + (size_t)layer * EXPERT_FF * D_MODEL;
    constexpr int I_IN = (D_MODEL / 128) * (IN_WIDTH / 256), I_INF = (D_MODEL / 128) * (HG_WIDTH / 256), I_HG = (HG_WIDTH / 128) * (D_MODEL / 256), I_ATT = (ATT_OUT / 128) * (D_MODEL / 256), I_OUT = (D_MODEL / 128) * (D_MODEL / 256);
    constexpr int I_E = (D_MODEL / 128) * (EXPERT_FF / 256);
    static_assert((EXPERT_FF / 128) * (D_MODEL / 256) == I_E, "item count of the down matrices");
    constexpr int NITEMS = I_IN + I_INF + I_HG + I_ATT + I_OUT + 3 * NEXP1 * I_E;
    auto decode = [&](int it) -> ConvJob {
        int r = it;
        if (r < I_IN) return ConvJob{w_in, ws + WS_WIN, D_MODEL, IN_WIDTH, 1, r, 0, IN_WIDTH, 1, 64.f}; r -= I_IN;
        if (r < I_INF) return ConvJob{w_in, ws + WS_WINF, D_MODEL, IN_WIDTH, 0, r, C_HF, HG_WIDTH, 0, 1.f}; r -= I_INF;
        if (r < I_HG) return ConvJob{w_hg, ws + WS_WHG, HG_WIDTH, D_MODEL, 0, r, 0, D_MODEL, 0, 1.f}; r -= I_HG;
        if (r < I_ATT) return ConvJob{w_att, ws + WS_WATT, ATT_OUT, D_MODEL, 0, r, 0, D_MODEL, 0, 1.f}; r -= I_ATT;
        if (r < I_OUT) return ConvJob{w_out, ws + WS_WOUT, D_MODEL, D_MODEL, 0, r, 0, D_MODEL, 1, 64.f}; r -= I_OUT;
        const int which = r / (NEXP1 * I_E); r -= which * (NEXP1 * I_E);
        const int e = r / I_E, ri = r % I_E; const int es = gu8 ? 1 : 2;
        if (which == 0) return ConvJob{(e < N_EXPERTS) ? w_eg + (size_t)e * D_MODEL * EXPERT_FF : w_sg, ws + (moe8 ? WS_WGU8 : WS_WGU) + (size_t)e * 1024 * D_MODEL * es, D_MODEL, EXPERT_FF, 2, ri, 0, EXPERT_FF, gu8 ? 1 : 0, 64.f};
        if (which == 1) return ConvJob{(e < N_EXPERTS) ? w_eu + (size_t)e * D_MODEL * EXPERT_FF : w_su, ws + (moe8 ? WS_WGU8 : WS_WGU) + (size_t)e * 1024 * D_MODEL * es, D_MODEL, EXPERT_FF, 3, ri, 0, EXPERT_FF, gu8 ? 1 : 0, 64.f};
        return ConvJob{(e < N_EXPERTS) ? w_ed + (size_t)e * EXPERT_FF * D_MODEL : w_sd, ws + (moe8 ? WS_WDN8 : WS_WDN) + (size_t)e * D_MODEL * EXPERT_FF, EXPERT_FF, D_MODEL, 0, ri, 0, D_MODEL, 1, 64.f};
    };
    constexpr int N_NONEXP = I_IN + I_INF + I_HG + I_ATT + I_OUT, NB16 = I_INF + I_HG + I_ATT;
    if (gu8) {
        constexpr int NF8 = NITEMS - NB16, NF8_NONEXP = I_IN + I_OUT;
        const int q_lo = (part == 2) ? NF8_NONEXP : 0, q_end = (part == 1) ? NF8_NONEXP : NF8, q_hi = q_end - tail;
        if (ctr != nullptr) {
            LAS unsigned* qw = (LAS unsigned*)(F.lds + LDS_TAB + 1536);
            for (;;) {
                if (tid == 0) *qw = __hip_atomic_fetch_add(ctr, 1u, RLX_AGENT);
                LDS_BARRIER();
                const int qd = q_hi + __builtin_amdgcn_readfirstlane((int)*qw);
                LDS_BARRIER();
                if (qd >= q_end) break;
                const ConvJob j = decode(qd < I_IN ? qd : qd + NB16); f32x4 v[16]; conv8_load(j, tid, v); conv8_store(j, tid, v); }
            return;
        }
        int q = q_lo + F.bid;
        if (q < q_hi) {
            f32x4 va[16], vb[16];
            conv8_load(decode(q < I_IN ? q : q + NB16), tid, va);
            for (;;) {
                const int q1 = q + F.G; const bool m1 = q1 < q_hi;
                if (m1) conv8_load(decode(q1 < I_IN ? q1 : q1 + NB16), tid, vb);
                conv8_store(decode(q < I_IN ? q : q + NB16), tid, va);
                if (!m1) break;
                const int q2 = q1 + F.G; const bool m2 = q2 < q_hi;
                if (m2) conv8_load(decode(q2 < I_IN ? q2 : q2 + NB16), tid, va);
                conv8_store(decode(q1 < I_IN ? q1 : q1 + NB16), tid, vb);
                if (!m2) break;
                q = q2; }
        }
        if (part != 2) {
            for (int it = I_IN + (F.G - 1 - F.bid); it < I_IN + NB16; it += F.G) { const ConvJob j = decode(it); f32x4 v[16];
                conv_load(j, tid, v); conv_to_lds(j, tid, v, TL); LDS_BARRIER(); conv_from_lds(j, tid, TL); LDS_BARRIER(); }
        }
    } else {
    const int it_lo = (part == 2) ? N_NONEXP : 0, it_hi = (part == 1) ? N_NONEXP : NITEMS;
    if (it_lo + F.bid < it_hi) {
        f32x4 va[16]; int it = it_lo + F.bid; ConvJob jc = decode(it);
        conv_load(jc, tid, va);
        for (;;) { const int itn = it + F.G; const bool more = itn < it_hi;
            conv_to_lds(jc, tid, va, TL);
            LDS_BARRIER();
            ConvJob jn = jc; if (more) { jn = decode(itn); conv_load(jn, tid, va); }
            conv_from_lds(jc, tid, TL);
            LDS_BARRIER();
            if (!more) break;
            jc = jn; it = itn; }
    }
    }
    if (layer == 0 && part != 2) {
        const GAS f32x4* x4 = (const GAS f32x4*)GIN(0); GAS u32x2* xb = (GAS u32x2*)(ws + WS_XB); GAS unsigned* xb8 = (GAS unsigned*)(ws + WS_XB8);
        for (size_t i = (size_t)F.bid * 512 + tid; i < (size_t)T * D_MODEL / 4; i += (size_t)F.G * 512) { const f32x4 v = x4[i]; u32x2 o; o.x = pk2(v[0], v[1]); o.y = pk2(v[2], v[3]); xb[i] = o;
            int w8 = __builtin_amdgcn_cvt_pk_fp8_f32(v[0], v[1], 0, false); w8 = __builtin_amdgcn_cvt_pk_fp8_f32(v[2], v[3], w8, true); xb8[i] = (unsigned)w8; }
        const GAS int* pos = (const GAS int*)GIN(1); GAS f32x2* rt = (GAS f32x2*)(ws + WS_ROPE);
        for (int i = F.bid * 512 + tid; i < T * 64; i += F.G * 512) { const int tk = i >> 6, fi = i & 63;
            const double inv = exp2(-(double)fi * (13.287712379549449 / 64.0));
            const double ang = (double)pos[tk] * inv; const double red = ang - rint(ang * 0.15915494309189535) * 6.283185307179586;
            const float rf = (float)red; rt[i] = (f32x2){cosf(rf), sinf(rf)}; }
        const GAS float* lbl = GIN(3); GAS float* lb = (GAS float*)(ws + WS_LB);
        for (int c = F.bid * 512 + tid; c < HG_WIDTH; c += F.G * 512) {
            float mx = -1e30f; for (int l = 0; l < DEPTH; ++l) mx = fmaxf(mx, lbl[l * HG_WIDTH + c]);
            float den = 0.f; for (int l = 0; l < DEPTH; ++l) den += expf(lbl[l * HG_WIDTH + c] - mx);
            float cum = 0.f, c0 = 0.f; for (int l = 0; l < DEPTH; ++l) { cum += expf(lbl[l * HG_WIDTH + c] - mx) / den; if (l == 0) c0 = cum; lb[l * HG_WIDTH + c] = cum - c0; }
        }
    }
}

constexpr int TROW = 272;
struct H1Regs { float lf[16]; u32x4 v[2]; };
__device__ __forceinline__ void h1_load(Frame& F, int chunk, int tid, H1Regs& R) {
    const GAS bf16_t* H = (const GAS bf16_t*)(F.ws + WS_H); const GAS _Float16* LF = (const GAS _Float16*)(F.ws + WS_LF);
    const int bh = chunk >> 5, n = chunk & 31, b = bh >> 3, head = bh & 7, tok0 = b * SEQ + n * 64, kk = tid & 127, part = tid >> 7;
    const GAS _Float16* p = LF + HOFF(head * 128, tok0 + part * 16) + kk;
#pragma unroll
    for (int j = 0; j < 16; ++j) R.lf[j] = (float)p[(size_t)j * 128];
#pragma unroll
    for (int j = 0; j < 2; ++j) { const int c = tid + 512 * j, row = c >> 4, ch = c & 15;
        R.v[j] = *(const GAS u32x4*)(H + HOFF(C_HI + head * 128, tok0 + row) + ch * 8); }
}
__device__ __forceinline__ void h1_item(Frame& F, int chunk, int tid, const H1Regs& R) {
    GAS float* UT = (GAS float*)(F.ws + WS_UT); GAS float* DEC = (GAS float*)(F.ws + WS_DEC);
    LAS unsigned char* KT = F.lds; LAS unsigned char* VT = F.lds + 17408; LAS float* TOT = (LAS float*)(F.lds + 34816);
    const int lane = tid & 63, w = __builtin_amdgcn_readfirstlane(tid >> 6);
    const int kk = tid & 127, part = tid >> 7, g = lane >> 4, i = lane & 15;
    float lf[16], cum[16];
#pragma unroll
    for (int j = 0; j < 16; ++j) lf[j] = R.lf[j];
#pragma unroll
    for (int j = 0; j < 2; ++j) { const int c = tid + 512 * j, row = c >> 4, ch = c & 15; *(LAS u32x4*)(VT + row * TROW + ch * 16) = R.v[j]; }
    float run = 0.f;
#pragma unroll
    for (int j = 0; j < 16; ++j) { run += lf[j]; cum[j] = run; }
    TOT[part * 128 + kk] = run;
    LDS_BARRIER();
    float off = 0.f, end = 0.f;
#pragma unroll
    for (int p = 0; p < 4; ++p) { const float t = TOT[p * 128 + kk]; if (p < part) off += t; end += t; }
#pragma unroll
    for (int j = 0; j < 16; ++j) { const float c = cum[j] + off; const float kt = (1.0f - __expf(lf[j])) * __expf(end - c);
        *(LAS unsigned short*)(KT + (part * 16 + j) * TROW + kk * 2) = (unsigned short)cvt_pk_bf16(kt, 0.f); }
    if (part == 0) DEC[(size_t)chunk * 128 + kk] = __expf(end);
    LDS_BARRIER();
    const unsigned ktb = (unsigned)(size_t)KT, vtb = (unsigned)(size_t)VT;
    const int q = i >> 2, p4 = i & 3;
    bf16x8 af[2];
#pragma unroll
    for (int ks = 0; ks < 2; ++ks) { const s16x4 lo = tr_read(ktb + (32 * ks + 8 * g + q) * TROW + (16 * w + 4 * p4) * 2), hi = tr_read(ktb + (32 * ks + 8 * g + 4 + q) * TROW + (16 * w + 4 * p4) * 2);
        af[ks] = (bf16x8){lo[0], lo[1], lo[2], lo[3], hi[0], hi[1], hi[2], hi[3]}; }
    f32x4 uacc[8];
#pragma unroll
    for (int vb = 0; vb < 8; ++vb) uacc[vb] = (f32x4){0.f, 0.f, 0.f, 0.f};
#pragma unroll
    for (int ks = 0; ks < 2; ++ks) { s16x4 lo[8], hi[8];
        tr_read8<32>(lo, vtb + (32 * ks + 8 * g + q) * TROW + 8 * p4); tr_read8<32>(hi, vtb + (32 * ks + 8 * g + 4 + q) * TROW + 8 * p4);
#pragma unroll
        for (int vb = 0; vb < 8; ++vb) uacc[vb] = mfma16(af[ks], TRCAT(lo[vb], hi[vb]), uacc[vb]); }
#pragma unroll
    for (int vb = 0; vb < 8; ++vb) { u32x2 wv; wv.x = pk2(uacc[vb][0], uacc[vb][1]); wv.y = pk2(uacc[vb][2], uacc[vb][3]);
        *(GAS u32x2*)((GAS bf16_t*)UT + (size_t)chunk * 16384 + (16 * vb + i) * 128 + 16 * w + 4 * g) = wv; }
    LDS_BARRIER();
}

__device__ __forceinline__ void attn_item(Frame& F, int it) {
    GAS bf16_t* H = (GAS bf16_t*)(F.ws + WS_H); GAS float* LSE = (GAS float*)(F.ws + WS_LSE);
    const int b = it / 192, rem = it % 192, h = rem >> 4, j = rem & 15, grp = h >> 2, dsh = 2 * grp, d = 1 << dsh, r = j & (d - 1), qb = j >> dsh;
    const int lbase = 128 * (qb - 1);
    GAS bf16_t* HbQ = H + HOFF(C_AQ + h * 128, b * SEQ); GAS bf16_t* HbK = H + HOFF(C_AK + h * 128, b * SEQ); GAS bf16_t* HbV = H + HOFF(C_AV + h * 128, b * SEQ);
    LAS unsigned char* KT = F.lds; LAS unsigned char* VT = F.lds + 256 * TROW;
    PHASE_IDS();
    const int g = lane >> 4, i = lane & 15;
    const int jb0 = (qb == 0) ? (8 - w) : 0;
#pragma unroll
    for (int jj = 0; jj < 8; ++jj) { if (qb == 0 && jj < 4) continue;
        const int c = tid + 512 * jj, row = c >> 4, ch = c & 15; int l = lbase + row; l = l < 0 ? 0 : l; const size_t tok = (size_t)(l * d + r);
        const u32x4 kv = *(const GAS u32x4*)(HbK + tok * 128 + ch * 8), vv = *(const GAS u32x4*)(HbV + tok * 128 + ch * 8);
        *(LAS u32x4*)(KT + row * TROW + ch * 16) = kv; *(LAS u32x4*)(VT + row * TROW + ch * 16) = vv; }
    const size_t tokq = (size_t)((128 * qb + 16 * w + i) * d + r);
    bf16x8 qf[4];
#pragma unroll
    for (int ks = 0; ks < 4; ++ks) qf[ks] = *(const GAS bf16x8*)(HbQ + tokq * 128 + 32 * ks + 8 * g);
    LDS_BARRIER();
    f32x4 s[9];
#pragma unroll
    for (int jb = 0; jb < 9; ++jb) { f32x4 a4 = {0.f, 0.f, 0.f, 0.f};
        if (jb >= jb0) {
#pragma unroll
            for (int ks = 0; ks < 4; ++ks) { const bf16x8 a = *(const LAS bf16x8*)(KT + (16 * (w + jb) + i) * TROW + (32 * ks + 8 * g) * 2); a4 = mfma16(a, qf[ks], a4); } }
        s[jb] = a4; }
    float mx = -1e30f;
#pragma unroll
    for (int jb = 0; jb < 9; ++jb)
#pragma unroll
        for (int rg = 0; rg < 4; ++rg) { const int kin = 4 * g + rg, dist = 128 - 16 * jb + i - kin, lk = lbase + 16 * (w + jb) + kin;
            const bool valid = ((unsigned)dist <= 128u) && (lk >= 0) && (jb >= jb0);
            const float v = valid ? s[jb][rg] : -INFINITY; s[jb][rg] = v; mx = fmaxf(mx, v); }
    mx = fmaxf(mx, __shfl_xor(mx, 16)); mx = fmaxf(mx, __shfl_xor(mx, 32));
    float den = 0.f;
#pragma unroll
    for (int jb = 0; jb < 9; ++jb)
#pragma unroll
        for (int rg = 0; rg < 4; ++rg) { const float p = __expf(s[jb][rg] - mx); s[jb][rg] = p; den += p; }
    den += __shfl_xor(den, 16); den += __shfl_xor(den, 32);
    f32x4 o[8];
#pragma unroll
    for (int db = 0; db < 8; ++db) o[db] = (f32x4){0.f, 0.f, 0.f, 0.f};
    const unsigned vtb = (unsigned)(size_t)VT; const int q = i >> 2, p4 = i & 3;
#pragma unroll
    for (int kp = 0; kp < 5; ++kp) {
        bf16x8 pb; { const unsigned a0 = cvt_pk_bf16(s[2 * kp][0], s[2 * kp][1]), a1 = cvt_pk_bf16(s[2 * kp][2], s[2 * kp][3]);
            unsigned b0 = 0u, b1 = 0u; if (kp < 4) { b0 = cvt_pk_bf16(s[2 * kp + 1][0], s[2 * kp + 1][1]); b1 = cvt_pk_bf16(s[2 * kp + 1][2], s[2 * kp + 1][3]); }
            const u32x4 t4 = {a0, a1, b0, b1}; pb = __builtin_bit_cast(bf16x8, t4); }
        if (2 * kp + 1 < jb0) continue;
        int r0 = 16 * (w + 2 * kp) + 4 * g + q; const int r1 = (kp < 4) ? r0 + 16 : r0;
        if (2 * kp < jb0) r0 = r1;
        s16x4 lo[8], hi[8];
        tr_read8<32>(lo, vtb + r0 * TROW + 8 * p4); tr_read8<32>(hi, vtb + r1 * TROW + 8 * p4);
#pragma unroll
        for (int db = 0; db < 8; ++db) o[db] = mfma16(TRCAT(lo[db], hi[db]), pb, o[db]);
    }
    const float rden = fdiv(1.0f, den);
#pragma unroll
    for (int db = 0; db < 8; ++db) { u32x2 wv; wv.x = cvt_pk_bf16(o[db][0] * rden, o[db][1] * rden); wv.y = cvt_pk_bf16(o[db][2] * rden, o[db][3] * rden);
        *(GAS u32x2*)(HbQ + tokq * 128 + 16 * db + 4 * g) = wv; }
    if (g == 0) LSE[(size_t)h * T + (size_t)b * SEQ + tokq] = mx + __logf(den);
    LDS_BARRIER();
}

__device__ __forceinline__ void scan_item(Frame& F, int item) {
    const GAS float* UT = (const GAS float*)(F.ws + WS_UT); const GAS float* DEC = (const GAS float*)(F.ws + WS_DEC); GAS bf16_t* SPT = (GAS bf16_t*)(F.ws + WS_SPT);
    PHASE_IDS();
    const int bh = item >> 2, q4 = item & 3, vv = q4 * 32 + (tid >> 4), kk0 = (tid & 15) * 8;
    f32x4 s0 = {0.f, 0.f, 0.f, 0.f}, s1 = {0.f, 0.f, 0.f, 0.f};
#pragma unroll 8
    for (int n = 0; n < 32; ++n) { const size_t chunk = (size_t)bh * 32 + n; const size_t eo = chunk * 16384 + (size_t)vv * 128 + kk0;
        const u32x4 ub = *(const GAS u32x4*)((const GAS bf16_t*)UT + eo); const f32x4 u0 = {bflo(ub.x), bfhi(ub.x), bflo(ub.y), bfhi(ub.y)}, u1 = {bflo(ub.z), bfhi(ub.z), bflo(ub.w), bfhi(ub.w)}, d0 = *(const GAS f32x4*)(DEC + chunk * 128 + kk0), d1 = *(const GAS f32x4*)(DEC + chunk * 128 + kk0 + 4);
        u32x4 wv; wv.x = cvt_pk_bf16(s0[0], s0[1]); wv.y = cvt_pk_bf16(s0[2], s0[3]); wv.z = cvt_pk_bf16(s1[0], s1[1]); wv.w = cvt_pk_bf16(s1[2], s1[3]);
        *(GAS u32x4*)(SPT + eo) = wv;
        s0 = d0 * s0 + u0; s1 = d1 * s1 + u1; }
}
__device__ __forceinline__ void attn_merge(Frame& F) {
    const GAS bf16_t* H = (const GAS bf16_t*)(F.ws + WS_H); const GAS float* LSE = (const GAS float*)(F.ws + WS_LSE); GAS bf16_t* ATTO = (GAS bf16_t*)(F.ws + WS_ATTO);
    PHASE_IDS();
    const int gw = F.bid * 8 + w, NGW = F.G * 8, hg = lane >> 4, d0 = (lane & 15) * 8;
    for (int t = gw; t < T; t += NGW) {
        const float l0 = LSE[(size_t)hg * T + t], l1 = LSE[(size_t)(4 + hg) * T + t], l2 = LSE[(size_t)(8 + hg) * T + t];
        const float mx = fmaxf(l0, fmaxf(l1, l2)); float w0 = __expf(l0 - mx), w1 = __expf(l1 - mx), w2 = __expf(l2 - mx); const float rs = fdiv(1.0f, w0 + w1 + w2); w0 *= rs; w1 *= rs; w2 *= rs;
        const GAS bf16_t* base = H + HOFF(C_AQ + hg * 128, t) + d0;
        const u32x4 a = *(const GAS u32x4*)base, bq = *(const GAS u32x4*)(base + (size_t)4 * T * 128), c = *(const GAS u32x4*)(base + (size_t)8 * T * 128);
        u32x4 wv;
        wv.x = cvt_pk_bf16(w0 * bflo(a.x) + w1 * bflo(bq.x) + w2 * bflo(c.x), w0 * bfhi(a.x) + w1 * bfhi(bq.x) + w2 * bfhi(c.x));
        wv.y = cvt_pk_bf16(w0 * bflo(a.y) + w1 * bflo(bq.y) + w2 * bflo(c.y), w0 * bfhi(a.y) + w1 * bfhi(bq.y) + w2 * bfhi(c.y));
        wv.z = cvt_pk_bf16(w0 * bflo(a.z) + w1 * bflo(bq.z) + w2 * bflo(c.z), w0 * bfhi(a.z) + w1 * bfhi(bq.z) + w2 * bfhi(c.z));
        wv.w = cvt_pk_bf16(w0 * bflo(a.w) + w1 * bflo(bq.w) + w2 * bflo(c.w), w0 * bfhi(a.w) + w1 * bfhi(bq.w) + w2 * bfhi(c.w));
        *(GAS u32x4*)(ATTO + (size_t)t * ATT_OUT + hg * 128 + d0) = wv;
    }
}

struct H3Regs { float lf[16]; unsigned short q[16]; u32x4 v[2]; u32x4 sp[4]; };
__device__ __forceinline__ void h3_load(Frame& F, int chunk, int tid, H3Regs& R) {
    const GAS bf16_t* H = (const GAS bf16_t*)(F.ws + WS_H); const GAS _Float16* LF = (const GAS _Float16*)(F.ws + WS_LF); const GAS bf16_t* SPT = (const GAS bf16_t*)(F.ws + WS_SPT);
    const int bh = chunk >> 5, n = chunk & 31, b = bh >> 3, head = bh & 7, tok0 = b * SEQ + n * 64, kk = tid & 127, part = tid >> 7;
    const GAS _Float16* p = LF + HOFF(head * 128, tok0 + part * 16) + kk; const GAS bf16_t* pq = H + HOFF(C_HQ + head * 128, tok0 + part * 16) + kk;
#pragma unroll
    for (int j = 0; j < 16; ++j) { R.lf[j] = (float)p[(size_t)j * 128]; R.q[j] = pq[(size_t)j * 128]; }
#pragma unroll
    for (int j = 0; j < 2; ++j) { const int c = tid + 512 * j, row = c >> 4, ch = c & 15; R.v[j] = *(const GAS u32x4*)(H + HOFF(C_HI + head * 128, tok0 + row) + ch * 8); }
#pragma unroll
    for (int j = 0; j < 4; ++j) { const int c = tid + 512 * j, row = c >> 4, ch = c & 15; R.sp[j] = *(const GAS u32x4*)(SPT + (size_t)chunk * 16384 + row * 128 + ch * 8); }
}
__device__ __forceinline__ void h3_item(Frame& F, int chunk, const GAS float* normg, int tid, const H3Regs& R) {
    const GAS bf16_t* H = (const GAS bf16_t*)(F.ws + WS_H); GAS bf16_t* HGO = (GAS bf16_t*)(F.ws + WS_HGO);
    const int bh = chunk >> 5, n = chunk & 31, b = bh >> 3, head = bh & 7, tok0 = b * SEQ + n * 64;
    LAS unsigned char* QT = F.lds; LAS unsigned char* QH = F.lds + 17408; LAS unsigned char* KH = F.lds + 34816; LAS unsigned char* VT = F.lds + 52224; LAS unsigned char* SP = F.lds + 69632;
    LAS float* TOT = (LAS float*)(F.lds + 104448); LAS float* RS = (LAS float*)(F.lds + 106496);
    const int lane = tid & 63, w = __builtin_amdgcn_readfirstlane(tid >> 6);
    const int kk = tid & 127, part = tid >> 7, g = lane >> 4, i = lane & 15;
    float lf[16], cum[16], qv[16];
#pragma unroll
    for (int j = 0; j < 16; ++j) { lf[j] = R.lf[j]; qv[j] = bf2f(R.q[j]); }
#pragma unroll
    for (int j = 0; j < 2; ++j) { const int c = tid + 512 * j, row = c >> 4, ch = c & 15; *(LAS u32x4*)(VT + row * TROW + ch * 16) = R.v[j]; }
#pragma unroll
    for (int j = 0; j < 4; ++j) { const int c = tid + 512 * j, row = c >> 4, ch = c & 15; *(LAS u32x4*)(SP + row * TROW + ch * 16) = R.sp[j]; }
    float run = 0.f;
#pragma unroll
    for (int j = 0; j < 16; ++j) { run += lf[j]; cum[j] = run; }
    TOT[part * 128 + kk] = run;
    LDS_BARRIER();
    float off = 0.f;
#pragma unroll
    for (int p = 0; p < 4; ++p) { const float t = TOT[p * 128 + kk]; if (p < part) off += t; }
    const float cmid = TOT[kk] + TOT[128 + kk];
#pragma unroll
    for (int j = 0; j < 16; ++j) { const float c = cum[j] + off; const int t = part * 16 + j; const float kq = 1.0f - __expf(lf[j]);
        const unsigned w01 = cvt_pk_bf16(qv[j] * __expf(c), qv[j] * __expf(fminf(c - cmid, 60.f)));
        *(LAS unsigned short*)(QT + t * TROW + kk * 2) = (unsigned short)w01;
        *(LAS unsigned short*)(QH + t * TROW + kk * 2) = (unsigned short)(w01 >> 16);
        *(LAS unsigned short*)(KH + t * TROW + kk * 2) = (unsigned short)cvt_pk_bf16(kq * __expf(fminf(cmid - c, 60.f)), 0.f); }
    LDS_BARRIER();
    const int tb = w & 3, vh = w >> 2;
    f32x4 at[4];
#pragma unroll
    for (int sb = 0; sb < 4; ++sb) { f32x4 a4 = {0.f, 0.f, 0.f, 0.f};
        if (sb <= tb) {
#pragma unroll
            for (int ks = 0; ks < 4; ++ks) { const bf16x8 a = *(const LAS bf16x8*)(KH + (16 * sb + i) * TROW + (32 * ks + 8 * g) * 2), bq = *(const LAS bf16x8*)(QH + (16 * tb + i) * TROW + (32 * ks + 8 * g) * 2);
                a4 = mfma16(a, bq, a4); }
            if (sb == tb) {
#pragma unroll
                for (int rg = 0; rg < 4; ++rg) a4[rg] = (4 * g + rg <= i) ? a4[rg] : 0.f; }
        }
        at[sb] = a4; }
    bf16x8 pb[2];
#pragma unroll
    for (int kp = 0; kp < 2; ++kp) { const u32x4 t4 = {pk2(at[2 * kp][0], at[2 * kp][1]), pk2(at[2 * kp][2], at[2 * kp][3]), pk2(at[2 * kp + 1][0], at[2 * kp + 1][1]), pk2(at[2 * kp + 1][2], at[2 * kp + 1][3])};
        pb[kp] = __builtin_bit_cast(bf16x8, t4); }
    const unsigned vtb = (unsigned)(size_t)VT; const int q = i >> 2, p4 = i & 3;
    f32x4 o[4]; float ss = 0.f;
    s16x4 vlo[2][4], vhi[2][4];
#pragma unroll
    for (int kp = 0; kp < 2; ++kp) tr_read4x2<32>(vlo[kp], vhi[kp], vtb + (32 * kp + 4 * g + q) * TROW + (64 * vh + 4 * p4) * 2, vtb + (32 * kp + 16 + 4 * g + q) * TROW + (64 * vh + 4 * p4) * 2);
#pragma unroll
    for (int vb = 0; vb < 4; ++vb) { const int vblk = 4 * vh + vb; f32x4 acc = {0.f, 0.f, 0.f, 0.f};
#pragma unroll
        for (int ks = 0; ks < 4; ++ks) { const bf16x8 a = *(const LAS bf16x8*)(SP + (16 * vblk + i) * TROW + (32 * ks + 8 * g) * 2), bq = *(const LAS bf16x8*)(QT + (16 * tb + i) * TROW + (32 * ks + 8 * g) * 2);
            acc = mfma16(a, bq, acc); }
#pragma unroll
        for (int kp = 0; kp < 2; ++kp) acc = mfma16(TRCAT(vlo[kp][vb], vhi[kp][vb]), pb[kp], acc);
        o[vb] = acc; ss += (acc[0] * acc[0] + acc[1] * acc[1]) + (acc[2] * acc[2] + acc[3] * acc[3]); }
    ss += __shfl_xor(ss, 16); ss += __shfl_xor(ss, 32);
    if (g == 0) RS[vh * 64 + 16 * tb + i] = ss;
    LDS_BARRIER();
    const float tot = RS[16 * tb + i] + RS[64 + 16 * tb + i];
    const float rinv = rsqrtf(tot * (1.0f / 128.0f) + NORM_EPS);
    const size_t tok = (size_t)(tok0 + 16 * tb + i);
#pragma unroll
    for (int vb = 0; vb < 4; ++vb) { const int vv = 16 * (4 * vh + vb) + 4 * g;
        const f32x4 ng = *(const GAS f32x4*)(normg + head * 128 + vv); const u32x2 gt = *(const GAS u32x2*)(H + HOFF(C_HGATE + head * 128, tok) + vv);
        u32x2 wv; wv.x = cvt_pk_bf16(o[vb][0] * rinv * ng[0] * bflo(gt.x), o[vb][1] * rinv * ng[1] * bfhi(gt.x)); wv.y = cvt_pk_bf16(o[vb][2] * rinv * ng[2] * bflo(gt.y), o[vb][3] * rinv * ng[3] * bfhi(gt.y));
        *(GAS u32x2*)(HGO + tok * HG_WIDTH + head * 128 + vv) = wv; }
    LDS_BARRIER();
}

template <bool X8>
__device__ __forceinline__ void ln_router_phase(Frame& F, int layer) {
    PHASE_ARGS();
    const GAS bf16_t* R = (const GAS bf16_t*)(F.ws + WS_R); GAS bf16_t* X1B = (GAS bf16_t*)(F.ws + WS_X1B); GAS unsigned char* X1B8 = F.ws + WS_X1B8;
    const GAS float* g1 = GIN(8) + (size_t)layer * D_MODEL; const GAS float* b1 = GIN(9) + (size_t)layer * D_MODEL;
    const GAS float* wrt = GIN(10) + (size_t)layer * D_MODEL * N_EXPERTS; const GAS float* rbias = GIN(11) + (size_t)layer * N_EXPERTS;
    GAS int* PE = (GAS int*)(F.ws + WS_PE); GAS int* PP = (GAS int*)(F.ws + WS_PP); GAS float* PG = (GAS float*)(F.ws + WS_PG); GAS int* RM = (GAS int*)(F.ws + WS_RM);
    GAS unsigned* cnt = F.ctl + CW_CNT + layer * 64;
    constexpr int XROW = 528, WROW = 144;
    LAS unsigned char* XSb = F.lds; LAS unsigned char* WSb = F.lds + 64 * XROW; LAS float* PART = (LAS float*)F.lds; LAS float* LG = (LAS float*)(F.lds + 32768);
    LAS int* LCNT = (LAS int*)(F.lds + 49152); LAS int* BASE = (LAS int*)(F.lds + 49408); LAS int* PEL = (LAS int*)(F.lds + 49664); LAS int* PLL = (LAS int*)(F.lds + 51712);
    PHASE_IDS();
    const int g = lane >> 4, i = lane & 15;
    for (int bt = F.bid; bt < T / 64; bt += F.G) {
        const int tok0 = bt * 64;
#pragma unroll 1
        for (int pr = 0; pr < 4; ++pr) {
            f32x4 ys[2][4][2];
#pragma unroll
            for (int tt = 0; tt < 2; ++tt) { const size_t token = (size_t)(tok0 + 8 * w + 2 * pr + tt);
                const GAS u32x4* rp = (const GAS u32x4*)(R + token * D_MODEL) + lane;
#pragma unroll
                for (int j = 0; j < 4; ++j) { const u32x4 r = rp[64 * j]; ys[tt][j][0] = (f32x4){bflo(r.x), bfhi(r.x), bflo(r.y), bfhi(r.y)}; ys[tt][j][1] = (f32x4){bflo(r.z), bfhi(r.z), bflo(r.w), bfhi(r.w)}; } }
#pragma unroll
            for (int tt = 0; tt < 2; ++tt) { const size_t token = (size_t)(tok0 + 8 * w + 2 * pr + tt); float s = 0.f;
#pragma unroll
                for (int j = 0; j < 4; ++j)
#pragma unroll
                    for (int h = 0; h < 2; ++h) s += (ys[tt][j][h][0] + ys[tt][j][h][1]) + (ys[tt][j][h][2] + ys[tt][j][h][3]);
                const float mean = wave_sum(s) * (1.0f / D_MODEL); float s2 = 0.f;
#pragma unroll
                for (int j = 0; j < 4; ++j)
#pragma unroll
                    for (int h = 0; h < 2; ++h) { ys[tt][j][h] = ys[tt][j][h] - mean; s2 += (ys[tt][j][h][0] * ys[tt][j][h][0] + ys[tt][j][h][1] * ys[tt][j][h][1]) + (ys[tt][j][h][2] * ys[tt][j][h][2] + ys[tt][j][h][3] * ys[tt][j][h][3]); }
                const float rstd = rsqrtf(wave_sum(s2) * (1.0f / D_MODEL) + LN_EPS);
#pragma unroll
                for (int j = 0; j < 4; ++j) { const int c = 8 * lane + 512 * j;
                    const f32x4 y0 = ys[tt][j][0] * rstd * *(const GAS f32x4*)(g1 + c) + *(const GAS f32x4*)(b1 + c), y1 = ys[tt][j][1] * rstd * *(const GAS f32x4*)(g1 + c + 4) + *(const GAS f32x4*)(b1 + c + 4);
                    u32x4 o; o.x = cvt_pk_bf16(y0[0], y0[1]); o.y = cvt_pk_bf16(y0[2], y0[3]); o.z = cvt_pk_bf16(y1[0], y1[1]); o.w = cvt_pk_bf16(y1[2], y1[3]);
                    *(GAS u32x4*)(X1B + token * D_MODEL + c) = o;
                    if constexpr (X8) { u32x2 w8; int q8 = __builtin_amdgcn_cvt_pk_fp8_f32(y0[0], y0[1], 0, false); q8 = __builtin_amdgcn_cvt_pk_fp8_f32(y0[2], y0[3], q8, true); w8.x = (unsigned)q8;
                        q8 = __builtin_amdgcn_cvt_pk_fp8_f32(y1[0], y1[1], 0, false); q8 = __builtin_amdgcn_cvt_pk_fp8_f32(y1[2], y1[3], q8, true); w8.y = (unsigned)q8;
                        *(GAS u32x2*)(X1B8 + token * D_MODEL + c) = w8; } }
            }
        }
        VM_WAIT(); __syncthreads();
        f32x4 dacc[4];
#pragma unroll
        for (int nb = 0; nb < 4; ++nb) dacc[nb] = (f32x4){0.f, 0.f, 0.f, 0.f};
        const int tt4 = w & 3, kh = w >> 2;
        u32x4 xr[4];
#pragma unroll
        for (int j = 0; j < 4; ++j) { const int idx = tid + 512 * j, row = idx >> 5, c8 = idx & 31; xr[j] = *(const GAS u32x4*)(X1B + (size_t)(tok0 + row) * D_MODEL + 8 * c8); }
#pragma unroll 1
        for (int ke = 0; ke < 8; ++ke) { const int k1 = 256 * (ke + 1);
#pragma unroll
            for (int j = 0; j < 4; ++j) { const int idx = tid + 512 * j, row = idx >> 5, c8 = idx & 31; *(LAS u32x4*)(XSb + row * XROW + c8 * 16) = xr[j]; }
#pragma unroll
            for (int j = 0; j < 8; ++j) { const int idx = tid + 512 * j, row = idx >> 4, c4 = idx & 15; const f32x4 v = *(const GAS f32x4*)(wrt + (size_t)(k1 - 256 + row) * N_EXPERTS + 4 * c4);
                u32x2 o; o.x = cvt_pk_bf16(v[0], v[1]); o.y = cvt_pk_bf16(v[2], v[3]); *(LAS u32x2*)(WSb + row * WROW + c4 * 8) = o; }
            LDS_BARRIER();
            if (ke < 7) {
#pragma unroll
                for (int j = 0; j < 4; ++j) { const int idx = tid + 512 * j, row = idx >> 5, c8 = idx & 31; xr[j] = *(const GAS u32x4*)(X1B + (size_t)(tok0 + row) * D_MODEL + k1 + 8 * c8); }
            }
            { const unsigned wsb = (unsigned)(size_t)WSb; const int q = i >> 2, p4 = i & 3;
#pragma unroll
              for (int ks = 0; ks < 4; ++ks) { const int kk0 = 128 * kh + 32 * ks;
                const bf16x8 a = *(const LAS bf16x8*)(XSb + (tt4 * 16 + i) * XROW + (kk0 + 8 * g) * 2);
                s16x4 lo4[4], hi4[4];
                tr_read4x2<32>(lo4, hi4, wsb + (kk0 + 8 * g + q) * WROW + 8 * p4, wsb + (kk0 + 8 * g + 4 + q) * WROW + 8 * p4);
#pragma unroll
                for (int nb = 0; nb < 4; ++nb) dacc[nb] = mfma16(a, TRCAT(lo4[nb], hi4[nb]), dacc[nb]); } }
            LDS_BARRIER();
        }
#pragma unroll
        for (int nb = 0; nb < 4; ++nb)
#pragma unroll
            for (int rg = 0; rg < 4; ++rg) PART[(kh * 64 + tt4 * 16 + 4 * g + rg) * 64 + 16 * nb + i] = dacc[nb][rg];
        __syncthreads();
        { const f32x4 a0 = *(const LAS f32x4*)(PART + tid * 8), a1 = *(const LAS f32x4*)(PART + tid * 8 + 4), c0 = *(const LAS f32x4*)(PART + 4096 + tid * 8), c1 = *(const LAS f32x4*)(PART + 4096 + tid * 8 + 4);
          __syncthreads();
          *(LAS f32x4*)(LG + tid * 8) = a0 + c0; *(LAS f32x4*)(LG + tid * 8 + 4) = a1 + c1; }
        if (tid < 64) { RM[(size_t)N_EXPERTS * T + tok0 + tid] = tok0 + tid; LCNT[tid] = 0; }
        __syncthreads();
#pragma unroll 1
        for (int tt = 0; tt < 8; ++tt) { const int tk = 8 * w + tt, token = tok0 + tk, e = lane;
            const float sc = 1.0f / (1.0f + expf(-LG[tk * 64 + e])); const float sel = sc + rbias[e];
            const float m1 = max8_dpp(sel);
            const unsigned long long bal = __ballot(sel == m1) & (0xFFull << (8 * (e >> 3)));
            const int first = __builtin_ctzll(bal);
            const float v2 = max8_dpp((e == first) ? -INFINITY : sel);
            const float gs = m1 + v2; int grank = 0;
#pragma unroll
            for (int gp = 0; gp < 8; ++gp) { const float o = __builtin_bit_cast(float, __builtin_amdgcn_readlane(__builtin_bit_cast(int, gs), 8 * gp)); grank += (o > gs || (o == gs && gp < (e >> 3))) ? 1 : 0; }
            const bool gsel = grank < TOPK_GROUPS; const float sel2 = gsel ? sel : -INFINITY; int rank = 0;
            const unsigned long long gbal = __ballot(gsel);
#pragma unroll 1
            for (int gp = 0; gp < 8; ++gp) { if (((gbal >> (8 * gp)) & 1ull) == 0ull) continue;
#pragma unroll
                for (int q = 0; q < 8; ++q) { const int ep = 8 * gp + q; const float o = __builtin_bit_cast(float, __builtin_amdgcn_readlane(__builtin_bit_cast(int, sel2), ep)); rank += (o > sel2 || (o == sel2 && ep < e)) ? 1 : 0; } }
            const bool chosen = gsel && rank < TOP_K;
            float wsum = 0.f; { unsigned long long cb = __ballot(chosen);
                while (cb) { const int l = __builtin_ctzll(cb); wsum += __builtin_bit_cast(float, __builtin_amdgcn_readlane(__builtin_bit_cast(int, sc), l)); cb &= cb - 1ull; } }
            if (chosen) { const int lpos = __hip_atomic_fetch_add(LCNT + e, 1, __ATOMIC_RELAXED, __HIP_MEMORY_SCOPE_WORKGROUP);
                PEL[tk * 8 + rank] = e; PLL[tk * 8 + rank] = lpos;
                PE[(size_t)token * 8 + rank] = e; PG[(size_t)token * 8 + rank] = sc / wsum * ROUTED_SCALE; }
        }
        __syncthreads();
        if (tid < 64) BASE[tid] = (int)__hip_atomic_fetch_add(cnt + tid, (unsigned)LCNT[tid], __ATOMIC_RELAXED, __HIP_MEMORY_SCOPE_AGENT);
        __syncthreads();
        { const int e = PEL[tid], pos = BASE[e] + PLL[tid], token = tok0 + (tid >> 3);
          PP[(size_t)token * 8 + (tid & 7)] = pos; RM[(size_t)e * T + pos] = token; }
        __syncthreads();
    }
}

__device__ __forceinline__ void build_toff(Frame& F, int layer) {
    LAS int* toff = (LAS int*)(F.lds + LDS_TAB);
    if (threadIdx.x < 64) {
        const GAS unsigned* cnt = F.ctl + CW_CNT + layer * 64; const int e = (int)threadIdx.x;
        const int tiles = ((int)__hip_atomic_load(cnt + e, RLX_AGENT) + 255) >> 8; int incl = tiles;
#pragma unroll
        for (int o = 1; o < 64; o <<= 1) { const int up = __shfl_up(incl, o); if (e >= o) incl += up; }
        toff[e] = incl - tiles;
        if (e == 63) { toff[N_EXPERTS] = incl; toff[NEXP1] = incl + T / 256; } }
    __syncthreads();
}

template <bool Y8, bool LAST>
__device__ __forceinline__ void combine_ln2_phase(Frame& F, int layer) {
    PHASE_ARGS(); GAS float* OUT = (GAS float*)(GAS float*)ap->out;
    const GAS bf16_t* Y = (const GAS bf16_t*)(F.ws + WS_Y); const GAS bf16_t* X1B = (const GAS bf16_t*)(F.ws + WS_X1B); GAS bf16_t* XB = (GAS bf16_t*)(F.ws + WS_XB); GAS unsigned char* XB8 = F.ws + WS_XB8;
    const GAS float* g2 = GIN(18) + (size_t)layer * D_MODEL; const GAS float* b2 = GIN(19) + (size_t)layer * D_MODEL;
    const GAS int* PE = (const GAS int*)(F.ws + WS_PE); const GAS int* PP = (const GAS int*)(F.ws + WS_PP); const GAS float* PG = (const GAS float*)(F.ws + WS_PG);
    const LAS int* toff = (const LAS int*)(F.lds + LDS_TAB);
    PHASE_IDS();
    const int gw = F.bid * 8 + w, NGW = F.G * 8;
    for (int tb = gw; tb < T; tb += 8 * NGW) {
        int myrow = 0; float mygate = 0.f;
        { const int tl = tb + (lane >> 3) * NGW; if (tl < T) { const int e = PE[(size_t)tl * 8 + (lane & 7)]; myrow = toff[e] * 256 + PP[(size_t)tl * 8 + (lane & 7)]; mygate = PG[(size_t)tl * 8 + (lane & 7)]; } }
#pragma unroll 1
      for (int tj = 0; tj < 8; ++tj) { const int t = tb + tj * NGW; if (t >= T) break;
        f32x4 a[4][2];
#pragma unroll
        for (int j = 0; j < 4; ++j) { a[j][0] = (f32x4){0.f, 0.f, 0.f, 0.f}; a[j][1] = (f32x4){0.f, 0.f, 0.f, 0.f}; }
#pragma unroll
        for (int k = 0; k < 9; ++k) { size_t row; float gt;
            if (k < 8) { row = (size_t)__shfl(myrow, tj * 8 + k); gt = __shfl(mygate, tj * 8 + k); }
            else { row = (size_t)toff[N_EXPERTS] * 256 + t; gt = 1.0f; }
            if constexpr (Y8) {
                const GAS u32x2* yp = (const GAS u32x2*)((const GAS unsigned char*)Y + row * D_MODEL) + lane;
#pragma unroll
                for (int j = 0; j < 4; ++j) { const u32x2 y = yp[64 * j];
                    const f32x2 p0 = __builtin_amdgcn_cvt_pk_f32_fp8((int)y.x, false), p1 = __builtin_amdgcn_cvt_pk_f32_fp8((int)y.x, true), p2 = __builtin_amdgcn_cvt_pk_f32_fp8((int)y.y, false), p3 = __builtin_amdgcn_cvt_pk_f32_fp8((int)y.y, true);
                    a[j][0] += (f32x4){p0[0], p0[1], p1[0], p1[1]} * gt; a[j][1] += (f32x4){p2[0], p2[1], p3[0], p3[1]} * gt; }
            } else {
            const GAS u32x4* yp = (const GAS u32x4*)(Y + row * D_MODEL) + lane;
#pragma unroll
            for (int j = 0; j < 4; ++j) { const u32x4 y = yp[64 * j];
                a[j][0] += (f32x4){bflo(y.x), bfhi(y.x), bflo(y.y), bfhi(y.y)} * gt; a[j][1] += (f32x4){bflo(y.z), bfhi(y.z), bflo(y.w), bfhi(y.w)} * gt; } } }
        float s = 0.f;
#pragma unroll
        for (int j = 0; j < 4; ++j) { const u32x4 xv = *(const GAS u32x4*)(X1B + (size_t)t * D_MODEL + 8 * lane + 512 * j);
            a[j][0] += (f32x4){bflo(xv.x), bfhi(xv.x), bflo(xv.y), bfhi(xv.y)} * DN_ALPHA; a[j][1] += (f32x4){bflo(xv.z), bfhi(xv.z), bflo(xv.w), bfhi(xv.w)} * DN_ALPHA;
            s += (a[j][0][0] + a[j][0][1]) + (a[j][0][2] + a[j][0][3]) + (a[j][1][0] + a[j][1][1]) + (a[j][1][2] + a[j][1][3]); }
        const float mean = wave_sum(s) * (1.0f / D_MODEL); float s2 = 0.f;
#pragma unroll
        for (int j = 0; j < 4; ++j) { a[j][0] = a[j][0] - mean; a[j][1] = a[j][1] - mean;
            s2 += (a[j][0][0] * a[j][0][0] + a[j][0][1] * a[j][0][1]) + (a[j][0][2] * a[j][0][2] + a[j][0][3] * a[j][0][3]) + (a[j][1][0] * a[j][1][0] + a[j][1][1] * a[j][1][1]) + (a[j][1][2] * a[j][1][2] + a[j][1][3] * a[j][1][3]); }
        const float rstd = rsqrtf(wave_sum(s2) * (1.0f / D_MODEL) + LN_EPS);
#pragma unroll
        for (int j = 0; j < 4; ++j) { const int c = 8 * lane + 512 * j;
            const f32x4 o0 = a[j][0] * rstd * *(const GAS f32x4*)(g2 + c) + *(const GAS f32x4*)(b2 + c), o1 = a[j][1] * rstd * *(const GAS f32x4*)(g2 + c + 4) + *(const GAS f32x4*)(b2 + c + 4);
            if constexpr (LAST) { *(GAS f32x4*)(OUT + (size_t)t * D_MODEL + c) = o0; *(GAS f32x4*)(OUT + (size_t)t * D_MODEL + c + 4) = o1; }
            else {
            u32x4 wv; wv.x = cvt_pk_bf16(o0[0], o0[1]); wv.y = cvt_pk_bf16(o0[2], o0[3]); wv.z = cvt_pk_bf16(o1[0], o1[1]); wv.w = cvt_pk_bf16(o1[2], o1[3]);
            *(GAS u32x4*)(XB + (size_t)t * D_MODEL + c) = wv;
            u32x2 w8; { int q = __builtin_amdgcn_cvt_pk_fp8_f32(o0[0], o0[1], 0, false); q = __builtin_amdgcn_cvt_pk_fp8_f32(o0[2], o0[3], q, true); w8.x = (unsigned)q;
                        q = __builtin_amdgcn_cvt_pk_fp8_f32(o1[0], o1[1], 0, false); q = __builtin_amdgcn_cvt_pk_fp8_f32(o1[2], o1[3], q, true); w8.y = (unsigned)q; }
            *(GAS u32x2*)(XB8 + (size_t)t * D_MODEL + c) = w8; } }
      }
    }
}

constexpr int PH_PER_LAYER = 11, N_PHASES = DEPTH * PH_PER_LAYER;
constexpr int CONV_TAIL = 1024;
constexpr bool GU8_ALL = true;
#ifndef PH_MASK
#define PH_MASK 0x7ff
#endif
#define IN(k) (((PH_MASK >> ((k) % PH_PER_LAYER)) & 1) && lo <= (k) && (k) < hi)
#ifndef PROBE_MASK
#define PROBE_MASK 0
#endif
#ifndef PROBE_AMP
#define PROBE_AMP 4
#endif
constexpr int LDS_STAMP = LDS_TAB + 1024;
#define SEAM(k) do { if (IN(k) && IN((k) + 1)) xcd_barrier(bar); \
    if (PROBE_MASK != 0 && threadIdx.x == 0) ((LAS unsigned long long*)(F0.lds + LDS_STAMP))[(k) + 1] = __builtin_amdgcn_s_memrealtime(); } while (0)
#define PHASE_FRAME() Frame F = F0; asm volatile("" : "+s"(F.ws), "+s"(F.ctl), "+s"(F.G), "+s"(F.bid), "+s"(F.lds)); \
    F.ws = (GAS unsigned char*)(GAS unsigned char*)F.ws; F.ctl = (GAS unsigned*)(GAS unsigned*)F.ctl;     \
    GAS unsigned char* ws = F.ws; (void)ws
template <int layer>
__device__ __forceinline__ void run_layer(const Frame& F0, const XcdBarrier& bar, const int lo, const int hi) {
        const int pb = layer * PH_PER_LAYER;
        constexpr bool GU8 = (layer == DEPTH - 1) || GU8_ALL;
        constexpr bool MOE8 = (layer == DEPTH - 1);
        if constexpr (layer == 0) { if (IN(pb + 0)) { PHASE_FRAME(); p0_convert(F, layer, GU8, MOE8, 1); } }
        SEAM(pb + 0);
        if (IN(pb + 1)) { PHASE_FRAME();
            EpiIn E{(GAS bf16_t*)(ws + WS_H), (GAS _Float16*)(ws + WS_LF), (const GAS float*)(ws + WS_LB) + layer * HG_WIDTH, (const GAS f32x4*)(ws + WS_ROPE)};
            DenseSched Sa{(const GAS char*)(ws + WS_XB), (const GAS char*)(ws + WS_WINF) - (size_t)C_HF * (D_MODEL * 2), D_MODEL * 2, D_MODEL * 2, D_MODEL / 64, T / 256, HG_WIDTH / 256, F.G, F.bid, 0, C_HF / 256};
            pg8::gemm_phase<EpiIn, DenseSched, false, false, true>(F.lds, Sa, E);
            DenseSched Sb{(const GAS char*)(ws + WS_XB8), (const GAS char*)(ws + WS_WIN), D_MODEL, D_MODEL, D_MODEL / 128, T / 256, (IN_WIDTH - HG_WIDTH) / 256, F.G, F.bid, C_HF / 256, HG_WIDTH / 256};
            if constexpr (layer == 0) {
                const long ntile = (long)Sb.nM * Sb.nN; const int nun = (int)((ntile - F.bid + F.G - 1) / F.G);
                const int ks = __builtin_amdgcn_readfirstlane(((F.bid & 7) * (nun + 1)) >> 3);
#pragma unroll 1
                for (int part = 0; part < 2; ++part) {
                    pg8::RangeSched<DenseSched> RS{Sb, part == 0 ? 0 : ks, part == 0 ? ks : (1 << 30)};
                    pg8::gemm_phase<EpiIn, pg8::RangeSched<DenseSched>, false, true, true>(F.lds, RS, E);
                    if (part == 0) p0_convert(F, layer, GU8, MOE8, 2, CONV_TAIL);
                }
                p0_convert(F, layer, GU8, MOE8, 2, CONV_TAIL, F.ctl + CW_CQ);
            } else pg8::gemm_phase<EpiIn, DenseSched, false, true, true>(F.lds, Sb, E);
        }
        SEAM(pb + 1);
        if (IN(pb + 2)) { PHASE_FRAME();
            { PHASE_IDS(); H1Regs ra, rb; int it = F.bid;
              if (it < NCHUNK * HG_HEADS) h1_load(F, it, tid, ra);
              for (; it < NCHUNK * HG_HEADS; it += F.G) { const int itn = it + F.G; if (itn < NCHUNK * HG_HEADS) h1_load(F, itn, tid, rb); h1_item(F, it, tid, ra); ra = rb; } }
            { constexpr int NAI = BATCH * ATT_HEADS * 16; const int nb = F.G >> 3, x = F.bid & 7, lb = F.bid >> 3;
              if ((F.G & 7) == 0 && NAI % 8 == 0) { for (int k = lb; k < NAI / 8; k += nb) { const int hh = k >> 4, jj = ((k & 15) + hh) & 15;
                  attn_item(F, x * (NAI / 8) + hh * 16 + jj); } }
              else { for (int it = F.bid; it < NAI; it += F.G) attn_item(F, it); } }
        }
        SEAM(pb + 2);
        if (IN(pb + 3)) { PHASE_FRAME();
            for (int it = F.bid; it < BATCH * HG_HEADS * 4; it += F.G) scan_item(F, it);
            attn_merge(F);
        }
        SEAM(pb + 3);
        if (IN(pb + 4)) { PHASE_FRAME();
            PHASE_ARGS(); const GAS float* normg = GIN(4) + (size_t)layer * HG_WIDTH;
            { PHASE_IDS(); H3Regs ra, rb; int it = F.bid;
              if (it < NCHUNK * HG_HEADS) h3_load(F, it, tid, ra);
              for (; it < NCHUNK * HG_HEADS; it += F.G) { const int itn = it + F.G; if (itn < NCHUNK * HG_HEADS) h3_load(F, itn, tid, rb); h3_item(F, it, normg, tid, ra); ra = rb; } }
        }
        SEAM(pb + 4);
        if (IN(pb + 5)) { PHASE_FRAME();
            MergeSched S{(const GAS char*)(ws + WS_HGO), (const GAS char*)(ws + WS_WHG), (const GAS char*)(ws + WS_ATTO), (const GAS char*)(ws + WS_WATT), T / 256, D_MODEL / 256, F.G, F.bid};
            EpiMerge E{(const GAS bf16_t*)(ws + WS_H), (GAS bf16_t*)(ws + WS_MRG)};
            pg8::gemm_phase<EpiMerge, MergeSched, false>(F.lds, S, E);
        }
        SEAM(pb + 5);
        if (IN(pb + 6)) { PHASE_FRAME();
            DenseSched S{(const GAS char*)(ws + WS_MRG), (const GAS char*)(ws + WS_WOUT), D_MODEL, D_MODEL, D_MODEL / 128, T / 256, D_MODEL / 256, F.G, F.bid, 1 << 30, 0};
            PHASE_ARGS(); EpiResid E{(const GAS bf16_t*)(ws + WS_XB), (GAS bf16_t*)(ws + WS_R)};
            pg8::gemm_phase<EpiResid, DenseSched, false, true, true>(F.lds, S, E);
        }
        SEAM(pb + 6);
        if (IN(pb + 7)) { PHASE_FRAME(); ln_router_phase<GU8>(F, layer); }
        SEAM(pb + 7);
        if (IN(pb + 8)) { PHASE_FRAME();
            build_toff(F, layer);
            {
                typedef MoeSched<4, true, GU8 ? 1 : 2> SchedT;
                SchedT S{(const LAS int*)(F.lds + LDS_TAB), F.ctl + CW_CNT + layer * 64, (const GAS char*)(ws + (GU8 ? WS_X1B8 : WS_X1B)), (const GAS char*)(ws + (MOE8 ? WS_WGU8 : WS_WGU)), (const GAS int*)(ws + WS_RM), F.G, F.bid, (const LAS int*)(F.lds + LDS_EPI), (const LAS int*)(F.lds + LDS_TAB + 512)}; S.build_units((LAS int*)(F.lds + LDS_TAB + 512));
                EpiGateUp<true> E{(GAS bf16_t*)(ws + WS_HID)};
                if constexpr (layer + 1 < DEPTH) {
                    int nun = 0; { const LAS int* ut = (const LAS int*)(F.lds + LDS_TAB + 512); for (int i = 0; i < 32; ++i) nun += ut[i * 4 + 3]; }
                    const int ks = __builtin_amdgcn_readfirstlane(((F.bid & 7) * (nun + 1)) >> 3);
#pragma unroll 1
                    for (int part = 0; part < 2; ++part) {
                        pg8::RangeSched<SchedT> RS{S, part == 0 ? 0 : ks, part == 0 ? ks : (1 << 30)};
                        pg8::gemm_phase<EpiGateUp<true>, pg8::RangeSched<SchedT>, true, GU8>(F.lds, RS, E);
                        if (part == 0) p0_convert(F, layer + 1, (layer + 1 == DEPTH - 1) || GU8_ALL, layer + 1 == DEPTH - 1, 0, CONV_TAIL);
                    }
                    p0_convert(F, layer + 1, (layer + 1 == DEPTH - 1) || GU8_ALL, layer + 1 == DEPTH - 1, 0, CONV_TAIL, F.ctl + CW_CQ + 64);
                } else pg8::gemm_phase<EpiGateUp<true>, SchedT, true, GU8>(F.lds, S, E);
            }
        }
        SEAM(pb + 8);
        if (IN(pb + 9)) { PHASE_FRAME();
            build_toff(F, layer);
            {
                EpiDown<true> E{(GAS bf16_t*)(ws + WS_Y)};
                MoeSched<8, false, 1> S{(const LAS int*)(F.lds + LDS_TAB), F.ctl + CW_CNT + layer * 64, (const GAS char*)(ws + WS_HID), (const GAS char*)(ws + (MOE8 ? WS_WDN8 : WS_WDN)), nullptr, F.G, F.bid, nullptr, (const LAS int*)(F.lds + LDS_TAB + 512)}; S.build_units((LAS int*)(F.lds + LDS_TAB + 512));
                pg8::gemm_phase<EpiDown<true>, MoeSched<8, false, 1>, false, true, true>(F.lds, S, E);
            }
        }
        SEAM(pb + 9);
        if (IN(pb + 10)) { PHASE_FRAME(); build_toff(F, layer); combine_ln2_phase<true, layer == DEPTH - 1>(F, layer); }
        if constexpr (layer == DEPTH - 1) { SEAM(pb + 10); } else { if (PROBE_MASK != 0 && threadIdx.x == 0) ((LAS unsigned long long*)(F0.lds + LDS_STAMP))[pb + 11] = __builtin_amdgcn_s_memrealtime(); }
}
#undef IN
#undef SEAM
__global__ void __launch_bounds__(512, 2) kfwd(Args args) {
    extern __shared__ __attribute__((aligned(16))) unsigned char lds_raw[];
    Frame F0;
    F0.lds = (LAS unsigned char*)lds_raw;
    F0.G = gridDim.x; F0.bid = blockIdx.x; F0.ws = (GAS unsigned char*)args.ws; F0.ctl = (GAS unsigned*)(args.ws + WS_CTL);
    for (int u = threadIdx.x; u < (LDS_BYTES - LDS_TAB) / 4; u += 512) ((LAS unsigned*)(F0.lds + LDS_TAB))[u] = 0u;
    __syncthreads();
    XcdBarrier bar = xcd_barrier_post((unsigned*)(F0.ctl + CW_BAR), (volatile LAS unsigned*)(F0.lds + LDS_MISC));
    const int lo = args.ph_lo, hi = args.ph_hi;
    if (PROBE_MASK != 0 && threadIdx.x == 0) ((LAS unsigned long long*)(F0.lds + LDS_STAMP))[0] = __builtin_amdgcn_s_memrealtime();
    run_layer<0>(F0, bar, lo, hi);
    run_layer<1>(F0, bar, lo, hi);
    if (PROBE_MASK != 0 && blockIdx.x == 0 && threadIdx.x == 0) {
        const LAS unsigned long long* ts = (const LAS unsigned long long*)(F0.lds + LDS_STAMP); unsigned long long tot = 0;
        for (int k = 0; k < N_PHASES; ++k) if ((PROBE_MASK >> (k % PH_PER_LAYER)) & 1) tot += ts[k + 1] - ts[k];
        const unsigned long long t0 = __builtin_amdgcn_s_memrealtime(), lim = tot * PROBE_AMP < 4000000ull ? tot * PROBE_AMP : 4000000ull;
        while (__builtin_amdgcn_s_memrealtime() - t0 < lim) __builtin_amdgcn_s_sleep(32);
    }
}

extern "C" void kernel_launch(void* const* d_in, const int* in_sizes, int n_in, void* d_out, int out_size, void* d_ws, size_t ws_size, hipStream_t stream) {
    static int grid = 0;
    if (grid == 0) {
        if (n_in != 20 || out_size != T * D_MODEL || ws_size < WS_END) { fprintf(stderr, "kernel_launch: unexpected shapes (n_in %d, out %d, ws %zu < %zu)\n", n_in, out_size, ws_size, (size_t)WS_END); grid = -1; return; }
        int dev = 0, cus = 0, per_cu = 0;
        if (hipGetDevice(&dev) != hipSuccess || hipDeviceGetAttribute(&cus, hipDeviceAttributeMultiprocessorCount, dev) != hipSuccess) { grid = -1; return; }
        if (hipFuncSetAttribute((const void*)kfwd, hipFuncAttributeMaxDynamicSharedMemorySize, LDS_BYTES) != hipSuccess) { fprintf(stderr, "kernel_launch: hipFuncSetAttribute failed\n"); grid = -1; return; }
        if (hipOccupancyMaxActiveBlocksPerMultiprocessor(&per_cu, (const void*)kfwd, 512, LDS_BYTES) != hipSuccess || per_cu < 1) fprintf(stderr, "kernel_launch: occupancy query says %d\n", per_cu);
        (void)hipGetLastError();
        grid = cus;
    }
    if (grid < 0) return;
    if (hipMemsetAsync((char*)d_ws + WS_CTL, 0, CTL_ZERO_BYTES, stream) != hipSuccess) return;
    Args a{};
    for (int i = 0; i < 20; ++i) a.in[i] = (const float*)d_in[i];
    a.out = (float*)d_out; a.ws = (unsigned char*)d_ws;
#if MK_LAUNCH_PER_PHASE
    for (int p = 0; p < N_PHASES; ++p) { a.ph_lo = p; a.ph_hi = p + 1; hipLaunchKernelGGL(kfwd, dim3(grid), dim3(512), LDS_BYTES, stream, a); }
#else
    a.ph_lo = 0; a.ph_hi = N_PHASES; hipLaunchKernelGGL(kfwd, dim3(grid), dim3(512), LDS_BYTES, stream, a);
#endif
}
```

```cpp
#include <hip/hip_runtime.h>
#include <cstdio>
#include <cstdint>

#ifndef MK_LAUNCH_PER_PHASE
#define MK_LAUNCH_PER_PHASE 0
#endif

#define GAS __attribute__((address_space(1)))
#define LAS __attribute__((address_space(3)))
typedef unsigned short bf16_t;
typedef short bf16x8 __attribute__((ext_vector_type(8)));
typedef short s16x4 __attribute__((ext_vector_type(4)));
typedef float f32x4 __attribute__((ext_vector_type(4)));
typedef float f32x2 __attribute__((ext_vector_type(2)));
typedef unsigned u32x4 __attribute__((ext_vector_type(4)));
typedef unsigned u32x2 __attribute__((ext_vector_type(2)));
typedef _Float16 f16x8 __attribute__((ext_vector_type(8)));

constexpr int D_MODEL = 2048, BATCH = 8, SEQ = 2048, DEPTH = 2, T = BATCH * SEQ;
constexpr int HG_HEADS = 8, HG_DIM = 128, HG_WIDTH = 1024, HG_CHUNK = 64, NCHUNK = T / HG_CHUNK;
constexpr int ATT_HEADS = 12, ATT_DIM = 128, ATT_WIDTH = 1536, ATT_OUT = 512;
constexpr int N_EXPERTS = 64, N_GROUPS = 8, TOPK_GROUPS = 4, TOP_K = 8, EXPERT_FF = 512;
constexpr int IN_WIDTH = 12800;
constexpr int C_HQ = 0, C_HF = 1024, C_HI = 2048, C_HGATE = 3072, C_AQ = 4096, C_AK = 5632, C_AV = 7168, C_GH = 8704, C_GA = 10752;
constexpr float ROUTED_SCALE = 2.5f, LN_EPS = 1e-5f, NORM_EPS = 1e-6f;
constexpr float DN_ALPHA = 1.41421356237309515f;
#define HOFF(c, row) (((size_t)((c) >> 7) * T + (size_t)(row)) * 128 + ((c) & 127))
constexpr int NEXP1 = N_EXPERTS + 1;
constexpr int MAXROWS = 163840;

constexpr size_t MiB = 1u << 20;
constexpr size_t WS_CTL = 0, CTL_ZERO_BYTES = 1 * MiB;
constexpr size_t WS_WIN = 4 * MiB;
constexpr size_t WS_WHG = 54 * MiB;
constexpr size_t WS_WATT = 58 * MiB;
constexpr size_t WS_WOUT = 60 * MiB;
constexpr size_t WS_WGU = 68 * MiB;
constexpr size_t WS_WDN = 328 * MiB;
constexpr size_t WS_ROPE = 458 * MiB;
constexpr size_t WS_LB = 466 * MiB;
constexpr size_t WS_R = 467 * MiB;
constexpr size_t WS_X1 = 595 * MiB;
constexpr size_t WS_XB = 723 * MiB;
constexpr size_t WS_X1B = 787 * MiB;
constexpr size_t WS_PE = 851 * MiB;
constexpr size_t WS_PP = 852 * MiB;
constexpr size_t WS_PG = 853 * MiB;
constexpr size_t WS_RM = 854 * MiB;
constexpr size_t WS_HID = 859 * MiB;
constexpr size_t WS_BIG = 1019 * MiB;
constexpr size_t WS_H = WS_BIG;
constexpr size_t WS_LF = WS_BIG + 400 * MiB;
constexpr size_t WS_UT = WS_BIG + 464 * MiB;
constexpr size_t WS_SPT = WS_BIG + 592 * MiB;
constexpr size_t WS_DEC = WS_BIG + 656 * MiB;
constexpr size_t WS_LSE = WS_BIG + 657 * MiB;
constexpr size_t WS_HGO = WS_BIG + 658 * MiB;
constexpr size_t WS_ATTO = WS_BIG + 690 * MiB;
constexpr size_t WS_MRG = WS_BIG + 706 * MiB;
constexpr size_t WS_Y = WS_BIG;
constexpr size_t WS_XB8 = WS_BIG + 772 * MiB;
constexpr size_t WS_WINF = WS_WIN + 30 * MiB;
constexpr size_t WS_X1B8 = WS_BIG + 804 * MiB;
constexpr size_t WS_WGU8 = 531 * MiB;
constexpr size_t WS_WDN8 = WS_BIG + 836 * MiB;
constexpr size_t WS_END = WS_BIG + 901 * MiB;
constexpr int CW_TMO = 0;
constexpr int CW_CNT = 1024;
constexpr int CW_CQ = 2048;
constexpr int CW_BAR = 4096;

constexpr int LDS_BYTES = 159744;
constexpr int LDS_EPI = 131072;
constexpr int LDS_TAB = 147456;
constexpr int LDS_MISC = LDS_TAB + 2048;

#define RLX_AGENT __ATOMIC_RELAXED, __HIP_MEMORY_SCOPE_AGENT
#define LDS_WAIT() asm volatile("s_waitcnt lgkmcnt(0)" ::: "memory")
#define VM_WAIT() asm volatile("s_waitcnt vmcnt(0)" ::: "memory")
#define LDS_BARRIER() asm volatile("s_waitcnt lgkmcnt(0)\n\ts_barrier" ::: "memory")
__device__ __forceinline__ unsigned f2bf(float f) { unsigned u = __builtin_bit_cast(unsigned, f); return (u + 0x7fffu + ((u >> 16) & 1u)) >> 16; }
__device__ __forceinline__ unsigned pk2(float lo, float hi) { return f2bf(lo) | (f2bf(hi) << 16); }
__device__ __forceinline__ float bf2f(unsigned short b) { return __builtin_bit_cast(float, ((unsigned)b) << 16); }
__device__ __forceinline__ float bflo(unsigned w) { return __builtin_bit_cast(float, w << 16); }
__device__ __forceinline__ float bfhi(unsigned w) { return __builtin_bit_cast(float, w & 0xffff0000u); }
__device__ __forceinline__ unsigned cvt_pk_bf16(float lo, float hi) { unsigned r; asm volatile("v_cvt_pk_bf16_f32 %0, %1, %2" : "=v"(r) : "v"(lo), "v"(hi)); return r; }
__device__ __forceinline__ float fdiv(float a, float b) { return a * __builtin_amdgcn_rcpf(b); }
__device__ __forceinline__ float fsigmoid(float x) { return __builtin_amdgcn_rcpf(1.0f + __expf(-x)); }
__device__ __forceinline__ float wave_sum(float v) {
#pragma unroll
    for (int o = 1; o < 64; o <<= 1) v += __shfl_xor(v, o);
    return v;
}
__device__ __forceinline__ float max8_dpp(float v) {
    v = fmaxf(v, __builtin_bit_cast(float, __builtin_amdgcn_update_dpp(0, __builtin_bit_cast(int, v), 0xB1, 0xF, 0xF, false)));
    v = fmaxf(v, __builtin_bit_cast(float, __builtin_amdgcn_update_dpp(0, __builtin_bit_cast(int, v), 0x4E, 0xF, 0xF, false)));
    v = fmaxf(v, __builtin_bit_cast(float, __builtin_amdgcn_update_dpp(0, __builtin_bit_cast(int, v), 0x141, 0xF, 0xF, false)));
    return v;
}
__device__ __forceinline__ f32x4 mfma16(bf16x8 a, bf16x8 b, f32x4 c) { return __builtin_amdgcn_mfma_f32_16x16x32_bf16(a, b, c, 0, 0, 0); }
__device__ __forceinline__ s16x4 tr_read(unsigned lds_addr) { s16x4 r; asm volatile("ds_read_b64_tr_b16 %0, %1\n\ts_waitcnt lgkmcnt(0)" : "=&v"(r) : "v"(lds_addr) : "memory"); return r; }

template <int STRIDE> __device__ __forceinline__ void tr_read8(s16x4 (&r)[8], unsigned a) {
    asm volatile("ds_read_b64_tr_b16 %0, %8\n\tds_read_b64_tr_b16 %1, %8 offset:%9\n\tds_read_b64_tr_b16 %2, %8 offset:%10\n\tds_read_b64_tr_b16 %3, %8 offset:%11\n\t"
                 "ds_read_b64_tr_b16 %4, %8 offset:%12\n\tds_read_b64_tr_b16 %5, %8 offset:%13\n\tds_read_b64_tr_b16 %6, %8 offset:%14\n\tds_read_b64_tr_b16 %7, %8 offset:%15\n\ts_waitcnt lgkmcnt(0)"
                 : "=&v"(r[0]), "=&v"(r[1]), "=&v"(r[2]), "=&v"(r[3]), "=&v"(r[4]), "=&v"(r[5]), "=&v"(r[6]), "=&v"(r[7])
                 : "v"(a), "i"(STRIDE), "i"(2 * STRIDE), "i"(3 * STRIDE), "i"(4 * STRIDE), "i"(5 * STRIDE), "i"(6 * STRIDE), "i"(7 * STRIDE) : "memory");
}
template <int STRIDE> __device__ __forceinline__ void tr_read4x2(s16x4 (&r0)[4], s16x4 (&r1)[4], unsigned a0, unsigned a1) {
    asm volatile("ds_read_b64_tr_b16 %0, %8\n\tds_read_b64_tr_b16 %1, %8 offset:%10\n\tds_read_b64_tr_b16 %2, %8 offset:%11\n\tds_read_b64_tr_b16 %3, %8 offset:%12\n\t"
                 "ds_read_b64_tr_b16 %4, %9\n\tds_read_b64_tr_b16 %5, %9 offset:%10\n\tds_read_b64_tr_b16 %6, %9 offset:%11\n\tds_read_b64_tr_b16 %7, %9 offset:%12\n\ts_waitcnt lgkmcnt(0)"
                 : "=&v"(r0[0]), "=&v"(r0[1]), "=&v"(r0[2]), "=&v"(r0[3]), "=&v"(r1[0]), "=&v"(r1[1]), "=&v"(r1[2]), "=&v"(r1[3])
                 : "v"(a0), "v"(a1), "i"(STRIDE), "i"(2 * STRIDE), "i"(3 * STRIDE) : "memory");
}
#define TRCAT(lo, hi) ((bf16x8){(lo)[0], (lo)[1], (lo)[2], (lo)[3], (hi)[0], (hi)[1], (hi)[2], (hi)[3]})
#define XB_TMO      128
#define XB_XCNT(j)  (256  + 64 * (j))
#define XB_XSUB(j)  (1280 + 64 * (j))
#define XB_XGEN(j)  (2304 + 64 * (j))
#define XB_TOP      3328
#define XB_TOPGEN   3392
#define XCD_BAR_WORDS 3456
#define XB_SPIN_CAP (1u << 18)
__device__ __forceinline__ unsigned xb_ld(unsigned* p)              { return __hip_atomic_load(p, __ATOMIC_RELAXED, __HIP_MEMORY_SCOPE_AGENT); }
__device__ __forceinline__ unsigned xb_add(unsigned* p, unsigned v) { return __hip_atomic_fetch_add(p, v, __ATOMIC_RELAXED, __HIP_MEMORY_SCOPE_AGENT); }
__device__ __forceinline__ unsigned xb_xcc_id() { return (unsigned)__builtin_amdgcn_s_getreg((3 << 11) | 20) & 0xFu; }
#define XB_SPIN(cond, bar) do { unsigned _sp = 0; while (cond) { __builtin_amdgcn_s_sleep(1); \
    if ((++_sp & 255u) == 0u) { if (xb_ld(&(bar)[XB_TMO])) break; if (_sp > XB_SPIN_CAP) { atomicAdd(&(bar)[XB_TMO], 1u); break; } } } } while (0)
struct XcdBarrier { unsigned* bar; unsigned x; volatile LAS unsigned* st; };
__device__ __forceinline__ XcdBarrier xcd_barrier_post(unsigned* bar, volatile LAS unsigned* st) {
    XcdBarrier b; b.bar = bar; b.x = xb_xcc_id(); b.st = st;
    if (threadIdx.x == 0) (void)xb_add(&bar[XB_XCNT(b.x)], 1u);
    return b;
}
__device__ __forceinline__ void xcd_barrier_complete(unsigned* bar, unsigned x, unsigned& nloc, unsigned& nx) {
    const unsigned G = gridDim.x * gridDim.y * gridDim.z;
    unsigned sum, cnt, mine, sp = 0u;
    for (;;) {
        sum = 0u; cnt = 0u; mine = 0u;
#pragma unroll
        for (unsigned j = 0; j < 16; ++j) { const unsigned c = xb_ld(&bar[XB_XCNT(j)]); sum += c; cnt += (c > 0u) ? 1u : 0u; mine = (j == x) ? c : mine; }
        if (sum == G) break;
        __builtin_amdgcn_s_sleep(1);
        if ((++sp & 255u) == 0u) { if (xb_ld(&bar[XB_TMO])) break; if (sp > XB_SPIN_CAP) { atomicAdd(&bar[XB_TMO], 1u); break; } }
    }
    nloc = mine > 0u ? mine : 1u; nx = cnt > 0u ? cnt : 1u;
}
__device__ __forceinline__ void xcd_barrier(const XcdBarrier& b) {
    asm volatile("s_waitcnt vmcnt(0)" ::: "memory");
    __syncthreads();
    if (threadIdx.x == 0) {
        unsigned* bar = b.bar;
        __builtin_amdgcn_s_waitcnt(0);
        unsigned nloc = b.st[0], nx = b.st[1];
        if (nloc == 0u) { xcd_barrier_complete(bar, b.x, nloc, nx); b.st[0] = nloc; b.st[1] = nx; }
        const unsigned old = xb_add(&bar[XB_XSUB(b.x)], 1u);
        const unsigned gen = old / nloc;
        if (old + 1u == (gen + 1u) * nloc) {
            __builtin_amdgcn_fence(__ATOMIC_RELEASE, "agent");
            asm volatile("s_waitcnt vmcnt(0)" ::: "memory");
            const unsigned og = xb_add(&bar[XB_TOP], 1u);
            const unsigned tg = og / nx;
            if (og + 1u == (tg + 1u) * nx) xb_add(&bar[XB_TOPGEN], 1u);
            else XB_SPIN(xb_ld(&bar[XB_TOPGEN]) == tg, bar);
            __builtin_amdgcn_fence(__ATOMIC_ACQUIRE, "agent");
            xb_add(&bar[XB_XGEN(b.x)], 1u);
            asm volatile("s_waitcnt vmcnt(0)" ::: "memory");
        } else {
            XB_SPIN(xb_ld(&bar[XB_XGEN(b.x)]) == gen, bar);
            __builtin_amdgcn_fence(__ATOMIC_ACQUIRE, "agent");
            asm volatile("s_waitcnt vmcnt(0)" ::: "memory");
        }
    }
    __syncthreads();
}

namespace pg8 {
constexpr int BM = 256, BK = 64, HALF = 128, HTB = HALF * BK * 2, STAGE_BYTES = 8 * HTB, NXCD = 8, WGM = 8;
__host__ __device__ __forceinline__ int lds_byte(int r, int c) { const int st = (r >> 4) * 2 + (c >> 5), rr = r & 15, cc = c & 31, ob = rr * 64 + cc * 2; return st * 1024 + (ob ^ (((ob >> 9) & 1) << 5)); }
__host__ __device__ __forceinline__ void stage_rc(int b, int& R, int& C) { const int st = b / 1024, sb = b % 1024, swz = sb ^ (((sb >> 9) & 1) << 5); R = (st >> 1) * 16 + swz / 64; C = (st & 1) * 32 + (swz % 64) / 2; }
__host__ __device__ __forceinline__ int perm32(int rho) { const int n = rho >> 4, i = rho & 15; return 8 * (i >> 2) + 4 * n + (i & 3); }

struct Unit {
    const GAS char* a; const GAS char* b; int lda, ldb, nt;
    int row0, col0, aux;
    const GAS int* gidx; int gcnt;
    const LAS int* gl;
};

template <class S> struct RangeSched { const S& s; int lo, hi; __device__ __forceinline__ bool next(int i, Unit& u) const { return (lo + i < hi) && s.next(lo + i, u); } };

__device__ __forceinline__ void tile_of(int L, int nM, int nN, int& pm, int& pn) {
    const int nwg = nM * nN; int wgid = L;
    { const int q = nwg / NXCD, r = nwg % NXCD, xcd = wgid % NXCD, off = wgid / NXCD; wgid = (xcd < r ? xcd * (q + 1) : r * (q + 1) + (xcd - r) * q) + off; }
    const int nig = WGM * nN, gid = wgid / nig, fm = gid * WGM, gsz = (nM - fm) < WGM ? (nM - fm) : WGM;
    pm = fm + ((wgid % nig) % gsz); pn = (wgid % nig) / gsz;
}

typedef int i32x8 __attribute__((ext_vector_type(8)));
typedef int i32x4v __attribute__((ext_vector_type(4)));
template <class Epi, class Sched, bool GATHER, bool FP8 = false, bool UNI = false>
__device__ __forceinline__ void gemm_phase(LAS unsigned char* lds, const Sched& S, const Epi& E) {
    int tid = threadIdx.x; asm volatile("" : "+v"(tid));
    const int wid = __builtin_amdgcn_readfirstlane(tid >> 6), lane = tid & 63, wr = wid >> 2, wc = wid & 3, fr = lane & 15, fq = lane >> 4;
    int sR[2], sC2[2], sRb[2];
#pragma unroll
    for (int i = 0; i < 2; ++i) { int R, C; stage_rc(tid * 16 + i * 8192, R, C); sR[i] = R; sC2[i] = C * 2; sRb[i] = Epi::WIDE ? (64 * (R >> 5) + perm32(R & 31)) : (Epi::PERM ? ((R & ~31) + perm32(R & 31)) : R); }
    const unsigned ldsw = (unsigned)wid * 1024u;
    const int aoff = lds_byte(wr * 64 + fr, fq * 8), boff = lds_byte(wc * 32 + fr, fq * 8);
    const int sclw = 0x79, scla = 0x7f;
    const int aoff8[2] = {lds_byte(wr * 64 + fr, fq * 16), lds_byte(wr * 64 + fr, fq * 16 + 8)}, boff8[2] = {lds_byte(wc * 32 + fr, fq * 16), lds_byte(wc * 32 + fr, fq * 16 + 8)};
#define PG8_SA(b, h) (((b) * 2 + (h)) * HTB)
#define PG8_SB(b, h) ((4 + (b) * 2 + (h)) * HTB)
#define PG8_STAGE(bufoff, gbase, voff) do { _Pragma("unroll") for (int _i = 0; _i < 2; ++_i) \
        __builtin_amdgcn_global_load_lds((const GAS unsigned*)((const GAS char*)(gbase) + (voff)[_i]), (LAS unsigned*)(lds + (bufoff) + ldsw + _i * 8192), 16, 0, 0); } while (0)
#define PG8_LDA(dst, b, h) do { _Pragma("unroll") for (int m = 0; m < 4; ++m) { dst[m].lo = *(const LAS i32x4v*)(lds + PG8_SA(b, h) + (FP8 ? aoff8[0] : aoff) + m * 2048); dst[m].hi = *(const LAS i32x4v*)(lds + PG8_SA(b, h) + (FP8 ? aoff8[1] : aoff + 1024) + m * 2048); } } while (0)
#define PG8_LDB(dst, b, h) do { _Pragma("unroll") for (int n = 0; n < 2; ++n) { dst[n].lo = *(const LAS i32x4v*)(lds + PG8_SB(b, h) + (FP8 ? boff8[0] : boff) + n * 2048); dst[n].hi = *(const LAS i32x4v*)(lds + PG8_SB(b, h) + (FP8 ? boff8[1] : boff + 1024) + n * 2048); } } while (0)
#define PG8_BF(x) __builtin_bit_cast(bf16x8, (i32x4v)(x))
#define PG8_MMA(ai, bj, At, Bt) do { __builtin_amdgcn_s_setprio(1); _Pragma("unroll") for (int m = 0; m < 4; ++m) _Pragma("unroll") for (int n = 0; n < 2; ++n) { \
        if constexpr (FP8) { asm volatile("v_mfma_scale_f32_16x16x128_f8f6f4 %0, %1, %2, %0, %3, %4 op_sel_hi:[0,0,0]" : "+v"(acc[ai][bj][m][n]) : "v"(Bt[n]), "v"(At[m]), "v"(sclw), "v"(scla)); } \
        else { acc[ai][bj][m][n] = __builtin_amdgcn_mfma_f32_16x16x32_bf16(PG8_BF(Bt[n].lo), PG8_BF(At[m].lo), acc[ai][bj][m][n], 0, 0, 0); \
               acc[ai][bj][m][n] = __builtin_amdgcn_mfma_f32_16x16x32_bf16(PG8_BF(Bt[n].hi), PG8_BF(At[m].hi), acc[ai][bj][m][n], 0, 0, 0); } } \
        __builtin_amdgcn_s_setprio(0); } while (0)
#define PG8_WAIT_V(n) asm volatile("s_waitcnt vmcnt(" #n ")" ::: "memory")
#define PG8_WAIT_L(n) asm volatile("s_waitcnt lgkmcnt(" #n ")" ::: "memory")
#define PG8_BAR __builtin_amdgcn_s_barrier()
#define PG8_SCHED __builtin_amdgcn_sched_barrier(0)
#define PG8_OFFS(u, ao, bo) do { _Pragma("unroll") for (int _i = 0; _i < 2; ++_i) { (bo)[_i] = (unsigned)(sRb[_i] * (u).ldb + sC2[_i]); \
        _Pragma("unroll") for (int _h = 0; _h < 2; ++_h) { int _r = _h * HALF + sR[_i]; if (GATHER) { _r = (u).gl ? (u).gl[_r] : ((_r < (u).gcnt) ? (u).gidx[_r] : 0); } (ao)[_h][_i] = (unsigned)(_r * (u).lda + sC2[_i]); } } } while (0)
    Unit cur, nxt; int ui = 0;
    if (!S.next(0, cur)) return;
    f32x4 acc[2][2][4][2];
#pragma unroll
    for (int a = 0; a < 2; ++a)
#pragma unroll
        for (int b = 0; b < 2; ++b)
#pragma unroll
            for (int m = 0; m < 4; ++m)
#pragma unroll
                for (int n = 0; n < 2; ++n) acc[a][b][m][n] = (f32x4){0.f, 0.f, 0.f, 0.f};
    i32x8 At[4], B0[2], B1[2];
    unsigned aoc[2][2], boc[2], aon[2][2], bon[2];
    PG8_OFFS(cur, aoc, boc);
    {
        const GAS char* cA = cur.a; const GAS char* cB = cur.b; const size_t hB = (size_t)(Epi::WIDE ? 32 : HALF) * cur.ldb;
        PG8_STAGE(PG8_SB(0, 0), cB, boc); PG8_STAGE(PG8_SB(0, 1), cB + hB, boc); PG8_STAGE(PG8_SA(0, 0), cA, aoc[0]); PG8_STAGE(PG8_SA(0, 1), cA, aoc[1]);
        if (wr == 1) PG8_BAR;
        PG8_WAIT_V(2); PG8_BAR;
        PG8_STAGE(PG8_SB(1, 0), cB + 128, boc); PG8_STAGE(PG8_SA(1, 0), cA + 128, aoc[0]); PG8_STAGE(PG8_SB(1, 1), cB + hB + 128, boc);
        PG8_WAIT_V(6); PG8_BAR;
    }
    for (;;) {
        const bool has_next = S.next(ui + 1, nxt);
        if constexpr (UNI) { if (!has_next) nxt = cur; }
        else { if (has_next) { PG8_OFFS(nxt, aon, bon); }
          else { nxt = cur;
#pragma unroll
            for (int i = 0; i < 2; ++i) { bon[i] = boc[i]; aon[0][i] = aoc[0][i]; aon[1][i] = aoc[1][i]; } } }
        const GAS char* cA = cur.a; const GAS char* cB = cur.b; const GAS char* nA = nxt.a; const GAS char* nB = nxt.b;
        const size_t hBc = (size_t)(Epi::WIDE ? 32 : HALF) * cur.ldb, hBn = (size_t)(Epi::WIDE ? 32 : HALF) * nxt.ldb;
        const int nt = cur.nt;
        for (int t = 0; t < nt; t += 2) {
            const bool last = (t == nt - 2);
            const GAS char* a1 = cA + (size_t)(t + 1) * 128;
            const GAS char* a2 = last ? nA : cA + (size_t)(t + 2) * 128; const GAS char* b2 = last ? nB : cB + (size_t)(t + 2) * 128;
            const GAS char* a3 = a2 + 128; const GAS char* b3 = b2 + 128;
            const size_t hB2 = last ? hBn : hBc;
            unsigned oa0[2], oa1[2], ob[2];
#pragma unroll
            for (int i = 0; i < 2; ++i) { if constexpr (UNI) { oa0[i] = aoc[0][i]; oa1[i] = aoc[1][i]; ob[i] = boc[i]; } else { oa0[i] = last ? aon[0][i] : aoc[0][i]; oa1[i] = last ? aon[1][i] : aoc[1][i]; ob[i] = last ? bon[i] : boc[i]; } }
            PG8_LDB(B0, 0, 0); PG8_LDB(B1, 0, 1); PG8_SCHED; PG8_LDA(At, 0, 0); PG8_STAGE(PG8_SA(1, 1), a1, aoc[1]);
            PG8_WAIT_V(8); PG8_WAIT_L(0); PG8_BAR; PG8_MMA(0, 0, At, B0); PG8_MMA(0, 1, At, B1); PG8_BAR; PG8_SCHED;
            PG8_LDA(At, 0, 1); PG8_STAGE(PG8_SB(0, 0), b2, ob); PG8_STAGE(PG8_SB(0, 1), b2 + hB2, ob); PG8_STAGE(PG8_SA(0, 0), a2, oa0);
            PG8_WAIT_V(8); PG8_WAIT_L(0); PG8_BAR; PG8_MMA(1, 0, At, B0); PG8_MMA(1, 1, At, B1); PG8_BAR; PG8_SCHED;
            PG8_LDB(B0, 1, 0); PG8_LDB(B1, 1, 1); PG8_SCHED; PG8_LDA(At, 1, 0); PG8_STAGE(PG8_SA(0, 1), a2, oa1);
            PG8_WAIT_V(8); PG8_WAIT_L(0); PG8_BAR; PG8_MMA(0, 0, At, B0); PG8_MMA(0, 1, At, B1); PG8_BAR; PG8_SCHED;
            PG8_LDA(At, 1, 1); PG8_STAGE(PG8_SB(1, 0), b3, ob); PG8_STAGE(PG8_SB(1, 1), b3 + hB2, ob); PG8_STAGE(PG8_SA(1, 0), a3, oa0);
            PG8_WAIT_V(8); PG8_WAIT_L(0); PG8_BAR; PG8_MMA(1, 0, At, B0); PG8_MMA(1, 1, At, B1); PG8_BAR; PG8_SCHED;
        }
        if (wr == 0) PG8_BAR;
        const bool keep = E(acc, cur, wr, wc, fr, fq, lds + LDS_EPI + wid * 2048);
        if (!has_next) break;
        if (!keep) {
#pragma unroll
            for (int a = 0; a < 2; ++a)
#pragma unroll
                for (int b = 0; b < 2; ++b)
#pragma unroll
                    for (int m = 0; m < 4; ++m)
#pragma unroll
                        for (int n = 0; n < 2; ++n) acc[a][b][m][n] = (f32x4){0.f, 0.f, 0.f, 0.f};
        }
        cur = nxt;
        if constexpr (!UNI) {
#pragma unroll
            for (int i = 0; i < 2; ++i) { boc[i] = bon[i]; aoc[0][i] = aon[0][i]; aoc[1][i] = aon[1][i]; } }
        ++ui;
        if (wr == 1) PG8_BAR;
    }
    PG8_WAIT_V(0);
    PG8_BAR;
#undef PG8_OFFS
#undef PG8_SA
#undef PG8_SB
#undef PG8_STAGE
#undef PG8_LDA
#undef PG8_LDB
#undef PG8_MMA
#undef PG8_BF
#undef PG8_WAIT_V
#undef PG8_WAIT_L
#undef PG8_BAR
#undef PG8_SCHED
}
}
using pg8::Unit;

struct DenseSched {
    const GAS char* A; const GAS char* Bt; int lda, ldb, nt, nM, nN, G, c;
    int skip_from, skip_n;
    __device__ __forceinline__ bool next(int i, Unit& u) const {
        const long L = (long)i * G + c; if (L >= (long)nM * nN) return false;
        int pm, pn; pg8::tile_of((int)L, nM, nN, pm, pn);
        if (pn >= skip_from) pn += skip_n;
        u.a = A + (size_t)pm * 256 * lda; u.b = Bt + (size_t)pn * 256 * ldb; u.lda = lda; u.ldb = ldb; u.nt = nt;
        u.row0 = pm * 256; u.col0 = pn * 256; u.aux = 0; u.gidx = nullptr; u.gcnt = 256; u.gl = nullptr; return true;
    }
};
struct MergeSched {
    const GAS char* A0; const GAS char* B0; const GAS char* A1; const GAS char* B1; int nM, nN, G, c;
    __device__ __forceinline__ bool next(int i, Unit& u) const {
        const long L = (long)(i >> 1) * G + c; if (L >= (long)nM * nN) return false;
        int pm, pn; pg8::tile_of((int)L, nM, nN, pm, pn);
        const int seg = i & 1;
        const int ld = seg ? ATT_OUT * 2 : HG_WIDTH * 2;
        u.a = (seg ? A1 : A0) + (size_t)pm * 256 * ld; u.b = (seg ? B1 : B0) + (size_t)pn * 256 * ld; u.lda = ld; u.ldb = ld; u.nt = seg ? ATT_OUT / 64 : HG_WIDTH / 64;
        u.row0 = pm * 256; u.col0 = pn * 256; u.aux = seg; u.gidx = nullptr; u.gcnt = 256; u.gl = nullptr; return true;
    }
};
template <int NT, bool UP, int ES = 2>
struct MoeSched {
    const LAS int* toff; const GAS unsigned* cnt;
    const GAS char* A; const GAS char* W; const GAS int* rowmap;
    int G, c;
    const LAS int* gtab;
    const LAS int* utab;
    __device__ __forceinline__ bool decode(int i, int& mtg, int& pn, int& e) const {
        const int total = toff[NEXP1];
        const int nb = G >> 3, x = c & 7, lb = c >> 3;
        const int tpx = (total + 7) >> 3, t0 = x * tpx; int nx = total - t0; nx = nx > tpx ? tpx : nx;
        const int jj = i * nb + lb;
        if (nx <= 0 || lb >= nb || jj >= nx * NT) return false;
        const int nig = 8 * NT, gid = jj / nig, fm = gid * 8, gsz = (nx - fm) < 8 ? (nx - fm) : 8;
        mtg = t0 + fm + ((jj % nig) % gsz); pn = (jj % nig) / gsz;
        int lo = 0, hi = NEXP1;
        while (hi - lo > 1) { const int mid = (lo + hi) >> 1; if (toff[mid] <= mtg) lo = mid; else hi = mid; }
        e = lo; return true;
    }
    __device__ __forceinline__ void build_units(LAS int* tab) const {
        if (threadIdx.x < 32) { int mtg = 0, pn = 0, e = 0; const bool ok = decode((int)threadIdx.x, mtg, pn, e);
            tab[threadIdx.x * 4 + 0] = mtg; tab[threadIdx.x * 4 + 1] = pn; tab[threadIdx.x * 4 + 2] = e; tab[threadIdx.x * 4 + 3] = ok ? 1 : 0; }
        __syncthreads();
        if (UP && gtab != nullptr) {
            LAS int* gt = (LAS int*)gtab;
            for (int i0 = 0; i0 < 16; i0 += 2) { const int i = i0 + (int)(threadIdx.x >> 8), r = (int)threadIdx.x & 255;
                if (tab[i * 4 + 3]) { const int mtg = tab[i * 4 + 0], e = tab[i * 4 + 2], mt = mtg - toff[e];
                    int v; if (e < N_EXPERTS) { const int n = (int)cnt[e] - mt * 256; v = (r < n) ? rowmap[(size_t)e * T + mt * 256 + r] : 0; } else v = mt * 256 + r;
                    gt[i * 256 + r] = v; } }
            __syncthreads(); }
    }
    __device__ __forceinline__ bool next(int i, Unit& u) const {
        int mtg, pn, e;
        if (i < 32) { const int ok = utab[i * 4 + 3]; if (!ok) return false; mtg = utab[i * 4 + 0]; pn = utab[i * 4 + 1]; e = utab[i * 4 + 2]; }
        else if (!decode(i, mtg, pn, e)) return false;
        mtg = __builtin_amdgcn_readfirstlane(mtg); pn = __builtin_amdgcn_readfirstlane(pn); e = __builtin_amdgcn_readfirstlane(e);
        const int mt = mtg - toff[e];
        if (UP) {
            u.a = A; u.lda = D_MODEL * ES; u.nt = D_MODEL * ES / 128;
            u.b = W + ((size_t)e * 1024 + (size_t)pn * 256) * (D_MODEL * ES); u.ldb = D_MODEL * ES;
            if (gtab != nullptr && i < 16) { u.gl = gtab + i * 256; u.gidx = nullptr; u.gcnt = 256; }
            else { u.gl = nullptr;
                if (e < N_EXPERTS) { u.gidx = rowmap + (size_t)e * T + mt * 256; const int n = (int)cnt[e] - mt * 256; u.gcnt = n < 256 ? n : 256; }
                else { u.gidx = rowmap + (size_t)N_EXPERTS * T + mt * 256; u.gcnt = 256; } }
            u.col0 = pn * 128;
        } else {
            u.a = A + (size_t)mtg * 256 * (EXPERT_FF * ES); u.lda = EXPERT_FF * ES; u.nt = EXPERT_FF * ES / 128;
            u.b = W + ((size_t)e * D_MODEL + (size_t)pn * 256) * (EXPERT_FF * ES); u.ldb = EXPERT_FF * ES;
            u.gidx = nullptr; u.gcnt = 256; u.gl = nullptr; u.col0 = pn * 256;
        }
        u.row0 = mtg * 256; u.aux = e; return true;
    }
};

struct EpiIn {
    static constexpr bool PERM = true, WIDE = false;
    GAS bf16_t* H; GAS _Float16* LF; const GAS float* lb; const GAS f32x4* rope;
    __device__ __forceinline__ bool operator()(f32x4 (&acc)[2][2][4][2], const Unit& u, int wr, int wc, int fr, int fq, LAS unsigned char* scr) const {
        const int row0 = u.row0 + wr * 64 + fr, colt = u.col0, cl = wc * 32 + 8 * fq;
        int mode;
        if (colt < C_HF) mode = 1; else if (colt < C_HI) mode = 3; else if (colt < C_HGATE) mode = 0; else if (colt < C_AQ) mode = 2;
        else if (colt < C_AK) mode = 4; else if (colt < C_AV) mode = 5; else if (colt < C_GH) mode = 0; else mode = 2;
        if (mode == 3) {
            f32x4 lbv[2][2];
#pragma unroll
            for (int bj = 0; bj < 2; ++bj)
#pragma unroll
                for (int n = 0; n < 2; ++n) lbv[bj][n] = *(const GAS f32x4*)(lb + (colt - C_HF) + bj * 128 + cl + 4 * n);
#pragma unroll
            for (int ai = 0; ai < 2; ++ai)
#pragma unroll
                for (int m = 0; m < 4; ++m) { GAS _Float16* rowp = LF + HOFF(colt - C_HF, row0 + ai * 128 + m * 16) + cl;
#pragma unroll
                    for (int bj = 0; bj < 2; ++bj) { f16x8 o8;
#pragma unroll
                        for (int n = 0; n < 2; ++n) { const f32x4 z = acc[ai][bj][m][n];
#pragma unroll
                            for (int j = 0; j < 4; ++j) { const float zz = fmaxf(z[j], -80.f), l = lbv[bj][n][j]; const float f = l + (1.0f - l) * fdiv(1.0f, 1.0f + __expf(-zz)); o8[4 * n + j] = (_Float16)__logf(f); } }
                        *(GAS f16x8*)(rowp + (size_t)bj * T * 128) = o8; } }
            return false;
        }
        if (mode >= 4) {
            const float sc = (mode == 4) ? 0.08838834764831845f : 1.0f;
            const int i0 = 16 * wc + 4 * fq;
#pragma unroll
            for (int ai = 0; ai < 2; ++ai)
#pragma unroll
                for (int m = 0; m < 4; ++m) { const int row = row0 + ai * 128 + m * 16; GAS bf16_t* rowp = H + HOFF(colt, row) + cl;
                    const f32x4 cs0 = rope[(size_t)row * 32 + (i0 >> 1)], cs1 = rope[(size_t)row * 32 + (i0 >> 1) + 1];
#pragma unroll
                    for (int bj = 0; bj < 2; ++bj) { const f32x4 v0 = acc[ai][bj][m][0], v1 = acc[ai][bj][m][1]; u32x4 w;
                        w.x = cvt_pk_bf16((v0[0] * cs0[0] - v0[1] * cs0[1]) * sc, (v0[1] * cs0[0] + v0[0] * cs0[1]) * sc);
                        w.y = cvt_pk_bf16((v0[2] * cs0[2] - v0[3] * cs0[3]) * sc, (v0[3] * cs0[2] + v0[2] * cs0[3]) * sc);
                        w.z = cvt_pk_bf16((v1[0] * cs1[0] - v1[1] * cs1[1]) * sc, (v1[1] * cs1[0] + v1[0] * cs1[1]) * sc);
                        w.w = cvt_pk_bf16((v1[2] * cs1[2] - v1[3] * cs1[3]) * sc, (v1[3] * cs1[2] + v1[2] * cs1[3]) * sc);
                        *(GAS u32x4*)(rowp + (size_t)bj * T * 128) = w; } }
            return false;
        }
#pragma unroll
        for (int ai = 0; ai < 2; ++ai)
#pragma unroll
            for (int m = 0; m < 4; ++m) { GAS bf16_t* rowp = H + HOFF(colt, row0 + ai * 128 + m * 16) + cl;
#pragma unroll
                for (int bj = 0; bj < 2; ++bj) { f32x4 v0 = acc[ai][bj][m][0], v1 = acc[ai][bj][m][1];
                    if (mode != 0) {
#pragma unroll
                        for (int j = 0; j < 4; ++j) { const float s0 = fsigmoid(v0[j]), s1 = fsigmoid(v1[j]); v0[j] = (mode == 1) ? v0[j] * s0 : s0; v1[j] = (mode == 1) ? v1[j] * s1 : s1; } }
                    u32x4 w; w.x = cvt_pk_bf16(v0[0], v0[1]); w.y = cvt_pk_bf16(v0[2], v0[3]); w.z = cvt_pk_bf16(v1[0], v1[1]); w.w = cvt_pk_bf16(v1[2], v1[3]);
                    *(GAS u32x4*)(rowp + (size_t)bj * T * 128) = w; } }
        return false;
    }
};
struct EpiMerge {
    static constexpr bool PERM = true, WIDE = true;
    const GAS bf16_t* H; GAS bf16_t* O;
    __device__ __forceinline__ bool operator()(f32x4 (&acc)[2][2][4][2], const Unit& u, int wr, int wc, int fr, int fq, LAS unsigned char* scr) const {
        const int lane = fq * 16 + fr, rowb = u.row0 + wr * 64, colb = u.col0 + wc * 64;
        const int lr = lane >> 3, lch = lane & 7;
        const int wo = lr * 128 + ((lch ^ (lr & 7)) * 16);
        const bool seg0 = (u.aux == 0);
#pragma unroll
        for (int ai = 0; ai < 2; ++ai)
#pragma unroll
            for (int m = 0; m < 4; ++m) { const size_t rg = (size_t)(rowb + ai * 128 + m * 16);
                const GAS bf16_t* gpa = H + HOFF(C_GA + colb, rg + lr) + lch * 8; const GAS bf16_t* gph = H + HOFF(C_GH + colb, rg + lr) + lch * 8;
                const u32x4 ga0 = *(const GAS u32x4*)gpa, ga1 = *(const GAS u32x4*)(gpa + 8 * 128);
                u32x4 gh0 = ga0, gh1 = ga1; if (seg0) { gh0 = *(const GAS u32x4*)gph; gh1 = *(const GAS u32x4*)(gph + 8 * 128); }
                *(LAS u32x4*)(scr + wo) = ga0; *(LAS u32x4*)(scr + wo + 1024) = ga1;
                LDS_WAIT();
                u32x4 gaf[2], ghf[2];
#pragma unroll
                for (int bj = 0; bj < 2; ++bj) gaf[bj] = *(const LAS u32x4*)(scr + fr * 128 + (((bj * 4 + fq) ^ (fr & 7)) * 16));
                LDS_WAIT();
                if (seg0) { *(LAS u32x4*)(scr + wo) = gh0; *(LAS u32x4*)(scr + wo + 1024) = gh1;
                    LDS_WAIT();
#pragma unroll
                    for (int bj = 0; bj < 2; ++bj) ghf[bj] = *(const LAS u32x4*)(scr + fr * 128 + (((bj * 4 + fq) ^ (fr & 7)) * 16));
                    LDS_WAIT(); }
#pragma unroll
                for (int bj = 0; bj < 2; ++bj) { const u32x4 ga = gaf[bj];
                    float a[8] = {bflo(ga.x), bfhi(ga.x), bflo(ga.y), bfhi(ga.y), bflo(ga.z), bfhi(ga.z), bflo(ga.w), bfhi(ga.w)};
                    if (seg0) { const u32x4 gh = ghf[bj];
                        float h[8] = {bflo(gh.x), bfhi(gh.x), bflo(gh.y), bfhi(gh.y), bflo(gh.z), bfhi(gh.z), bflo(gh.w), bfhi(gh.w)};
#pragma unroll
                        for (int j = 0; j < 4; ++j) { acc[ai][bj][m][0][j] *= fdiv(h[j], a[j]); acc[ai][bj][m][1][j] *= fdiv(h[4 + j], a[4 + j]); }
                    } else {
                        f32x4 v0 = acc[ai][bj][m][0], v1 = acc[ai][bj][m][1];
#pragma unroll
                        for (int j = 0; j < 4; ++j) { v0[j] *= a[j]; v1[j] *= a[4 + j]; }
                        u32x2 w8; int q = __builtin_amdgcn_cvt_pk_fp8_f32(v0[0], v0[1], 0, false); q = __builtin_amdgcn_cvt_pk_fp8_f32(v0[2], v0[3], q, true); w8.x = (unsigned)q;
                        q = __builtin_amdgcn_cvt_pk_fp8_f32(v1[0], v1[1], 0, false); q = __builtin_amdgcn_cvt_pk_fp8_f32(v1[2], v1[3], q, true); w8.y = (unsigned)q;
                        *(LAS u32x2*)(scr + fr * 64 + bj * 32 + fq * 8) = w8; } }
                if (!seg0) { LDS_WAIT();
                    const int r = lane >> 2, ch = lane & 3; const u32x4 o = *(const LAS u32x4*)(scr + r * 64 + ch * 16);
                    *(GAS u32x4*)((GAS unsigned char*)O + (rg + r) * D_MODEL + colb + ch * 16) = o;
                    LDS_WAIT(); }
            }
        return seg0;
    }
};
struct EpiResid {
    static constexpr bool PERM = false, WIDE = false;
    const GAS bf16_t* X; GAS bf16_t* R;
    __device__ __forceinline__ bool operator()(f32x4 (&acc)[2][2][4][2], const Unit& u, int wr, int wc, int fr, int fq, LAS unsigned char* scr) const {
        const int row0 = u.row0 + wr * 64 + fr, col0 = u.col0 + wc * 32 + 4 * fq;
#pragma unroll
        for (int ai = 0; ai < 2; ++ai)
#pragma unroll
            for (int m = 0; m < 4; ++m) { const size_t off = (size_t)(row0 + ai * 128 + m * 16) * D_MODEL + col0;
#pragma unroll
                for (int bj = 0; bj < 2; ++bj)
#pragma unroll
                    for (int n = 0; n < 2; ++n) { const u32x2 xv = *(const GAS u32x2*)(X + off + bj * 128 + n * 16); const f32x4 a = acc[ai][bj][m][n];
                        u32x2 o; o.x = cvt_pk_bf16(bflo(xv.x) * DN_ALPHA + a[0], bfhi(xv.x) * DN_ALPHA + a[1]); o.y = cvt_pk_bf16(bflo(xv.y) * DN_ALPHA + a[2], bfhi(xv.y) * DN_ALPHA + a[3]);
                        *(GAS u32x2*)(R + off + bj * 128 + n * 16) = o; } }
        return false;
    }
};
template <bool F8OUT>
struct EpiGateUp {
    static constexpr bool PERM = true, WIDE = false;
    GAS bf16_t* HID;
    __device__ __forceinline__ bool operator()(f32x4 (&acc)[2][2][4][2], const Unit& u, int wr, int wc, int fr, int fq, LAS unsigned char* scr) const {
        const int row0 = u.row0 + wr * 64 + fr, col0 = u.col0 + wc * 32 + 8 * fq;
#pragma unroll
        for (int ai = 0; ai < 2; ++ai)
#pragma unroll
            for (int m = 0; m < 4; ++m) { GAS bf16_t* rowp = HID + (size_t)(row0 + ai * 128 + m * 16) * EXPERT_FF + col0;
                f32x4 g0 = acc[ai][0][m][0], g1 = acc[ai][0][m][1]; const f32x4 u0 = acc[ai][1][m][0], u1 = acc[ai][1][m][1];
#pragma unroll
                for (int j = 0; j < 4; ++j) { g0[j] = g0[j] * fsigmoid(g0[j]) * u0[j]; g1[j] = g1[j] * fsigmoid(g1[j]) * u1[j]; }
                if constexpr (F8OUT) { u32x2 w8; int q = __builtin_amdgcn_cvt_pk_fp8_f32(g0[0], g0[1], 0, false); q = __builtin_amdgcn_cvt_pk_fp8_f32(g0[2], g0[3], q, true); w8.x = (unsigned)q;
                    q = __builtin_amdgcn_cvt_pk_fp8_f32(g1[0], g1[1], 0, false); q = __builtin_amdgcn_cvt_pk_fp8_f32(g1[2], g1[3], q, true); w8.y = (unsigned)q;
                    *(GAS u32x2*)((GAS unsigned char*)HID + (size_t)(row0 + ai * 128 + m * 16) * EXPERT_FF + col0) = w8; }
                else { u32x4 w; w.x = cvt_pk_bf16(g0[0], g0[1]); w.y = cvt_pk_bf16(g0[2], g0[3]); w.z = cvt_pk_bf16(g1[0], g1[1]); w.w = cvt_pk_bf16(g1[2], g1[3]);
                    *(GAS u32x4*)rowp = w; } }
        return false;
    }
};
template <bool F8OUT>
struct EpiDown {
    static constexpr bool PERM = true, WIDE = true;
    GAS bf16_t* Y;
    __device__ __forceinline__ bool operator()(f32x4 (&acc)[2][2][4][2], const Unit& u, int wr, int wc, int fr, int fq, LAS unsigned char* scr) const {
        const int lane = fq * 16 + fr, rowb = u.row0 + wr * 64, colb = u.col0 + wc * 64;
#pragma unroll
        for (int ai = 0; ai < 2; ++ai)
#pragma unroll
            for (int m = 0; m < 4; ++m) { const size_t rg = (size_t)(rowb + ai * 128 + m * 16);
                if constexpr (F8OUT) {
#pragma unroll
                    for (int bj = 0; bj < 2; ++bj) { const f32x4 v0 = acc[ai][bj][m][0], v1 = acc[ai][bj][m][1]; u32x2 w8;
                        int q = __builtin_amdgcn_cvt_pk_fp8_f32(v0[0], v0[1], 0, false); q = __builtin_amdgcn_cvt_pk_fp8_f32(v0[2], v0[3], q, true); w8.x = (unsigned)q;
                        q = __builtin_amdgcn_cvt_pk_fp8_f32(v1[0], v1[1], 0, false); q = __builtin_amdgcn_cvt_pk_fp8_f32(v1[2], v1[3], q, true); w8.y = (unsigned)q;
                        *(LAS u32x2*)(scr + fr * 64 + bj * 32 + fq * 8) = w8; }
                    LDS_WAIT();
                    const int r = lane >> 2, ch = lane & 3; const u32x4 o = *(const LAS u32x4*)(scr + r * 64 + ch * 16);
                    *(GAS u32x4*)((GAS unsigned char*)Y + (rg + r) * D_MODEL + colb + ch * 16) = o;
                } else {
#pragma unroll
                    for (int bj = 0; bj < 2; ++bj) { const f32x4 v0 = acc[ai][bj][m][0], v1 = acc[ai][bj][m][1];
                        u32x4 w; w.x = cvt_pk_bf16(v0[0], v0[1]); w.y = cvt_pk_bf16(v0[2], v0[3]); w.z = cvt_pk_bf16(v1[0], v1[1]); w.w = cvt_pk_bf16(v1[2], v1[3]);
                        *(LAS u32x4*)(scr + fr * 128 + (((bj * 4 + fq) ^ (fr & 7)) * 16)) = w; }
                    LDS_WAIT();
                    const int r = lane >> 3, ch = lane & 7;
                    const u32x4 o0 = *(const LAS u32x4*)(scr + r * 128 + ((ch ^ (r & 7)) * 16)), o1 = *(const LAS u32x4*)(scr + (r + 8) * 128 + ((ch ^ (r & 7)) * 16));
                    *(GAS u32x4*)(Y + (rg + r) * D_MODEL + colb + ch * 8) = o0; *(GAS u32x4*)(Y + (rg + r + 8) * D_MODEL + colb + ch * 8) = o1;
                }
                LDS_WAIT(); }
        return false;
    }
};

struct Args { const float* in[20]; float* out; unsigned char* ws; int ph_lo, ph_hi; };
typedef const __attribute__((address_space(4))) Args* CArgsP;
#define GIN(k) ((const GAS float*)(GAS const float*)ap->in[k])
#define PHASE_ARGS() CArgsP ap = (CArgsP)__builtin_amdgcn_kernarg_segment_ptr(); asm volatile("" : "+s"(ap))
struct Frame {
    LAS unsigned char* lds;
    GAS unsigned* ctl;
    GAS unsigned char* ws;
    int G, bid;
};
#define PHASE_IDS() int tid = threadIdx.x; asm volatile("" : "+v"(tid)); const int lane = tid & 63, w = __builtin_amdgcn_readfirstlane(tid >> 6); (void)lane; (void)w

__device__ __forceinline__ int conv_src_col(int mode, int p) {
    if (mode == 1 && p >= C_AQ && p < C_AV) { const int hb = p & ~127, q = p & 127; return hb + (q >> 1) + 64 * (q & 1); }
    return p;
}
__device__ __forceinline__ int conv_dst_row(int mode, int n) {
    if (mode == 1) { if (n >= C_AQ && n < C_AV) { const int hb = n & ~127, dd = n & 127; return hb + (dd < 64 ? 2 * dd : 2 * (dd - 64) + 1); } return n; }
    if (mode == 2) return (n >> 7) * 256 + (n & 127);
    if (mode == 3) return (n >> 7) * 256 + 128 + (n & 127);
    return n;
}
struct ConvJob { const GAS float* W; GAS unsigned char* WT; int K, N, mode, item, ncol0, ncols, f8; float sc8; };
__device__ __forceinline__ void conv_load(const ConvJob& J, int tid, f32x4 (&v)[16]) {
    const int nblk = J.ncols / 256, k0 = 128 * (J.item / nblk), n0 = J.ncol0 + 256 * (J.item % nblk);
    {
#pragma unroll
        for (int ii = 0; ii < 16; ++ii) { const int idx = tid + 512 * ii, k = idx >> 6, c4 = idx & 63; v[ii] = *(const GAS f32x4*)(J.W + (size_t)(k0 + k) * J.N + n0 + 4 * c4); }
    }
}
__device__ __forceinline__ void conv_to_lds(const ConvJob& J, int tid, const f32x4 (&v)[16], LAS float* T) {
#pragma unroll
    for (int ii = 0; ii < 16; ++ii) { const int idx = tid + 512 * ii, k = idx >> 6, c4 = idx & 63; const int g = J.f8 ? ((k >> 4) & 7) : ((k >> 3) & 15);
        *(LAS f32x4*)(T + k * 256 + 4 * (c4 ^ g)) = v[ii]; }
}
__device__ __forceinline__ void conv_from_lds(const ConvJob& J, int tid, const LAS float* T) {
    const int nblk = J.ncols / 256, k0 = 128 * (J.item / nblk), n0 = J.ncol0 + 256 * (J.item % nblk);
    const int lane = tid & 63, w = tid >> 6, j = lane & 3;
    if (J.f8) {
        const int c = (lane >> 2) & 7; const float sc8 = J.sc8;
#pragma unroll
        for (int it = 0; it < 4; ++it) { const int c4n = w * 8 + it * 2 + (lane >> 5), n = 4 * c4n + j; const LAS float* base = T + 4 * (c4n ^ c) + j; u32x4 o;
#pragma unroll
            for (int d = 0; d < 4; ++d) { const int kk = 16 * c + 4 * d;
                int wv = __builtin_amdgcn_cvt_pk_fp8_f32(base[(kk + 0) * 256] * sc8, base[(kk + 1) * 256] * sc8, 0, false);
                wv = __builtin_amdgcn_cvt_pk_fp8_f32(base[(kk + 2) * 256] * sc8, base[(kk + 3) * 256] * sc8, wv, true); o[d] = (unsigned)wv; }
            *(GAS u32x4*)(J.WT + (size_t)conv_dst_row(J.mode, n0 - J.ncol0 + n) * J.K + k0 + 16 * c) = o; }
    } else {
        const int c = ((lane >> 2) & 7) + 8 * (lane >> 5);
#pragma unroll
        for (int it = 0; it < 8; ++it) { const int c4n = w * 8 + it, n = 4 * c4n + j; const LAS float* base = T + 4 * (c4n ^ c) + j + (8 * c) * 256;
            u32x4 o; o.x = cvt_pk_bf16(base[0 * 256], base[1 * 256]); o.y = cvt_pk_bf16(base[2 * 256], base[3 * 256]); o.z = cvt_pk_bf16(base[4 * 256], base[5 * 256]); o.w = cvt_pk_bf16(base[6 * 256], base[7 * 256]);
            *(GAS u32x4*)(J.WT + ((size_t)conv_dst_row(J.mode, n0 - J.ncol0 + n) * J.K + k0 + 8 * c) * 2) = o; }
    }
}
__device__ __forceinline__ void conv8_load(const ConvJob& J, int tid, f32x4 (&v)[16]) {
    const int nblk = J.ncols / 256, k0 = 128 * (J.item / nblk), n0 = J.ncol0 + 256 * (J.item % nblk);
    const int lane = tid & 63, w = tid >> 6, kg = lane & 7, nq = lane >> 3;
    const GAS float* p = J.W + (size_t)(k0 + 16 * kg) * J.N + n0 + 32 * w + 4 * nq;
#pragma unroll
    for (int j = 0; j < 16; ++j) v[j] = *(const GAS f32x4*)(p + (size_t)j * J.N);
}
__device__ __forceinline__ void conv8_store(const ConvJob& J, int tid, const f32x4 (&v)[16]) {
    const int nblk = J.ncols / 256, k0 = 128 * (J.item / nblk), n0 = J.ncol0 + 256 * (J.item % nblk);
    const int lane = tid & 63, w = tid >> 6, kg = lane & 7, nq = lane >> 3; const float sc8 = J.sc8;
#pragma unroll
    for (int c = 0; c < 4; ++c) { u32x4 o;
#pragma unroll
        for (int d = 0; d < 4; ++d) { int wv = __builtin_amdgcn_cvt_pk_fp8_f32(v[4 * d][c] * sc8, v[4 * d + 1][c] * sc8, 0, false);
            wv = __builtin_amdgcn_cvt_pk_fp8_f32(v[4 * d + 2][c] * sc8, v[4 * d + 3][c] * sc8, wv, true); o[d] = (unsigned)wv; }
        *(GAS u32x4*)(J.WT + (size_t)conv_dst_row(J.mode, n0 - J.ncol0 + 32 * w + 4 * nq + c) * J.K + k0 + 16 * kg) = o; }
}
__device__ __forceinline__ void p0_convert(Frame& F, int layer, bool gu8, bool moe8, int part = 0, int tail = 0, GAS unsigned* ctr = nullptr) {
    PHASE_IDS(); PHASE_ARGS();
    LAS float* TL = (LAS float*)F.lds;
    GAS unsigned char* ws = F.ws;
    const GAS float* w_in = GIN(2) + (size_t)layer * D_MODEL * IN_WIDTH;
    const GAS float* w_hg = GIN(5) + (size_t)layer * HG_WIDTH * D_MODEL;
    const GAS float* w_att = GIN(6) + (size_t)layer * ATT_OUT * D_MODEL;
    const GAS float* w_out = GIN(7) + (size_t)layer * D_MODEL * D_MODEL;
    const GAS float* w_eg = GIN(12) + (size_t)layer * N_EXPERTS * D_MODEL * EXPERT_FF;
    const GAS float* w_eu = GIN(13) + (size_t)layer * N_EXPERTS * D_MODEL * EXPERT_FF;
    const GAS float* w_ed = GIN(14) + (size_t)layer * N_EXPERTS * EXPERT_FF * D_MODEL;
    const GAS float* w_sg = GIN(15) + (size_t)layer * D_MODEL * EXPERT_FF;
    const GAS float* w_su = GIN(16) + (size_t)layer * D_MODEL * EXPERT_FF;
    const GAS float* w_sd = GIN(17) + (size_t)layer * EXPERT_FF * D_MODEL;
    constexpr int I_IN = (D_MODEL / 128) * (IN_WIDTH / 256), I_INF = (D_MODEL / 128) * (HG_WIDTH / 256), I_HG = (HG_WIDTH / 128) * (D_MODEL / 256), I_ATT = (ATT_OUT / 128) * (D_MODEL / 256), I_OUT = (D_MODEL / 128) * (D_MODEL / 256);
    constexpr int I_E = (D_MODEL / 128) * (EXPERT_FF / 256);
    static_assert((EXPERT_FF / 128) * (D_MODEL / 256) == I_E, "item count of the down matrices");
    constexpr int NITEMS = I_IN + I_INF + I_HG + I_ATT + I_OUT + 3 * NEXP1 * I_E;
    auto decode = [&](int it) -> ConvJob {
        int r = it;
        if (r < I_IN) return ConvJob{w_in, ws + WS_WIN, D_MODEL, IN_WIDTH, 1, r, 0, IN_WIDTH, 1, 64.f}; r -= I_IN;
        if (r < I_INF) return ConvJob{w_in, ws + WS_WINF, D_MODEL, IN_WIDTH, 0, r, C_HF, HG_WIDTH, 0, 1.f}; r -= I_INF;
        if (r < I_HG) return ConvJob{w_hg, ws + WS_WHG, HG_WIDTH, D_MODEL, 0, r, 0, D_MODEL, 0, 1.f}; r -= I_HG;
        if (r < I_ATT) return ConvJob{w_att, ws + WS_WATT, ATT_OUT, D_MODEL, 0, r, 0, D_MODEL, 0, 1.f}; r -= I_ATT;
        if (r < I_OUT) return ConvJob{w_out, ws + WS_WOUT, D_MODEL, D_MODEL, 0, r, 0, D_MODEL, 1, 64.f}; r -= I_OUT;
        const int which = r / (NEXP1 * I_E); r -= which * (NEXP1 * I_E);
        const int e = r / I_E, ri = r % I_E; const int es = gu8 ? 1 : 2;
        if (which == 0) return ConvJob{(e < N_EXPERTS) ? w_eg + (size_t)e * D_MODEL * EXPERT_FF : w_sg, ws + (moe8 ? WS_WGU8 : WS_WGU) + (size_t)e * 1024 * D_MODEL * es, D_MODEL, EXPERT_FF, 2, ri, 0, EXPERT_FF, gu8 ? 1 : 0, 64.f};
        if (which == 1) return ConvJob{(e < N_EXPERTS) ? w_eu + (size_t)e * D_MODEL * EXPERT_FF : w_su, ws + (moe8 ? WS_WGU8 : WS_WGU) + (size_t)e * 1024 * D_MODEL * es, D_MODEL, EXPERT_FF, 3, ri, 0, EXPERT_FF, gu8 ? 1 : 0, 64.f};
        return ConvJob{(e < N_EXPERTS) ? w_ed + (size_t)e * EXPERT_FF * D_MODEL : w_sd, ws + (moe8 ? WS_WDN8 : WS_WDN) + (size_t)e * D_MODEL * EXPERT_FF, EXPERT_FF, D_MODEL, 0, ri, 0, D_MODEL, 1, 64.f};
    };
    constexpr int N_NONEXP = I_IN + I_INF + I_HG + I_ATT + I_OUT, NB16 = I_INF + I_HG + I_ATT;
    if (gu8) {
        constexpr int NF8 = NITEMS - NB16, NF8_NONEXP = I_IN + I_OUT;
        const int q_lo = (part == 2) ? NF8_NONEXP : 0, q_end = (part == 1) ? NF8_NONEXP : NF8, q_hi = q_end - tail;
        if (ctr != nullptr) {
            LAS unsigned* qw = (LAS unsigned*)(F.lds + LDS_TAB + 1536);
            for (;;) {
                if (tid == 0) *qw = __hip_atomic_fetch_add(ctr, 1u, RLX_AGENT);
                LDS_BARRIER();
                const int qd = q_hi + __builtin_amdgcn_readfirstlane((int)*qw);
                LDS_BARRIER();
                if (qd >= q_end) break;
                const ConvJob j = decode(qd < I_IN ? qd : qd + NB16); f32x4 v[16]; conv8_load(j, tid, v); conv8_store(j, tid, v); }
            return;
        }
        int q = q_lo + F.bid;
        if (q < q_hi) {
            f32x4 va[16], vb[16];
            conv8_load(decode(q < I_IN ? q : q + NB16), tid, va);
            for (;;) {
                const int q1 = q + F.G; const bool m1 = q1 < q_hi;
                if (m1) conv8_load(decode(q1 < I_IN ? q1 : q1 + NB16), tid, vb);
                conv8_store(decode(q < I_IN ? q : q + NB16), tid, va);
                if (!m1) break;
                const int q2 = q1 + F.G; const bool m2 = q2 < q_hi;
                if (m2) conv8_load(decode(q2 < I_IN ? q2 : q2 + NB16), tid, va);
                conv8_store(decode(q1 < I_IN ? q1 : q1 + NB16), tid, vb);
                if (!m2) break;
                q = q2; }
        }
        if (part != 2) {
            for (int it = I_IN + (F.G - 1 - F.bid); it < I_IN + NB16; it += F.G) { const ConvJob j = decode(it); f32x4 v[16];
                conv_load(j, tid, v); conv_to_lds(j, tid, v, TL); LDS_BARRIER(); conv_from_lds(j, tid, TL); LDS_BARRIER(); }
        }
    } else {
    const int it_lo = (part == 2) ? N_NONEXP : 0, it_hi = (part == 1) ? N_NONEXP : NITEMS;
    if (it_lo + F.bid < it_hi) {
        f32x4 va[16]; int it = it_lo + F.bid; ConvJob jc = decode(it);
        conv_load(jc, tid, va);
        for (;;) { const int itn = it + F.G; const bool more = itn < it_hi;
            conv_to_lds(jc, tid, va, TL);
            LDS_BARRIER();
            ConvJob jn = jc; if (more) { jn = decode(itn); conv_load(jn, tid, va); }
            conv_from_lds(jc, tid, TL);
            LDS_BARRIER();
            if (!more) break;
            jc = jn; it = itn; }
    }
    }
    if (layer == 0 && part != 2) {
        const GAS f32x4* x4 = (const GAS f32x4*)GIN(0); GAS u32x2* xb = (GAS u32x2*)(ws + WS_XB); GAS unsigned* xb8 = (GAS unsigned*)(ws + WS_XB8);
        for (size_t i = (size_t)F.bid * 512 + tid; i < (size_t)T * D_MODEL / 4; i += (size_t)F.G * 512) { const f32x4 v = x4[i]; u32x2 o; o.x = pk2(v[0], v[1]); o.y = pk2(v[2], v[3]); xb[i] = o;
            int w8 = __builtin_amdgcn_cvt_pk_fp8_f32(v[0], v[1], 0, false); w8 = __builtin_amdgcn_cvt_pk_fp8_f32(v[2], v[3], w8, true); xb8[i] = (unsigned)w8; }
        const GAS int* pos = (const GAS int*)GIN(1); GAS f32x2* rt = (GAS f32x2*)(ws + WS_ROPE);
        for (int i = F.bid * 512 + tid; i < T * 64; i += F.G * 512) { const int tk = i >> 6, fi = i & 63;
            const double inv = exp2(-(double)fi * (13.287712379549449 / 64.0));
            const double ang = (double)pos[tk] * inv; const double red = ang - rint(ang * 0.15915494309189535) * 6.283185307179586;
            const float rf = (float)red; rt[i] = (f32x2){cosf(rf), sinf(rf)}; }
        const GAS float* lbl = GIN(3); GAS float* lb = (GAS float*)(ws + WS_LB);
        for (int c = F.bid * 512 + tid; c < HG_WIDTH; c += F.G * 512) {
            float mx = -1e30f; for (int l = 0; l < DEPTH; ++l) mx = fmaxf(mx, lbl[l * HG_WIDTH + c]);
            float den = 0.f; for (int l = 0; l < DEPTH; ++l) den += expf(lbl[l * HG_WIDTH + c] - mx);
            float cum = 0.f, c0 = 0.f; for (int l = 0; l < DEPTH; ++l) { cum += expf(lbl[l * HG_WIDTH + c] - mx) / den; if (l == 0) c0 = cum; lb[l * HG_WIDTH + c] = cum - c0; }
        }
    }
}

constexpr int TROW = 272;
struct H1Regs { float lf[16]; u32x4 v[2]; };
__device__ __forceinline__ void h1_load(Frame& F, int chunk, int tid, H1Regs& R) {
    const GAS bf16_t* H = (const GAS bf16_t*)(F.ws + WS_H); const GAS _Float16* LF = (const GAS _Float16*)(F.ws + WS_LF);
    const int bh = chunk >> 5, n = chunk & 31, b = bh >> 3, head = bh & 7, tok0 = b * SEQ + n * 64, kk = tid & 127, part = tid >> 7;
    const GAS _Float16* p = LF + HOFF(head * 128, tok0 + part * 16) + kk;
#pragma unroll
    for (int j = 0; j < 16; ++j) R.lf[j] = (float)p[(size_t)j * 128];
#pragma unroll
    for (int j = 0; j < 2; ++j) { const int c = tid + 512 * j, row = c >> 4, ch = c & 15;
        R.v[j] = *(const GAS u32x4*)(H + HOFF(C_HI + head * 128, tok0 + row) + ch * 8); }
}
__device__ __forceinline__ void h1_item(Frame& F, int chunk, int tid, const H1Regs& R) {
    GAS float* UT = (GAS float*)(F.ws + WS_UT); GAS float* DEC = (GAS float*)(F.ws + WS_DEC);
    LAS unsigned char* KT = F.lds; LAS unsigned char* VT = F.lds + 17408; LAS float* TOT = (LAS float*)(F.lds + 34816);
    const int lane = tid & 63, w = __builtin_amdgcn_readfirstlane(tid >> 6);
    const int kk = tid & 127, part = tid >> 7, g = lane >> 4, i = lane & 15;
    float lf[16], cum[16];
#pragma unroll
    for (int j = 0; j < 16; ++j) lf[j] = R.lf[j];
#pragma unroll
    for (int j = 0; j < 2; ++j) { const int c = tid + 512 * j, row = c >> 4, ch = c & 15; *(LAS u32x4*)(VT + row * TROW + ch * 16) = R.v[j]; }
    float run = 0.f;
#pragma unroll
    for (int j = 0; j < 16; ++j) { run += lf[j]; cum[j] = run; }
    TOT[part * 128 + kk] = run;
    LDS_BARRIER();
    float off = 0.f, end = 0.f;
#pragma unroll
    for (int p = 0; p < 4; ++p) { const float t = TOT[p * 128 + kk]; if (p < part) off += t; end += t; }
#pragma unroll
    for (int j = 0; j < 16; ++j) { const float c = cum[j] + off; const float kt = (1.0f - __expf(lf[j])) * __expf(end - c);
        *(LAS unsigned short*)(KT + (part * 16 + j) * TROW + kk * 2) = (unsigned short)cvt_pk_bf16(kt, 0.f); }
    if (part == 0) DEC[(size_t)chunk * 128 + kk] = __expf(end);
    LDS_BARRIER();
    const unsigned ktb = (unsigned)(size_t)KT, vtb = (unsigned)(size_t)VT;
    const int q = i >> 2, p4 = i & 3;
    bf16x8 af[2];
#pragma unroll
    for (int ks = 0; ks < 2; ++ks) { const s16x4 lo = tr_read(ktb + (32 * ks + 8 * g + q) * TROW + (16 * w + 4 * p4) * 2), hi = tr_read(ktb + (32 * ks + 8 * g + 4 + q) * TROW + (16 * w + 4 * p4) * 2);
        af[ks] = (bf16x8){lo[0], lo[1], lo[2], lo[3], hi[0], hi[1], hi[2], hi[3]}; }
    f32x4 uacc[8];
#pragma unroll
    for (int vb = 0; vb < 8; ++vb) uacc[vb] = (f32x4){0.f, 0.f, 0.f, 0.f};
#pragma unroll
    for (int ks = 0; ks < 2; ++ks) { s16x4 lo[8], hi[8];
        tr_read8<32>(lo, vtb + (32 * ks + 8 * g + q) * TROW + 8 * p4); tr_read8<32>(hi, vtb + (32 * ks + 8 * g + 4 + q) * TROW + 8 * p4);
#pragma unroll
        for (int vb = 0; vb < 8; ++vb) uacc[vb] = mfma16(af[ks], TRCAT(lo[vb], hi[vb]), uacc[vb]); }
#pragma unroll
    for (int vb = 0; vb < 8; ++vb) { u32x2 wv; wv.x = pk2(uacc[vb][0], uacc[vb][1]); wv.y = pk2(uacc[vb][2], uacc[vb][3]);
        *(GAS u32x2*)((GAS bf16_t*)UT + (size_t)chunk * 16384 + (16 * vb + i) * 128 + 16 * w + 4 * g) = wv; }
    LDS_BARRIER();
}

__device__ __forceinline__ void attn_item(Frame& F, int it) {
    GAS bf16_t* H = (GAS bf16_t*)(F.ws + WS_H); GAS float* LSE = (GAS float*)(F.ws + WS_LSE);
    const int b = it / 192, rem = it % 192, h = rem >> 4, j = rem & 15, grp = h >> 2, dsh = 2 * grp, d = 1 << dsh, r = j & (d - 1), qb = j >> dsh;
    const int lbase = 128 * (qb - 1);
    GAS bf16_t* HbQ = H + HOFF(C_AQ + h * 128, b * SEQ); GAS bf16_t* HbK = H + HOFF(C_AK + h * 128, b * SEQ); GAS bf16_t* HbV = H + HOFF(C_AV + h * 128, b * SEQ);
    LAS unsigned char* KT = F.lds; LAS unsigned char* VT = F.lds + 256 * TROW;
    PHASE_IDS();
    const int g = lane >> 4, i = lane & 15;
    const int jb0 = (qb == 0) ? (8 - w) : 0;
#pragma unroll
    for (int jj = 0; jj < 8; ++jj) { if (qb == 0 && jj < 4) continue;
        const int c = tid + 512 * jj, row = c >> 4, ch = c & 15; int l = lbase + row; l = l < 0 ? 0 : l; const size_t tok = (size_t)(l * d + r);
        const u32x4 kv = *(const GAS u32x4*)(HbK + tok * 128 + ch * 8), vv = *(const GAS u32x4*)(HbV + tok * 128 + ch * 8);
        *(LAS u32x4*)(KT + row * TROW + ch * 16) = kv; *(LAS u32x4*)(VT + row * TROW + ch * 16) = vv; }
    const size_t tokq = (size_t)((128 * qb + 16 * w + i) * d + r);
    bf16x8 qf[4];
#pragma unroll
    for (int ks = 0; ks < 4; ++ks) qf[ks] = *(const GAS bf16x8*)(HbQ + tokq * 128 + 32 * ks + 8 * g);
    LDS_BARRIER();
    f32x4 s[9];
#pragma unroll
    for (int jb = 0; jb < 9; ++jb) { f32x4 a4 = {0.f, 0.f, 0.f, 0.f};
        if (jb >= jb0) {
#pragma unroll
            for (int ks = 0; ks < 4; ++ks) { const bf16x8 a = *(const LAS bf16x8*)(KT + (16 * (w + jb) + i) * TROW + (32 * ks + 8 * g) * 2); a4 = mfma16(a, qf[ks], a4); } }
        s[jb] = a4; }
    float mx = -1e30f;
#pragma unroll
    for (int jb = 0; jb < 9; ++jb)
#pragma unroll
        for (int rg = 0; rg < 4; ++rg) { const int kin = 4 * g + rg, dist = 128 - 16 * jb + i - kin, lk = lbase + 16 * (w + jb) + kin;
            const bool valid = ((unsigned)dist <= 128u) && (lk >= 0) && (jb >= jb0);
            const float v = valid ? s[jb][rg] : -INFINITY; s[jb][rg] = v; mx = fmaxf(mx, v); }
    mx = fmaxf(mx, __shfl_xor(mx, 16)); mx = fmaxf(mx, __shfl_xor(mx, 32));
    float den = 0.f;
#pragma unroll
    for (int jb = 0; jb < 9; ++jb)
#pragma unroll
        for (int rg = 0; rg < 4; ++rg) { const float p = __expf(s[jb][rg] - mx); s[jb][rg] = p; den += p; }
    den += __shfl_xor(den, 16); den += __shfl_xor(den, 32);
    f32x4 o[8];
#pragma unroll
    for (int db = 0; db < 8; ++db) o[db] = (f32x4){0.f, 0.f, 0.f, 0.f};
    const unsigned vtb = (unsigned)(size_t)VT; const int q = i >> 2, p4 = i & 3;
#pragma unroll
    for (int kp = 0; kp < 5; ++kp) {
        bf16x8 pb; { const unsigned a0 = cvt_pk_bf16(s[2 * kp][0], s[2 * kp][1]), a1 = cvt_pk_bf16(s[2 * kp][2], s[2 * kp][3]);
            unsigned b0 = 0u, b1 = 0u; if (kp < 4) { b0 = cvt_pk_bf16(s[2 * kp + 1][0], s[2 * kp + 1][1]); b1 = cvt_pk_bf16(s[2 * kp + 1][2], s[2 * kp + 1][3]); }
            const u32x4 t4 = {a0, a1, b0, b1}; pb = __builtin_bit_cast(bf16x8, t4); }
        if (2 * kp + 1 < jb0) continue;
        int r0 = 16 * (w + 2 * kp) + 4 * g + q; const int r1 = (kp < 4) ? r0 + 16 : r0;
        if (2 * kp < jb0) r0 = r1;
        s16x4 lo[8], hi[8];
        tr_read8<32>(lo, vtb + r0 * TROW + 8 * p4); tr_read8<32>(hi, vtb + r1 * TROW + 8 * p4);
#pragma unroll
        for (int db = 0; db < 8; ++db) o[db] = mfma16(TRCAT(lo[db], hi[db]), pb, o[db]);
    }
    const float rden = fdiv(1.0f, den);
#pragma unroll
    for (int db = 0; db < 8; ++db) { u32x2 wv; wv.x = cvt_pk_bf16(o[db][0] * rden, o[db][1] * rden); wv.y = cvt_pk_bf16(o[db][2] * rden, o[db][3] * rden);
        *(GAS u32x2*)(HbQ + tokq * 128 + 16 * db + 4 * g) = wv; }
    if (g == 0) LSE[(size_t)h * T + (size_t)b * SEQ + tokq] = mx + __logf(den);
    LDS_BARRIER();
}

__device__ __forceinline__ void scan_item(Frame& F, int item) {
    const GAS float* UT = (const GAS float*)(F.ws + WS_UT); const GAS float* DEC = (const GAS float*)(F.ws + WS_DEC); GAS bf16_t* SPT = (GAS bf16_t*)(F.ws + WS_SPT);
    PHASE_IDS();
    const int bh = item >> 2, q4 = item & 3, vv = q4 * 32 + (tid >> 4), kk0 = (tid & 15) * 8;
    f32x4 s0 = {0.f, 0.f, 0.f, 0.f}, s1 = {0.f, 0.f, 0.f, 0.f};
#pragma unroll 8
    for (int n = 0; n < 32; ++n) { const size_t chunk = (size_t)bh * 32 + n; const size_t eo = chunk * 16384 + (size_t)vv * 128 + kk0;
        const u32x4 ub = *(const GAS u32x4*)((const GAS bf16_t*)UT + eo); const f32x4 u0 = {bflo(ub.x), bfhi(ub.x), bflo(ub.y), bfhi(ub.y)}, u1 = {bflo(ub.z), bfhi(ub.z), bflo(ub.w), bfhi(ub.w)}, d0 = *(const GAS f32x4*)(DEC + chunk * 128 + kk0), d1 = *(const GAS f32x4*)(DEC + chunk * 128 + kk0 + 4);
        u32x4 wv; wv.x = cvt_pk_bf16(s0[0], s0[1]); wv.y = cvt_pk_bf16(s0[2], s0[3]); wv.z = cvt_pk_bf16(s1[0], s1[1]); wv.w = cvt_pk_bf16(s1[2], s1[3]);
        *(GAS u32x4*)(SPT + eo) = wv;
        s0 = d0 * s0 + u0; s1 = d1 * s1 + u1; }
}
__device__ __forceinline__ void attn_merge(Frame& F) {
    const GAS bf16_t* H = (const GAS bf16_t*)(F.ws + WS_H); const GAS float* LSE = (const GAS float*)(F.ws + WS_LSE); GAS bf16_t* ATTO = (GAS bf16_t*)(F.ws + WS_ATTO);
    PHASE_IDS();
    const int gw = F.bid * 8 + w, NGW = F.G * 8, hg = lane >> 4, d0 = (lane & 15) * 8;
    for (int t = gw; t < T; t += NGW) {
        const float l0 = LSE[(size_t)hg * T + t], l1 = LSE[(size_t)(4 + hg) * T + t], l2 = LSE[(size_t)(8 + hg) * T + t];
        const float mx = fmaxf(l0, fmaxf(l1, l2)); float w0 = __expf(l0 - mx), w1 = __expf(l1 - mx), w2 = __expf(l2 - mx); const float rs = fdiv(1.0f, w0 + w1 + w2); w0 *= rs; w1 *= rs; w2 *= rs;
        const GAS bf16_t* base = H + HOFF(C_AQ + hg * 128, t) + d0;
        const u32x4 a = *(const GAS u32x4*)base, bq = *(const GAS u32x4*)(base + (size_t)4 * T * 128), c = *(const GAS u32x4*)(base + (size_t)8 * T * 128);
        u32x4 wv;
        wv.x = cvt_pk_bf16(w0 * bflo(a.x) + w1 * bflo(bq.x) + w2 * bflo(c.x), w0 * bfhi(a.x) + w1 * bfhi(bq.x) + w2 * bfhi(c.x));
        wv.y = cvt_pk_bf16(w0 * bflo(a.y) + w1 * bflo(bq.y) + w2 * bflo(c.y), w0 * bfhi(a.y) + w1 * bfhi(bq.y) + w2 * bfhi(c.y));
        wv.z = cvt_pk_bf16(w0 * bflo(a.z) + w1 * bflo(bq.z) + w2 * bflo(c.z), w0 * bfhi(a.z) + w1 * bfhi(bq.z) + w2 * bfhi(c.z));
        wv.w = cvt_pk_bf16(w0 * bflo(a.w) + w1 * bflo(bq.w) + w2 * bflo(c.w), w0 * bfhi(a.w) + w1 * bfhi(bq.w) + w2 * bfhi(c.w));
        *(GAS u32x4*)(ATTO + (size_t)t * ATT_OUT + hg * 128 + d0) = wv;
    }
}

struct H3Regs { float lf[16]; unsigned short q[16]; u32x4 v[2]; u32x4 sp[4]; };
__device__ __forceinline__ void h3_load(Frame& F, int chunk, int tid, H3Regs& R) {
    const GAS bf16_t* H = (const GAS bf16_t*)(F.ws + WS_H); const GAS _Float16* LF = (const GAS _Float16*)(F.ws + WS_LF); const GAS bf16_t* SPT = (const GAS bf16_t*)(F.ws + WS_SPT);
    const int bh = chunk >> 5, n = chunk & 31, b = bh >> 3, head = bh & 7, tok0 = b * SEQ + n * 64, kk = tid & 127, part = tid >> 7;
    const GAS _Float16* p = LF + HOFF(head * 128, tok0 + part * 16) + kk; const GAS bf16_t* pq = H + HOFF(C_HQ + head * 128, tok0 + part * 16) + kk;
#pragma unroll
    for (int j = 0; j < 16; ++j) { R.lf[j] = (float)p[(size_t)j * 128]; R.q[j] = pq[(size_t)j * 128]; }
#pragma unroll
    for (int j = 0; j < 2; ++j) { const int c = tid + 512 * j, row = c >> 4, ch = c & 15; R.v[j] = *(const GAS u32x4*)(H + HOFF(C_HI + head * 128, tok0 + row) + ch * 8); }
#pragma unroll
    for (int j = 0; j < 4; ++j) { const int c = tid + 512 * j, row = c >> 4, ch = c & 15; R.sp[j] = *(const GAS u32x4*)(SPT + (size_t)chunk * 16384 + row * 128 + ch * 8); }
}
__device__ __forceinline__ void h3_item(Frame& F, int chunk, const GAS float* normg, int tid, const H3Regs& R) {
    const GAS bf16_t* H = (const GAS bf16_t*)(F.ws + WS_H); GAS bf16_t* HGO = (GAS bf16_t*)(F.ws + WS_HGO);
    const int bh = chunk >> 5, n = chunk & 31, b = bh >> 3, head = bh & 7, tok0 = b * SEQ + n * 64;
    LAS unsigned char* QT = F.lds; LAS unsigned char* QH = F.lds + 17408; LAS unsigned char* KH = F.lds + 34816; LAS unsigned char* VT = F.lds + 52224; LAS unsigned char* SP = F.lds + 69632;
    LAS float* TOT = (LAS float*)(F.lds + 104448); LAS float* RS = (LAS float*)(F.lds + 106496);
    const int lane = tid & 63, w = __builtin_amdgcn_readfirstlane(tid >> 6);
    const int kk = tid & 127, part = tid >> 7, g = lane >> 4, i = lane & 15;
    float lf[16], cum[16], qv[16];
#pragma unroll
    for (int j = 0; j < 16; ++j) { lf[j] = R.lf[j]; qv[j] = bf2f(R.q[j]); }
#pragma unroll
    for (int j = 0; j < 2; ++j) { const int c = tid + 512 * j, row = c >> 4, ch = c & 15; *(LAS u32x4*)(VT + row * TROW + ch * 16) = R.v[j]; }
#pragma unroll
    for (int j = 0; j < 4; ++j) { const int c = tid + 512 * j, row = c >> 4, ch = c & 15; *(LAS u32x4*)(SP + row * TROW + ch * 16) = R.sp[j]; }
    float run = 0.f;
#pragma unroll
    for (int j = 0; j < 16; ++j) { run += lf[j]; cum[j] = run; }
    TOT[part * 128 + kk] = run;
    LDS_BARRIER();
    float off = 0.f;
#pragma unroll
    for (int p = 0; p < 4; ++p) { const float t = TOT[p * 128 + kk]; if (p < part) off += t; }
    const float cmid = TOT[kk] + TOT[128 + kk];
#pragma unroll
    for (int j = 0; j < 16; ++j) { const float c = cum[j] + off; const int t = part * 16 + j; const float kq = 1.0f - __expf(lf[j]);
        const unsigned w01 = cvt_pk_bf16(qv[j] * __expf(c), qv[j] * __expf(fminf(c - cmid, 60.f)));
        *(LAS unsigned short*)(QT + t * TROW + kk * 2) = (unsigned short)w01;
        *(LAS unsigned short*)(QH + t * TROW + kk * 2) = (unsigned short)(w01 >> 16);
        *(LAS unsigned short*)(KH + t * TROW + kk * 2) = (unsigned short)cvt_pk_bf16(kq * __expf(fminf(cmid - c, 60.f)), 0.f); }
    LDS_BARRIER();
    const int tb = w & 3, vh = w >> 2;
    f32x4 at[4];
#pragma unroll
    for (int sb = 0; sb < 4; ++sb) { f32x4 a4 = {0.f, 0.f, 0.f, 0.f};
        if (sb <= tb) {
#pragma unroll
            for (int ks = 0; ks < 4; ++ks) { const bf16x8 a = *(const LAS bf16x8*)(KH + (16 * sb + i) * TROW + (32 * ks + 8 * g) * 2), bq = *(const LAS bf16x8*)(QH + (16 * tb + i) * TROW + (32 * ks + 8 * g) * 2);
                a4 = mfma16(a, bq, a4); }
            if (sb == tb) {
#pragma unroll
                for (int rg = 0; rg < 4; ++rg) a4[rg] = (4 * g + rg <= i) ? a4[rg] : 0.f; }
        }
        at[sb] = a4; }
    bf16x8 pb[2];
#pragma unroll
    for (int kp = 0; kp < 2; ++kp) { const u32x4 t4 = {pk2(at[2 * kp][0], at[2 * kp][1]), pk2(at[2 * kp][2], at[2 * kp][3]), pk2(at[2 * kp + 1][0], at[2 * kp + 1][1]), pk2(at[2 * kp + 1][2], at[2 * kp + 1][3])};
        pb[kp] = __builtin_bit_cast(bf16x8, t4); }
    const unsigned vtb = (unsigned)(size_t)VT; const int q = i >> 2, p4 = i & 3;
    f32x4 o[4]; float ss = 0.f;
    s16x4 vlo[2][4], vhi[2][4];
#pragma unroll
    for (int kp = 0; kp < 2; ++kp) tr_read4x2<32>(vlo[kp], vhi[kp], vtb + (32 * kp + 4 * g + q) * TROW + (64 * vh + 4 * p4) * 2, vtb + (32 * kp + 16 + 4 * g + q) * TROW + (64 * vh + 4 * p4) * 2);
#pragma unroll
    for (int vb = 0; vb < 4; ++vb) { const int vblk = 4 * vh + vb; f32x4 acc = {0.f, 0.f, 0.f, 0.f};
#pragma unroll
        for (int ks = 0; ks < 4; ++ks) { const bf16x8 a = *(const LAS bf16x8*)(SP + (16 * vblk + i) * TROW + (32 * ks + 8 * g) * 2), bq = *(const LAS bf16x8*)(QT + (16 * tb + i) * TROW + (32 * ks + 8 * g) * 2);
            acc = mfma16(a, bq, acc); }
#pragma unroll
        for (int kp = 0; kp < 2; ++kp) acc = mfma16(TRCAT(vlo[kp][vb], vhi[kp][vb]), pb[kp], acc);
        o[vb] = acc; ss += (acc[0] * acc[0] + acc[1] * acc[1]) + (acc[2] * acc[2] + acc[3] * acc[3]); }
    ss += __shfl_xor(ss, 16); ss += __shfl_xor(ss, 32);
    if (g == 0) RS[vh * 64 + 16 * tb + i] = ss;
    LDS_BARRIER();
    const float tot = RS[16 * tb + i] + RS[64 + 16 * tb + i];
    const float rinv = rsqrtf(tot * (1.0f / 128.0f) + NORM_EPS);
    const size_t tok = (size_t)(tok0 + 16 * tb + i);
#pragma unroll
    for (int vb = 0; vb < 4; ++vb) { const int vv = 16 * (4 * vh + vb) + 4 * g;
        const f32x4 ng = *(const GAS f32x4*)(normg + head * 128 + vv); const u32x2 gt = *(const GAS u32x2*)(H + HOFF(C_HGATE + head * 128, tok) + vv);
        u32x2 wv; wv.x = cvt_pk_bf16(o[vb][0] * rinv * ng[0] * bflo(gt.x), o[vb][1] * rinv * ng[1] * bfhi(gt.x)); wv.y = cvt_pk_bf16(o[vb][2] * rinv * ng[2] * bflo(gt.y), o[vb][3] * rinv * ng[3] * bfhi(gt.y));
        *(GAS u32x2*)(HGO + tok * HG_WIDTH + head * 128 + vv) = wv; }
    LDS_BARRIER();
}

template <bool X8>
__device__ __forceinline__ void ln_router_phase(Frame& F, int layer) {
    PHASE_ARGS();
    const GAS bf16_t* R = (const GAS bf16_t*)(F.ws + WS_R); GAS bf16_t* X1B = (GAS bf16_t*)(F.ws + WS_X1B); GAS unsigned char* X1B8 = F.ws + WS_X1B8;
    const GAS float* g1 = GIN(8) + (size_t)layer * D_MODEL; const GAS float* b1 = GIN(9) + (size_t)layer * D_MODEL;
    const GAS float* wrt = GIN(10) + (size_t)layer * D_MODEL * N_EXPERTS; const GAS float* rbias = GIN(11) + (size_t)layer * N_EXPERTS;
    GAS int* PE = (GAS int*)(F.ws + WS_PE); GAS int* PP = (GAS int*)(F.ws + WS_PP); GAS float* PG = (GAS float*)(F.ws + WS_PG); GAS int* RM = (GAS int*)(F.ws + WS_RM);
    GAS unsigned* cnt = F.ctl + CW_CNT + layer * 64;
    constexpr int XROW = 528, WROW = 144;
    LAS unsigned char* XSb = F.lds; LAS unsigned char* WSb = F.lds + 64 * XROW; LAS float* PART = (LAS float*)F.lds; LAS float* LG = (LAS float*)(F.lds + 32768);
    LAS int* LCNT = (LAS int*)(F.lds + 49152); LAS int* BASE = (LAS int*)(F.lds + 49408); LAS int* PEL = (LAS int*)(F.lds + 49664); LAS int* PLL = (LAS int*)(F.lds + 51712);
    PHASE_IDS();
    const int g = lane >> 4, i = lane & 15;
    for (int bt = F.bid; bt < T / 64; bt += F.G) {
        const int tok0 = bt * 64;
#pragma unroll 1
        for (int pr = 0; pr < 4; ++pr) {
            f32x4 ys[2][4][2];
#pragma unroll
            for (int tt = 0; tt < 2; ++tt) { const size_t token = (size_t)(tok0 + 8 * w + 2 * pr + tt);
                const GAS u32x4* rp = (const GAS u32x4*)(R + token * D_MODEL) + lane;
#pragma unroll
                for (int j = 0; j < 4; ++j) { const u32x4 r = rp[64 * j]; ys[tt][j][0] = (f32x4){bflo(r.x), bfhi(r.x), bflo(r.y), bfhi(r.y)}; ys[tt][j][1] = (f32x4){bflo(r.z), bfhi(r.z), bflo(r.w), bfhi(r.w)}; } }
#pragma unroll
            for (int tt = 0; tt < 2; ++tt) { const size_t token = (size_t)(tok0 + 8 * w + 2 * pr + tt); float s = 0.f;
#pragma unroll
                for (int j = 0; j < 4; ++j)
#pragma unroll
                    for (int h = 0; h < 2; ++h) s += (ys[tt][j][h][0] + ys[tt][j][h][1]) + (ys[tt][j][h][2] + ys[tt][j][h][3]);
                const float mean = wave_sum(s) * (1.0f / D_MODEL); float s2 = 0.f;
#pragma unroll
                for (int j = 0; j < 4; ++j)
#pragma unroll
                    for (int h = 0; h < 2; ++h) { ys[tt][j][h] = ys[tt][j][h] - mean; s2 += (ys[tt][j][h][0] * ys[tt][j][h][0] + ys[tt][j][h][1] * ys[tt][j][h][1]) + (ys[tt][j][h][2] * ys[tt][j][h][2] + ys[tt][j][h][3] * ys[tt][j][h][3]); }
                const float rstd = rsqrtf(wave_sum(s2) * (1.0f / D_MODEL) + LN_EPS);
#pragma unroll
                for (int j = 0; j < 4; ++j) { const int c = 8 * lane + 512 * j;
                    const f32x4 y0 = ys[tt][j][0] * rstd * *(const GAS f32x4*)(g1 + c) + *(const GAS f32x4*)(b1 + c), y1 = ys[tt][j][1] * rstd * *(const GAS f32x4*)(g1 + c + 4) + *(const GAS f32x4*)(b1 + c + 4);
                    u32x4 o; o.x = cvt_pk_bf16(y0[0], y0[1]); o.y = cvt_pk_bf16(y0[2], y0[3]); o.z = cvt_pk_bf16(y1[0], y1[1]); o.w = cvt_pk_bf16(y1[2], y1[3]);
                    *(GAS u32x4*)(X1B + token * D_MODEL + c) = o;
                    if constexpr (X8) { u32x2 w8; int q8 = __builtin_amdgcn_cvt_pk_fp8_f32(y0[0], y0[1], 0, false); q8 = __builtin_amdgcn_cvt_pk_fp8_f32(y0[2], y0[3], q8, true); w8.x = (unsigned)q8;
                        q8 = __builtin_amdgcn_cvt_pk_fp8_f32(y1[0], y1[1], 0, false); q8 = __builtin_amdgcn_cvt_pk_fp8_f32(y1[2], y1[3], q8, true); w8.y = (unsigned)q8;
                        *(GAS u32x2*)(X1B8 + token * D_MODEL + c) = w8; } }
            }
        }
        VM_WAIT(); __syncthreads();
        f32x4 dacc[4];
#pragma unroll
        for (int nb = 0; nb < 4; ++nb) dacc[nb] = (f32x4){0.f, 0.f, 0.f, 0.f};
        const int tt4 = w & 3, kh = w >> 2;
        u32x4 xr[4];
#pragma unroll
        for (int j = 0; j < 4; ++j) { const int idx = tid + 512 * j, row = idx >> 5, c8 = idx & 31; xr[j] = *(const GAS u32x4*)(X1B + (size_t)(tok0 + row) * D_MODEL + 8 * c8); }
#pragma unroll 1
        for (int ke = 0; ke < 8; ++ke) { const int k1 = 256 * (ke + 1);
#pragma unroll
            for (int j = 0; j < 4; ++j) { const int idx = tid + 512 * j, row = idx >> 5, c8 = idx & 31; *(LAS u32x4*)(XSb + row * XROW + c8 * 16) = xr[j]; }
#pragma unroll
            for (int j = 0; j < 8; ++j) { const int idx = tid + 512 * j, row = idx >> 4, c4 = idx & 15; const f32x4 v = *(const GAS f32x4*)(wrt + (size_t)(k1 - 256 + row) * N_EXPERTS + 4 * c4);
                u32x2 o; o.x = cvt_pk_bf16(v[0], v[1]); o.y = cvt_pk_bf16(v[2], v[3]); *(LAS u32x2*)(WSb + row * WROW + c4 * 8) = o; }
            LDS_BARRIER();
            if (ke < 7) {
#pragma unroll
                for (int j = 0; j < 4; ++j) { const int idx = tid + 512 * j, row = idx >> 5, c8 = idx & 31; xr[j] = *(const GAS u32x4*)(X1B + (size_t)(tok0 + row) * D_MODEL + k1 + 8 * c8); }
            }
            { const unsigned wsb = (unsigned)(size_t)WSb; const int q = i >> 2, p4 = i & 3;
#pragma unroll
              for (int ks = 0; ks < 4; ++ks) { const int kk0 = 128 * kh + 32 * ks;
                const bf16x8 a = *(const LAS bf16x8*)(XSb + (tt4 * 16 + i) * XROW + (kk0 + 8 * g) * 2);
                s16x4 lo4[4], hi4[4];
                tr_read4x2<32>(lo4, hi4, wsb + (kk0 + 8 * g + q) * WROW + 8 * p4, wsb + (kk0 + 8 * g + 4 + q) * WROW + 8 * p4);
#pragma unroll
                for (int nb = 0; nb < 4; ++nb) dacc[nb] = mfma16(a, TRCAT(lo4[nb], hi4[nb]), dacc[nb]); } }
            LDS_BARRIER();
        }
#pragma unroll
        for (int nb = 0; nb < 4; ++nb)
#pragma unroll
            for (int rg = 0; rg < 4; ++rg) PART[(kh * 64 + tt4 * 16 + 4 * g + rg) * 64 + 16 * nb + i] = dacc[nb][rg];
        __syncthreads();
        { const f32x4 a0 = *(const LAS f32x4*)(PART + tid * 8), a1 = *(const LAS f32x4*)(PART + tid * 8 + 4), c0 = *(const LAS f32x4*)(PART + 4096 + tid * 8), c1 = *(const LAS f32x4*)(PART + 4096 + tid * 8 + 4);
          __syncthreads();
          *(LAS f32x4*)(LG + tid * 8) = a0 + c0; *(LAS f32x4*)(LG + tid * 8 + 4) = a1 + c1; }
        if (tid < 64) { RM[(size_t)N_EXPERTS * T + tok0 + tid] = tok0 + tid; LCNT[tid] = 0; }
        __syncthreads();
#pragma unroll 1
        for (int tt = 0; tt < 8; ++tt) { const int tk = 8 * w + tt, token = tok0 + tk, e = lane;
            const float sc = 1.0f / (1.0f + expf(-LG[tk * 64 + e])); const float sel = sc + rbias[e];
            const float m1 = max8_dpp(sel);
            const unsigned long long bal = __ballot(sel == m1) & (0xFFull << (8 * (e >> 3)));
            const int first = __builtin_ctzll(bal);
            const float v2 = max8_dpp((e == first) ? -INFINITY : sel);
            const float gs = m1 + v2; int grank = 0;
#pragma unroll
            for (int gp = 0; gp < 8; ++gp) { const float o = __builtin_bit_cast(float, __builtin_amdgcn_readlane(__builtin_bit_cast(int, gs), 8 * gp)); grank += (o > gs || (o == gs && gp < (e >> 3))) ? 1 : 0; }
            const bool gsel = grank < TOPK_GROUPS; const float sel2 = gsel ? sel : -INFINITY; int rank = 0;
            const unsigned long long gbal = __ballot(gsel);
#pragma unroll 1
            for (int gp = 0; gp < 8; ++gp) { if (((gbal >> (8 * gp)) & 1ull) == 0ull) continue;
#pragma unroll
                for (int q = 0; q < 8; ++q) { const int ep = 8 * gp + q; const float o = __builtin_bit_cast(float, __builtin_amdgcn_readlane(__builtin_bit_cast(int, sel2), ep)); rank += (o > sel2 || (o == sel2 && ep < e)) ? 1 : 0; } }
            const bool chosen = gsel && rank < TOP_K;
            float wsum = 0.f; { unsigned long long cb = __ballot(chosen);
                while (cb) { const int l = __builtin_ctzll(cb); wsum += __builtin_bit_cast(float, __builtin_amdgcn_readlane(__builtin_bit_cast(int, sc), l)); cb &= cb - 1ull; } }
            if (chosen) { const int lpos = __hip_atomic_fetch_add(LCNT + e, 1, __ATOMIC_RELAXED, __HIP_MEMORY_SCOPE_WORKGROUP);
                PEL[tk * 8 + rank] = e; PLL[tk * 8 + rank] = lpos;
                PE[(size_t)token * 8 + rank] = e; PG[(size_t)token * 8 + rank] = sc / wsum * ROUTED_SCALE; }
        }
        __syncthreads();
        if (tid < 64) BASE[tid] = (int)__hip_atomic_fetch_add(cnt + tid, (unsigned)LCNT[tid], __ATOMIC_RELAXED, __HIP_MEMORY_SCOPE_AGENT);
        __syncthreads();
        { const int e = PEL[tid], pos = BASE[e] + PLL[tid], token = tok0 + (tid >> 3);
          PP[(size_t)token * 8 + (tid & 7)] = pos; RM[(size_t)e * T + pos] = token; }
        __syncthreads();
    }
}

__device__ __forceinline__ void build_toff(Frame& F, int layer) {
    LAS int* toff = (LAS int*)(F.lds + LDS_TAB);
    if (threadIdx.x < 64) {
        const GAS unsigned* cnt = F.ctl + CW_CNT + layer * 64; const int e = (int)threadIdx.x;
        const int tiles = ((int)__hip_atomic_load(cnt + e, RLX_AGENT) + 255) >> 8; int incl = tiles;
#pragma unroll
        for (int o = 1; o < 64; o <<= 1) { const int up = __shfl_up(incl, o); if (e >= o) incl += up; }
        toff[e] = incl - tiles;
        if (e == 63) { toff[N_EXPERTS] = incl; toff[NEXP1] = incl + T / 256; } }
    __syncthreads();
}

template <bool Y8, bool LAST>
__device__ __forceinline__ void combine_ln2_phase(Frame& F, int layer) {
    PHASE_ARGS(); GAS float* OUT = (GAS float*)(GAS float*)ap->out;
    const GAS bf16_t* Y = (const GAS bf16_t*)(F.ws + WS_Y); const GAS bf16_t* X1B = (const GAS bf16_t*)(F.ws + WS_X1B); GAS bf16_t* XB = (GAS bf16_t*)(F.ws + WS_XB); GAS unsigned char* XB8 = F.ws + WS_XB8;
    const GAS float* g2 = GIN(18) + (size_t)layer * D_MODEL; const GAS float* b2 = GIN(19) + (size_t)layer * D_MODEL;
    const GAS int* PE = (const GAS int*)(F.ws + WS_PE); const GAS int* PP = (const GAS int*)(F.ws + WS_PP); const GAS float* PG = (const GAS float*)(F.ws + WS_PG);
    const LAS int* toff = (const LAS int*)(F.lds + LDS_TAB);
    PHASE_IDS();
    const int gw = F.bid * 8 + w, NGW = F.G * 8;
    for (int tb = gw; tb < T; tb += 8 * NGW) {
        int myrow = 0; float mygate = 0.f;
        { const int tl = tb + (lane >> 3) * NGW; if (tl < T) { const int e = PE[(size_t)tl * 8 + (lane & 7)]; myrow = toff[e] * 256 + PP[(size_t)tl * 8 + (lane & 7)]; mygate = PG[(size_t)tl * 8 + (lane & 7)]; } }
#pragma unroll 1
      for (int tj = 0; tj < 8; ++tj) { const int t = tb + tj * NGW; if (t >= T) break;
        f32x4 a[4][2];
#pragma unroll
        for (int j = 0; j < 4; ++j) { a[j][0] = (f32x4){0.f, 0.f, 0.f, 0.f}; a[j][1] = (f32x4){0.f, 0.f, 0.f, 0.f}; }
#pragma unroll
        for (int k = 0; k < 9; ++k) { size_t row; float gt;
            if (k < 8) { row = (size_t)__shfl(myrow, tj * 8 + k); gt = __shfl(mygate, tj * 8 + k); }
            else { row = (size_t)toff[N_EXPERTS] * 256 + t; gt = 1.0f; }
            if constexpr (Y8) {
                const GAS u32x2* yp = (const GAS u32x2*)((const GAS unsigned char*)Y + row * D_MODEL) + lane;
#pragma unroll
                for (int j = 0; j < 4; ++j) { const u32x2 y = yp[64 * j];
                    const f32x2 p0 = __builtin_amdgcn_cvt_pk_f32_fp8((int)y.x, false), p1 = __builtin_amdgcn_cvt_pk_f32_fp8((int)y.x, true), p2 = __builtin_amdgcn_cvt_pk_f32_fp8((int)y.y, false), p3 = __builtin_amdgcn_cvt_pk_f32_fp8((int)y.y, true);
                    a[j][0] += (f32x4){p0[0], p0[1], p1[0], p1[1]} * gt; a[j][1] += (f32x4){p2[0], p2[1], p3[0], p3[1]} * gt; }
            } else {
            const GAS u32x4* yp = (const GAS u32x4*)(Y + row * D_MODEL) + lane;
#pragma unroll
            for (int j = 0; j < 4; ++j) { const u32x4 y = yp[64 * j];
                a[j][0] += (f32x4){bflo(y.x), bfhi(y.x), bflo(y.y), bfhi(y.y)} * gt; a[j][1] += (f32x4){bflo(y.z), bfhi(y.z), bflo(y.w), bfhi(y.w)} * gt; } } }
        float s = 0.f;
#pragma unroll
        for (int j = 0; j < 4; ++j) { const u32x4 xv = *(const GAS u32x4*)(X1B + (size_t)t * D_MODEL + 8 * lane + 512 * j);
            a[j][0] += (f32x4){bflo(xv.x), bfhi(xv.x), bflo(xv.y), bfhi(xv.y)} * DN_ALPHA; a[j][1] += (f32x4){bflo(xv.z), bfhi(xv.z), bflo(xv.w), bfhi(xv.w)} * DN_ALPHA;
            s += (a[j][0][0] + a[j][0][1]) + (a[j][0][2] + a[j][0][3]) + (a[j][1][0] + a[j][1][1]) + (a[j][1][2] + a[j][1][3]); }
        const float mean = wave_sum(s) * (1.0f / D_MODEL); float s2 = 0.f;
#pragma unroll
        for (int j = 0; j < 4; ++j) { a[j][0] = a[j][0] - mean; a[j][1] = a[j][1] - mean;
            s2 += (a[j][0][0] * a[j][0][0] + a[j][0][1] * a[j][0][1]) + (a[j][0][2] * a[j][0][2] + a[j][0][3] * a[j][0][3]) + (a[j][1][0] * a[j][1][0] + a[j][1][1] * a[j][1][1]) + (a[j][1][2] * a[j][1][2] + a[j][1][3] * a[j][1][3]); }
        const float rstd = rsqrtf(wave_sum(s2) * (1.0f / D_MODEL) + LN_EPS);
#pragma unroll
        for (int j = 0; j < 4; ++j) { const int c = 8 * lane + 512 * j;
            const f32x4 o0 = a[j][0] * rstd * *(const GAS f32x4*)(g2 + c) + *(const GAS f32x4*)(b2 + c), o1 = a[j][1] * rstd * *(const GAS f32x4*)(g2 + c + 4) + *(const GAS f32x4*)(b2 + c + 4);
            if constexpr (LAST) { *(GAS f32x4*)(OUT + (size_t)t * D_MODEL + c) = o0; *(GAS f32x4*)(OUT + (size_t)t * D_MODEL + c + 4) = o1; }
            else {
            u32x4 wv; wv.x = cvt_pk_bf16(o0[0], o0[1]); wv.y = cvt_pk_bf16(o0[2], o0[3]); wv.z = cvt_pk_bf16(o1[0], o1[1]); wv.w = cvt_pk_bf16(o1[2], o1[3]);
            *(GAS u32x4*)(XB + (size_t)t * D_MODEL + c) = wv;
            u32x2 w8; { int q = __builtin_amdgcn_cvt_pk_fp8_f32(o0[0], o0[1], 0, false); q = __builtin_amdgcn_cvt_pk_fp8_f32(o0[2], o0[3], q, true); w8.x = (unsigned)q;
                        q = __builtin_amdgcn_cvt_pk_fp8_f32(o1[0], o1[1], 0, false); q = __builtin_amdgcn_cvt_pk_fp8_f32(o1[2], o1[3], q, true); w8.y = (unsigned)q; }
            *(GAS u32x2*)(XB8 + (size_t)t * D_MODEL + c) = w8; } }
      }
    }
}

constexpr int PH_PER_LAYER = 11, N_PHASES = DEPTH * PH_PER_LAYER;
constexpr int CONV_TAIL = 2048;
constexpr bool GU8_ALL = true;
#ifndef PH_MASK
#define PH_MASK 0x7ff
#endif
#define IN(k) (((PH_MASK >> ((k) % PH_PER_LAYER)) & 1) && lo <= (k) && (k) < hi)
#ifndef PROBE_MASK
#define PROBE_MASK 0
#endif
#ifndef PROBE_AMP
#define PROBE_AMP 4
#endif
constexpr int LDS_STAMP = LDS_TAB + 1024;
#define SEAM(k) do { if (IN(k) && IN((k) + 1)) xcd_barrier(bar); \
    if (PROBE_MASK != 0 && threadIdx.x == 0) ((LAS unsigned long long*)(F0.lds + LDS_STAMP))[(k) + 1] = __builtin_amdgcn_s_memrealtime(); } while (0)
#define PHASE_FRAME() Frame F = F0; asm volatile("" : "+s"(F.ws), "+s"(F.ctl), "+s"(F.G), "+s"(F.bid), "+s"(F.lds)); \
    F.ws = (GAS unsigned char*)(GAS unsigned char*)F.ws; F.ctl = (GAS unsigned*)(GAS unsigned*)F.ctl;     \
    GAS unsigned char* ws = F.ws; (void)ws
template <int layer>
__device__ __forceinline__ void run_layer(const Frame& F0, const XcdBarrier& bar, const int lo, const int hi) {
        const int pb = layer * PH_PER_LAYER;
        constexpr bool GU8 = (layer == DEPTH - 1) || GU8_ALL;
        constexpr bool MOE8 = (layer == DEPTH - 1);
        if constexpr (layer == 0) { if (IN(pb + 0)) { PHASE_FRAME(); p0_convert(F, layer, GU8, MOE8, 1); } }
        SEAM(pb + 0);
        if (IN(pb + 1)) { PHASE_FRAME();
            EpiIn E{(GAS bf16_t*)(ws + WS_H), (GAS _Float16*)(ws + WS_LF), (const GAS float*)(ws + WS_LB) + layer * HG_WIDTH, (const GAS f32x4*)(ws + WS_ROPE)};
            DenseSched Sa{(const GAS char*)(ws + WS_XB), (const GAS char*)(ws + WS_WINF) - (size_t)C_HF * (D_MODEL * 2), D_MODEL * 2, D_MODEL * 2, D_MODEL / 64, T / 256, HG_WIDTH / 256, F.G, F.bid, 0, C_HF / 256};
            pg8::gemm_phase<EpiIn, DenseSched, false, false, true>(F.lds, Sa, E);
            DenseSched Sb{(const GAS char*)(ws + WS_XB8), (const GAS char*)(ws + WS_WIN), D_MODEL, D_MODEL, D_MODEL / 128, T / 256, (IN_WIDTH - HG_WIDTH) / 256, F.G, F.bid, C_HF / 256, HG_WIDTH / 256};
            if constexpr (layer == 0) {
                const long ntile = (long)Sb.nM * Sb.nN; const int nun = (int)((ntile - F.bid + F.G - 1) / F.G);
                const int ks = __builtin_amdgcn_readfirstlane(((F.bid & 7) * (nun + 1)) >> 3);
#pragma unroll 1
                for (int part = 0; part < 2; ++part) {
                    pg8::RangeSched<DenseSched> RS{Sb, part == 0 ? 0 : ks, part == 0 ? ks : (1 << 30)};
                    pg8::gemm_phase<EpiIn, pg8::RangeSched<DenseSched>, false, true, true>(F.lds, RS, E);
                    if (part == 0) p0_convert(F, layer, GU8, MOE8, 2, CONV_TAIL);
                }
                p0_convert(F, layer, GU8, MOE8, 2, CONV_TAIL, F.ctl + CW_CQ);
            } else pg8::gemm_phase<EpiIn, DenseSched, false, true, true>(F.lds, Sb, E);
        }
        SEAM(pb + 1);
        if (IN(pb + 2)) { PHASE_FRAME();
            { PHASE_IDS(); H1Regs ra, rb; int it = F.bid;
              if (it < NCHUNK * HG_HEADS) h1_load(F, it, tid, ra);
              for (; it < NCHUNK * HG_HEADS; it += F.G) { const int itn = it + F.G; if (itn < NCHUNK * HG_HEADS) h1_load(F, itn, tid, rb); h1_item(F, it, tid, ra); ra = rb; } }
            { constexpr int NAI = BATCH * ATT_HEADS * 16; const int nb = F.G >> 3, x = F.bid & 7, lb = F.bid >> 3;
              if ((F.G & 7) == 0 && NAI % 8 == 0) { for (int k = lb; k < NAI / 8; k += nb) { const int hh = k >> 4, jj = ((k & 15) + hh) & 15;
                  attn_item(F, x * (NAI / 8) + hh * 16 + jj); } }
              else { for (int it = F.bid; it < NAI; it += F.G) attn_item(F, it); } }
        }
        SEAM(pb + 2);
        if (IN(pb + 3)) { PHASE_FRAME();
            for (int it = F.bid; it < BATCH * HG_HEADS * 4; it += F.G) scan_item(F, it);
            attn_merge(F);
        }
        SEAM(pb + 3);
        if (IN(pb + 4)) { PHASE_FRAME();
            PHASE_ARGS(); const GAS float* normg = GIN(4) + (size_t)layer * HG_WIDTH;
            { PHASE_IDS(); H3Regs ra, rb; int it = F.bid;
              if (it < NCHUNK * HG_HEADS) h3_load(F, it, tid, ra);
              for (; it < NCHUNK * HG_HEADS; it += F.G) { const int itn = it + F.G; if (itn < NCHUNK * HG_HEADS) h3_load(F, itn, tid, rb); h3_item(F, it, normg, tid, ra); ra = rb; } }
        }
        SEAM(pb + 4);
        if (IN(pb + 5)) { PHASE_FRAME();
            MergeSched S{(const GAS char*)(ws + WS_HGO), (const GAS char*)(ws + WS_WHG), (const GAS char*)(ws + WS_ATTO), (const GAS char*)(ws + WS_WATT), T / 256, D_MODEL / 256, F.G, F.bid};
            EpiMerge E{(const GAS bf16_t*)(ws + WS_H), (GAS bf16_t*)(ws + WS_MRG)};
            pg8::gemm_phase<EpiMerge, MergeSched, false>(F.lds, S, E);
        }
        SEAM(pb + 5);
        if (IN(pb + 6)) { PHASE_FRAME();
            DenseSched S{(const GAS char*)(ws + WS_MRG), (const GAS char*)(ws + WS_WOUT), D_MODEL, D_MODEL, D_MODEL / 128, T / 256, D_MODEL / 256, F.G, F.bid, 1 << 30, 0};
            PHASE_ARGS(); EpiResid E{(const GAS bf16_t*)(ws + WS_XB), (GAS bf16_t*)(ws + WS_R)};
            pg8::gemm_phase<EpiResid, DenseSched, false, true, true>(F.lds, S, E);
        }
        SEAM(pb + 6);
        if (IN(pb + 7)) { PHASE_FRAME(); ln_router_phase<GU8>(F, layer); }
        SEAM(pb + 7);
        if (IN(pb + 8)) { PHASE_FRAME();
            build_toff(F, layer);
            {
                typedef MoeSched<4, true, GU8 ? 1 : 2> SchedT;
                SchedT S{(const LAS int*)(F.lds + LDS_TAB), F.ctl + CW_CNT + layer * 64, (const GAS char*)(ws + (GU8 ? WS_X1B8 : WS_X1B)), (const GAS char*)(ws + (MOE8 ? WS_WGU8 : WS_WGU)), (const GAS int*)(ws + WS_RM), F.G, F.bid, (const LAS int*)(F.lds + LDS_EPI), (const LAS int*)(F.lds + LDS_TAB + 512)}; S.build_units((LAS int*)(F.lds + LDS_TAB + 512));
                EpiGateUp<true> E{(GAS bf16_t*)(ws + WS_HID)};
                if constexpr (layer + 1 < DEPTH) {
                    int nun = 0; { const LAS int* ut = (const LAS int*)(F.lds + LDS_TAB + 512); for (int i = 0; i < 32; ++i) nun += ut[i * 4 + 3]; }
                    const int ks = __builtin_amdgcn_readfirstlane(((F.bid & 7) * (nun + 1)) >> 3);
#pragma unroll 1
                    for (int part = 0; part < 2; ++part) {
                        pg8::RangeSched<SchedT> RS{S, part == 0 ? 0 : ks, part == 0 ? ks : (1 << 30)};
                        pg8::gemm_phase<EpiGateUp<true>, pg8::RangeSched<SchedT>, true, GU8>(F.lds, RS, E);
                        if (part == 0) p0_convert(F, layer + 1, (layer + 1 == DEPTH - 1) || GU8_ALL, layer + 1 == DEPTH - 1, 0, CONV_TAIL);
                    }
                    p0_convert(F, layer + 1, (layer + 1 == DEPTH - 1) || GU8_ALL, layer + 1 == DEPTH - 1, 0, CONV_TAIL, F.ctl + CW_CQ + 64);
                } else pg8::gemm_phase<EpiGateUp<true>, SchedT, true, GU8>(F.lds, S, E);
            }
        }
        SEAM(pb + 8);
        if (IN(pb + 9)) { PHASE_FRAME();
            build_toff(F, layer);
            {
                EpiDown<true> E{(GAS bf16_t*)(ws + WS_Y)};
                MoeSched<8, false, 1> S{(const LAS int*)(F.lds + LDS_TAB), F.ctl + CW_CNT + layer * 64, (const GAS char*)(ws + WS_HID), (const GAS char*)(ws + (MOE8 ? WS_WDN8 : WS_WDN)), nullptr, F.G, F.bid, nullptr, (const LAS int*)(F.lds + LDS_TAB + 512)}; S.build_units((LAS int*)(F.lds + LDS_TAB + 512));
                pg8::gemm_phase<EpiDown<true>, MoeSched<8, false, 1>, false, true, true>(F.lds, S, E);
            }
        }
        SEAM(pb + 9);
        if (IN(pb + 10)) { PHASE_FRAME(); build_toff(F, layer); combine_ln2_phase<true, layer == DEPTH - 1>(F, layer); }
        if constexpr (layer == DEPTH - 1) { SEAM(pb + 10); } else { if (PROBE_MASK != 0 && threadIdx.x == 0) ((LAS unsigned long long*)(F0.lds + LDS_STAMP))[pb + 11] = __builtin_amdgcn_s_memrealtime(); }
}
#undef IN
#undef SEAM
__global__ void __launch_bounds__(512, 2) kfwd(Args args) {
    extern __shared__ __attribute__((aligned(16))) unsigned char lds_raw[];
    Frame F0;
    F0.lds = (LAS unsigned char*)lds_raw;
    F0.G = gridDim.x; F0.bid = blockIdx.x; F0.ws = (GAS unsigned char*)args.ws; F0.ctl = (GAS unsigned*)(args.ws + WS_CTL);
    for (int u = threadIdx.x; u < (LDS_BYTES - LDS_TAB) / 4; u += 512) ((LAS unsigned*)(F0.lds + LDS_TAB))[u] = 0u;
    __syncthreads();
    XcdBarrier bar = xcd_barrier_post((unsigned*)(F0.ctl + CW_BAR), (volatile LAS unsigned*)(F0.lds + LDS_MISC));
    const int lo = args.ph_lo, hi = args.ph_hi;
    if (PROBE_MASK != 0 && threadIdx.x == 0) ((LAS unsigned long long*)(F0.lds + LDS_STAMP))[0] = __builtin_amdgcn_s_memrealtime();
    run_layer<0>(F0, bar, lo, hi);
    run_layer<1>(F0, bar, lo, hi);
    if (PROBE_MASK != 0 && blockIdx.x == 0 && threadIdx.x == 0) {
        const LAS unsigned long long* ts = (const LAS unsigned long long*)(F0.lds + LDS_STAMP); unsigned long long tot = 0;
        for (int k = 0; k < N_PHASES; ++k) if ((PROBE_MASK >> (k % PH_PER_LAYER)) & 1) tot += ts[k + 1] - ts[k];
        const unsigned long long t0 = __builtin_amdgcn_s_memrealtime(), lim = tot * PROBE_AMP < 4000000ull ? tot * PROBE_AMP : 4000000ull;
        while (__builtin_amdgcn_s_memrealtime() - t0 < lim) __builtin_amdgcn_s_sleep(32);
    }
}

extern "C" void kernel_launch(void* const* d_in, const int* in_sizes, int n_in, void* d_out, int out_size, void* d_ws, size_t ws_size, hipStream_t stream) {
    static int grid = 0;
    if (grid == 0) {
        if (n_in != 20 || out_size != T * D_MODEL || ws_size < WS_END) { fprintf(stderr, "kernel_launch: unexpected shapes (n_in %d, out %d, ws %zu < %zu)\n", n_in, out_size, ws_size, (size_t)WS_END); grid = -1; return; }
        int dev = 0, cus = 0, per_cu = 0;
        if (hipGetDevice(&dev) != hipSuccess || hipDeviceGetAttribute(&cus, hipDeviceAttributeMultiprocessorCount, dev) != hipSuccess) { grid = -1; return; }
        if (hipFuncSetAttribute((const void*)kfwd, hipFuncAttributeMaxDynamicSharedMemorySize, LDS_BYTES) != hipSuccess) { fprintf(stderr, "kernel_launch: hipFuncSetAttribute failed\n"); grid = -1; return; }
        if (hipOccupancyMaxActiveBlocksPerMultiprocessor(&per_cu, (const void*)kfwd, 512, LDS_BYTES) != hipSuccess || per_cu < 1) fprintf(stderr, "kernel_launch: occupancy query says %d\n", per_cu);
        (void)hipGetLastError();
        grid = cus;
    }
    if (grid < 0) return;
    if (hipMemsetAsync((char*)d_ws + WS_CTL, 0, CTL_ZERO_BYTES, stream) != hipSuccess) return;
    Args a{};
    for (int i = 0; i < 20; ++i) a.in[i] = (const float*)d_in[i];
    a.out = (float*)d_out; a.ws = (unsigned char*)d_ws;
#if MK_LAUNCH_PER_PHASE
    for (int p = 0; p < N_PHASES; ++p) { a.ph_lo = p; a.ph_hi = p + 1; hipLaunchKernelGGL(kfwd, dim3(grid), dim3(512), LDS_BYTES, stream, a); }
#else
    a.ph_lo = 0; a.ph_hi = N_PHASES; hipLaunchKernelGGL(kfwd, dim3(grid), dim3(512), LDS_BYTES, stream, a);
#endif
}
```

```cpp
#include <hip/hip_runtime.h>
#include <cstdio>
#include <cstdint>

#ifndef MK_LAUNCH_PER_PHASE
#define MK_LAUNCH_PER_PHASE 0
#endif

#define GAS __attribute__((address_space(1)))
#define LAS __attribute__((address_space(3)))
typedef unsigned short bf16_t;
typedef short bf16x8 __attribute__((ext_vector_type(8)));
typedef short s16x4 __attribute__((ext_vector_type(4)));
typedef float f32x4 __attribute__((ext_vector_type(4)));
typedef float f32x2 __attribute__((ext_vector_type(2)));
typedef unsigned u32x4 __attribute__((ext_vector_type(4)));
typedef unsigned u32x2 __attribute__((ext_vector_type(2)));
typedef _Float16 f16x8 __attribute__((ext_vector_type(8)));

constexpr int D_MODEL = 2048, BATCH = 8, SEQ = 2048, DEPTH = 2, T = BATCH * SEQ;
constexpr int HG_HEADS = 8, HG_DIM = 128, HG_WIDTH = 1024, HG_CHUNK = 64, NCHUNK = T / HG_CHUNK;
constexpr int ATT_HEADS = 12, ATT_DIM = 128, ATT_WIDTH = 1536, ATT_OUT = 512;
constexpr int N_EXPERTS = 64, N_GROUPS = 8, TOPK_GROUPS = 4, TOP_K = 8, EXPERT_FF = 512;
constexpr int IN_WIDTH = 12800;
constexpr int C_HQ = 0, C_HF = 1024, C_HI = 2048, C_HGATE = 3072, C_AQ = 4096, C_AK = 5632, C_AV = 7168, C_GH = 8704, C_GA = 10752;
constexpr float ROUTED_SCALE = 2.5f, LN_EPS = 1e-5f, NORM_EPS = 1e-6f;
constexpr float DN_ALPHA = 1.41421356237309515f;
#define HOFF(c, row) (((size_t)((c) >> 7) * T + (size_t)(row)) * 128 + ((c) & 127))
constexpr int NEXP1 = N_EXPERTS + 1;
constexpr int MAXROWS = 163840;

constexpr size_t MiB = 1u << 20;
constexpr size_t WS_CTL = 0, CTL_ZERO_BYTES = 1 * MiB;
constexpr size_t WS_WIN = 4 * MiB;
constexpr size_t WS_WHG = 54 * MiB;
constexpr size_t WS_WATT = 58 * MiB;
constexpr size_t WS_WOUT = 60 * MiB;
constexpr size_t WS_WGU = 68 * MiB;
constexpr size_t WS_WDN = 328 * MiB;
constexpr size_t WS_ROPE = 458 * MiB;
constexpr size_t WS_LB = 466 * MiB;
constexpr size_t WS_R = 467 * MiB;
constexpr size_t WS_X1 = 595 * MiB;
constexpr size_t WS_XB = 723 * MiB;
constexpr size_t WS_X1B = 787 * MiB;
constexpr size_t WS_PE = 851 * MiB;
constexpr size_t WS_PP = 852 * MiB;
constexpr size_t WS_PG = 853 * MiB;
constexpr size_t WS_RM = 854 * MiB;
constexpr size_t WS_HID = 859 * MiB;
constexpr size_t WS_BIG = 1019 * MiB;
constexpr size_t WS_H = WS_BIG;
constexpr size_t WS_LF = WS_BIG + 400 * MiB;
constexpr size_t WS_UT = WS_BIG + 464 * MiB;
constexpr size_t WS_SPT = WS_BIG + 592 * MiB;
constexpr size_t WS_DEC = WS_BIG + 656 * MiB;
constexpr size_t WS_LSE = WS_BIG + 657 * MiB;
constexpr size_t WS_HGO = WS_BIG + 658 * MiB;
constexpr size_t WS_ATTO = WS_BIG + 690 * MiB;
constexpr size_t WS_MRG = WS_BIG + 706 * MiB;
constexpr size_t WS_Y = WS_BIG;
constexpr size_t WS_XB8 = WS_BIG + 772 * MiB;
constexpr size_t WS_WINF = WS_WIN + 30 * MiB;
constexpr size_t WS_X1B8 = WS_BIG + 804 * MiB;
constexpr size_t WS_WGU8 = 531 * MiB;
constexpr size_t WS_WDN8 = WS_BIG + 836 * MiB;
constexpr size_t WS_END = WS_BIG + 901 * MiB;
constexpr int CW_TMO = 0;
constexpr int CW_CNT = 1024;
constexpr int CW_CQ = 2048;
constexpr int CW_BAR = 4096;

constexpr int LDS_BYTES = 159744;
constexpr int LDS_EPI = 131072;
constexpr int LDS_TAB = 147456;
constexpr int LDS_MISC = LDS_TAB + 2048;

#define RLX_AGENT __ATOMIC_RELAXED, __HIP_MEMORY_SCOPE_AGENT
#define LDS_WAIT() asm volatile("s_waitcnt lgkmcnt(0)" ::: "memory")
#define VM_WAIT() asm volatile("s_waitcnt vmcnt(0)" ::: "memory")
#define LDS_BARRIER() asm volatile("s_waitcnt lgkmcnt(0)\n\ts_barrier" ::: "memory")
__device__ __forceinline__ unsigned f2bf(float f) { unsigned u = __builtin_bit_cast(unsigned, f); return (u + 0x7fffu + ((u >> 16) & 1u)) >> 16; }
__device__ __forceinline__ unsigned pk2(float lo, float hi) { return f2bf(lo) | (f2bf(hi) << 16); }
__device__ __forceinline__ float bf2f(unsigned short b) { return __builtin_bit_cast(float, ((unsigned)b) << 16); }
__device__ __forceinline__ float bflo(unsigned w) { return __builtin_bit_cast(float, w << 16); }
__device__ __forceinline__ float bfhi(unsigned w) { return __builtin_bit_cast(float, w & 0xffff0000u); }
__device__ __forceinline__ unsigned cvt_pk_bf16(float lo, float hi) { unsigned r; asm volatile("v_cvt_pk_bf16_f32 %0, %1, %2" : "=v"(r) : "v"(lo), "v"(hi)); return r; }
__device__ __forceinline__ float fdiv(float a, float b) { return a * __builtin_amdgcn_rcpf(b); }
__device__ __forceinline__ float fsigmoid(float x) { return __builtin_amdgcn_rcpf(1.0f + __expf(-x)); }
__device__ __forceinline__ float wave_sum(float v) {
#pragma unroll
    for (int o = 1; o < 64; o <<= 1) v += __shfl_xor(v, o);
    return v;
}
__device__ __forceinline__ float max8_dpp(float v) {
    v = fmaxf(v, __builtin_bit_cast(float, __builtin_amdgcn_update_dpp(0, __builtin_bit_cast(int, v), 0xB1, 0xF, 0xF, false)));
    v = fmaxf(v, __builtin_bit_cast(float, __builtin_amdgcn_update_dpp(0, __builtin_bit_cast(int, v), 0x4E, 0xF, 0xF, false)));
    v = fmaxf(v, __builtin_bit_cast(float, __builtin_amdgcn_update_dpp(0, __builtin_bit_cast(int, v), 0x141, 0xF, 0xF, false)));
    return v;
}
__device__ __forceinline__ f32x4 mfma16(bf16x8 a, bf16x8 b, f32x4 c) { return __builtin_amdgcn_mfma_f32_16x16x32_bf16(a, b, c, 0, 0, 0); }
__device__ __forceinline__ s16x4 tr_read(unsigned lds_addr) { s16x4 r; asm volatile("ds_read_b64_tr_b16 %0, %1\n\ts_waitcnt lgkmcnt(0)" : "=&v"(r) : "v"(lds_addr) : "memory"); return r; }

template <int STRIDE> __device__ __forceinline__ void tr_read8(s16x4 (&r)[8], unsigned a) {
    asm volatile("ds_read_b64_tr_b16 %0, %8\n\tds_read_b64_tr_b16 %1, %8 offset:%9\n\tds_read_b64_tr_b16 %2, %8 offset:%10\n\tds_read_b64_tr_b16 %3, %8 offset:%11\n\t"
                 "ds_read_b64_tr_b16 %4, %8 offset:%12\n\tds_read_b64_tr_b16 %5, %8 offset:%13\n\tds_read_b64_tr_b16 %6, %8 offset:%14\n\tds_read_b64_tr_b16 %7, %8 offset:%15\n\ts_waitcnt lgkmcnt(0)"
                 : "=&v"(r[0]), "=&v"(r[1]), "=&v"(r[2]), "=&v"(r[3]), "=&v"(r[4]), "=&v"(r[5]), "=&v"(r[6]), "=&v"(r[7])
                 : "v"(a), "i"(STRIDE), "i"(2 * STRIDE), "i"(3 * STRIDE), "i"(4 * STRIDE), "i"(5 * STRIDE), "i"(6 * STRIDE), "i"(7 * STRIDE) : "memory");
}
template <int STRIDE> __device__ __forceinline__ void tr_read4x2(s16x4 (&r0)[4], s16x4 (&r1)[4], unsigned a0, unsigned a1) {
    asm volatile("ds_read_b64_tr_b16 %0, %8\n\tds_read_b64_tr_b16 %1, %8 offset:%10\n\tds_read_b64_tr_b16 %2, %8 offset:%11\n\tds_read_b64_tr_b16 %3, %8 offset:%12\n\t"
                 "ds_read_b64_tr_b16 %4, %9\n\tds_read_b64_tr_b16 %5, %9 offset:%10\n\tds_read_b64_tr_b16 %6, %9 offset:%11\n\tds_read_b64_tr_b16 %7, %9 offset:%12\n\ts_waitcnt lgkmcnt(0)"
                 : "=&v"(r0[0]), "=&v"(r0[1]), "=&v"(r0[2]), "=&v"(r0[3]), "=&v"(r1[0]), "=&v"(r1[1]), "=&v"(r1[2]), "=&v"(r1[3])
                 : "v"(a0), "v"(a1), "i"(STRIDE), "i"(2 * STRIDE), "i"(3 * STRIDE) : "memory");
}
#define TRCAT(lo, hi) ((bf16x8){(lo)[0], (lo)[1], (lo)[2], (lo)[3], (hi)[0], (hi)[1], (hi)[2], (hi)[3]})
#define XB_TMO      128
#define XB_XCNT(j)  (256  + 64 * (j))
#define XB_XSUB(j)  (1280 + 64 * (j))
#define XB_XGEN(j)  (2304 + 64 * (j))
#define XB_TOP      3328
#define XB_TOPGEN   3392
#define XCD_BAR_WORDS 3456
#define XB_SPIN_CAP (1u << 18)
__device__ __forceinline__ unsigned xb_ld(unsigned* p)              { return __hip_atomic_load(p, __ATOMIC_RELAXED, __HIP_MEMORY_SCOPE_AGENT); }
__device__ __forceinline__ unsigned xb_add(unsigned* p, unsigned v) { return __hip_atomic_fetch_add(p, v, __ATOMIC_RELAXED, __HIP_MEMORY_SCOPE_AGENT); }
__device__ __forceinline__ unsigned xb_xcc_id() { return (unsigned)__builtin_amdgcn_s_getreg((3 << 11) | 20) & 0xFu; }
#define XB_SPIN(cond, bar) do { unsigned _sp = 0; while (cond) { __builtin_amdgcn_s_sleep(1); \
    if ((++_sp & 255u) == 0u) { if (xb_ld(&(bar)[XB_TMO])) break; if (_sp > XB_SPIN_CAP) { atomicAdd(&(bar)[XB_TMO], 1u); break; } } } } while (0)
struct XcdBarrier { unsigned* bar; unsigned x; volatile LAS unsigned* st; };
__device__ __forceinline__ XcdBarrier xcd_barrier_post(unsigned* bar, volatile LAS unsigned* st) {
    XcdBarrier b; b.bar = bar; b.x = xb_xcc_id(); b.st = st;
    if (threadIdx.x == 0) (void)xb_add(&bar[XB_XCNT(b.x)], 1u);
    return b;
}
__device__ __forceinline__ void xcd_barrier_complete(unsigned* bar, unsigned x, unsigned& nloc, unsigned& nx) {
    const unsigned G = gridDim.x * gridDim.y * gridDim.z;
    unsigned sum, cnt, mine, sp = 0u;
    for (;;) {
        sum = 0u; cnt = 0u; mine = 0u;
#pragma unroll
        for (unsigned j = 0; j < 16; ++j) { const unsigned c = xb_ld(&bar[XB_XCNT(j)]); sum += c; cnt += (c > 0u) ? 1u : 0u; mine = (j == x) ? c : mine; }
        if (sum == G) break;
        __builtin_amdgcn_s_sleep(1);
        if ((++sp & 255u) == 0u) { if (xb_ld(&bar[XB_TMO])) break; if (sp > XB_SPIN_CAP) { atomicAdd(&bar[XB_TMO], 1u); break; } }
    }
    nloc = mine > 0u ? mine : 1u; nx = cnt > 0u ? cnt : 1u;
}
__device__ __forceinline__ void xcd_barrier(const XcdBarrier& b) {
    asm volatile("s_waitcnt vmcnt(0)" ::: "memory");
    __syncthreads();
    if (threadIdx.x == 0) {
        unsigned* bar = b.bar;
        __builtin_amdgcn_s_waitcnt(0);
        unsigned nloc = b.st[0], nx = b.st[1];
        if (nloc == 0u) { xcd_barrier_complete(bar, b.x, nloc, nx); b.st[0] = nloc; b.st[1] = nx; }
        const unsigned old = xb_add(&bar[XB_XSUB(b.x)], 1u);
        const unsigned gen = old / nloc;
        if (old + 1u == (gen + 1u) * nloc) {
            __builtin_amdgcn_fence(__ATOMIC_RELEASE, "agent");
            asm volatile("s_waitcnt vmcnt(0)" ::: "memory");
            const unsigned og = xb_add(&bar[XB_TOP], 1u);
            const unsigned tg = og / nx;
            if (og + 1u == (tg + 1u) * nx) xb_add(&bar[XB_TOPGEN], 1u);
            else XB_SPIN(xb_ld(&bar[XB_TOPGEN]) == tg, bar);
            __builtin_amdgcn_fence(__ATOMIC_ACQUIRE, "agent");
            xb_add(&bar[XB_XGEN(b.x)], 1u);
            asm volatile("s_waitcnt vmcnt(0)" ::: "memory");
        } else {
            XB_SPIN(xb_ld(&bar[XB_XGEN(b.x)]) == gen, bar);
            __builtin_amdgcn_fence(__ATOMIC_ACQUIRE, "agent");
            asm volatile("s_waitcnt vmcnt(0)" ::: "memory");
        }
    }
    __syncthreads();
}

namespace pg8 {
constexpr int BM = 256, BK = 64, HALF = 128, HTB = HALF * BK * 2, STAGE_BYTES = 8 * HTB, NXCD = 8, WGM = 8;
__host__ __device__ __forceinline__ int lds_byte(int r, int c) { const int st = (r >> 4) * 2 + (c >> 5), rr = r & 15, cc = c & 31, ob = rr * 64 + cc * 2; return st * 1024 + (ob ^ (((ob >> 9) & 1) << 5)); }
__host__ __device__ __forceinline__ void stage_rc(int b, int& R, int& C) { const int st = b / 1024, sb = b % 1024, swz = sb ^ (((sb >> 9) & 1) << 5); R = (st >> 1) * 16 + swz / 64; C = (st & 1) * 32 + (swz % 64) / 2; }
__host__ __device__ __forceinline__ int perm32(int rho) { const int n = rho >> 4, i = rho & 15; return 8 * (i >> 2) + 4 * n + (i & 3); }

struct Unit {
    const GAS char* a; const GAS char* b; int lda, ldb, nt;
    int row0, col0, aux;
    const GAS int* gidx; int gcnt;
    const LAS int* gl;
};

template <class S> struct RangeSched { const S& s; int lo, hi; __device__ __forceinline__ bool next(int i, Unit& u) const { return (lo + i < hi) && s.next(lo + i, u); } };

__device__ __forceinline__ void tile_of(int L, int nM, int nN, int& pm, int& pn) {
    const int nwg = nM * nN; int wgid = L;
    { const int q = nwg / NXCD, r = nwg % NXCD, xcd = wgid % NXCD, off = wgid / NXCD; wgid = (xcd < r ? xcd * (q + 1) : r * (q + 1) + (xcd - r) * q) + off; }
    const int nig = WGM * nN, gid = wgid / nig, fm = gid * WGM, gsz = (nM - fm) < WGM ? (nM - fm) : WGM;
    pm = fm + ((wgid % nig) % gsz); pn = (wgid % nig) / gsz;
}

typedef int i32x8 __attribute__((ext_vector_type(8)));
typedef int i32x4v __attribute__((ext_vector_type(4)));
template <class Epi, class Sched, bool GATHER, bool FP8 = false, bool UNI = false>
__device__ __forceinline__ void gemm_phase(LAS unsigned char* lds, const Sched& S, const Epi& E) {
    int tid = threadIdx.x; asm volatile("" : "+v"(tid));
    const int wid = __builtin_amdgcn_readfirstlane(tid >> 6), lane = tid & 63, wr = wid >> 2, wc = wid & 3, fr = lane & 15, fq = lane >> 4;
    int sR[2], sC2[2], sRb[2];
#pragma unroll
    for (int i = 0; i < 2; ++i) { int R, C; stage_rc(tid * 16 + i * 8192, R, C); sR[i] = R; sC2[i] = C * 2; sRb[i] = Epi::WIDE ? (64 * (R >> 5) + perm32(R & 31)) : (Epi::PERM ? ((R & ~31) + perm32(R & 31)) : R); }
    const unsigned ldsw = (unsigned)wid * 1024u;
    const int aoff = lds_byte(wr * 64 + fr, fq * 8), boff = lds_byte(wc * 32 + fr, fq * 8);
    const int sclw = 0x79, scla = 0x7f;
    const int aoff8[2] = {lds_byte(wr * 64 + fr, fq * 16), lds_byte(wr * 64 + fr, fq * 16 + 8)}, boff8[2] = {lds_byte(wc * 32 + fr, fq * 16), lds_byte(wc * 32 + fr, fq * 16 + 8)};
#define PG8_SA(b, h) (((b) * 2 + (h)) * HTB)
#define PG8_SB(b, h) ((4 + (b) * 2 + (h)) * HTB)
#define PG8_STAGE(bufoff, gbase, voff) do { _Pragma("unroll") for (int _i = 0; _i < 2; ++_i) \
        __builtin_amdgcn_global_load_lds((const GAS unsigned*)((const GAS char*)(gbase) + (voff)[_i]), (LAS unsigned*)(lds + (bufoff) + ldsw + _i * 8192), 16, 0, 0); } while (0)
#define PG8_LDA(dst, b, h) do { _Pragma("unroll") for (int m = 0; m < 4; ++m) { dst[m].lo = *(const LAS i32x4v*)(lds + PG8_SA(b, h) + (FP8 ? aoff8[0] : aoff) + m * 2048); dst[m].hi = *(const LAS i32x4v*)(lds + PG8_SA(b, h) + (FP8 ? aoff8[1] : aoff + 1024) + m * 2048); } } while (0)
#define PG8_LDB(dst, b, h) do { _Pragma("unroll") for (int n = 0; n < 2; ++n) { dst[n].lo = *(const LAS i32x4v*)(lds + PG8_SB(b, h) + (FP8 ? boff8[0] : boff) + n * 2048); dst[n].hi = *(const LAS i32x4v*)(lds + PG8_SB(b, h) + (FP8 ? boff8[1] : boff + 1024) + n * 2048); } } while (0)
#define PG8_BF(x) __builtin_bit_cast(bf16x8, (i32x4v)(x))
#define PG8_MMA(ai, bj, At, Bt) do { __builtin_amdgcn_s_setprio(1); _Pragma("unroll") for (int m = 0; m < 4; ++m) _Pragma("unroll") for (int n = 0; n < 2; ++n) { \
        if constexpr (FP8) { asm volatile("v_mfma_scale_f32_16x16x128_f8f6f4 %0, %1, %2, %0, %3, %4 op_sel_hi:[0,0,0]" : "+v"(acc[ai][bj][m][n]) : "v"(Bt[n]), "v"(At[m]), "v"(sclw), "v"(scla)); } \
        else { acc[ai][bj][m][n] = __builtin_amdgcn_mfma_f32_16x16x32_bf16(PG8_BF(Bt[n].lo), PG8_BF(At[m].lo), acc[ai][bj][m][n], 0, 0, 0); \
               acc[ai][bj][m][n] = __builtin_amdgcn_mfma_f32_16x16x32_bf16(PG8_BF(Bt[n].hi), PG8_BF(At[m].hi), acc[ai][bj][m][n], 0, 0, 0); } } \
        __builtin_amdgcn_s_setprio(0); } while (0)
#define PG8_WAIT_V(n) asm volatile("s_waitcnt vmcnt(" #n ")" ::: "memory")
#define PG8_WAIT_L(n) asm volatile("s_waitcnt lgkmcnt(" #n ")" ::: "memory")
#define PG8_BAR __builtin_amdgcn_s_barrier()
#define PG8_SCHED __builtin_amdgcn_sched_barrier(0)
#define PG8_OFFS(u, ao, bo) do { _Pragma("unroll") for (int _i = 0; _i < 2; ++_i) { (bo)[_i] = (unsigned)(sRb[_i] * (u).ldb + sC2[_i]); \
        _Pragma("unroll") for (int _h = 0; _h < 2; ++_h) { int _r = _h * HALF + sR[_i]; if (GATHER) { _r = (u).gl ? (u).gl[_r] : ((_r < (u).gcnt) ? (u).gidx[_r] : 0); } (ao)[_h][_i] = (unsigned)(_r * (u).lda + sC2[_i]); } } } while (0)
    Unit cur, nxt; int ui = 0;
    if (!S.next(0, cur)) return;
    f32x4 acc[2][2][4][2];
#pragma unroll
    for (int a = 0; a < 2; ++a)
#pragma unroll
        for (int b = 0; b < 2; ++b)
#pragma unroll
            for (int m = 0; m < 4; ++m)
#pragma unroll
                for (int n = 0; n < 2; ++n) acc[a][b][m][n] = (f32x4){0.f, 0.f, 0.f, 0.f};
    i32x8 At[4], B0[2], B1[2];
    unsigned aoc[2][2], boc[2], aon[2][2], bon[2];
    PG8_OFFS(cur, aoc, boc);
    {
        const GAS char* cA = cur.a; const GAS char* cB = cur.b; const size_t hB = (size_t)(Epi::WIDE ? 32 : HALF) * cur.ldb;
        PG8_STAGE(PG8_SB(0, 0), cB, boc); PG8_STAGE(PG8_SB(0, 1), cB + hB, boc); PG8_STAGE(PG8_SA(0, 0), cA, aoc[0]); PG8_STAGE(PG8_SA(0, 1), cA, aoc[1]);
        if (wr == 1) PG8_BAR;
        PG8_WAIT_V(2); PG8_BAR;
        PG8_STAGE(PG8_SB(1, 0), cB + 128, boc); PG8_STAGE(PG8_SA(1, 0), cA + 128, aoc[0]); PG8_STAGE(PG8_SB(1, 1), cB + hB + 128, boc);
        PG8_WAIT_V(6); PG8_BAR;
    }
    for (;;) {
        const bool has_next = S.next(ui + 1, nxt);
        if constexpr (UNI) { if (!has_next) nxt = cur; }
        else { if (has_next) { PG8_OFFS(nxt, aon, bon); }
          else { nxt = cur;
#pragma unroll
            for (int i = 0; i < 2; ++i) { bon[i] = boc[i]; aon[0][i] = aoc[0][i]; aon[1][i] = aoc[1][i]; } } }
        const GAS char* cA = cur.a; const GAS char* cB = cur.b; const GAS char* nA = nxt.a; const GAS char* nB = nxt.b;
        const size_t hBc = (size_t)(Epi::WIDE ? 32 : HALF) * cur.ldb, hBn = (size_t)(Epi::WIDE ? 32 : HALF) * nxt.ldb;
        const int nt = cur.nt;
        for (int t = 0; t < nt; t += 2) {
            const bool last = (t == nt - 2);
            const GAS char* a1 = cA + (size_t)(t + 1) * 128;
            const GAS char* a2 = last ? nA : cA + (size_t)(t + 2) * 128; const GAS char* b2 = last ? nB : cB + (size_t)(t + 2) * 128;
            const GAS char* a3 = a2 + 128; const GAS char* b3 = b2 + 128;
            const size_t hB2 = last ? hBn : hBc;
            unsigned oa0[2], oa1[2], ob[2];
#pragma unroll
            for (int i = 0; i < 2; ++i) { if constexpr (UNI) { oa0[i] = aoc[0][i]; oa1[i] = aoc[1][i]; ob[i] = boc[i]; } else { oa0[i] = last ? aon[0][i] : aoc[0][i]; oa1[i] = last ? aon[1][i] : aoc[1][i]; ob[i] = last ? bon[i] : boc[i]; } }
            PG8_LDB(B0, 0, 0); PG8_LDB(B1, 0, 1); PG8_SCHED; PG8_LDA(At, 0, 0); PG8_STAGE(PG8_SA(1, 1), a1, aoc[1]);
            PG8_WAIT_V(8); PG8_WAIT_L(0); PG8_BAR; PG8_MMA(0, 0, At, B0); PG8_MMA(0, 1, At, B1); PG8_BAR; PG8_SCHED;
            PG8_LDA(At, 0, 1); PG8_STAGE(PG8_SB(0, 0), b2, ob); PG8_STAGE(PG8_SB(0, 1), b2 + hB2, ob); PG8_STAGE(PG8_SA(0, 0), a2, oa0);
            PG8_WAIT_V(8); PG8_WAIT_L(0); PG8_BAR; PG8_MMA(1, 0, At, B0); PG8_MMA(1, 1, At, B1); PG8_BAR; PG8_SCHED;
            PG8_LDB(B0, 1, 0); PG8_LDB(B1, 1, 1); PG8_SCHED; PG8_LDA(At, 1, 0); PG8_STAGE(PG8_SA(0, 1), a2, oa1);
            PG8_WAIT_V(8); PG8_WAIT_L(0); PG8_BAR; PG8_MMA(0, 0, At, B0); PG8_MMA(0, 1, At, B1); PG8_BAR; PG8_SCHED;
            PG8_LDA(At, 1, 1); PG8_STAGE(PG8_SB(1, 0), b3, ob); PG8_STAGE(PG8_SB(1, 1), b3 + hB2, ob); PG8_STAGE(PG8_SA(1, 0), a3, oa0);
            PG8_WAIT_V(8); PG8_WAIT_L(0); PG8_BAR; PG8_MMA(1, 0, At, B0); PG8_MMA(1, 1, At, B1); PG8_BAR; PG8_SCHED;
        }
        if (wr == 0) PG8_BAR;
        const bool keep = E(acc, cur, wr, wc, fr, fq, lds + LDS_EPI + wid * 2048);
        if (!has_next) break;
        if (!keep) {
#pragma unroll
            for (int a = 0; a < 2; ++a)
#pragma unroll
                for (int b = 0; b < 2; ++b)
#pragma unroll
                    for (int m = 0; m < 4; ++m)
#pragma unroll
                        for (int n = 0; n < 2; ++n) acc[a][b][m][n] = (f32x4){0.f, 0.f, 0.f, 0.f};
        }
        cur = nxt;
        if constexpr (!UNI) {
#pragma unroll
            for (int i = 0; i < 2; ++i) { boc[i] = bon[i]; aoc[0][i] = aon[0][i]; aoc[1][i] = aon[1][i]; } }
        ++ui;
        if (wr == 1) PG8_BAR;
    }
    PG8_WAIT_V(0);
    PG8_BAR;
#undef PG8_OFFS
#undef PG8_SA
#undef PG8_SB
#undef PG8_STAGE
#undef PG8_LDA
#undef PG8_LDB
#undef PG8_MMA
#undef PG8_BF
#undef PG8_WAIT_V
#undef PG8_WAIT_L
#undef PG8_BAR
#undef PG8_SCHED
}
}
using pg8::Unit;

struct DenseSched {
    const GAS char* A; const GAS char* Bt; int lda, ldb, nt, nM, nN, G, c;
    int skip_from, skip_n;
    __device__ __forceinline__ bool next(int i, Unit& u) const {
        const long L = (long)i * G + c; if (L >= (long)nM * nN) return false;
        int pm, pn; pg8::tile_of((int)L, nM, nN, pm, pn);
        if (pn >= skip_from) pn += skip_n;
        u.a = A + (size_t)pm * 256 * lda; u.b = Bt + (size_t)pn * 256 * ldb; u.lda = lda; u.ldb = ldb; u.nt = nt;
        u.row0 = pm * 256; u.col0 = pn * 256; u.aux = 0; u.gidx = nullptr; u.gcnt = 256; u.gl = nullptr; return true;
    }
};
struct MergeSched {
    const GAS char* A0; const GAS char* B0; const GAS char* A1; const GAS char* B1; int nM, nN, G, c;
    __device__ __forceinline__ bool next(int i, Unit& u) const {
        const long L = (long)(i >> 1) * G + c; if (L >= (long)nM * nN) return false;
        int pm, pn; pg8::tile_of((int)L, nM, nN, pm, pn);
        const int seg = i & 1;
        const int ld = seg ? ATT_OUT * 2 : HG_WIDTH * 2;
        u.a = (seg ? A1 : A0) + (size_t)pm * 256 * ld; u.b = (seg ? B1 : B0) + (size_t)pn * 256 * ld; u.lda = ld; u.ldb = ld; u.nt = seg ? ATT_OUT / 64 : HG_WIDTH / 64;
        u.row0 = pm * 256; u.col0 = pn * 256; u.aux = seg; u.gidx = nullptr; u.gcnt = 256; u.gl = nullptr; return true;
    }
};
template <int NT, bool UP, int ES = 2>
struct MoeSched {
    const LAS int* toff; const GAS unsigned* cnt;
    const GAS char* A; const GAS char* W; const GAS int* rowmap;
    int G, c;
    const LAS int* gtab;
    const LAS int* utab;
    __device__ __forceinline__ bool decode(int i, int& mtg, int& pn, int& e) const {
        const int total = toff[NEXP1];
        const int nb = G >> 3, x = c & 7, lb = c >> 3;
        const int tpx = (total + 7) >> 3, t0 = x * tpx; int nx = total - t0; nx = nx > tpx ? tpx : nx;
        const int jj = i * nb + lb;
        if (nx <= 0 || lb >= nb || jj >= nx * NT) return false;
        const int nig = 8 * NT, gid = jj / nig, fm = gid * 8, gsz = (nx - fm) < 8 ? (nx - fm) : 8;
        mtg = t0 + fm + ((jj % nig) % gsz); pn = (jj % nig) / gsz;
        int lo = 0, hi = NEXP1;
        while (hi - lo > 1) { const int mid = (lo + hi) >> 1; if (toff[mid] <= mtg) lo = mid; else hi = mid; }
        e = lo; return true;
    }
    __device__ __forceinline__ void build_units(LAS int* tab) const {
        if (threadIdx.x < 32) { int mtg = 0, pn = 0, e = 0; const bool ok = decode((int)threadIdx.x, mtg, pn, e);
            tab[threadIdx.x * 4 + 0] = mtg; tab[threadIdx.x * 4 + 1] = pn; tab[threadIdx.x * 4 + 2] = e; tab[threadIdx.x * 4 + 3] = ok ? 1 : 0; }
        __syncthreads();
        if (UP && gtab != nullptr) {
            LAS int* gt = (LAS int*)gtab;
            for (int i0 = 0; i0 < 16; i0 += 2) { const int i = i0 + (int)(threadIdx.x >> 8), r = (int)threadIdx.x & 255;
                if (tab[i * 4 + 3]) { const int mtg = tab[i * 4 + 0], e = tab[i * 4 + 2], mt = mtg - toff[e];
                    int v; if (e < N_EXPERTS) { const int n = (int)cnt[e] - mt * 256; v = (r < n) ? rowmap[(size_t)e * T + mt * 256 + r] : 0; } else v = mt * 256 + r;
                    gt[i * 256 + r] = v; } }
            __syncthreads(); }
    }
    __device__ __forceinline__ bool next(int i, Unit& u) const {
        int mtg, pn, e;
        if (i < 32) { const int ok = utab[i * 4 + 3]; if (!ok) return false; mtg = utab[i * 4 + 0]; pn = utab[i * 4 + 1]; e = utab[i * 4 + 2]; }
        else if (!decode(i, mtg, pn, e)) return false;
        mtg = __builtin_amdgcn_readfirstlane(mtg); pn = __builtin_amdgcn_readfirstlane(pn); e = __builtin_amdgcn_readfirstlane(e);
        const int mt = mtg - toff[e];
        if (UP) {
            u.a = A; u.lda = D_MODEL * ES; u.nt = D_MODEL * ES / 128;
            u.b = W + ((size_t)e * 1024 + (size_t)pn * 256) * (D_MODEL * ES); u.ldb = D_MODEL * ES;
            if (gtab != nullptr && i < 16) { u.gl = gtab + i * 256; u.gidx = nullptr; u.gcnt = 256; }
            else { u.gl = nullptr;
                if (e < N_EXPERTS) { u.gidx = rowmap + (size_t)e * T + mt * 256; const int n = (int)cnt[e] - mt * 256; u.gcnt = n < 256 ? n : 256; }
                else { u.gidx = rowmap + (size_t)N_EXPERTS * T + mt * 256; u.gcnt = 256; } }
            u.col0 = pn * 128;
        } else {
            u.a = A + (size_t)mtg * 256 * (EXPERT_FF * ES); u.lda = EXPERT_FF * ES; u.nt = EXPERT_FF * ES / 128;
            u.b = W + ((size_t)e * D_MODEL + (size_t)pn * 256) * (EXPERT_FF * ES); u.ldb = EXPERT_FF * ES;
            u.gidx = nullptr; u.gcnt = 256; u.gl = nullptr; u.col0 = pn * 256;
        }
        u.row0 = mtg * 256; u.aux = e; return true;
    }
};

struct EpiIn {
    static constexpr bool PERM = true, WIDE = false;
    GAS bf16_t* H; GAS _Float16* LF; const GAS float* lb; const GAS f32x4* rope;
    __device__ __forceinline__ bool operator()(f32x4 (&acc)[2][2][4][2], const Unit& u, int wr, int wc, int fr, int fq, LAS unsigned char* scr) const {
        const int row0 = u.row0 + wr * 64 + fr, colt = u.col0, cl = wc * 32 + 8 * fq;
        int mode;
        if (colt < C_HF) mode = 1; else if (colt < C_HI) mode = 3; else if (colt < C_HGATE) mode = 0; else if (colt < C_AQ) mode = 2;
        else if (colt < C_AK) mode = 4; else if (colt < C_AV) mode = 5; else if (colt < C_GH) mode = 0; else mode = 2;
        if (mode == 3) {
            f32x4 lbv[2][2];
#pragma unroll
            for (int bj = 0; bj < 2; ++bj)
#pragma unroll
                for (int n = 0; n < 2; ++n) lbv[bj][n] = *(const GAS f32x4*)(lb + (colt - C_HF) + bj * 128 + cl + 4 * n);
#pragma unroll
            for (int ai = 0; ai < 2; ++ai)
#pragma unroll
                for (int m = 0; m < 4; ++m) { GAS _Float16* rowp = LF + HOFF(colt - C_HF, row0 + ai * 128 + m * 16) + cl;
#pragma unroll
                    for (int bj = 0; bj < 2; ++bj) { f16x8 o8;
#pragma unroll
                        for (int n = 0; n < 2; ++n) { const f32x4 z = acc[ai][bj][m][n];
#pragma unroll
                            for (int j = 0; j < 4; ++j) { const float zz = fmaxf(z[j], -80.f), l = lbv[bj][n][j]; const float f = l + (1.0f - l) * fdiv(1.0f, 1.0f + __expf(-zz)); o8[4 * n + j] = (_Float16)__logf(f); } }
                        *(GAS f16x8*)(rowp + (size_t)bj * T * 128) = o8; } }
            return false;
        }
        if (mode >= 4) {
            const float sc = (mode == 4) ? 0.08838834764831845f : 1.0f;
            const int i0 = 16 * wc + 4 * fq;
#pragma unroll
            for (int ai = 0; ai < 2; ++ai)
#pragma unroll
                for (int m = 0; m < 4; ++m) { const int row = row0 + ai * 128 + m * 16; GAS bf16_t* rowp = H + HOFF(colt, row) + cl;
                    const f32x4 cs0 = rope[(size_t)row * 32 + (i0 >> 1)], cs1 = rope[(size_t)row * 32 + (i0 >> 1) + 1];
#pragma unroll
                    for (int bj = 0; bj < 2; ++bj) { const f32x4 v0 = acc[ai][bj][m][0], v1 = acc[ai][bj][m][1]; u32x4 w;
                        w.x = cvt_pk_bf16((v0[0] * cs0[0] - v0[1] * cs0[1]) * sc, (v0[1] * cs0[0] + v0[0] * cs0[1]) * sc);
                        w.y = cvt_pk_bf16((v0[2] * cs0[2] - v0[3] * cs0[3]) * sc, (v0[3] * cs0[2] + v0[2] * cs0[3]) * sc);
                        w.z = cvt_pk_bf16((v1[0] * cs1[0] - v1[1] * cs1[1]) * sc, (v1[1] * cs1[0] + v1[0] * cs1[1]) * sc);
                        w.w = cvt_pk_bf16((v1[2] * cs1[2] - v1[3] * cs1[3]) * sc, (v1[3] * cs1[2] + v1[2] * cs1[3]) * sc);
                        *(GAS u32x4*)(rowp + (size_t)bj * T * 128) = w; } }
            return false;
        }
#pragma unroll
        for (int ai = 0; ai < 2; ++ai)
#pragma unroll
            for (int m = 0; m < 4; ++m) { GAS bf16_t* rowp = H + HOFF(colt, row0 + ai * 128 + m * 16) + cl;
#pragma unroll
                for (int bj = 0; bj < 2; ++bj) { f32x4 v0 = acc[ai][bj][m][0], v1 = acc[ai][bj][m][1];
                    if (mode != 0) {
#pragma unroll
                        for (int j = 0; j < 4; ++j) { const float s0 = fsigmoid(v0[j]), s1 = fsigmoid(v1[j]); v0[j] = (mode == 1) ? v0[j] * s0 : s0; v1[j] = (mode == 1) ? v1[j] * s1 : s1; } }
                    u32x4 w; w.x = cvt_pk_bf16(v0[0], v0[1]); w.y = cvt_pk_bf16(v0[2], v0[3]); w.z = cvt_pk_bf16(v1[0], v1[1]); w.w = cvt_pk_bf16(v1[2], v1[3]);
                    *(GAS u32x4*)(rowp + (size_t)bj * T * 128) = w; } }
        return false;
    }
};
struct EpiMerge {
    static constexpr bool PERM = true, WIDE = true;
    const GAS bf16_t* H; GAS bf16_t* O;
    __device__ __forceinline__ bool operator()(f32x4 (&acc)[2][2][4][2], const Unit& u, int wr, int wc, int fr, int fq, LAS unsigned char* scr) const {
        const int lane = fq * 16 + fr, rowb = u.row0 + wr * 64, colb = u.col0 + wc * 64;
        const int lr = lane >> 3, lch = lane & 7;
        const int wo = lr * 128 + ((lch ^ (lr & 7)) * 16);
        const bool seg0 = (u.aux == 0);
#pragma unroll
        for (int ai = 0; ai < 2; ++ai)
#pragma unroll
            for (int m = 0; m < 4; ++m) { const size_t rg = (size_t)(rowb + ai * 128 + m * 16);
                const GAS bf16_t* gpa = H + HOFF(C_GA + colb, rg + lr) + lch * 8; const GAS bf16_t* gph = H + HOFF(C_GH + colb, rg + lr) + lch * 8;
                const u32x4 ga0 = *(const GAS u32x4*)gpa, ga1 = *(const GAS u32x4*)(gpa + 8 * 128);
                u32x4 gh0 = ga0, gh1 = ga1; if (seg0) { gh0 = *(const GAS u32x4*)gph; gh1 = *(const GAS u32x4*)(gph + 8 * 128); }
                *(LAS u32x4*)(scr + wo) = ga0; *(LAS u32x4*)(scr + wo + 1024) = ga1;
                LDS_WAIT();
                u32x4 gaf[2], ghf[2];
#pragma unroll
                for (int bj = 0; bj < 2; ++bj) gaf[bj] = *(const LAS u32x4*)(scr + fr * 128 + (((bj * 4 + fq) ^ (fr & 7)) * 16));
                LDS_WAIT();
                if (seg0) { *(LAS u32x4*)(scr + wo) = gh0; *(LAS u32x4*)(scr + wo + 1024) = gh1;
                    LDS_WAIT();
#pragma unroll
                    for (int bj = 0; bj < 2; ++bj) ghf[bj] = *(const LAS u32x4*)(scr + fr * 128 + (((bj * 4 + fq) ^ (fr & 7)) * 16));
                    LDS_WAIT(); }
#pragma unroll
                for (int bj = 0; bj < 2; ++bj) { const u32x4 ga = gaf[bj];
                    float a[8] = {bflo(ga.x), bfhi(ga.x), bflo(ga.y), bfhi(ga.y), bflo(ga.z), bfhi(ga.z), bflo(ga.w), bfhi(ga.w)};
                    if (seg0) { const u32x4 gh = ghf[bj];
                        float h[8] = {bflo(gh.x), bfhi(gh.x), bflo(gh.y), bfhi(gh.y), bflo(gh.z), bfhi(gh.z), bflo(gh.w), bfhi(gh.w)};
#pragma unroll
                        for (int j = 0; j < 4; ++j) { acc[ai][bj][m][0][j] *= fdiv(h[j], a[j]); acc[ai][bj][m][1][j] *= fdiv(h[4 + j], a[4 + j]); }
                    } else {
                        f32x4 v0 = acc[ai][bj][m][0], v1 = acc[ai][bj][m][1];
#pragma unroll
                        for (int j = 0; j < 4; ++j) { v0[j] *= a[j]; v1[j] *= a[4 + j]; }
                        u32x2 w8; int q = __builtin_amdgcn_cvt_pk_fp8_f32(v0[0], v0[1], 0, false); q = __builtin_amdgcn_cvt_pk_fp8_f32(v0[2], v0[3], q, true); w8.x = (unsigned)q;
                        q = __builtin_amdgcn_cvt_pk_fp8_f32(v1[0], v1[1], 0, false); q = __builtin_amdgcn_cvt_pk_fp8_f32(v1[2], v1[3], q, true); w8.y = (unsigned)q;
                        *(LAS u32x2*)(scr + fr * 64 + bj * 32 + fq * 8) = w8; } }
                if (!seg0) { LDS_WAIT();
                    const int r = lane >> 2, ch = lane & 3; const u32x4 o = *(const LAS u32x4*)(scr + r * 64 + ch * 16);
                    *(GAS u32x4*)((GAS unsigned char*)O + (rg + r) * D_MODEL + colb + ch * 16) = o;
                    LDS_WAIT(); }
            }
        return seg0;
    }
};
struct EpiResid {
    static constexpr bool PERM = false, WIDE = false;
    const GAS bf16_t* X; GAS bf16_t* R;
    __device__ __forceinline__ bool operator()(f32x4 (&acc)[2][2][4][2], const Unit& u, int wr, int wc, int fr, int fq, LAS unsigned char* scr) const {
        const int row0 = u.row0 + wr * 64 + fr, col0 = u.col0 + wc * 32 + 4 * fq;
#pragma unroll
        for (int ai = 0; ai < 2; ++ai)
#pragma unroll
            for (int m = 0; m < 4; ++m) { const size_t off = (size_t)(row0 + ai * 128 + m * 16) * D_MODEL + col0;
#pragma unroll
                for (int bj = 0; bj < 2; ++bj)
#pragma unroll
                    for (int n = 0; n < 2; ++n) { const u32x2 xv = *(const GAS u32x2*)(X + off + bj * 128 + n * 16); const f32x4 a = acc[ai][bj][m][n];
                        u32x2 o; o.x = cvt_pk_bf16(bflo(xv.x) * DN_ALPHA + a[0], bfhi(xv.x) * DN_ALPHA + a[1]); o.y = cvt_pk_bf16(bflo(xv.y) * DN_ALPHA + a[2], bfhi(xv.y) * DN_ALPHA + a[3]);
                        *(GAS u32x2*)(R + off + bj * 128 + n * 16) = o; } }
        return false;
    }
};
template <bool F8OUT>
struct EpiGateUp {
    static constexpr bool PERM = true, WIDE = false;
    GAS bf16_t* HID;
    __device__ __forceinline__ bool operator()(f32x4 (&acc)[2][2][4][2], const Unit& u, int wr, int wc, int fr, int fq, LAS unsigned char* scr) const {
        const int row0 = u.row0 + wr * 64 + fr, col0 = u.col0 + wc * 32 + 8 * fq;
#pragma unroll
        for (int ai = 0; ai < 2; ++ai)
#pragma unroll
            for (int m = 0; m < 4; ++m) { GAS bf16_t* rowp = HID + (size_t)(row0 + ai * 128 + m * 16) * EXPERT_FF + col0;
                f32x4 g0 = acc[ai][0][m][0], g1 = acc[ai][0][m][1]; const f32x4 u0 = acc[ai][1][m][0], u1 = acc[ai][1][m][1];
#pragma unroll
                for (int j = 0; j < 4; ++j) { g0[j] = g0[j] * fsigmoid(g0[j]) * u0[j]; g1[j] = g1[j] * fsigmoid(g1[j]) * u1[j]; }
                if constexpr (F8OUT) { u32x2 w8; int q = __builtin_amdgcn_cvt_pk_fp8_f32(g0[0], g0[1], 0, false); q = __builtin_amdgcn_cvt_pk_fp8_f32(g0[2], g0[3], q, true); w8.x = (unsigned)q;
                    q = __builtin_amdgcn_cvt_pk_fp8_f32(g1[0], g1[1], 0, false); q = __builtin_amdgcn_cvt_pk_fp8_f32(g1[2], g1[3], q, true); w8.y = (unsigned)q;
                    *(GAS u32x2*)((GAS unsigned char*)HID + (size_t)(row0 + ai * 128 + m * 16) * EXPERT_FF + col0) = w8; }
                else { u32x4 w; w.x = cvt_pk_bf16(g0[0], g0[1]); w.y = cvt_pk_bf16(g0[2], g0[3]); w.z = cvt_pk_bf16(g1[0], g1[1]); w.w = cvt_pk_bf16(g1[2], g1[3]);
                    *(GAS u32x4*)rowp = w; } }
        return false;
    }
};
template <bool F8OUT>
struct EpiDown {
    static constexpr bool PERM = true, WIDE = true;
    GAS bf16_t* Y;
    __device__ __forceinline__ bool operator()(f32x4 (&acc)[2][2][4][2], const Unit& u, int wr, int wc, int fr, int fq, LAS unsigned char* scr) const {
        const int lane = fq * 16 + fr, rowb = u.row0 + wr * 64, colb = u.col0 + wc * 64;
#pragma unroll
        for (int ai = 0; ai < 2; ++ai)
#pragma unroll
            for (int m = 0; m < 4; ++m) { const size_t rg = (size_t)(rowb + ai * 128 + m * 16);
                if constexpr (F8OUT) {
#pragma unroll
                    for (int bj = 0; bj < 2; ++bj) { const f32x4 v0 = acc[ai][bj][m][0], v1 = acc[ai][bj][m][1]; u32x2 w8;
                        int q = __builtin_amdgcn_cvt_pk_fp8_f32(v0[0], v0[1], 0, false); q = __builtin_amdgcn_cvt_pk_fp8_f32(v0[2], v0[3], q, true); w8.x = (unsigned)q;
                        q = __builtin_amdgcn_cvt_pk_fp8_f32(v1[0], v1[1], 0, false); q = __builtin_amdgcn_cvt_pk_fp8_f32(v1[2], v1[3], q, true); w8.y = (unsigned)q;
                        *(LAS u32x2*)(scr + fr * 64 + bj * 32 + fq * 8) = w8; }
                    LDS_WAIT();
                    const int r = lane >> 2, ch = lane & 3; const u32x4 o = *(const LAS u32x4*)(scr + r * 64 + ch * 16);
                    *(GAS u32x4*)((GAS unsigned char*)Y + (rg + r) * D_MODEL + colb + ch * 16) = o;
                } else {
#pragma unroll
                    for (int bj = 0; bj < 2; ++bj) { const f32x4 v0 = acc[ai][bj][m][0], v1 = acc[ai][bj][m][1];
                        u32x4 w; w.x = cvt_pk_bf16(v0[0], v0[1]); w.y = cvt_pk_bf16(v0[2], v0[3]); w.z = cvt_pk_bf16(v1[0], v1[1]); w.w = cvt_pk_bf16(v1[2], v1[3]);
                        *(LAS u32x4*)(scr + fr * 128 + (((bj * 4 + fq) ^ (fr & 7)) * 16)) = w; }
                    LDS_WAIT();
                    const int r = lane >> 3, ch = lane & 7;
                    const u32x4 o0 = *(const LAS u32x4*)(scr + r * 128 + ((ch ^ (r & 7)) * 16)), o1 = *(const LAS u32x4*)(scr + (r + 8) * 128 + ((ch ^ (r & 7)) * 16));
                    *(GAS u32x4*)(Y + (rg + r) * D_MODEL + colb + ch * 8) = o0; *(GAS u32x4*)(Y + (rg + r + 8) * D_MODEL + colb + ch * 8) = o1;
                }
                LDS_WAIT(); }
        return false;
    }
};

struct Args { const float* in[20]; float* out; unsigned char* ws; int ph_lo, ph_hi; };
typedef const __attribute__((address_space(4))) Args* CArgsP;
#define GIN(k) ((const GAS float*)(GAS const float*)ap->in[k])
#define PHASE_ARGS() CArgsP ap = (CArgsP)__builtin_amdgcn_kernarg_segment_ptr(); asm volatile("" : "+s"(ap))
struct Frame {
    LAS unsigned char* lds;
    GAS unsigned* ctl;
    GAS unsigned char* ws;
    int G, bid;
};
#define PHASE_IDS() int tid = threadIdx.x; asm volatile("" : "+v"(tid)); const int lane = tid & 63, w = __builtin_amdgcn_readfirstlane(tid >> 6); (void)lane; (void)w

__device__ __forceinline__ int conv_src_col(int mode, int p) {
    if (mode == 1 && p >= C_AQ && p < C_AV) { const int hb = p & ~127, q = p & 127; return hb + (q >> 1) + 64 * (q & 1); }
    return p;
}
__device__ __forceinline__ int conv_dst_row(int mode, int n) {
    if (mode == 1) { if (n >= C_AQ && n < C_AV) { const int hb = n & ~127, dd = n & 127; return hb + (dd < 64 ? 2 * dd : 2 * (dd - 64) + 1); } return n; }
    if (mode == 2) return (n >> 7) * 256 + (n & 127);
    if (mode == 3) return (n >> 7) * 256 + 128 + (n & 127);
    return n;
}
struct ConvJob { const GAS float* W; GAS unsigned char* WT; int K, N, mode, item, ncol0, ncols, f8; float sc8; };
__device__ __forceinline__ void conv_load(const ConvJob& J, int tid, f32x4 (&v)[16]) {
    const int nblk = J.ncols / 256, k0 = 128 * (J.item / nblk), n0 = J.ncol0 + 256 * (J.item % nblk);
    {
#pragma unroll
        for (int ii = 0; ii < 16; ++ii) { const int idx = tid + 512 * ii, k = idx >> 6, c4 = idx & 63; v[ii] = *(const GAS f32x4*)(J.W + (size_t)(k0 + k) * J.N + n0 + 4 * c4); }
    }
}
__device__ __forceinline__ void conv_to_lds(const ConvJob& J, int tid, const f32x4 (&v)[16], LAS float* T) {
#pragma unroll
    for (int ii = 0; ii < 16; ++ii) { const int idx = tid + 512 * ii, k = idx >> 6, c4 = idx & 63; const int g = J.f8 ? ((k >> 4) & 7) : ((k >> 3) & 15);
        *(LAS f32x4*)(T + k * 256 + 4 * (c4 ^ g)) = v[ii]; }
}
__device__ __forceinline__ void conv_from_lds(const ConvJob& J, int tid, const LAS float* T) {
    const int nblk = J.ncols / 256, k0 = 128 * (J.item / nblk), n0 = J.ncol0 + 256 * (J.item % nblk);
    const int lane = tid & 63, w = tid >> 6, j = lane & 3;
    if (J.f8) {
        const int c = (lane >> 2) & 7; const float sc8 = J.sc8;
#pragma unroll
        for (int it = 0; it < 4; ++it) { const int c4n = w * 8 + it * 2 + (lane >> 5), n = 4 * c4n + j; const LAS float* base = T + 4 * (c4n ^ c) + j; u32x4 o;
#pragma unroll
            for (int d = 0; d < 4; ++d) { const int kk = 16 * c + 4 * d;
                int wv = __builtin_amdgcn_cvt_pk_fp8_f32(base[(kk + 0) * 256] * sc8, base[(kk + 1) * 256] * sc8, 0, false);
                wv = __builtin_amdgcn_cvt_pk_fp8_f32(base[(kk + 2) * 256] * sc8, base[(kk + 3) * 256] * sc8, wv, true); o[d] = (unsigned)wv; }
            *(GAS u32x4*)(J.WT + (size_t)conv_dst_row(J.mode, n0 - J.ncol0 + n) * J.K + k0 + 16 * c) = o; }
    } else {
        const int c = ((lane >> 2) & 7) + 8 * (lane >> 5);
#pragma unroll
        for (int it = 0; it < 8; ++it) { const int c4n = w * 8 + it, n = 4 * c4n + j; const LAS float* base = T + 4 * (c4n ^ c) + j + (8 * c) * 256;
            u32x4 o; o.x = cvt_pk_bf16(base[0 * 256], base[1 * 256]); o.y = cvt_pk_bf16(base[2 * 256], base[3 * 256]); o.z = cvt_pk_bf16(base[4 * 256], base[5 * 256]); o.w = cvt_pk_bf16(base[6 * 256], base[7 * 256]);
            *(GAS u32x4*)(J.WT + ((size_t)conv_dst_row(J.mode, n0 - J.ncol0 + n) * J.K + k0 + 8 * c) * 2) = o; }
    }
}
__device__ __forceinline__ void conv8_load(const ConvJob& J, int tid, f32x4 (&v)[16]) {
    const int nblk = J.ncols / 256, k0 = 128 * (J.item / nblk), n0 = J.ncol0 + 256 * (J.item % nblk);
    const int lane = tid & 63, w = tid >> 6, kg = lane & 7, nq = lane >> 3;
    const GAS float* p = J.W + (size_t)(k0 + 16 * kg) * J.N + n0 + 32 * w + 4 * nq;
#pragma unroll
    for (int j = 0; j < 16; ++j) v[j] = *(const GAS f32x4*)(p + (size_t)j * J.N);
}
__device__ __forceinline__ void conv8_store(const ConvJob& J, int tid, const f32x4 (&v)[16]) {
    const int nblk = J.ncols / 256, k0 = 128 * (J.item / nblk), n0 = J.ncol0 + 256 * (J.item % nblk);
    const int lane = tid & 63, w = tid >> 6, kg = lane & 7, nq = lane >> 3; const float sc8 = J.sc8;
#pragma unroll
    for (int c = 0; c < 4; ++c) { u32x4 o;
#pragma unroll
        for (int d = 0; d < 4; ++d) { int wv = __builtin_amdgcn_cvt_pk_fp8_f32(v[4 * d][c] * sc8, v[4 * d + 1][c] * sc8, 0, false);
            wv = __builtin_amdgcn_cvt_pk_fp8_f32(v[4 * d + 2][c] * sc8, v[4 * d + 3][c] * sc8, wv, true); o[d] = (unsigned)wv; }
        *(GAS u32x4*)(J.WT + (size_t)conv_dst_row(J.mode, n0 - J.ncol0 + 32 * w + 4 * nq + c) * J.K + k0 + 16 * kg) = o; }
}
__device__ __forceinline__ void p0_convert(Frame& F, int layer, bool gu8, bool moe8, int part = 0, int tail = 0, GAS unsigned* ctr = nullptr) {
    PHASE_IDS(); PHASE_ARGS();
    LAS float* TL = (LAS float*)F.lds;
    GAS unsigned char* ws = F.ws;
    const GAS float* w_in = GIN(2) + (size_t)layer * D_MODEL * IN_WIDTH;
    const GAS float* w_hg = GIN(5) + (size_t)layer * HG_WIDTH * D_MODEL;
    const GAS float* w_att = GIN(6) + (size_t)layer * ATT_OUT * D_MODEL;
    const GAS float* w_out = GIN(7) + (size_t)layer * D_MODEL * D_MODEL;
    const GAS float* w_eg = GIN(12) + (size_t)layer * N_EXPERTS * D_MODEL * EXPERT_FF;
    const GAS float* w_eu = GIN(13) + (size_t)layer * N_EXPERTS * D_MODEL * EXPERT_FF;
    const GAS float* w_ed = GIN(14) + (size_t)layer * N_EXPERTS * EXPERT_FF * D_MODEL;
    const GAS float* w_sg = GIN(15) + (size_t)layer * D_MODEL * EXPERT_FF;
    const GAS float* w_su = GIN(16) + (size_t)layer * D_MODEL * EXPERT_FF;
    const GAS float* w_sd = GIN(17) + (size_t)layer * EXPERT_FF * D_MODEL;
    constexpr int I_IN = (D_MODEL / 128) * (IN_WIDTH / 256), I_INF = (D_MODEL / 128) * (HG_WIDTH / 256), I_HG = (HG_WIDTH / 128) * (D_MODEL / 256), I_ATT = (ATT_OUT / 128) * (D_MODEL / 256), I_OUT = (D_MODEL / 128) * (D_MODEL / 256);
    constexpr int I_E = (D_MODEL / 128) * (EXPERT_FF / 256);
    static_assert((EXPERT_FF / 128) * (D_MODEL / 256) == I_E, "item count of the down matrices");
    constexpr int NITEMS = I_IN + I_INF + I_HG + I_ATT + I_OUT + 3 * NEXP1 * I_E;
    auto decode = [&](int it) -> ConvJob {
        int r = it;
        if (r < I_IN) return ConvJob{w_in, ws + WS_WIN, D_MODEL, IN_WIDTH, 1, r, 0, IN_WIDTH, 1, 64.f}; r -= I_IN;
        if (r < I_INF) return ConvJob{w_in, ws + WS_WINF, D_MODEL, IN_WIDTH, 0, r, C_HF, HG_WIDTH, 0, 1.f}; r -= I_INF;
        if (r < I_HG) return ConvJob{w_hg, ws + WS_WHG, HG_WIDTH, D_MODEL, 0, r, 0, D_MODEL, 0, 1.f}; r -= I_HG;
        if (r < I_ATT) return ConvJob{w_att, ws + WS_WATT, ATT_OUT, D_MODEL, 0, r, 0, D_MODEL, 0, 1.f}; r -= I_ATT;
        if (r < I_OUT) return ConvJob{w_out, ws + WS_WOUT, D_MODEL, D_MODEL, 0, r, 0, D_MODEL, 1, 64.f}; r -= I_OUT;
        const int which = r / (NEXP1 * I_E); r -= which * (NEXP1 * I_E);
        const int e = r / I_E, ri = r % I_E; const int es = gu8 ? 1 : 2;
        if (which == 0) return ConvJob{(e < N_EXPERTS) ? w_eg + (size_t)e * D_MODEL * EXPERT_FF : w_sg, ws + (moe8 ? WS_WGU8 : WS_WGU) + (size_t)e * 1024 * D_MODEL * es, D_MODEL, EXPERT_FF, 2, ri, 0, EXPERT_FF, gu8 ? 1 : 0, 64.f};
        if (which == 1) return ConvJob{(e < N_EXPERTS) ? w_eu + (size_t)e * D_MODEL * EXPERT_FF : w_su, ws + (moe8 ? WS_WGU8 : WS_WGU) + (size_t)e * 1024 * D_MODEL * es, D_MODEL, EXPERT_FF, 3, ri, 0, EXPERT_FF, gu8 ? 1 : 0, 64.f};
        return ConvJob{(e < N_EXPERTS) ? w_ed + (size_t)e * EXPERT_FF * D_MODEL : w_sd, ws + (moe8 ? WS_WDN8 : WS_WDN) + (size_t)e * D_MODEL * EXPERT_FF, EXPERT_FF, D_MODEL, 0, ri, 0, D_MODEL, 1, 64.f};
    };
    constexpr int N_NONEXP = I_IN + I_INF + I_HG + I_ATT + I_OUT, NB16 = I_INF + I_HG + I_ATT;
    if (gu8) {
        constexpr int NF8 = NITEMS - NB16, NF8_NONEXP = I_IN + I_OUT;
        const int q_lo = (part == 2) ? NF8_NONEXP : 0, q_end = (part == 1) ? NF8_NONEXP : NF8, q_hi = q_end - tail;
        if (ctr != nullptr) {
            LAS unsigned* qw = (LAS unsigned*)(F.lds + LDS_TAB + 1536);
            for (;;) {
                if (tid == 0) *qw = __hip_atomic_fetch_add(ctr, 1u, RLX_AGENT);
                LDS_BARRIER();
                const int qd = q_hi + __builtin_amdgcn_readfirstlane((int)*qw);
                LDS_BARRIER();
                if (qd >= q_end) break;
                const ConvJob j = decode(qd < I_IN ? qd : qd + NB16); f32x4 v[16]; conv8_load(j, tid, v); conv8_store(j, tid, v); }
            return;
        }
        int q = q_lo + F.bid;
        if (q < q_hi) {
            f32x4 va[16], vb[16];
            conv8_load(decode(q < I_IN ? q : q + NB16), tid, va);
            for (;;) {
                const int q1 = q + F.G; const bool m1 = q1 < q_hi;
                if (m1) conv8_load(decode(q1 < I_IN ? q1 : q1 + NB16), tid, vb);
                conv8_store(decode(q < I_IN ? q : q + NB16), tid, va);
                if (!m1) break;
                const int q2 = q1 + F.G; const bool m2 = q2 < q_hi;
                if (m2) conv8_load(decode(q2 < I_IN ? q2 : q2 + NB16), tid, va);
                conv8_store(decode(q1 < I_IN ? q1 : q1 + NB16), tid, vb);
                if (!m2) break;
                q = q2; }
        }
        if (part != 2) {
            for (int it = I_IN + (F.G - 1 - F.bid); it < I_IN + NB16; it += F.G) { const ConvJob j = decode(it); f32x4 v[16];
                conv_load(j, tid, v); conv_to_lds(j, tid, v, TL); LDS_BARRIER(); conv_from_lds(j, tid, TL); LDS_BARRIER(); }
        }
    } else {
    const int it_lo = (part == 2) ? N_NONEXP : 0, it_hi = (part == 1) ? N_NONEXP : NITEMS;
    if (it_lo + F.bid < it_hi) {
        f32x4 va[16]; int it = it_lo + F.bid; ConvJob jc = decode(it);
        conv_load(jc, tid, va);
        for (;;) { const int itn = it + F.G; const bool more = itn < it_hi;
            conv_to_lds(jc, tid, va, TL);
            LDS_BARRIER();
            ConvJob jn = jc; if (more) { jn = decode(itn); conv_load(jn, tid, va); }
            conv_from_lds(jc, tid, TL);
            LDS_BARRIER();
            if (!more) break;
            jc = jn; it = itn; }
    }
    }
    if (layer == 0 && part != 2) {
        const GAS f32x4* x4 = (const GAS f32x4*)GIN(0); GAS u32x2* xb = (GAS u32x2*)(ws + WS_XB); GAS unsigned* xb8 = (GAS unsigned*)(ws + WS_XB8);
        for (size_t i = (size_t)F.bid * 512 + tid; i < (size_t)T * D_MODEL / 4; i += (size_t)F.G * 512) { const f32x4 v = x4[i]; u32x2 o; o.x = pk2(v[0], v[1]); o.y = pk2(v[2], v[3]); xb[i] = o;
            int w8 = __builtin_amdgcn_cvt_pk_fp8_f32(v[0], v[1], 0, false); w8 = __builtin_amdgcn_cvt_pk_fp8_f32(v[2], v[3], w8, true); xb8[i] = (unsigned)w8; }
        const GAS int* pos = (const GAS int*)GIN(1); GAS f32x2* rt = (GAS f32x2*)(ws + WS_ROPE);
        for (int i = F.bid * 512 + tid; i < T * 64; i += F.G * 512) { const int tk = i >> 6, fi = i & 63;
            const double inv = exp2(-(double)fi * (13.287712379549449 / 64.0));
            const double ang = (double)pos[tk] * inv; const double red = ang - rint(ang * 0.15915494309189535) * 6.283185307179586;
            const float rf = (float)red; rt[i] = (f32x2){cosf(rf), sinf(rf)}; }
        const GAS float* lbl = GIN(3); GAS float* lb = (GAS float*)(ws + WS_LB);
        for (int c = F.bid * 512 + tid; c < HG_WIDTH; c += F.G * 512) {
            float mx = -1e30f; for (int l = 0; l < DEPTH; ++l) mx = fmaxf(mx, lbl[l * HG_WIDTH + c]);
            float den = 0.f; for (int l = 0; l < DEPTH; ++l) den += expf(lbl[l * HG_WIDTH + c] - mx);
            float cum = 0.f, c0 = 0.f; for (int l = 0; l < DEPTH; ++l) { cum += expf(lbl[l * HG_WIDTH + c] - mx) / den; if (l == 0) c0 = cum; lb[l * HG_WIDTH + c] = cum - c0; }
        }
    }
}

constexpr int TROW = 272;
struct H1Regs { float lf[16]; u32x4 v[2]; };
__device__ __forceinline__ void h1_load(Frame& F, int chunk, int tid, H1Regs& R) {
    const GAS bf16_t* H = (const GAS bf16_t*)(F.ws + WS_H); const GAS _Float16* LF = (const GAS _Float16*)(F.ws + WS_LF);
    const int bh = chunk >> 5, n = chunk & 31, b = bh >> 3, head = bh & 7, tok0 = b * SEQ + n * 64, kk = tid & 127, part = tid >> 7;
    const GAS _Float16* p = LF + HOFF(head * 128, tok0 + part * 16) + kk;
#pragma unroll
    for (int j = 0; j < 16; ++j) R.lf[j] = (float)p[(size_t)j * 128];
#pragma unroll
    for (int j = 0; j < 2; ++j) { const int c = tid + 512 * j, row = c >> 4, ch = c & 15;
        R.v[j] = *(const GAS u32x4*)(H + HOFF(C_HI + head * 128, tok0 + row) + ch * 8); }
}
__device__ __forceinline__ void h1_item(Frame& F, int chunk, int tid, const H1Regs& R) {
    GAS float* UT = (GAS float*)(F.ws + WS_UT); GAS float* DEC = (GAS float*)(F.ws + WS_DEC);
    LAS unsigned char* KT = F.lds; LAS unsigned char* VT = F.lds + 17408; LAS float* TOT = (LAS float*)(F.lds + 34816);
    const int lane = tid & 63, w = __builtin_amdgcn_readfirstlane(tid >> 6);
    const int kk = tid & 127, part = tid >> 7, g = lane >> 4, i = lane & 15;
    float lf[16], cum[16];
#pragma unroll
    for (int j = 0; j < 16; ++j) lf[j] = R.lf[j];
#pragma unroll
    for (int j = 0; j < 2; ++j) { const int c = tid + 512 * j, row = c >> 4, ch = c & 15; *(LAS u32x4*)(VT + row * TROW + ch * 16) = R.v[j]; }
    float run = 0.f;
#pragma unroll
    for (int j = 0; j < 16; ++j) { run += lf[j]; cum[j] = run; }
    TOT[part * 128 + kk] = run;
    LDS_BARRIER();
    float off = 0.f, end = 0.f;
#pragma unroll
    for (int p = 0; p < 4; ++p) { const float t = TOT[p * 128 + kk]; if (p < part) off += t; end += t; }
#pragma unroll
    for (int j = 0; j < 16; ++j) { const float c = cum[j] + off; const float kt = (1.0f - __expf(lf[j])) * __expf(end - c);
        *(LAS unsigned short*)(KT + (part * 16 + j) * TROW + kk * 2) = (unsigned short)cvt_pk_bf16(kt, 0.f); }
    if (part == 0) DEC[(size_t)chunk * 128 + kk] = __expf(end);
    LDS_BARRIER();
    const unsigned ktb = (unsigned)(size_t)KT, vtb = (unsigned)(size_t)VT;
    const int q = i >> 2, p4 = i & 3;
    bf16x8 af[2];
#pragma unroll
    for (int ks = 0; ks < 2; ++ks) { const s16x4 lo = tr_read(ktb + (32 * ks + 8 * g + q) * TROW + (16 * w + 4 * p4) * 2), hi = tr_read(ktb + (32 * ks + 8 * g + 4 + q) * TROW + (16 * w + 4 * p4) * 2);
        af[ks] = (bf16x8){lo[0], lo[1], lo[2], lo[3], hi[0], hi[1], hi[2], hi[3]}; }
    f32x4 uacc[8];
#pragma unroll
    for (int vb = 0; vb < 8; ++vb) uacc[vb] = (f32x4){0.f, 0.f, 0.f, 0.f};
#pragma unroll
    for (int ks = 0; ks < 2; ++ks) { s16x4 lo[8], hi[8];
        tr_read8<32>(lo, vtb + (32 * ks + 8 * g + q) * TROW + 8 * p4); tr_read8<32>(hi, vtb + (32 * ks + 8 * g + 4 + q) * TROW + 8 * p4);
#pragma unroll
        for (int vb = 0; vb < 8; ++vb) uacc[vb] = mfma16(af[ks], TRCAT(lo[vb], hi[vb]), uacc[vb]); }
#pragma unroll
    for (int vb = 0; vb < 8; ++vb) { u32x2 wv; wv.x = pk2(uacc[vb][0], uacc[vb][1]); wv.y = pk2(uacc[vb][2], uacc[vb][3]);
        *(GAS u32x2*)((GAS bf16_t*)UT + (size_t)chunk * 16384 + (16 * vb + i) * 128 + 16 * w + 4 * g) = wv; }
    LDS_BARRIER();
}

struct AttKV { u32x4 k[8], v[8]; };
__device__ __forceinline__ void attn_kv_load(Frame& F, int it, int tid, AttKV& R) {
    const GAS bf16_t* H = (const GAS bf16_t*)(F.ws + WS_H);
    const int b = it / 192, rem = it % 192, h = rem >> 4, j = rem & 15, grp = h >> 2, dsh = 2 * grp, d = 1 << dsh, r = j & (d - 1), qb = j >> dsh;
    const int lbase = 128 * (qb - 1);
    const GAS bf16_t* HbK = H + HOFF(C_AK + h * 128, b * SEQ); const GAS bf16_t* HbV = H + HOFF(C_AV + h * 128, b * SEQ);
#pragma unroll
    for (int jj = 0; jj < 8; ++jj) { if (qb == 0 && jj < 4) continue;
        const int c = tid + 512 * jj, row = c >> 4, ch = c & 15; int l = lbase + row; l = l < 0 ? 0 : l; const size_t tok = (size_t)(l * d + r);
        R.k[jj] = *(const GAS u32x4*)(HbK + tok * 128 + ch * 8); R.v[jj] = *(const GAS u32x4*)(HbV + tok * 128 + ch * 8); }
}
__device__ __forceinline__ void attn_item(Frame& F, int it, AttKV& R, int it_next) {
    GAS bf16_t* H = (GAS bf16_t*)(F.ws + WS_H); GAS float* LSE = (GAS float*)(F.ws + WS_LSE);
    const int b = it / 192, rem = it % 192, h = rem >> 4, j = rem & 15, grp = h >> 2, dsh = 2 * grp, d = 1 << dsh, r = j & (d - 1), qb = j >> dsh;
    const int lbase = 128 * (qb - 1);
    GAS bf16_t* HbQ = H + HOFF(C_AQ + h * 128, b * SEQ); GAS bf16_t* HbK = H + HOFF(C_AK + h * 128, b * SEQ); GAS bf16_t* HbV = H + HOFF(C_AV + h * 128, b * SEQ);
    LAS unsigned char* KT = F.lds; LAS unsigned char* VT = F.lds + 256 * TROW;
    PHASE_IDS();
    const int g = lane >> 4, i = lane & 15;
    const int jb0 = (qb == 0) ? (8 - w) : 0;
#pragma unroll
    for (int jj = 0; jj < 8; ++jj) { if (qb == 0 && jj < 4) continue;
        const int c = tid + 512 * jj, row = c >> 4, ch = c & 15;
        *(LAS u32x4*)(KT + row * TROW + ch * 16) = R.k[jj]; *(LAS u32x4*)(VT + row * TROW + ch * 16) = R.v[jj]; }
    const size_t tokq = (size_t)((128 * qb + 16 * w + i) * d + r);
    bf16x8 qf[4];
#pragma unroll
    for (int ks = 0; ks < 4; ++ks) qf[ks] = *(const GAS bf16x8*)(HbQ + tokq * 128 + 32 * ks + 8 * g);
    if (it_next >= 0) attn_kv_load(F, it_next, tid, R);
    LDS_BARRIER();
    f32x4 s[9];
#pragma unroll
    for (int jb = 0; jb < 9; ++jb) { f32x4 a4 = {0.f, 0.f, 0.f, 0.f};
        if (jb >= jb0) {
#pragma unroll
            for (int ks = 0; ks < 4; ++ks) { const bf16x8 a = *(const LAS bf16x8*)(KT + (16 * (w + jb) + i) * TROW + (32 * ks + 8 * g) * 2); a4 = mfma16(a, qf[ks], a4); } }
        s[jb] = a4; }
    float mx = -1e30f;
#pragma unroll
    for (int jb = 0; jb < 9; ++jb)
#pragma unroll
        for (int rg = 0; rg < 4; ++rg) { const int kin = 4 * g + rg, dist = 128 - 16 * jb + i - kin, lk = lbase + 16 * (w + jb) + kin;
            const bool valid = ((unsigned)dist <= 128u) && (lk >= 0) && (jb >= jb0);
            const float v = valid ? s[jb][rg] : -INFINITY; s[jb][rg] = v; mx = fmaxf(mx, v); }
    mx = fmaxf(mx, __shfl_xor(mx, 16)); mx = fmaxf(mx, __shfl_xor(mx, 32));
    float den = 0.f;
#pragma unroll
    for (int jb = 0; jb < 9; ++jb)
#pragma unroll
        for (int rg = 0; rg < 4; ++rg) { const float p = __expf(s[jb][rg] - mx); s[jb][rg] = p; den += p; }
    den += __shfl_xor(den, 16); den += __shfl_xor(den, 32);
    f32x4 o[8];
#pragma unroll
    for (int db = 0; db < 8; ++db) o[db] = (f32x4){0.f, 0.f, 0.f, 0.f};
    const unsigned vtb = (unsigned)(size_t)VT; const int q = i >> 2, p4 = i & 3;
#pragma unroll
    for (int kp = 0; kp < 5; ++kp) {
        bf16x8 pb; { const unsigned a0 = cvt_pk_bf16(s[2 * kp][0], s[2 * kp][1]), a1 = cvt_pk_bf16(s[2 * kp][2], s[2 * kp][3]);
            unsigned b0 = 0u, b1 = 0u; if (kp < 4) { b0 = cvt_pk_bf16(s[2 * kp + 1][0], s[2 * kp + 1][1]); b1 = cvt_pk_bf16(s[2 * kp + 1][2], s[2 * kp + 1][3]); }
            const u32x4 t4 = {a0, a1, b0, b1}; pb = __builtin_bit_cast(bf16x8, t4); }
        if (2 * kp + 1 < jb0) continue;
        int r0 = 16 * (w + 2 * kp) + 4 * g + q; const int r1 = (kp < 4) ? r0 + 16 : r0;
        if (2 * kp < jb0) r0 = r1;
        s16x4 lo[8], hi[8];
        tr_read8<32>(lo, vtb + r0 * TROW + 8 * p4); tr_read8<32>(hi, vtb + r1 * TROW + 8 * p4);
#pragma unroll
        for (int db = 0; db < 8; ++db) o[db] = mfma16(TRCAT(lo[db], hi[db]), pb, o[db]);
    }
    const float rden = fdiv(1.0f, den);
#pragma unroll
    for (int db = 0; db < 8; ++db) { u32x2 wv; wv.x = cvt_pk_bf16(o[db][0] * rden, o[db][1] * rden); wv.y = cvt_pk_bf16(o[db][2] * rden, o[db][3] * rden);
        *(GAS u32x2*)(HbQ + tokq * 128 + 16 * db + 4 * g) = wv; }
    if (g == 0) LSE[(size_t)h * T + (size_t)b * SEQ + tokq] = mx + __logf(den);
    LDS_BARRIER();
}

__device__ __forceinline__ void scan_item(Frame& F, int item) {
    const GAS float* UT = (const GAS float*)(F.ws + WS_UT); const GAS float* DEC = (const GAS float*)(F.ws + WS_DEC); GAS bf16_t* SPT = (GAS bf16_t*)(F.ws + WS_SPT);
    PHASE_IDS();
    const int bh = item >> 2, q4 = item & 3, vv = q4 * 32 + (tid >> 4), kk0 = (tid & 15) * 8;
    f32x4 s0 = {0.f, 0.f, 0.f, 0.f}, s1 = {0.f, 0.f, 0.f, 0.f};
#pragma unroll 8
    for (int n = 0; n < 32; ++n) { const size_t chunk = (size_t)bh * 32 + n; const size_t eo = chunk * 16384 + (size_t)vv * 128 + kk0;
        const u32x4 ub = *(const GAS u32x4*)((const GAS bf16_t*)UT + eo); const f32x4 u0 = {bflo(ub.x), bfhi(ub.x), bflo(ub.y), bfhi(ub.y)}, u1 = {bflo(ub.z), bfhi(ub.z), bflo(ub.w), bfhi(ub.w)}, d0 = *(const GAS f32x4*)(DEC + chunk * 128 + kk0), d1 = *(const GAS f32x4*)(DEC + chunk * 128 + kk0 + 4);
        u32x4 wv; wv.x = cvt_pk_bf16(s0[0], s0[1]); wv.y = cvt_pk_bf16(s0[2], s0[3]); wv.z = cvt_pk_bf16(s1[0], s1[1]); wv.w = cvt_pk_bf16(s1[2], s1[3]);
        *(GAS u32x4*)(SPT + eo) = wv;
        s0 = d0 * s0 + u0; s1 = d1 * s1 + u1; }
}
__device__ __forceinline__ void attn_merge(Frame& F) {
    const GAS bf16_t* H = (const GAS bf16_t*)(F.ws + WS_H); const GAS float* LSE = (const GAS float*)(F.ws + WS_LSE); GAS bf16_t* ATTO = (GAS bf16_t*)(F.ws + WS_ATTO);
    PHASE_IDS();
    const int gw = F.bid * 8 + w, NGW = F.G * 8, hg = lane >> 4, d0 = (lane & 15) * 8;
    for (int t = gw; t < T; t += NGW) {
        const float l0 = LSE[(size_t)hg * T + t], l1 = LSE[(size_t)(4 + hg) * T + t], l2 = LSE[(size_t)(8 + hg) * T + t];
        const float mx = fmaxf(l0, fmaxf(l1, l2)); float w0 = __expf(l0 - mx), w1 = __expf(l1 - mx), w2 = __expf(l2 - mx); const float rs = fdiv(1.0f, w0 + w1 + w2); w0 *= rs; w1 *= rs; w2 *= rs;
        const GAS bf16_t* base = H + HOFF(C_AQ + hg * 128, t) + d0;
        const u32x4 a = *(const GAS u32x4*)base, bq = *(const GAS u32x4*)(base + (size_t)4 * T * 128), c = *(const GAS u32x4*)(base + (size_t)8 * T * 128);
        u32x4 wv;
        wv.x = cvt_pk_bf16(w0 * bflo(a.x) + w1 * bflo(bq.x) + w2 * bflo(c.x), w0 * bfhi(a.x) + w1 * bfhi(bq.x) + w2 * bfhi(c.x));
        wv.y = cvt_pk_bf16(w0 * bflo(a.y) + w1 * bflo(bq.y) + w2 * bflo(c.y), w0 * bfhi(a.y) + w1 * bfhi(bq.y) + w2 * bfhi(c.y));
        wv.z = cvt_pk_bf16(w0 * bflo(a.z) + w1 * bflo(bq.z) + w2 * bflo(c.z), w0 * bfhi(a.z) + w1 * bfhi(bq.z) + w2 * bfhi(c.z));
        wv.w = cvt_pk_bf16(w0 * bflo(a.w) + w1 * bflo(bq.w) + w2 * bflo(c.w), w0 * bfhi(a.w) + w1 * bfhi(bq.w) + w2 * bfhi(c.w));
        *(GAS u32x4*)(ATTO + (size_t)t * ATT_OUT + hg * 128 + d0) = wv;
    }
}

struct H3Regs { float lf[16]; unsigned short q[16]; u32x4 v[2]; u32x4 sp[4]; };
__device__ __forceinline__ void h3_load(Frame& F, int chunk, int tid, H3Regs& R) {
    const GAS bf16_t* H = (const GAS bf16_t*)(F.ws + WS_H); const GAS _Float16* LF = (const GAS _Float16*)(F.ws + WS_LF); const GAS bf16_t* SPT = (const GAS bf16_t*)(F.ws + WS_SPT);
    const int bh = chunk >> 5, n = chunk & 31, b = bh >> 3, head = bh & 7, tok0 = b * SEQ + n * 64, kk = tid & 127, part = tid >> 7;
    const GAS _Float16* p = LF + HOFF(head * 128, tok0 + part * 16) + kk; const GAS bf16_t* pq = H + HOFF(C_HQ + head * 128, tok0 + part * 16) + kk;
#pragma unroll
    for (int j = 0; j < 16; ++j) { R.lf[j] = (float)p[(size_t)j * 128]; R.q[j] = pq[(size_t)j * 128]; }
#pragma unroll
    for (int j = 0; j < 2; ++j) { const int c = tid + 512 * j, row = c >> 4, ch = c & 15; R.v[j] = *(const GAS u32x4*)(H + HOFF(C_HI + head * 128, tok0 + row) + ch * 8); }
#pragma unroll
    for (int j = 0; j < 4; ++j) { const int c = tid + 512 * j, row = c >> 4, ch = c & 15; R.sp[j] = *(const GAS u32x4*)(SPT + (size_t)chunk * 16384 + row * 128 + ch * 8); }
}
__device__ __forceinline__ void h3_item(Frame& F, int chunk, const GAS float* normg, int tid, const H3Regs& R) {
    const GAS bf16_t* H = (const GAS bf16_t*)(F.ws + WS_H); GAS bf16_t* HGO = (GAS bf16_t*)(F.ws + WS_HGO);
    const int bh = chunk >> 5, n = chunk & 31, b = bh >> 3, head = bh & 7, tok0 = b * SEQ + n * 64;
    LAS unsigned char* QT = F.lds; LAS unsigned char* QH = F.lds + 17408; LAS unsigned char* KH = F.lds + 34816; LAS unsigned char* VT = F.lds + 52224; LAS unsigned char* SP = F.lds + 69632;
    LAS float* TOT = (LAS float*)(F.lds + 104448); LAS float* RS = (LAS float*)(F.lds + 106496);
    const int lane = tid & 63, w = __builtin_amdgcn_readfirstlane(tid >> 6);
    const int kk = tid & 127, part = tid >> 7, g = lane >> 4, i = lane & 15;
    const int tb = w & 3, vh = w >> 2;
    const size_t tok = (size_t)(tok0 + 16 * tb + i);
    f32x4 ngv[4]; u32x2 gtv[4];
#pragma unroll
    for (int vb = 0; vb < 4; ++vb) { const int vv = 16 * (4 * vh + vb) + 4 * g; ngv[vb] = *(const GAS f32x4*)(normg + head * 128 + vv); gtv[vb] = *(const GAS u32x2*)(H + HOFF(C_HGATE + head * 128, tok) + vv); }
    float lf[16], cum[16], qv[16];
#pragma unroll
    for (int j = 0; j < 16; ++j) { lf[j] = R.lf[j]; qv[j] = bf2f(R.q[j]); }
#pragma unroll
    for (int j = 0; j < 2; ++j) { const int c = tid + 512 * j, row = c >> 4, ch = c & 15; *(LAS u32x4*)(VT + row * TROW + ch * 16) = R.v[j]; }
#pragma unroll
    for (int j = 0; j < 4; ++j) { const int c = tid + 512 * j, row = c >> 4, ch = c & 15; *(LAS u32x4*)(SP + row * TROW + ch * 16) = R.sp[j]; }
    float run = 0.f;
#pragma unroll
    for (int j = 0; j < 16; ++j) { run += lf[j]; cum[j] = run; }
    TOT[part * 128 + kk] = run;
    LDS_BARRIER();
    float off = 0.f;
#pragma unroll
    for (int p = 0; p < 4; ++p) { const float t = TOT[p * 128 + kk]; if (p < part) off += t; }
    const float cmid = TOT[kk] + TOT[128 + kk];
#pragma unroll
    for (int j = 0; j < 16; ++j) { const float c = cum[j] + off; const int t = part * 16 + j; const float kq = 1.0f - __expf(lf[j]);
        const unsigned w01 = cvt_pk_bf16(qv[j] * __expf(c), qv[j] * __expf(fminf(c - cmid, 60.f)));
        *(LAS unsigned short*)(QT + t * TROW + kk * 2) = (unsigned short)w01;
        *(LAS unsigned short*)(QH + t * TROW + kk * 2) = (unsigned short)(w01 >> 16);
        *(LAS unsigned short*)(KH + t * TROW + kk * 2) = (unsigned short)cvt_pk_bf16(kq * __expf(fminf(cmid - c, 60.f)), 0.f); }
    LDS_BARRIER();
    f32x4 at[4];
#pragma unroll
    for (int sb = 0; sb < 4; ++sb) { f32x4 a4 = {0.f, 0.f, 0.f, 0.f};
        if (sb <= tb) {
#pragma unroll
            for (int ks = 0; ks < 4; ++ks) { const bf16x8 a = *(const LAS bf16x8*)(KH + (16 * sb + i) * TROW + (32 * ks + 8 * g) * 2), bq = *(const LAS bf16x8*)(QH + (16 * tb + i) * TROW + (32 * ks + 8 * g) * 2);
                a4 = mfma16(a, bq, a4); }
            if (sb == tb) {
#pragma unroll
                for (int rg = 0; rg < 4; ++rg) a4[rg] = (4 * g + rg <= i) ? a4[rg] : 0.f; }
        }
        at[sb] = a4; }
    bf16x8 pb[2];
#pragma unroll
    for (int kp = 0; kp < 2; ++kp) { const u32x4 t4 = {pk2(at[2 * kp][0], at[2 * kp][1]), pk2(at[2 * kp][2], at[2 * kp][3]), pk2(at[2 * kp + 1][0], at[2 * kp + 1][1]), pk2(at[2 * kp + 1][2], at[2 * kp + 1][3])};
        pb[kp] = __builtin_bit_cast(bf16x8, t4); }
    const unsigned vtb = (unsigned)(size_t)VT; const int q = i >> 2, p4 = i & 3;
    f32x4 o[4]; float ss = 0.f;
    s16x4 vlo[2][4], vhi[2][4];
#pragma unroll
    for (int kp = 0; kp < 2; ++kp) tr_read4x2<32>(vlo[kp], vhi[kp], vtb + (32 * kp + 4 * g + q) * TROW + (64 * vh + 4 * p4) * 2, vtb + (32 * kp + 16 + 4 * g + q) * TROW + (64 * vh + 4 * p4) * 2);
#pragma unroll
    for (int vb = 0; vb < 4; ++vb) { const int vblk = 4 * vh + vb; f32x4 acc = {0.f, 0.f, 0.f, 0.f};
#pragma unroll
        for (int ks = 0; ks < 4; ++ks) { const bf16x8 a = *(const LAS bf16x8*)(SP + (16 * vblk + i) * TROW + (32 * ks + 8 * g) * 2), bq = *(const LAS bf16x8*)(QT + (16 * tb + i) * TROW + (32 * ks + 8 * g) * 2);
            acc = mfma16(a, bq, acc); }
#pragma unroll
        for (int kp = 0; kp < 2; ++kp) acc = mfma16(TRCAT(vlo[kp][vb], vhi[kp][vb]), pb[kp], acc);
        o[vb] = acc; ss += (acc[0] * acc[0] + acc[1] * acc[1]) + (acc[2] * acc[2] + acc[3] * acc[3]); }
    ss += __shfl_xor(ss, 16); ss += __shfl_xor(ss, 32);
    if (g == 0) RS[vh * 64 + 16 * tb + i] = ss;
    LDS_BARRIER();
    const float tot = RS[16 * tb + i] + RS[64 + 16 * tb + i];
    const float rinv = rsqrtf(tot * (1.0f / 128.0f) + NORM_EPS);
#pragma unroll
    for (int vb = 0; vb < 4; ++vb) { const int vv = 16 * (4 * vh + vb) + 4 * g;
        const f32x4 ng = ngv[vb]; const u32x2 gt = gtv[vb];
        u32x2 wv; wv.x = cvt_pk_bf16(o[vb][0] * rinv * ng[0] * bflo(gt.x), o[vb][1] * rinv * ng[1] * bfhi(gt.x)); wv.y = cvt_pk_bf16(o[vb][2] * rinv * ng[2] * bflo(gt.y), o[vb][3] * rinv * ng[3] * bfhi(gt.y));
        *(GAS u32x2*)(HGO + tok * HG_WIDTH + head * 128 + vv) = wv; }
    LDS_BARRIER();
}

template <bool X8>
__device__ __forceinline__ void ln_router_phase(Frame& F, int layer) {
    PHASE_ARGS();
    const GAS bf16_t* R = (const GAS bf16_t*)(F.ws + WS_R); GAS bf16_t* X1B = (GAS bf16_t*)(F.ws + WS_X1B); GAS unsigned char* X1B8 = F.ws + WS_X1B8;
    const GAS float* g1 = GIN(8) + (size_t)layer * D_MODEL; const GAS float* b1 = GIN(9) + (size_t)layer * D_MODEL;
    const GAS float* wrt = GIN(10) + (size_t)layer * D_MODEL * N_EXPERTS; const GAS float* rbias = GIN(11) + (size_t)layer * N_EXPERTS;
    GAS int* PE = (GAS int*)(F.ws + WS_PE); GAS int* PP = (GAS int*)(F.ws + WS_PP); GAS float* PG = (GAS float*)(F.ws + WS_PG); GAS int* RM = (GAS int*)(F.ws + WS_RM);
    GAS unsigned* cnt = F.ctl + CW_CNT + layer * 64;
    constexpr int XROW = 528, WROW = 144;
    LAS unsigned char* XSb = F.lds; LAS unsigned char* WSb = F.lds + 64 * XROW; LAS float* PART = (LAS float*)F.lds; LAS float* LG = (LAS float*)(F.lds + 32768);
    LAS int* LCNT = (LAS int*)(F.lds + 49152); LAS int* BASE = (LAS int*)(F.lds + 49408); LAS int* PEL = (LAS int*)(F.lds + 49664); LAS int* PLL = (LAS int*)(F.lds + 51712);
    PHASE_IDS();
    const int g = lane >> 4, i = lane & 15;
    for (int bt = F.bid; bt < T / 64; bt += F.G) {
        const int tok0 = bt * 64;
#pragma unroll 1
        for (int pr = 0; pr < 4; ++pr) {
            f32x4 ys[2][4][2];
#pragma unroll
            for (int tt = 0; tt < 2; ++tt) { const size_t token = (size_t)(tok0 + 8 * w + 2 * pr + tt);
                const GAS u32x4* rp = (const GAS u32x4*)(R + token * D_MODEL) + lane;
#pragma unroll
                for (int j = 0; j < 4; ++j) { const u32x4 r = rp[64 * j]; ys[tt][j][0] = (f32x4){bflo(r.x), bfhi(r.x), bflo(r.y), bfhi(r.y)}; ys[tt][j][1] = (f32x4){bflo(r.z), bfhi(r.z), bflo(r.w), bfhi(r.w)}; } }
#pragma unroll
            for (int tt = 0; tt < 2; ++tt) { const size_t token = (size_t)(tok0 + 8 * w + 2 * pr + tt); float s = 0.f;
#pragma unroll
                for (int j = 0; j < 4; ++j)
#pragma unroll
                    for (int h = 0; h < 2; ++h) s += (ys[tt][j][h][0] + ys[tt][j][h][1]) + (ys[tt][j][h][2] + ys[tt][j][h][3]);
                const float mean = wave_sum(s) * (1.0f / D_MODEL); float s2 = 0.f;
#pragma unroll
                for (int j = 0; j < 4; ++j)
#pragma unroll
                    for (int h = 0; h < 2; ++h) { ys[tt][j][h] = ys[tt][j][h] - mean; s2 += (ys[tt][j][h][0] * ys[tt][j][h][0] + ys[tt][j][h][1] * ys[tt][j][h][1]) + (ys[tt][j][h][2] * ys[tt][j][h][2] + ys[tt][j][h][3] * ys[tt][j][h][3]); }
                const float rstd = rsqrtf(wave_sum(s2) * (1.0f / D_MODEL) + LN_EPS);
#pragma unroll
                for (int j = 0; j < 4; ++j) { const int c = 8 * lane + 512 * j;
                    const f32x4 y0 = ys[tt][j][0] * rstd * *(const GAS f32x4*)(g1 + c) + *(const GAS f32x4*)(b1 + c), y1 = ys[tt][j][1] * rstd * *(const GAS f32x4*)(g1 + c + 4) + *(const GAS f32x4*)(b1 + c + 4);
                    u32x4 o; o.x = cvt_pk_bf16(y0[0], y0[1]); o.y = cvt_pk_bf16(y0[2], y0[3]); o.z = cvt_pk_bf16(y1[0], y1[1]); o.w = cvt_pk_bf16(y1[2], y1[3]);
                    *(GAS u32x4*)(X1B + token * D_MODEL + c) = o;
                    if constexpr (X8) { u32x2 w8; int q8 = __builtin_amdgcn_cvt_pk_fp8_f32(y0[0], y0[1], 0, false); q8 = __builtin_amdgcn_cvt_pk_fp8_f32(y0[2], y0[3], q8, true); w8.x = (unsigned)q8;
                        q8 = __builtin_amdgcn_cvt_pk_fp8_f32(y1[0], y1[1], 0, false); q8 = __builtin_amdgcn_cvt_pk_fp8_f32(y1[2], y1[3], q8, true); w8.y = (unsigned)q8;
                        *(GAS u32x2*)(X1B8 + token * D_MODEL + c) = w8; } }
            }
        }
        VM_WAIT(); __syncthreads();
        f32x4 dacc[4];
#pragma unroll
        for (int nb = 0; nb < 4; ++nb) dacc[nb] = (f32x4){0.f, 0.f, 0.f, 0.f};
        const int tt4 = w & 3, kh = w >> 2;
        u32x4 xr[4];
#pragma unroll
        for (int j = 0; j < 4; ++j) { const int idx = tid + 512 * j, row = idx >> 5, c8 = idx & 31; xr[j] = *(const GAS u32x4*)(X1B + (size_t)(tok0 + row) * D_MODEL + 8 * c8); }
#pragma unroll 1
        for (int ke = 0; ke < 8; ++ke) { const int k1 = 256 * (ke + 1);
#pragma unroll
            for (int j = 0; j < 4; ++j) { const int idx = tid + 512 * j, row = idx >> 5, c8 = idx & 31; *(LAS u32x4*)(XSb + row * XROW + c8 * 16) = xr[j]; }
#pragma unroll
            for (int j = 0; j < 8; ++j) { const int idx = tid + 512 * j, row = idx >> 4, c4 = idx & 15; const f32x4 v = *(const GAS f32x4*)(wrt + (size_t)(k1 - 256 + row) * N_EXPERTS + 4 * c4);
                u32x2 o; o.x = cvt_pk_bf16(v[0], v[1]); o.y = cvt_pk_bf16(v[2], v[3]); *(LAS u32x2*)(WSb + row * WROW + c4 * 8) = o; }
            LDS_BARRIER();
            if (ke < 7) {
#pragma unroll
                for (int j = 0; j < 4; ++j) { const int idx = tid + 512 * j, row = idx >> 5, c8 = idx & 31; xr[j] = *(const GAS u32x4*)(X1B + (size_t)(tok0 + row) * D_MODEL + k1 + 8 * c8); }
            }
            { const unsigned wsb = (unsigned)(size_t)WSb; const int q = i >> 2, p4 = i & 3;
#pragma unroll
              for (int ks = 0; ks < 4; ++ks) { const int kk0 = 128 * kh + 32 * ks;
                const bf16x8 a = *(const LAS bf16x8*)(XSb + (tt4 * 16 + i) * XROW + (kk0 + 8 * g) * 2);
                s16x4 lo4[4], hi4[4];
                tr_read4x2<32>(lo4, hi4, wsb + (kk0 + 8 * g + q) * WROW + 8 * p4, wsb + (kk0 + 8 * g + 4 + q) * WROW + 8 * p4);
#pragma unroll
                for (int nb = 0; nb < 4; ++nb) dacc[nb] = mfma16(a, TRCAT(lo4[nb], hi4[nb]), dacc[nb]); } }
            LDS_BARRIER();
        }
#pragma unroll
        for (int nb = 0; nb < 4; ++nb)
#pragma unroll
            for (int rg = 0; rg < 4; ++rg) PART[(kh * 64 + tt4 * 16 + 4 * g + rg) * 64 + 16 * nb + i] = dacc[nb][rg];
        __syncthreads();
        { const f32x4 a0 = *(const LAS f32x4*)(PART + tid * 8), a1 = *(const LAS f32x4*)(PART + tid * 8 + 4), c0 = *(const LAS f32x4*)(PART + 4096 + tid * 8), c1 = *(const LAS f32x4*)(PART + 4096 + tid * 8 + 4);
          __syncthreads();
          *(LAS f32x4*)(LG + tid * 8) = a0 + c0; *(LAS f32x4*)(LG + tid * 8 + 4) = a1 + c1; }
        if (tid < 64) { RM[(size_t)N_EXPERTS * T + tok0 + tid] = tok0 + tid; LCNT[tid] = 0; }
        __syncthreads();
#pragma unroll 1
        for (int tt = 0; tt < 8; ++tt) { const int tk = 8 * w + tt, token = tok0 + tk, e = lane;
            const float sc = 1.0f / (1.0f + expf(-LG[tk * 64 + e])); const float sel = sc + rbias[e];
            const float m1 = max8_dpp(sel);
            const unsigned long long bal = __ballot(sel == m1) & (0xFFull << (8 * (e >> 3)));
            const int first = __builtin_ctzll(bal);
            const float v2 = max8_dpp((e == first) ? -INFINITY : sel);
            const float gs = m1 + v2; int grank = 0;
#pragma unroll
            for (int gp = 0; gp < 8; ++gp) { const float o = __builtin_bit_cast(float, __builtin_amdgcn_readlane(__builtin_bit_cast(int, gs), 8 * gp)); grank += (o > gs || (o == gs && gp < (e >> 3))) ? 1 : 0; }
            const bool gsel = grank < TOPK_GROUPS; const float sel2 = gsel ? sel : -INFINITY; int rank = 0;
            const unsigned long long gbal = __ballot(gsel);
#pragma unroll 1
            for (int gp = 0; gp < 8; ++gp) { if (((gbal >> (8 * gp)) & 1ull) == 0ull) continue;
#pragma unroll
                for (int q = 0; q < 8; ++q) { const int ep = 8 * gp + q; const float o = __builtin_bit_cast(float, __builtin_amdgcn_readlane(__builtin_bit_cast(int, sel2), ep)); rank += (o > sel2 || (o == sel2 && ep < e)) ? 1 : 0; } }
            const bool chosen = gsel && rank < TOP_K;
            float wsum = 0.f; { unsigned long long cb = __ballot(chosen);
                while (cb) { const int l = __builtin_ctzll(cb); wsum += __builtin_bit_cast(float, __builtin_amdgcn_readlane(__builtin_bit_cast(int, sc), l)); cb &= cb - 1ull; } }
            if (chosen) { const int lpos = __hip_atomic_fetch_add(LCNT + e, 1, __ATOMIC_RELAXED, __HIP_MEMORY_SCOPE_WORKGROUP);
                PEL[tk * 8 + rank] = e; PLL[tk * 8 + rank] = lpos;
                PE[(size_t)token * 8 + rank] = e; PG[(size_t)token * 8 + rank] = sc / wsum * ROUTED_SCALE; }
        }
        __syncthreads();
        if (tid < 64) BASE[tid] = (int)__hip_atomic_fetch_add(cnt + tid, (unsigned)LCNT[tid], __ATOMIC_RELAXED, __HIP_MEMORY_SCOPE_AGENT);
        __syncthreads();
        { const int e = PEL[tid], pos = BASE[e] + PLL[tid], token = tok0 + (tid >> 3);
          PP[(size_t)token * 8 + (tid & 7)] = pos; RM[(size_t)e * T + pos] = token; }
        __syncthreads();
    }
}

__device__ __forceinline__ void build_toff(Frame& F, int layer) {
    LAS int* toff = (LAS int*)(F.lds + LDS_TAB);
    if (threadIdx.x < 64) {
        const GAS unsigned* cnt = F.ctl + CW_CNT + layer * 64; const int e = (int)threadIdx.x;
        const int tiles = ((int)__hip_atomic_load(cnt + e, RLX_AGENT) + 255) >> 8; int incl = tiles;
#pragma unroll
        for (int o = 1; o < 64; o <<= 1) { const int up = __shfl_up(incl, o); if (e >= o) incl += up; }
        toff[e] = incl - tiles;
        if (e == 63) { toff[N_EXPERTS] = incl; toff[NEXP1] = incl + T / 256; } }
    __syncthreads();
}

template <bool Y8, bool LAST>
__device__ __forceinline__ void combine_ln2_phase(Frame& F, int layer) {
    PHASE_ARGS(); GAS float* OUT = (GAS float*)(GAS float*)ap->out;
    const GAS bf16_t* Y = (const GAS bf16_t*)(F.ws + WS_Y); const GAS bf16_t* X1B = (const GAS bf16_t*)(F.ws + WS_X1B); GAS bf16_t* XB = (GAS bf16_t*)(F.ws + WS_XB); GAS unsigned char* XB8 = F.ws + WS_XB8;
    const GAS float* g2 = GIN(18) + (size_t)layer * D_MODEL; const GAS float* b2 = GIN(19) + (size_t)layer * D_MODEL;
    const GAS int* PE = (const GAS int*)(F.ws + WS_PE); const GAS int* PP = (const GAS int*)(F.ws + WS_PP); const GAS float* PG = (const GAS float*)(F.ws + WS_PG);
    const LAS int* toff = (const LAS int*)(F.lds + LDS_TAB);
    PHASE_IDS();
    const int gw = F.bid * 8 + w, NGW = F.G * 8;
    for (int tb = gw; tb < T; tb += 8 * NGW) {
        int myrow = 0; float mygate = 0.f;
        { const int tl = tb + (lane >> 3) * NGW; if (tl < T) { const int e = PE[(size_t)tl * 8 + (lane & 7)]; myrow = toff[e] * 256 + PP[(size_t)tl * 8 + (lane & 7)]; mygate = PG[(size_t)tl * 8 + (lane & 7)]; } }
#pragma unroll 1
      for (int tj = 0; tj < 8; ++tj) { const int t = tb + tj * NGW; if (t >= T) break;
        f32x4 a[4][2];
#pragma unroll
        for (int j = 0; j < 4; ++j) { a[j][0] = (f32x4){0.f, 0.f, 0.f, 0.f}; a[j][1] = (f32x4){0.f, 0.f, 0.f, 0.f}; }
#pragma unroll
        for (int k = 0; k < 9; ++k) { size_t row; float gt;
            if (k < 8) { row = (size_t)__shfl(myrow, tj * 8 + k); gt = __shfl(mygate, tj * 8 + k); }
            else { row = (size_t)toff[N_EXPERTS] * 256 + t; gt = 1.0f; }
            if constexpr (Y8) {
                const GAS u32x2* yp = (const GAS u32x2*)((const GAS unsigned char*)Y + row * D_MODEL) + lane;
#pragma unroll
                for (int j = 0; j < 4; ++j) { const u32x2 y = yp[64 * j];
                    const f32x2 p0 = __builtin_amdgcn_cvt_pk_f32_fp8((int)y.x, false), p1 = __builtin_amdgcn_cvt_pk_f32_fp8((int)y.x, true), p2 = __builtin_amdgcn_cvt_pk_f32_fp8((int)y.y, false), p3 = __builtin_amdgcn_cvt_pk_f32_fp8((int)y.y, true);
                    a[j][0] += (f32x4){p0[0], p0[1], p1[0], p1[1]} * gt; a[j][1] += (f32x4){p2[0], p2[1], p3[0], p3[1]} * gt; }
            } else {
            const GAS u32x4* yp = (const GAS u32x4*)(Y + row * D_MODEL) + lane;
#pragma unroll
            for (int j = 0; j < 4; ++j) { const u32x4 y = yp[64 * j];
                a[j][0] += (f32x4){bflo(y.x), bfhi(y.x), bflo(y.y), bfhi(y.y)} * gt; a[j][1] += (f32x4){bflo(y.z), bfhi(y.z), bflo(y.w), bfhi(y.w)} * gt; } } }
        float s = 0.f;
#pragma unroll
        for (int j = 0; j < 4; ++j) { const u32x4 xv = *(const GAS u32x4*)(X1B + (size_t)t * D_MODEL + 8 * lane + 512 * j);
            a[j][0] += (f32x4){bflo(xv.x), bfhi(xv.x), bflo(xv.y), bfhi(xv.y)} * DN_ALPHA; a[j][1] += (f32x4){bflo(xv.z), bfhi(xv.z), bflo(xv.w), bfhi(xv.w)} * DN_ALPHA;
            s += (a[j][0][0] + a[j][0][1]) + (a[j][0][2] + a[j][0][3]) + (a[j][1][0] + a[j][1][1]) + (a[j][1][2] + a[j][1][3]); }
        const float mean = wave_sum(s) * (1.0f / D_MODEL); float s2 = 0.f;
#pragma unroll
        for (int j = 0; j < 4; ++j) { a[j][0] = a[j][0] - mean; a[j][1] = a[j][1] - mean;
            s2 += (a[j][0][0] * a[j][0][0] + a[j][0][1] * a[j][0][1]) + (a[j][0][2] * a[j][0][2] + a[j][0][3] * a[j][0][3]) + (a[j][1][0] * a[j][1][0] + a[j][1][1] * a[j][1][1]) + (a[j][1][2] * a[j][1][2] + a[j][1][3] * a[j][1][3]); }
        const float rstd = rsqrtf(wave_sum(s2) * (1.0f / D_MODEL) + LN_EPS);
#pragma unroll
        for (int j = 0; j < 4; ++j) { const int c = 8 * lane + 512 * j;
            const f32x4 o0 = a[j][0] * rstd * *(const GAS f32x4*)(g2 + c) + *(const GAS f32x4*)(b2 + c), o1 = a[j][1] * rstd * *(const GAS f32x4*)(g2 + c + 4) + *(const GAS f32x4*)(b2 + c + 4);
            if constexpr (LAST) { *(GAS f32x4*)(OUT + (size_t)t * D_MODEL + c) = o0; *(GAS f32x4*)(OUT + (size_t)t * D_MODEL + c + 4) = o1; }
            else {
            u32x4 wv; wv.x = cvt_pk_bf16(o0[0], o0[1]); wv.y = cvt_pk_bf16(o0[2], o0[3]); wv.z = cvt_pk_bf16(o1[0], o1[1]); wv.w = cvt_pk_bf16(o1[2], o1[3]);
            *(GAS u32x4*)(XB + (size_t)t * D_MODEL + c) = wv;
            u32x2 w8; { int q = __builtin_amdgcn_cvt_pk_fp8_f32(o0[0], o0[1], 0, false); q = __builtin_amdgcn_cvt_pk_fp8_f32(o0[2], o0[3], q, true); w8.x = (unsigned)q;
                        q = __builtin_amdgcn_cvt_pk_fp8_f32(o1[0], o1[1], 0, false); q = __builtin_amdgcn_cvt_pk_fp8_f32(o1[2], o1[3], q, true); w8.y = (unsigned)q; }
            *(GAS u32x2*)(XB8 + (size_t)t * D_MODEL + c) = w8; } }
      }
    }
}

constexpr int PH_PER_LAYER = 11, N_PHASES = DEPTH * PH_PER_LAYER;
constexpr int CONV_TAIL = 2048;
constexpr bool GU8_ALL = true;
#ifndef PH_MASK
#define PH_MASK 0x7ff
#endif
#define IN(k) (((PH_MASK >> ((k) % PH_PER_LAYER)) & 1) && lo <= (k) && (k) < hi)
#ifndef PROBE_MASK
#define PROBE_MASK 0
#endif
#ifndef PROBE_AMP
#define PROBE_AMP 4
#endif
constexpr int LDS_STAMP = LDS_TAB + 1024;
#define SEAM(k) do { if (IN(k) && IN((k) + 1)) xcd_barrier(bar); \
    if (PROBE_MASK != 0 && threadIdx.x == 0) ((LAS unsigned long long*)(F0.lds + LDS_STAMP))[(k) + 1] = __builtin_amdgcn_s_memrealtime(); } while (0)
#define PHASE_FRAME() Frame F = F0; asm volatile("" : "+s"(F.ws), "+s"(F.ctl), "+s"(F.G), "+s"(F.bid), "+s"(F.lds)); \
    F.ws = (GAS unsigned char*)(GAS unsigned char*)F.ws; F.ctl = (GAS unsigned*)(GAS unsigned*)F.ctl;     \
    GAS unsigned char* ws = F.ws; (void)ws
template <int layer>
__device__ __forceinline__ void run_layer(const Frame& F0, const XcdBarrier& bar, const int lo, const int hi) {
        const int pb = layer * PH_PER_LAYER;
        constexpr bool GU8 = (layer == DEPTH - 1) || GU8_ALL;
        constexpr bool MOE8 = (layer == DEPTH - 1);
        if constexpr (layer == 0) { if (IN(pb + 0)) { PHASE_FRAME(); p0_convert(F, layer, GU8, MOE8, 1); } }
        SEAM(pb + 0);
        if (IN(pb + 1)) { PHASE_FRAME();
            EpiIn E{(GAS bf16_t*)(ws + WS_H), (GAS _Float16*)(ws + WS_LF), (const GAS float*)(ws + WS_LB) + layer * HG_WIDTH, (const GAS f32x4*)(ws + WS_ROPE)};
            DenseSched Sa{(const GAS char*)(ws + WS_XB), (const GAS char*)(ws + WS_WINF) - (size_t)C_HF * (D_MODEL * 2), D_MODEL * 2, D_MODEL * 2, D_MODEL / 64, T / 256, HG_WIDTH / 256, F.G, F.bid, 0, C_HF / 256};
            pg8::gemm_phase<EpiIn, DenseSched, false, false, true>(F.lds, Sa, E);
            DenseSched Sb{(const GAS char*)(ws + WS_XB8), (const GAS char*)(ws + WS_WIN), D_MODEL, D_MODEL, D_MODEL / 128, T / 256, (IN_WIDTH - HG_WIDTH) / 256, F.G, F.bid, C_HF / 256, HG_WIDTH / 256};
            if constexpr (layer == 0) {
                const long ntile = (long)Sb.nM * Sb.nN; const int nun = (int)((ntile - F.bid + F.G - 1) / F.G);
                const int ks = __builtin_amdgcn_readfirstlane(((F.bid & 7) * (nun + 1)) >> 3);
#pragma unroll 1
                for (int part = 0; part < 2; ++part) {
                    pg8::RangeSched<DenseSched> RS{Sb, part == 0 ? 0 : ks, part == 0 ? ks : (1 << 30)};
                    pg8::gemm_phase<EpiIn, pg8::RangeSched<DenseSched>, false, true, true>(F.lds, RS, E);
                    if (part == 0) p0_convert(F, layer, GU8, MOE8, 2, CONV_TAIL);
                }
                p0_convert(F, layer, GU8, MOE8, 2, CONV_TAIL, F.ctl + CW_CQ);
            } else pg8::gemm_phase<EpiIn, DenseSched, false, true, true>(F.lds, Sb, E);
        }
        SEAM(pb + 1);
        if (IN(pb + 2)) { PHASE_FRAME();
            { PHASE_IDS(); H1Regs ra, rb; int it = F.bid;
              if (it < NCHUNK * HG_HEADS) h1_load(F, it, tid, ra);
              for (; it < NCHUNK * HG_HEADS; it += F.G) { const int itn = it + F.G; if (itn < NCHUNK * HG_HEADS) h1_load(F, itn, tid, rb); h1_item(F, it, tid, ra); ra = rb; } }
            { constexpr int NAI = BATCH * ATT_HEADS * 16; const int nb = F.G >> 3, x = F.bid & 7, lb = F.bid >> 3;
              PHASE_IDS(); AttKV R;
              if ((F.G & 7) == 0 && NAI % 8 == 0) {
                  auto item_of = [&](int k) { const int hh = k >> 4, jj = ((k & 15) + hh) & 15; return x * (NAI / 8) + hh * 16 + jj; };
                  int k = lb; if (k < NAI / 8) attn_kv_load(F, item_of(k), tid, R);
                  for (; k < NAI / 8; k += nb) attn_item(F, item_of(k), R, (k + nb < NAI / 8) ? item_of(k + nb) : -1); }
              else { int it = F.bid; if (it < NAI) attn_kv_load(F, it, tid, R);
                  for (; it < NAI; it += F.G) attn_item(F, it, R, (it + F.G < NAI) ? it + F.G : -1); } }
        }
        SEAM(pb + 2);
        if (IN(pb + 3)) { PHASE_FRAME();
            for (int it = F.bid; it < BATCH * HG_HEADS * 4; it += F.G) scan_item(F, it);
            attn_merge(F);
        }
        SEAM(pb + 3);
        if (IN(pb + 4)) { PHASE_FRAME();
            PHASE_ARGS(); const GAS float* normg = GIN(4) + (size_t)layer * HG_WIDTH;
            { PHASE_IDS(); H3Regs ra, rb; int it = F.bid;
              if (it < NCHUNK * HG_HEADS) h3_load(F, it, tid, ra);
              for (; it < NCHUNK * HG_HEADS; it += F.G) { const int itn = it + F.G; if (itn < NCHUNK * HG_HEADS) h3_load(F, itn, tid, rb); h3_item(F, it, normg, tid, ra); ra = rb; } }
        }
        SEAM(pb + 4);
        if (IN(pb + 5)) { PHASE_FRAME();
            MergeSched S{(const GAS char*)(ws + WS_HGO), (const GAS char*)(ws + WS_WHG), (const GAS char*)(ws + WS_ATTO), (const GAS char*)(ws + WS_WATT), T / 256, D_MODEL / 256, F.G, F.bid};
            EpiMerge E{(const GAS bf16_t*)(ws + WS_H), (GAS bf16_t*)(ws + WS_MRG)};
            pg8::gemm_phase<EpiMerge, MergeSched, false>(F.lds, S, E);
        }
        SEAM(pb + 5);
        if (IN(pb + 6)) { PHASE_FRAME();
            DenseSched S{(const GAS char*)(ws + WS_MRG), (const GAS char*)(ws + WS_WOUT), D_MODEL, D_MODEL, D_MODEL / 128, T / 256, D_MODEL / 256, F.G, F.bid, 1 << 30, 0};
            PHASE_ARGS(); EpiResid E{(const GAS bf16_t*)(ws + WS_XB), (GAS bf16_t*)(ws + WS_R)};
            pg8::gemm_phase<EpiResid, DenseSched, false, true, true>(F.lds, S, E);
        }
        SEAM(pb + 6);
        if (IN(pb + 7)) { PHASE_FRAME(); ln_router_phase<GU8>(F, layer); }
        SEAM(pb + 7);
        if (IN(pb + 8)) { PHASE_FRAME();
            build_toff(F, layer);
            {
                typedef MoeSched<4, true, GU8 ? 1 : 2> SchedT;
                SchedT S{(const LAS int*)(F.lds + LDS_TAB), F.ctl + CW_CNT + layer * 64, (const GAS char*)(ws + (GU8 ? WS_X1B8 : WS_X1B)), (const GAS char*)(ws + (MOE8 ? WS_WGU8 : WS_WGU)), (const GAS int*)(ws + WS_RM), F.G, F.bid, (const LAS int*)(F.lds + LDS_EPI), (const LAS int*)(F.lds + LDS_TAB + 512)}; S.build_units((LAS int*)(F.lds + LDS_TAB + 512));
                EpiGateUp<true> E{(GAS bf16_t*)(ws + WS_HID)};
                if constexpr (layer + 1 < DEPTH) {
                    int nun = 0; { const LAS int* ut = (const LAS int*)(F.lds + LDS_TAB + 512); for (int i = 0; i < 32; ++i) nun += ut[i * 4 + 3]; }
                    const int ks = __builtin_amdgcn_readfirstlane(((F.bid & 7) * (nun + 1)) >> 3);
#pragma unroll 1
                    for (int part = 0; part < 2; ++part) {
                        pg8::RangeSched<SchedT> RS{S, part == 0 ? 0 : ks, part == 0 ? ks : (1 << 30)};
                        pg8::gemm_phase<EpiGateUp<true>, pg8::RangeSched<SchedT>, true, GU8>(F.lds, RS, E);
                        if (part == 0) p0_convert(F, layer + 1, (layer + 1 == DEPTH - 1) || GU8_ALL, layer + 1 == DEPTH - 1, 0, CONV_TAIL);
                    }
                    p0_convert(F, layer + 1, (layer + 1 == DEPTH - 1) || GU8_ALL, layer + 1 == DEPTH - 1, 0, CONV_TAIL, F.ctl + CW_CQ + 64);
                } else pg8::gemm_phase<EpiGateUp<true>, SchedT, true, GU8>(F.lds, S, E);
            }
        }
        SEAM(pb + 8);
        if (IN(pb + 9)) { PHASE_FRAME();
            build_toff(F, layer);
            {
                EpiDown<true> E{(GAS bf16_t*)(ws + WS_Y)};
                MoeSched<8, false, 1> S{(const LAS int*)(F.lds + LDS_TAB), F.ctl + CW_CNT + layer * 64, (const GAS char*)(ws + WS_HID), (const GAS char*)(ws + (MOE8 ? WS_WDN8 : WS_WDN)), nullptr, F.G, F.bid, nullptr, (const LAS int*)(F.lds + LDS_TAB + 512)}; S.build_units((LAS int*)(F.lds + LDS_TAB + 512));
                pg8::gemm_phase<EpiDown<true>, MoeSched<8, false, 1>, false, true, true>(F.lds, S, E);
            }
        }
        SEAM(pb + 9);
        if (IN(pb + 10)) { PHASE_FRAME(); build_toff(F, layer); combine_ln2_phase<true, layer == DEPTH - 1>(F, layer); }
        if constexpr (layer == DEPTH - 1) { SEAM(pb + 10); } else { if (PROBE_MASK != 0 && threadIdx.x == 0) ((LAS unsigned long long*)(F0.lds + LDS_STAMP))[pb + 11] = __builtin_amdgcn_s_memrealtime(); }
}
#undef IN
#undef SEAM
__global__ void __launch_bounds__(512, 2) kfwd(Args args) {
    extern __shared__ __attribute__((aligned(16))) unsigned char lds_raw[];
    Frame F0;
    F0.lds = (LAS unsigned char*)lds_raw;
    F0.G = gridDim.x; F0.bid = blockIdx.x; F0.ws = (GAS unsigned char*)args.ws; F0.ctl = (GAS unsigned*)(args.ws + WS_CTL);
    for (int u = threadIdx.x; u < (LDS_BYTES - LDS_TAB) / 4; u += 512) ((LAS unsigned*)(F0.lds + LDS_TAB))[u] = 0u;
    __syncthreads();
    XcdBarrier bar = xcd_barrier_post((unsigned*)(F0.ctl + CW_BAR), (volatile LAS unsigned*)(F0.lds + LDS_MISC));
    const int lo = args.ph_lo, hi = args.ph_hi;
    if (PROBE_MASK != 0 && threadIdx.x == 0) ((LAS unsigned long long*)(F0.lds + LDS_STAMP))[0] = __builtin_amdgcn_s_memrealtime();
    run_layer<0>(F0, bar, lo, hi);
    run_layer<1>(F0, bar, lo, hi);
    if (PROBE_MASK != 0 && blockIdx.x == 0 && threadIdx.x == 0) {
        const LAS unsigned long long* ts = (const LAS unsigned long long*)(F0.lds + LDS_STAMP); unsigned long long tot = 0;
        for (int k = 0; k < N_PHASES; ++k) if ((PROBE_MASK >> (k % PH_PER_LAYER)) & 1) tot += ts[k + 1] - ts[k];
        const unsigned long long t0 = __builtin_amdgcn_s_memrealtime(), lim = tot * PROBE_AMP < 4000000ull ? tot * PROBE_AMP : 4000000ull;
        while (__builtin_amdgcn_s_memrealtime() - t0 < lim) __builtin_amdgcn_s_sleep(32);
    }
}

extern "C" void kernel_launch(void* const* d_in, const int* in_sizes, int n_in, void* d_out, int out_size, void* d_ws, size_t ws_size, hipStream_t stream) {
    static int grid = 0;
    if (grid == 0) {
        if (n_in != 20 || out_size != T * D_MODEL || ws_size < WS_END) { fprintf(stderr, "kernel_launch: unexpected shapes (n_in %d, out %d, ws %zu < %zu)\n", n_in, out_size, ws_size, (size_t)WS_END); grid = -1; return; }
        int dev = 0, cus = 0, per_cu = 0;
        if (hipGetDevice(&dev) != hipSuccess || hipDeviceGetAttribute(&cus, hipDeviceAttributeMultiprocessorCount, dev) != hipSuccess) { grid = -1; return; }
        if (hipFuncSetAttribute((const void*)kfwd, hipFuncAttributeMaxDynamicSharedMemorySize, LDS_BYTES) != hipSuccess) { fprintf(stderr, "kernel_launch: hipFuncSetAttribute failed\n"); grid = -1; return; }
        if (hipOccupancyMaxActiveBlocksPerMultiprocessor(&per_cu, (const void*)kfwd, 512, LDS_BYTES) != hipSuccess || per_cu < 1) fprintf(stderr, "kernel_launch: occupancy query says %d\n", per_cu);
        (void)hipGetLastError();
        grid = cus;
    }
    if (grid < 0) return;
    if (hipMemsetAsync((char*)d_ws + WS_CTL, 0, CTL_ZERO_BYTES, stream) != hipSuccess) return;
    Args a{};
    for (int i = 0; i < 20; ++i) a.in[i] = (const float*)d_in[i];
    a.out = (float*)d_out; a.ws = (unsigned char*)d_ws;
#if MK_LAUNCH_PER_PHASE
    for (int p = 0; p < N_PHASES; ++p) { a.ph_lo = p; a.ph_hi = p + 1; hipLaunchKernelGGL(kfwd, dim3(grid), dim3(512), LDS_BYTES, stream, a); }
#else
    a.ph_lo = 0; a.ph_hi = N_PHASES; hipLaunchKernelGGL(kfwd, dim3(grid), dim3(512), LDS_BYTES, stream, a);
#endif
}
```

```cpp
#include <hip/hip_runtime.h>
#include <cstdio>
#include <cstdint>

#ifndef MK_LAUNCH_PER_PHASE
#define MK_LAUNCH_PER_PHASE 0
#endif

#define GAS __attribute__((address_space(1)))
#define LAS __attribute__((address_space(3)))
typedef unsigned short bf16_t;
typedef short bf16x8 __attribute__((ext_vector_type(8)));
typedef short s16x4 __attribute__((ext_vector_type(4)));
typedef float f32x4 __attribute__((ext_vector_type(4)));
typedef float f32x2 __attribute__((ext_vector_type(2)));
typedef unsigned u32x4 __attribute__((ext_vector_type(4)));
typedef unsigned u32x2 __attribute__((ext_vector_type(2)));
typedef _Float16 f16x8 __attribute__((ext_vector_type(8)));

constexpr int D_MODEL = 2048, BATCH = 8, SEQ = 2048, DEPTH = 2, T = BATCH * SEQ;
constexpr int HG_HEADS = 8, HG_DIM = 128, HG_WIDTH = 1024, HG_CHUNK = 64, NCHUNK = T / HG_CHUNK;
constexpr int ATT_HEADS = 12, ATT_DIM = 128, ATT_WIDTH = 1536, ATT_OUT = 512;
constexpr int N_EXPERTS = 64, N_GROUPS = 8, TOPK_GROUPS = 4, TOP_K = 8, EXPERT_FF = 512;
constexpr int IN_WIDTH = 12800;
constexpr int C_HQ = 0, C_HF = 1024, C_HI = 2048, C_HGATE = 3072, C_AQ = 4096, C_AK = 5632, C_AV = 7168, C_GH = 8704, C_GA = 10752;
constexpr float ROUTED_SCALE = 2.5f, LN_EPS = 1e-5f, NORM_EPS = 1e-6f;
constexpr float DN_ALPHA = 1.41421356237309515f;
#define HOFF(c, row) (((size_t)((c) >> 7) * T + (size_t)(row)) * 128 + ((c) & 127))
constexpr int NEXP1 = N_EXPERTS + 1;
constexpr int MAXROWS = 163840;

constexpr size_t MiB = 1u << 20;
constexpr size_t WS_CTL = 0, CTL_ZERO_BYTES = 1 * MiB;
constexpr size_t WS_WIN = 4 * MiB;
constexpr size_t WS_WHG = 54 * MiB;
constexpr size_t WS_WATT = 58 * MiB;
constexpr size_t WS_WOUT = 60 * MiB;
constexpr size_t WS_WGU = 68 * MiB;
constexpr size_t WS_WDN = 328 * MiB;
constexpr size_t WS_ROPE = 458 * MiB;
constexpr size_t WS_LB = 466 * MiB;
constexpr size_t WS_R = 467 * MiB;
constexpr size_t WS_X1 = 595 * MiB;
constexpr size_t WS_XB = 723 * MiB;
constexpr size_t WS_X1B = 787 * MiB;
constexpr size_t WS_PE = 851 * MiB;
constexpr size_t WS_PP = 852 * MiB;
constexpr size_t WS_PG = 853 * MiB;
constexpr size_t WS_RM = 854 * MiB;
constexpr size_t WS_HID = 859 * MiB;
constexpr size_t WS_BIG = 1019 * MiB;
constexpr size_t WS_H = WS_BIG;
constexpr size_t WS_LF = WS_BIG + 400 * MiB;
constexpr size_t WS_UT = WS_BIG + 464 * MiB;
constexpr size_t WS_SPT = WS_BIG + 592 * MiB;
constexpr size_t WS_DEC = WS_BIG + 656 * MiB;
constexpr size_t WS_LSE = WS_BIG + 657 * MiB;
constexpr size_t WS_HGO = WS_BIG + 658 * MiB;
constexpr size_t WS_ATTO = WS_BIG + 690 * MiB;
constexpr size_t WS_MRG = WS_BIG + 706 * MiB;
constexpr size_t WS_Y = WS_BIG;
constexpr size_t WS_XB8 = WS_BIG + 772 * MiB;
constexpr size_t WS_WINF = WS_WIN + 30 * MiB;
constexpr size_t WS_X1B8 = WS_BIG + 804 * MiB;
constexpr size_t WS_WGU8 = 531 * MiB;
constexpr size_t WS_WDN8 = WS_BIG + 836 * MiB;
constexpr size_t WS_END = WS_BIG + 901 * MiB;
constexpr int CW_TMO = 0;
constexpr int CW_CNT = 1024;
constexpr int CW_CQ = 2048;
constexpr int CW_BAR = 4096;

constexpr int LDS_BYTES = 159744;
constexpr int LDS_EPI = 131072;
constexpr int LDS_TAB = 147456;
constexpr int LDS_MISC = LDS_TAB + 2048;

#define RLX_AGENT __ATOMIC_RELAXED, __HIP_MEMORY_SCOPE_AGENT
#define LDS_WAIT() asm volatile("s_waitcnt lgkmcnt(0)" ::: "memory")
#define VM_WAIT() asm volatile("s_waitcnt vmcnt(0)" ::: "memory")
#define LDS_BARRIER() asm volatile("s_waitcnt lgkmcnt(0)\n\ts_barrier" ::: "memory")
__device__ __forceinline__ unsigned f2bf(float f) { unsigned u = __builtin_bit_cast(unsigned, f); return (u + 0x7fffu + ((u >> 16) & 1u)) >> 16; }
__device__ __forceinline__ unsigned pk2(float lo, float hi) { return f2bf(lo) | (f2bf(hi) << 16); }
__device__ __forceinline__ float bf2f(unsigned short b) { return __builtin_bit_cast(float, ((unsigned)b) << 16); }
__device__ __forceinline__ float bflo(unsigned w) { return __builtin_bit_cast(float, w << 16); }
__device__ __forceinline__ float bfhi(unsigned w) { return __builtin_bit_cast(float, w & 0xffff0000u); }
__device__ __forceinline__ unsigned cvt_pk_bf16(float lo, float hi) { unsigned r; asm volatile("v_cvt_pk_bf16_f32 %0, %1, %2" : "=v"(r) : "v"(lo), "v"(hi)); return r; }
__device__ __forceinline__ float fdiv(float a, float b) { return a * __builtin_amdgcn_rcpf(b); }
__device__ __forceinline__ float fsigmoid(float x) { return __builtin_amdgcn_rcpf(1.0f + __expf(-x)); }
__device__ __forceinline__ float wave_sum(float v) {
#pragma unroll
    for (int o = 1; o < 64; o <<= 1) v += __shfl_xor(v, o);
    return v;
}
__device__ __forceinline__ float max8_dpp(float v) {
    v = fmaxf(v, __builtin_bit_cast(float, __builtin_amdgcn_update_dpp(0, __builtin_bit_cast(int, v), 0xB1, 0xF, 0xF, false)));
    v = fmaxf(v, __builtin_bit_cast(float, __builtin_amdgcn_update_dpp(0, __builtin_bit_cast(int, v), 0x4E, 0xF, 0xF, false)));
    v = fmaxf(v, __builtin_bit_cast(float, __builtin_amdgcn_update_dpp(0, __builtin_bit_cast(int, v), 0x141, 0xF, 0xF, false)));
    return v;
}
__device__ __forceinline__ f32x4 mfma16(bf16x8 a, bf16x8 b, f32x4 c) { return __builtin_amdgcn_mfma_f32_16x16x32_bf16(a, b, c, 0, 0, 0); }
__device__ __forceinline__ s16x4 tr_read(unsigned lds_addr) { s16x4 r; asm volatile("ds_read_b64_tr_b16 %0, %1\n\ts_waitcnt lgkmcnt(0)" : "=&v"(r) : "v"(lds_addr) : "memory"); return r; }

template <int STRIDE> __device__ __forceinline__ void tr_read8(s16x4 (&r)[8], unsigned a) {
    asm volatile("ds_read_b64_tr_b16 %0, %8\n\tds_read_b64_tr_b16 %1, %8 offset:%9\n\tds_read_b64_tr_b16 %2, %8 offset:%10\n\tds_read_b64_tr_b16 %3, %8 offset:%11\n\t"
                 "ds_read_b64_tr_b16 %4, %8 offset:%12\n\tds_read_b64_tr_b16 %5, %8 offset:%13\n\tds_read_b64_tr_b16 %6, %8 offset:%14\n\tds_read_b64_tr_b16 %7, %8 offset:%15\n\ts_waitcnt lgkmcnt(0)"
                 : "=&v"(r[0]), "=&v"(r[1]), "=&v"(r[2]), "=&v"(r[3]), "=&v"(r[4]), "=&v"(r[5]), "=&v"(r[6]), "=&v"(r[7])
                 : "v"(a), "i"(STRIDE), "i"(2 * STRIDE), "i"(3 * STRIDE), "i"(4 * STRIDE), "i"(5 * STRIDE), "i"(6 * STRIDE), "i"(7 * STRIDE) : "memory");
}
template <int STRIDE> __device__ __forceinline__ void tr_read4x2(s16x4 (&r0)[4], s16x4 (&r1)[4], unsigned a0, unsigned a1) {
    asm volatile("ds_read_b64_tr_b16 %0, %8\n\tds_read_b64_tr_b16 %1, %8 offset:%10\n\tds_read_b64_tr_b16 %2, %8 offset:%11\n\tds_read_b64_tr_b16 %3, %8 offset:%12\n\t"
                 "ds_read_b64_tr_b16 %4, %9\n\tds_read_b64_tr_b16 %5, %9 offset:%10\n\tds_read_b64_tr_b16 %6, %9 offset:%11\n\tds_read_b64_tr_b16 %7, %9 offset:%12\n\ts_waitcnt lgkmcnt(0)"
                 : "=&v"(r0[0]), "=&v"(r0[1]), "=&v"(r0[2]), "=&v"(r0[3]), "=&v"(r1[0]), "=&v"(r1[1]), "=&v"(r1[2]), "=&v"(r1[3])
                 : "v"(a0), "v"(a1), "i"(STRIDE), "i"(2 * STRIDE), "i"(3 * STRIDE) : "memory");
}
#define TRCAT(lo, hi) ((bf16x8){(lo)[0], (lo)[1], (lo)[2], (lo)[3], (hi)[0], (hi)[1], (hi)[2], (hi)[3]})
#define XB_TMO      128
#define XB_XCNT(j)  (256  + 64 * (j))
#define XB_XSUB(j)  (1280 + 64 * (j))
#define XB_XGEN(j)  (2304 + 64 * (j))
#define XB_TOP      3328
#define XB_TOPGEN   3392
#define XCD_BAR_WORDS 3456
#define XB_SPIN_CAP (1u << 18)
__device__ __forceinline__ unsigned xb_ld(unsigned* p)              { return __hip_atomic_load(p, __ATOMIC_RELAXED, __HIP_MEMORY_SCOPE_AGENT); }
__device__ __forceinline__ unsigned xb_add(unsigned* p, unsigned v) { return __hip_atomic_fetch_add(p, v, __ATOMIC_RELAXED, __HIP_MEMORY_SCOPE_AGENT); }
__device__ __forceinline__ unsigned xb_xcc_id() { return (unsigned)__builtin_amdgcn_s_getreg((3 << 11) | 20) & 0xFu; }
#define XB_SPIN(cond, bar) do { unsigned _sp = 0; while (cond) { __builtin_amdgcn_s_sleep(1); \
    if ((++_sp & 255u) == 0u) { if (xb_ld(&(bar)[XB_TMO])) break; if (_sp > XB_SPIN_CAP) { atomicAdd(&(bar)[XB_TMO], 1u); break; } } } } while (0)
struct XcdBarrier { unsigned* bar; unsigned x; volatile LAS unsigned* st; };
__device__ __forceinline__ XcdBarrier xcd_barrier_post(unsigned* bar, volatile LAS unsigned* st) {
    XcdBarrier b; b.bar = bar; b.x = xb_xcc_id(); b.st = st;
    if (threadIdx.x == 0) (void)xb_add(&bar[XB_XCNT(b.x)], 1u);
    return b;
}
__device__ __forceinline__ void xcd_barrier_complete(unsigned* bar, unsigned x, unsigned& nloc, unsigned& nx) {
    const unsigned G = gridDim.x * gridDim.y * gridDim.z;
    unsigned sum, cnt, mine, sp = 0u;
    for (;;) {
        sum = 0u; cnt = 0u; mine = 0u;
#pragma unroll
        for (unsigned j = 0; j < 16; ++j) { const unsigned c = xb_ld(&bar[XB_XCNT(j)]); sum += c; cnt += (c > 0u) ? 1u : 0u; mine = (j == x) ? c : mine; }
        if (sum == G) break;
        __builtin_amdgcn_s_sleep(1);
        if ((++sp & 255u) == 0u) { if (xb_ld(&bar[XB_TMO])) break; if (sp > XB_SPIN_CAP) { atomicAdd(&bar[XB_TMO], 1u); break; } }
    }
    nloc = mine > 0u ? mine : 1u; nx = cnt > 0u ? cnt : 1u;
}
__device__ __forceinline__ void xcd_barrier(const XcdBarrier& b) {
    asm volatile("s_waitcnt vmcnt(0)" ::: "memory");
    __syncthreads();
    if (threadIdx.x == 0) {
        unsigned* bar = b.bar;
        __builtin_amdgcn_s_waitcnt(0);
        unsigned nloc = b.st[0], nx = b.st[1];
        if (nloc == 0u) { xcd_barrier_complete(bar, b.x, nloc, nx); b.st[0] = nloc; b.st[1] = nx; }
        const unsigned old = xb_add(&bar[XB_XSUB(b.x)], 1u);
        const unsigned gen = old / nloc;
        if (old + 1u == (gen + 1u) * nloc) {
            __builtin_amdgcn_fence(__ATOMIC_RELEASE, "agent");
            asm volatile("s_waitcnt vmcnt(0)" ::: "memory");
            const unsigned og = xb_add(&bar[XB_TOP], 1u);
            const unsigned tg = og / nx;
            if (og + 1u == (tg + 1u) * nx) xb_add(&bar[XB_TOPGEN], 1u);
            else XB_SPIN(xb_ld(&bar[XB_TOPGEN]) == tg, bar);
            __builtin_amdgcn_fence(__ATOMIC_ACQUIRE, "agent");
            xb_add(&bar[XB_XGEN(b.x)], 1u);
            asm volatile("s_waitcnt vmcnt(0)" ::: "memory");
        } else {
            XB_SPIN(xb_ld(&bar[XB_XGEN(b.x)]) == gen, bar);
            __builtin_amdgcn_fence(__ATOMIC_ACQUIRE, "agent");
            asm volatile("s_waitcnt vmcnt(0)" ::: "memory");
        }
    }
    __syncthreads();
}

namespace pg8 {
constexpr int BM = 256, BK = 64, HALF = 128, HTB = HALF * BK * 2, STAGE_BYTES = 8 * HTB, NXCD = 8, WGM = 8;
__host__ __device__ __forceinline__ int lds_byte(int r, int c) { const int st = (r >> 4) * 2 + (c >> 5), rr = r & 15, cc = c & 31, ob = rr * 64 + cc * 2; return st * 1024 + (ob ^ (((ob >> 9) & 1) << 5)); }
__host__ __device__ __forceinline__ void stage_rc(int b, int& R, int& C) { const int st = b / 1024, sb = b % 1024, swz = sb ^ (((sb >> 9) & 1) << 5); R = (st >> 1) * 16 + swz / 64; C = (st & 1) * 32 + (swz % 64) / 2; }
__host__ __device__ __forceinline__ int perm32(int rho) { const int n = rho >> 4, i = rho & 15; return 8 * (i >> 2) + 4 * n + (i & 3); }

struct Unit {
    const GAS char* a; const GAS char* b; int lda, ldb, nt;
    int row0, col0, aux;
    const GAS int* gidx; int gcnt;
    const LAS int* gl;
};

template <class S> struct RangeSched { const S& s; int lo, hi; __device__ __forceinline__ bool next(int i, Unit& u) const { return (lo + i < hi) && s.next(lo + i, u); } };

__device__ __forceinline__ void tile_of(int L, int nM, int nN, int& pm, int& pn) {
    const int nwg = nM * nN; int wgid = L;
    { const int q = nwg / NXCD, r = nwg % NXCD, xcd = wgid % NXCD, off = wgid / NXCD; wgid = (xcd < r ? xcd * (q + 1) : r * (q + 1) + (xcd - r) * q) + off; }
    const int nig = WGM * nN, gid = wgid / nig, fm = gid * WGM, gsz = (nM - fm) < WGM ? (nM - fm) : WGM;
    pm = fm + ((wgid % nig) % gsz); pn = (wgid % nig) / gsz;
}

typedef int i32x8 __attribute__((ext_vector_type(8)));
typedef int i32x4v __attribute__((ext_vector_type(4)));
template <class Epi, class Sched, bool GATHER, bool FP8 = false, bool UNI = false>
__device__ __forceinline__ void gemm_phase(LAS unsigned char* lds, const Sched& S, const Epi& E) {
    int tid = threadIdx.x; asm volatile("" : "+v"(tid));
    const int wid = __builtin_amdgcn_readfirstlane(tid >> 6), lane = tid & 63, wr = wid >> 2, wc = wid & 3, fr = lane & 15, fq = lane >> 4;
    int sR[2], sC2[2], sRb[2];
#pragma unroll
    for (int i = 0; i < 2; ++i) { int R, C; stage_rc(tid * 16 + i * 8192, R, C); sR[i] = R; sC2[i] = C * 2; sRb[i] = Epi::WIDE ? (64 * (R >> 5) + perm32(R & 31)) : (Epi::PERM ? ((R & ~31) + perm32(R & 31)) : R); }
    const unsigned ldsw = (unsigned)wid * 1024u;
    const int aoff = lds_byte(wr * 64 + fr, fq * 8), boff = lds_byte(wc * 32 + fr, fq * 8);
    const int sclw = 0x79, scla = 0x7f;
    const int aoff8[2] = {lds_byte(wr * 64 + fr, fq * 16), lds_byte(wr * 64 + fr, fq * 16 + 8)}, boff8[2] = {lds_byte(wc * 32 + fr, fq * 16), lds_byte(wc * 32 + fr, fq * 16 + 8)};
#define PG8_SA(b, h) (((b) * 2 + (h)) * HTB)
#define PG8_SB(b, h) ((4 + (b) * 2 + (h)) * HTB)
#define PG8_STAGE(bufoff, gbase, voff) do { _Pragma("unroll") for (int _i = 0; _i < 2; ++_i) \
        __builtin_amdgcn_global_load_lds((const GAS unsigned*)((const GAS char*)(gbase) + (voff)[_i]), (LAS unsigned*)(lds + (bufoff) + ldsw + _i * 8192), 16, 0, 0); } while (0)
#define PG8_LDA(dst, b, h) do { _Pragma("unroll") for (int m = 0; m < 4; ++m) { dst[m].lo = *(const LAS i32x4v*)(lds + PG8_SA(b, h) + (FP8 ? aoff8[0] : aoff) + m * 2048); dst[m].hi = *(const LAS i32x4v*)(lds + PG8_SA(b, h) + (FP8 ? aoff8[1] : aoff + 1024) + m * 2048); } } while (0)
#define PG8_LDB(dst, b, h) do { _Pragma("unroll") for (int n = 0; n < 2; ++n) { dst[n].lo = *(const LAS i32x4v*)(lds + PG8_SB(b, h) + (FP8 ? boff8[0] : boff) + n * 2048); dst[n].hi = *(const LAS i32x4v*)(lds + PG8_SB(b, h) + (FP8 ? boff8[1] : boff + 1024) + n * 2048); } } while (0)
#define PG8_BF(x) __builtin_bit_cast(bf16x8, (i32x4v)(x))
#define PG8_MMA(ai, bj, At, Bt) do { __builtin_amdgcn_s_setprio(1); _Pragma("unroll") for (int m = 0; m < 4; ++m) _Pragma("unroll") for (int n = 0; n < 2; ++n) { \
        if constexpr (FP8) { asm volatile("v_mfma_scale_f32_16x16x128_f8f6f4 %0, %1, %2, %0, %3, %4 op_sel_hi:[0,0,0]" : "+v"(acc[ai][bj][m][n]) : "v"(Bt[n]), "v"(At[m]), "v"(sclw), "v"(scla)); } \
        else { acc[ai][bj][m][n] = __builtin_amdgcn_mfma_f32_16x16x32_bf16(PG8_BF(Bt[n].lo), PG8_BF(At[m].lo), acc[ai][bj][m][n], 0, 0, 0); \
               acc[ai][bj][m][n] = __builtin_amdgcn_mfma_f32_16x16x32_bf16(PG8_BF(Bt[n].hi), PG8_BF(At[m].hi), acc[ai][bj][m][n], 0, 0, 0); } } \
        __builtin_amdgcn_s_setprio(0); } while (0)
#define PG8_WAIT_V(n) asm volatile("s_waitcnt vmcnt(" #n ")" ::: "memory")
#define PG8_WAIT_L(n) asm volatile("s_waitcnt lgkmcnt(" #n ")" ::: "memory")
#define PG8_BAR __builtin_amdgcn_s_barrier()
#define PG8_SCHED __builtin_amdgcn_sched_barrier(0)
#define PG8_OFFS(u, ao, bo) do { _Pragma("unroll") for (int _i = 0; _i < 2; ++_i) { (bo)[_i] = (unsigned)(sRb[_i] * (u).ldb + sC2[_i]); \
        _Pragma("unroll") for (int _h = 0; _h < 2; ++_h) { int _r = _h * HALF + sR[_i]; if (GATHER) { _r = (u).gl ? (u).gl[_r] : ((_r < (u).gcnt) ? (u).gidx[_r] : 0); } (ao)[_h][_i] = (unsigned)(_r * (u).lda + sC2[_i]); } } } while (0)
    Unit cur, nxt; int ui = 0;
    if (!S.next(0, cur)) return;
    f32x4 acc[2][2][4][2];
#pragma unroll
    for (int a = 0; a < 2; ++a)
#pragma unroll
        for (int b = 0; b < 2; ++b)
#pragma unroll
            for (int m = 0; m < 4; ++m)
#pragma unroll
                for (int n = 0; n < 2; ++n) acc[a][b][m][n] = (f32x4){0.f, 0.f, 0.f, 0.f};
    i32x8 At[4], B0[2], B1[2];
    unsigned aoc[2][2], boc[2], aon[2][2], bon[2];
    PG8_OFFS(cur, aoc, boc);
    {
        const GAS char* cA = cur.a; const GAS char* cB = cur.b; const size_t hB = (size_t)(Epi::WIDE ? 32 : HALF) * cur.ldb;
        PG8_STAGE(PG8_SB(0, 0), cB, boc); PG8_STAGE(PG8_SB(0, 1), cB + hB, boc); PG8_STAGE(PG8_SA(0, 0), cA, aoc[0]); PG8_STAGE(PG8_SA(0, 1), cA, aoc[1]);
        if (wr == 1) PG8_BAR;
        PG8_WAIT_V(2); PG8_BAR;
        PG8_STAGE(PG8_SB(1, 0), cB + 128, boc); PG8_STAGE(PG8_SA(1, 0), cA + 128, aoc[0]); PG8_STAGE(PG8_SB(1, 1), cB + hB + 128, boc);
        PG8_WAIT_V(6); PG8_BAR;
    }
    for (;;) {
        const bool has_next = S.next(ui + 1, nxt);
        if constexpr (UNI) { if (!has_next) nxt = cur; }
        else { if (has_next) { PG8_OFFS(nxt, aon, bon); }
          else { nxt = cur;
#pragma unroll
            for (int i = 0; i < 2; ++i) { bon[i] = boc[i]; aon[0][i] = aoc[0][i]; aon[1][i] = aoc[1][i]; } } }
        const GAS char* cA = cur.a; const GAS char* cB = cur.b; const GAS char* nA = nxt.a; const GAS char* nB = nxt.b;
        const size_t hBc = (size_t)(Epi::WIDE ? 32 : HALF) * cur.ldb, hBn = (size_t)(Epi::WIDE ? 32 : HALF) * nxt.ldb;
        const int nt = cur.nt;
        for (int t = 0; t < nt; t += 2) {
            const bool last = (t == nt - 2);
            const GAS char* a1 = cA + (size_t)(t + 1) * 128;
            const GAS char* a2 = last ? nA : cA + (size_t)(t + 2) * 128; const GAS char* b2 = last ? nB : cB + (size_t)(t + 2) * 128;
            const GAS char* a3 = a2 + 128; const GAS char* b3 = b2 + 128;
            const size_t hB2 = last ? hBn : hBc;
            unsigned oa0[2], oa1[2], ob[2];
#pragma unroll
            for (int i = 0; i < 2; ++i) { if constexpr (UNI) { oa0[i] = aoc[0][i]; oa1[i] = aoc[1][i]; ob[i] = boc[i]; } else { oa0[i] = last ? aon[0][i] : aoc[0][i]; oa1[i] = last ? aon[1][i] : aoc[1][i]; ob[i] = last ? bon[i] : boc[i]; } }
            PG8_LDB(B0, 0, 0); PG8_LDB(B1, 0, 1); PG8_SCHED; PG8_LDA(At, 0, 0); PG8_STAGE(PG8_SA(1, 1), a1, aoc[1]);
            PG8_WAIT_V(8); PG8_WAIT_L(0); PG8_BAR; PG8_MMA(0, 0, At, B0); PG8_MMA(0, 1, At, B1); PG8_BAR; PG8_SCHED;
            PG8_LDA(At, 0, 1); PG8_STAGE(PG8_SB(0, 0), b2, ob); PG8_STAGE(PG8_SB(0, 1), b2 + hB2, ob); PG8_STAGE(PG8_SA(0, 0), a2, oa0);
            PG8_WAIT_V(8); PG8_WAIT_L(0); PG8_BAR; PG8_MMA(1, 0, At, B0); PG8_MMA(1, 1, At, B1); PG8_BAR; PG8_SCHED;
            PG8_LDB(B0, 1, 0); PG8_LDB(B1, 1, 1); PG8_SCHED; PG8_LDA(At, 1, 0); PG8_STAGE(PG8_SA(0, 1), a2, oa1);
            PG8_WAIT_V(8); PG8_WAIT_L(0); PG8_BAR; PG8_MMA(0, 0, At, B0); PG8_MMA(0, 1, At, B1); PG8_BAR; PG8_SCHED;
            PG8_LDA(At, 1, 1); PG8_STAGE(PG8_SB(1, 0), b3, ob); PG8_STAGE(PG8_SB(1, 1), b3 + hB2, ob); PG8_STAGE(PG8_SA(1, 0), a3, oa0);
            PG8_WAIT_V(8); PG8_WAIT_L(0); PG8_BAR; PG8_MMA(1, 0, At, B0); PG8_MMA(1, 1, At, B1); PG8_BAR; PG8_SCHED;
        }
        if (wr == 0) PG8_BAR;
        const bool keep = E(acc, cur, wr, wc, fr, fq, lds + LDS_EPI + wid * 2048);
        if (!has_next) break;
        if (!keep) {
#pragma unroll
            for (int a = 0; a < 2; ++a)
#pragma unroll
                for (int b = 0; b < 2; ++b)
#pragma unroll
                    for (int m = 0; m < 4; ++m)
#pragma unroll
                        for (int n = 0; n < 2; ++n) acc[a][b][m][n] = (f32x4){0.f, 0.f, 0.f, 0.f};
        }
        cur = nxt;
        if constexpr (!UNI) {
#pragma unroll
            for (int i = 0; i < 2; ++i) { boc[i] = bon[i]; aoc[0][i] = aon[0][i]; aoc[1][i] = aon[1][i]; } }
        ++ui;
        if (wr == 1) PG8_BAR;
    }
    PG8_WAIT_V(0);
    PG8_BAR;
#undef PG8_OFFS
#undef PG8_SA
#undef PG8_SB
#undef PG8_STAGE
#undef PG8_LDA
#undef PG8_LDB
#undef PG8_MMA
#undef PG8_BF
#undef PG8_WAIT_V
#undef PG8_WAIT_L
#undef PG8_BAR
#undef PG8_SCHED
}
}
using pg8::Unit;

struct DenseSched {
    const GAS char* A; const GAS char* Bt; int lda, ldb, nt, nM, nN, G, c;
    int skip_from, skip_n;
    __device__ __forceinline__ bool next(int i, Unit& u) const {
        const long L = (long)i * G + c; if (L >= (long)nM * nN) return false;
        int pm, pn; pg8::tile_of((int)L, nM, nN, pm, pn);
        if (pn >= skip_from) pn += skip_n;
        u.a = A + (size_t)pm * 256 * lda; u.b = Bt + (size_t)pn * 256 * ldb; u.lda = lda; u.ldb = ldb; u.nt = nt;
        u.row0 = pm * 256; u.col0 = pn * 256; u.aux = 0; u.gidx = nullptr; u.gcnt = 256; u.gl = nullptr; return true;
    }
};
struct MergeSched {
    const GAS char* A0; const GAS char* B0; const GAS char* A1; const GAS char* B1; int nM, nN, G, c;
    __device__ __forceinline__ bool next(int i, Unit& u) const {
        const long L = (long)(i >> 1) * G + c; if (L >= (long)nM * nN) return false;
        int pm, pn; pg8::tile_of((int)L, nM, nN, pm, pn);
        const int seg = i & 1;
        const int ld = seg ? ATT_OUT * 2 : HG_WIDTH * 2;
        u.a = (seg ? A1 : A0) + (size_t)pm * 256 * ld; u.b = (seg ? B1 : B0) + (size_t)pn * 256 * ld; u.lda = ld; u.ldb = ld; u.nt = seg ? ATT_OUT / 64 : HG_WIDTH / 64;
        u.row0 = pm * 256; u.col0 = pn * 256; u.aux = seg; u.gidx = nullptr; u.gcnt = 256; u.gl = nullptr; return true;
    }
};
template <int NT, bool UP, int ES = 2>
struct MoeSched {
    const LAS int* toff; const GAS unsigned* cnt;
    const GAS char* A; const GAS char* W; const GAS int* rowmap;
    int G, c;
    const LAS int* gtab;
    const LAS int* utab;
    __device__ __forceinline__ bool decode(int i, int& mtg, int& pn, int& e) const {
        const int total = toff[NEXP1];
        const int nb = G >> 3, x = c & 7, lb = c >> 3;
        const int tpx = (total + 7) >> 3, t0 = x * tpx; int nx = total - t0; nx = nx > tpx ? tpx : nx;
        const int jj = i * nb + lb;
        if (nx <= 0 || lb >= nb || jj >= nx * NT) return false;
        const int nig = 8 * NT, gid = jj / nig, fm = gid * 8, gsz = (nx - fm) < 8 ? (nx - fm) : 8;
        mtg = t0 + fm + ((jj % nig) % gsz); pn = (jj % nig) / gsz;
        int lo = 0, hi = NEXP1;
        while (hi - lo > 1) { const int mid = (lo + hi) >> 1; if (toff[mid] <= mtg) lo = mid; else hi = mid; }
        e = lo; return true;
    }
    __device__ __forceinline__ void build_units(LAS int* tab) const {
        if (threadIdx.x < 32) { int mtg = 0, pn = 0, e = 0; const bool ok = decode((int)threadIdx.x, mtg, pn, e);
            tab[threadIdx.x * 4 + 0] = mtg; tab[threadIdx.x * 4 + 1] = pn; tab[threadIdx.x * 4 + 2] = e; tab[threadIdx.x * 4 + 3] = ok ? 1 : 0; }
        __syncthreads();
        if (UP && gtab != nullptr) {
            LAS int* gt = (LAS int*)gtab;
            for (int i0 = 0; i0 < 16; i0 += 2) { const int i = i0 + (int)(threadIdx.x >> 8), r = (int)threadIdx.x & 255;
                if (tab[i * 4 + 3]) { const int mtg = tab[i * 4 + 0], e = tab[i * 4 + 2], mt = mtg - toff[e];
                    int v; if (e < N_EXPERTS) { const int n = (int)cnt[e] - mt * 256; v = (r < n) ? rowmap[(size_t)e * T + mt * 256 + r] : 0; } else v = mt * 256 + r;
                    gt[i * 256 + r] = v; } }
            __syncthreads(); }
    }
    __device__ __forceinline__ bool next(int i, Unit& u) const {
        int mtg, pn, e;
        if (i < 32) { const int ok = utab[i * 4 + 3]; if (!ok) return false; mtg = utab[i * 4 + 0]; pn = utab[i * 4 + 1]; e = utab[i * 4 + 2]; }
        else if (!decode(i, mtg, pn, e)) return false;
        mtg = __builtin_amdgcn_readfirstlane(mtg); pn = __builtin_amdgcn_readfirstlane(pn); e = __builtin_amdgcn_readfirstlane(e);
        const int mt = mtg - toff[e];
        if (UP) {
            u.a = A; u.lda = D_MODEL * ES; u.nt = D_MODEL * ES / 128;
            u.b = W + ((size_t)e * 1024 + (size_t)pn * 256) * (D_MODEL * ES); u.ldb = D_MODEL * ES;
            if (gtab != nullptr && i < 16) { u.gl = gtab + i * 256; u.gidx = nullptr; u.gcnt = 256; }
            else { u.gl = nullptr;
                if (e < N_EXPERTS) { u.gidx = rowmap + (size_t)e * T + mt * 256; const int n = (int)cnt[e] - mt * 256; u.gcnt = n < 256 ? n : 256; }
                else { u.gidx = rowmap + (size_t)N_EXPERTS * T + mt * 256; u.gcnt = 256; } }
            u.col0 = pn * 128;
        } else {
            u.a = A + (size_t)mtg * 256 * (EXPERT_FF * ES); u.lda = EXPERT_FF * ES; u.nt = EXPERT_FF * ES / 128;
            u.b = W + ((size_t)e * D_MODEL + (size_t)pn * 256) * (EXPERT_FF * ES); u.ldb = EXPERT_FF * ES;
            u.gidx = nullptr; u.gcnt = 256; u.gl = nullptr; u.col0 = pn * 256;
        }
        u.row0 = mtg * 256; u.aux = e; return true;
    }
};

struct EpiIn {
    static constexpr bool PERM = true, WIDE = false;
    GAS bf16_t* H; GAS _Float16* LF; const GAS float* lb; const GAS f32x4* rope;
    __device__ __forceinline__ bool operator()(f32x4 (&acc)[2][2][4][2], const Unit& u, int wr, int wc, int fr, int fq, LAS unsigned char* scr) const {
        const int row0 = u.row0 + wr * 64 + fr, colt = u.col0, cl = wc * 32 + 8 * fq;
        int mode;
        if (colt < C_HF) mode = 1; else if (colt < C_HI) mode = 3; else if (colt < C_HGATE) mode = 0; else if (colt < C_AQ) mode = 2;
        else if (colt < C_AK) mode = 4; else if (colt < C_AV) mode = 5; else if (colt < C_GH) mode = 0; else mode = 2;
        if (mode == 3) {
            f32x4 lbv[2][2];
#pragma unroll
            for (int bj = 0; bj < 2; ++bj)
#pragma unroll
                for (int n = 0; n < 2; ++n) lbv[bj][n] = *(const GAS f32x4*)(lb + (colt - C_HF) + bj * 128 + cl + 4 * n);
#pragma unroll
            for (int ai = 0; ai < 2; ++ai)
#pragma unroll
                for (int m = 0; m < 4; ++m) { GAS _Float16* rowp = LF + HOFF(colt - C_HF, row0 + ai * 128 + m * 16) + cl;
#pragma unroll
                    for (int bj = 0; bj < 2; ++bj) { f16x8 o8;
#pragma unroll
                        for (int n = 0; n < 2; ++n) { const f32x4 z = acc[ai][bj][m][n];
#pragma unroll
                            for (int j = 0; j < 4; ++j) { const float zz = fmaxf(z[j], -80.f), l = lbv[bj][n][j]; const float f = l + (1.0f - l) * fdiv(1.0f, 1.0f + __expf(-zz)); o8[4 * n + j] = (_Float16)__logf(f); } }
                        *(GAS f16x8*)(rowp + (size_t)bj * T * 128) = o8; } }
            return false;
        }
        if (mode >= 4) {
            const float sc = (mode == 4) ? 0.08838834764831845f : 1.0f;
            const int i0 = 16 * wc + 4 * fq;
#pragma unroll
            for (int ai = 0; ai < 2; ++ai)
#pragma unroll
                for (int m = 0; m < 4; ++m) { const int row = row0 + ai * 128 + m * 16; GAS bf16_t* rowp = H + HOFF(colt, row) + cl;
                    const f32x4 cs0 = rope[(size_t)row * 32 + (i0 >> 1)], cs1 = rope[(size_t)row * 32 + (i0 >> 1) + 1];
#pragma unroll
                    for (int bj = 0; bj < 2; ++bj) { const f32x4 v0 = acc[ai][bj][m][0], v1 = acc[ai][bj][m][1]; u32x4 w;
                        w.x = cvt_pk_bf16((v0[0] * cs0[0] - v0[1] * cs0[1]) * sc, (v0[1] * cs0[0] + v0[0] * cs0[1]) * sc);
                        w.y = cvt_pk_bf16((v0[2] * cs0[2] - v0[3] * cs0[3]) * sc, (v0[3] * cs0[2] + v0[2] * cs0[3]) * sc);
                        w.z = cvt_pk_bf16((v1[0] * cs1[0] - v1[1] * cs1[1]) * sc, (v1[1] * cs1[0] + v1[0] * cs1[1]) * sc);
                        w.w = cvt_pk_bf16((v1[2] * cs1[2] - v1[3] * cs1[3]) * sc, (v1[3] * cs1[2] + v1[2] * cs1[3]) * sc);
                        *(GAS u32x4*)(rowp + (size_t)bj * T * 128) = w; } }
            return false;
        }
#pragma unroll
        for (int ai = 0; ai < 2; ++ai)
#pragma unroll
            for (int m = 0; m < 4; ++m) { GAS bf16_t* rowp = H + HOFF(colt, row0 + ai * 128 + m * 16) + cl;
#pragma unroll
                for (int bj = 0; bj < 2; ++bj) { f32x4 v0 = acc[ai][bj][m][0], v1 = acc[ai][bj][m][1];
                    if (mode != 0) {
#pragma unroll
                        for (int j = 0; j < 4; ++j) { const float s0 = fsigmoid(v0[j]), s1 = fsigmoid(v1[j]); v0[j] = (mode == 1) ? v0[j] * s0 : s0; v1[j] = (mode == 1) ? v1[j] * s1 : s1; } }
                    u32x4 w; w.x = cvt_pk_bf16(v0[0], v0[1]); w.y = cvt_pk_bf16(v0[2], v0[3]); w.z = cvt_pk_bf16(v1[0], v1[1]); w.w = cvt_pk_bf16(v1[2], v1[3]);
                    *(GAS u32x4*)(rowp + (size_t)bj * T * 128) = w; } }
        return false;
    }
};
struct EpiMerge {
    static constexpr bool PERM = true, WIDE = true;
    const GAS bf16_t* H; GAS bf16_t* O;
    __device__ __forceinline__ bool operator()(f32x4 (&acc)[2][2][4][2], const Unit& u, int wr, int wc, int fr, int fq, LAS unsigned char* scr) const {
        const int lane = fq * 16 + fr, rowb = u.row0 + wr * 64, colb = u.col0 + wc * 64;
        const int lr = lane >> 3, lch = lane & 7;
        const int wo = lr * 128 + ((lch ^ (lr & 7)) * 16);
        const bool seg0 = (u.aux == 0);
#pragma unroll
        for (int ai = 0; ai < 2; ++ai)
#pragma unroll
            for (int m = 0; m < 4; ++m) { const size_t rg = (size_t)(rowb + ai * 128 + m * 16);
                const GAS bf16_t* gpa = H + HOFF(C_GA + colb, rg + lr) + lch * 8; const GAS bf16_t* gph = H + HOFF(C_GH + colb, rg + lr) + lch * 8;
                const u32x4 ga0 = *(const GAS u32x4*)gpa, ga1 = *(const GAS u32x4*)(gpa + 8 * 128);
                u32x4 gh0 = ga0, gh1 = ga1; if (seg0) { gh0 = *(const GAS u32x4*)gph; gh1 = *(const GAS u32x4*)(gph + 8 * 128); }
                *(LAS u32x4*)(scr + wo) = ga0; *(LAS u32x4*)(scr + wo + 1024) = ga1;
                LDS_WAIT();
                u32x4 gaf[2], ghf[2];
#pragma unroll
                for (int bj = 0; bj < 2; ++bj) gaf[bj] = *(const LAS u32x4*)(scr + fr * 128 + (((bj * 4 + fq) ^ (fr & 7)) * 16));
                LDS_WAIT();
                if (seg0) { *(LAS u32x4*)(scr + wo) = gh0; *(LAS u32x4*)(scr + wo + 1024) = gh1;
                    LDS_WAIT();
#pragma unroll
                    for (int bj = 0; bj < 2; ++bj) ghf[bj] = *(const LAS u32x4*)(scr + fr * 128 + (((bj * 4 + fq) ^ (fr & 7)) * 16));
                    LDS_WAIT(); }
#pragma unroll
                for (int bj = 0; bj < 2; ++bj) { const u32x4 ga = gaf[bj];
                    float a[8] = {bflo(ga.x), bfhi(ga.x), bflo(ga.y), bfhi(ga.y), bflo(ga.z), bfhi(ga.z), bflo(ga.w), bfhi(ga.w)};
                    if (seg0) { const u32x4 gh = ghf[bj];
                        float h[8] = {bflo(gh.x), bfhi(gh.x), bflo(gh.y), bfhi(gh.y), bflo(gh.z), bfhi(gh.z), bflo(gh.w), bfhi(gh.w)};
#pragma unroll
                        for (int j = 0; j < 4; ++j) { acc[ai][bj][m][0][j] *= fdiv(h[j], a[j]); acc[ai][bj][m][1][j] *= fdiv(h[4 + j], a[4 + j]); }
                    } else {
                        f32x4 v0 = acc[ai][bj][m][0], v1 = acc[ai][bj][m][1];
#pragma unroll
                        for (int j = 0; j < 4; ++j) { v0[j] *= a[j]; v1[j] *= a[4 + j]; }
                        u32x2 w8; int q = __builtin_amdgcn_cvt_pk_fp8_f32(v0[0], v0[1], 0, false); q = __builtin_amdgcn_cvt_pk_fp8_f32(v0[2], v0[3], q, true); w8.x = (unsigned)q;
                        q = __builtin_amdgcn_cvt_pk_fp8_f32(v1[0], v1[1], 0, false); q = __builtin_amdgcn_cvt_pk_fp8_f32(v1[2], v1[3], q, true); w8.y = (unsigned)q;
                        *(LAS u32x2*)(scr + fr * 64 + bj * 32 + fq * 8) = w8; } }
                if (!seg0) { LDS_WAIT();
                    const int r = lane >> 2, ch = lane & 3; const u32x4 o = *(const LAS u32x4*)(scr + r * 64 + ch * 16);
                    *(GAS u32x4*)((GAS unsigned char*)O + (rg + r) * D_MODEL + colb + ch * 16) = o;
                    LDS_WAIT(); }
            }
        return seg0;
    }
};
struct EpiResid {
    static constexpr bool PERM = false, WIDE = false;
    const GAS bf16_t* X; GAS bf16_t* R;
    __device__ __forceinline__ bool operator()(f32x4 (&acc)[2][2][4][2], const Unit& u, int wr, int wc, int fr, int fq, LAS unsigned char* scr) const {
        const int row0 = u.row0 + wr * 64 + fr, col0 = u.col0 + wc * 32 + 4 * fq;
#pragma unroll
        for (int ai = 0; ai < 2; ++ai)
#pragma unroll
            for (int m = 0; m < 4; ++m) { const size_t off = (size_t)(row0 + ai * 128 + m * 16) * D_MODEL + col0;
#pragma unroll
                for (int bj = 0; bj < 2; ++bj)
#pragma unroll
                    for (int n = 0; n < 2; ++n) { const u32x2 xv = *(const GAS u32x2*)(X + off + bj * 128 + n * 16); const f32x4 a = acc[ai][bj][m][n];
                        u32x2 o; o.x = cvt_pk_bf16(bflo(xv.x) * DN_ALPHA + a[0], bfhi(xv.x) * DN_ALPHA + a[1]); o.y = cvt_pk_bf16(bflo(xv.y) * DN_ALPHA + a[2], bfhi(xv.y) * DN_ALPHA + a[3]);
                        *(GAS u32x2*)(R + off + bj * 128 + n * 16) = o; } }
        return false;
    }
};
template <bool F8OUT>
struct EpiGateUp {
    static constexpr bool PERM = true, WIDE = false;
    GAS bf16_t* HID;
    __device__ __forceinline__ bool operator()(f32x4 (&acc)[2][2][4][2], const Unit& u, int wr, int wc, int fr, int fq, LAS unsigned char* scr) const {
        const int row0 = u.row0 + wr * 64 + fr, col0 = u.col0 + wc * 32 + 8 * fq;
#pragma unroll
        for (int ai = 0; ai < 2; ++ai)
#pragma unroll
            for (int m = 0; m < 4; ++m) { GAS bf16_t* rowp = HID + (size_t)(row0 + ai * 128 + m * 16) * EXPERT_FF + col0;
                f32x4 g0 = acc[ai][0][m][0], g1 = acc[ai][0][m][1]; const f32x4 u0 = acc[ai][1][m][0], u1 = acc[ai][1][m][1];
#pragma unroll
                for (int j = 0; j < 4; ++j) { g0[j] = g0[j] * fsigmoid(g0[j]) * u0[j]; g1[j] = g1[j] * fsigmoid(g1[j]) * u1[j]; }
                if constexpr (F8OUT) { u32x2 w8; int q = __builtin_amdgcn_cvt_pk_fp8_f32(g0[0], g0[1], 0, false); q = __builtin_amdgcn_cvt_pk_fp8_f32(g0[2], g0[3], q, true); w8.x = (unsigned)q;
                    q = __builtin_amdgcn_cvt_pk_fp8_f32(g1[0], g1[1], 0, false); q = __builtin_amdgcn_cvt_pk_fp8_f32(g1[2], g1[3], q, true); w8.y = (unsigned)q;
                    *(GAS u32x2*)((GAS unsigned char*)HID + (size_t)(row0 + ai * 128 + m * 16) * EXPERT_FF + col0) = w8; }
                else { u32x4 w; w.x = cvt_pk_bf16(g0[0], g0[1]); w.y = cvt_pk_bf16(g0[2], g0[3]); w.z = cvt_pk_bf16(g1[0], g1[1]); w.w = cvt_pk_bf16(g1[2], g1[3]);
                    *(GAS u32x4*)rowp = w; } }
        return false;
    }
};
template <bool F8OUT>
struct EpiDown {
    static constexpr bool PERM = true, WIDE = true;
    GAS bf16_t* Y;
    __device__ __forceinline__ bool operator()(f32x4 (&acc)[2][2][4][2], const Unit& u, int wr, int wc, int fr, int fq, LAS unsigned char* scr) const {
        const int lane = fq * 16 + fr, rowb = u.row0 + wr * 64, colb = u.col0 + wc * 64;
#pragma unroll
        for (int ai = 0; ai < 2; ++ai)
#pragma unroll
            for (int m = 0; m < 4; ++m) { const size_t rg = (size_t)(rowb + ai * 128 + m * 16);
                if constexpr (F8OUT) {
#pragma unroll
                    for (int bj = 0; bj < 2; ++bj) { const f32x4 v0 = acc[ai][bj][m][0], v1 = acc[ai][bj][m][1]; u32x2 w8;
                        int q = __builtin_amdgcn_cvt_pk_fp8_f32(v0[0], v0[1], 0, false); q = __builtin_amdgcn_cvt_pk_fp8_f32(v0[2], v0[3], q, true); w8.x = (unsigned)q;
                        q = __builtin_amdgcn_cvt_pk_fp8_f32(v1[0], v1[1], 0, false); q = __builtin_amdgcn_cvt_pk_fp8_f32(v1[2], v1[3], q, true); w8.y = (unsigned)q;
                        *(LAS u32x2*)(scr + fr * 64 + bj * 32 + fq * 8) = w8; }
                    LDS_WAIT();
                    const int r = lane >> 2, ch = lane & 3; const u32x4 o = *(const LAS u32x4*)(scr + r * 64 + ch * 16);
                    *(GAS u32x4*)((GAS unsigned char*)Y + (rg + r) * D_MODEL + colb + ch * 16) = o;
                } else {
#pragma unroll
                    for (int bj = 0; bj < 2; ++bj) { const f32x4 v0 = acc[ai][bj][m][0], v1 = acc[ai][bj][m][1];
                        u32x4 w; w.x = cvt_pk_bf16(v0[0], v0[1]); w.y = cvt_pk_bf16(v0[2], v0[3]); w.z = cvt_pk_bf16(v1[0], v1[1]); w.w = cvt_pk_bf16(v1[2], v1[3]);
                        *(LAS u32x4*)(scr + fr * 128 + (((bj * 4 + fq) ^ (fr & 7)) * 16)) = w; }
                    LDS_WAIT();
                    const int r = lane >> 3, ch = lane & 7;
                    const u32x4 o0 = *(const LAS u32x4*)(scr + r * 128 + ((ch ^ (r & 7)) * 16)), o1 = *(const LAS u32x4*)(scr + (r + 8) * 128 + ((ch ^ (r & 7)) * 16));
                    *(GAS u32x4*)(Y + (rg + r) * D_MODEL + colb + ch * 8) = o0; *(GAS u32x4*)(Y + (rg + r + 8) * D_MODEL + colb + ch * 8) = o1;
                }
                LDS_WAIT(); }
        return false;
    }
};

struct Args { const float* in[20]; float* out; unsigned char* ws; int ph_lo, ph_hi; };
typedef const __attribute__((address_space(4))) Args* CArgsP;
#define GIN(k) ((const GAS float*)(GAS const float*)ap->in[k])
#define PHASE_ARGS() CArgsP ap = (CArgsP)__builtin_amdgcn_kernarg_segment_ptr(); asm volatile("" : "+s"(ap))
struct Frame {
    LAS unsigned char* lds;
    GAS unsigned* ctl;
    GAS unsigned char* ws;
    int G, bid;
};
#define PHASE_IDS() int tid = threadIdx.x; asm volatile("" : "+v"(tid)); const int lane = tid & 63, w = __builtin_amdgcn_readfirstlane(tid >> 6); (void)lane; (void)w

__device__ __forceinline__ int conv_src_col(int mode, int p) {
    if (mode == 1 && p >= C_AQ && p < C_AV) { const int hb = p & ~127, q = p & 127; return hb + (q >> 1) + 64 * (q & 1); }
    return p;
}
__device__ __forceinline__ int conv_dst_row(int mode, int n) {
    if (mode == 1) { if (n >= C_AQ && n < C_AV) { const int hb = n & ~127, dd = n & 127; return hb + (dd < 64 ? 2 * dd : 2 * (dd - 64) + 1); } return n; }
    if (mode == 2) return (n >> 7) * 256 + (n & 127);
    if (mode == 3) return (n >> 7) * 256 + 128 + (n & 127);
    return n;
}
struct ConvJob { const GAS float* W; GAS unsigned char* WT; int K, N, mode, item, ncol0, ncols, f8; float sc8; };
__device__ __forceinline__ void conv_load(const ConvJob& J, int tid, f32x4 (&v)[16]) {
    const int nblk = J.ncols / 256, k0 = 128 * (J.item / nblk), n0 = J.ncol0 + 256 * (J.item % nblk);
    {
#pragma unroll
        for (int ii = 0; ii < 16; ++ii) { const int idx = tid + 512 * ii, k = idx >> 6, c4 = idx & 63; v[ii] = *(const GAS f32x4*)(J.W + (size_t)(k0 + k) * J.N + n0 + 4 * c4); }
    }
}
__device__ __forceinline__ void conv_to_lds(const ConvJob& J, int tid, const f32x4 (&v)[16], LAS float* T) {
#pragma unroll
    for (int ii = 0; ii < 16; ++ii) { const int idx = tid + 512 * ii, k = idx >> 6, c4 = idx & 63; const int g = J.f8 ? ((k >> 4) & 7) : ((k >> 3) & 15);
        *(LAS f32x4*)(T + k * 256 + 4 * (c4 ^ g)) = v[ii]; }
}
__device__ __forceinline__ void conv_from_lds(const ConvJob& J, int tid, const LAS float* T) {
    const int nblk = J.ncols / 256, k0 = 128 * (J.item / nblk), n0 = J.ncol0 + 256 * (J.item % nblk);
    const int lane = tid & 63, w = tid >> 6, j = lane & 3;
    if (J.f8) {
        const int c = (lane >> 2) & 7; const float sc8 = J.sc8;
#pragma unroll
        for (int it = 0; it < 4; ++it) { const int c4n = w * 8 + it * 2 + (lane >> 5), n = 4 * c4n + j; const LAS float* base = T + 4 * (c4n ^ c) + j; u32x4 o;
#pragma unroll
            for (int d = 0; d < 4; ++d) { const int kk = 16 * c + 4 * d;
                int wv = __builtin_amdgcn_cvt_pk_fp8_f32(base[(kk + 0) * 256] * sc8, base[(kk + 1) * 256] * sc8, 0, false);
                wv = __builtin_amdgcn_cvt_pk_fp8_f32(base[(kk + 2) * 256] * sc8, base[(kk + 3) * 256] * sc8, wv, true); o[d] = (unsigned)wv; }
            *(GAS u32x4*)(J.WT + (size_t)conv_dst_row(J.mode, n0 - J.ncol0 + n) * J.K + k0 + 16 * c) = o; }
    } else {
        const int c = ((lane >> 2) & 7) + 8 * (lane >> 5);
#pragma unroll
        for (int it = 0; it < 8; ++it) { const int c4n = w * 8 + it, n = 4 * c4n + j; const LAS float* base = T + 4 * (c4n ^ c) + j + (8 * c) * 256;
            u32x4 o; o.x = cvt_pk_bf16(base[0 * 256], base[1 * 256]); o.y = cvt_pk_bf16(base[2 * 256], base[3 * 256]); o.z = cvt_pk_bf16(base[4 * 256], base[5 * 256]); o.w = cvt_pk_bf16(base[6 * 256], base[7 * 256]);
            *(GAS u32x4*)(J.WT + ((size_t)conv_dst_row(J.mode, n0 - J.ncol0 + n) * J.K + k0 + 8 * c) * 2) = o; }
    }
}
__device__ __forceinline__ void conv8_load(const ConvJob& J, int tid, f32x4 (&v)[16]) {
    const int nblk = J.ncols / 256, k0 = 128 * (J.item / nblk), n0 = J.ncol0 + 256 * (J.item % nblk);
    const int lane = tid & 63, w = tid >> 6, kg = lane & 7, nq = lane >> 3;
    const GAS float* p = J.W + (size_t)(k0 + 16 * kg) * J.N + n0 + 32 * w + 4 * nq;
#pragma unroll
    for (int j = 0; j < 16; ++j) v[j] = *(const GAS f32x4*)(p + (size_t)j * J.N);
}
__device__ __forceinline__ void conv8_store(const ConvJob& J, int tid, const f32x4 (&v)[16]) {
    const int nblk = J.ncols / 256, k0 = 128 * (J.item / nblk), n0 = J.ncol0 + 256 * (J.item % nblk);
    const int lane = tid & 63, w = tid >> 6, kg = lane & 7, nq = lane >> 3; const float sc8 = J.sc8;
#pragma unroll
    for (int c = 0; c < 4; ++c) { u32x4 o;
#pragma unroll
        for (int d = 0; d < 4; ++d) { int wv = __builtin_amdgcn_cvt_pk_fp8_f32(v[4 * d][c] * sc8, v[4 * d + 1][c] * sc8, 0, false);
            wv = __builtin_amdgcn_cvt_pk_fp8_f32(v[4 * d + 2][c] * sc8, v[4 * d + 3][c] * sc8, wv, true); o[d] = (unsigned)wv; }
        *(GAS u32x4*)(J.WT + (size_t)conv_dst_row(J.mode, n0 - J.ncol0 + 32 * w + 4 * nq + c) * J.K + k0 + 16 * kg) = o; }
}
__device__ __forceinline__ void p0_convert(Frame& F, int layer, bool gu8, bool moe8, int part = 0, int tail = 0, GAS unsigned* ctr = nullptr) {
    PHASE_IDS(); PHASE_ARGS();
    LAS float* TL = (LAS float*)F.lds;
    GAS unsigned char* ws = F.ws;
    const GAS float* w_in = GIN(2) + (size_t)layer * D_MODEL * IN_WIDTH;
    const GAS float* w_hg = GIN(5) + (size_t)layer * HG_WIDTH * D_MODEL;
    const GAS float* w_att = GIN(6) + (size_t)layer * ATT_OUT * D_MODEL;
    const GAS float* w_out = GIN(7) + (size_t)layer * D_MODEL * D_MODEL;
    const GAS float* w_eg = GIN(12) + (size_t)layer * N_EXPERTS * D_MODEL * EXPERT_FF;
    const GAS float* w_eu = GIN(13) + (size_t)layer * N_EXPERTS * D_MODEL * EXPERT_FF;
    const GAS float* w_ed = GIN(14) + (size_t)layer * N_EXPERTS * EXPERT_FF * D_MODEL;
    const GAS float* w_sg = GIN(15) + (size_t)layer * D_MODEL * EXPERT_FF;
    const GAS float* w_su = GIN(16) + (size_t)layer * D_MODEL * EXPERT_FF;
    const GAS float* w_sd = GIN(17) + (size_t)layer * EXPERT_FF * D_MODEL;
    constexpr int I_IN = (D_MODEL / 128) * (IN_WIDTH / 256), I_INF = (D_MODEL / 128) * (HG_WIDTH / 256), I_HG = (HG_WIDTH / 128) * (D_MODEL / 256), I_ATT = (ATT_OUT / 128) * (D_MODEL / 256), I_OUT = (D_MODEL / 128) * (D_MODEL / 256);
    constexpr int I_E = (D_MODEL / 128) * (EXPERT_FF / 256);
    static_assert((EXPERT_FF / 128) * (D_MODEL / 256) == I_E, "item count of the down matrices");
    constexpr int NITEMS = I_IN + I_INF + I_HG + I_ATT + I_OUT + 3 * NEXP1 * I_E;
    auto decode = [&](int it) -> ConvJob {
        int r = it;
        if (r < I_IN) return ConvJob{w_in, ws + WS_WIN, D_MODEL, IN_WIDTH, 1, r, 0, IN_WIDTH, 1, 64.f}; r -= I_IN;
        if (r < I_INF) return ConvJob{w_in, ws + WS_WINF, D_MODEL, IN_WIDTH, 0, r, C_HF, HG_WIDTH, 0, 1.f}; r -= I_INF;
        if (r < I_HG) return ConvJob{w_hg, ws + WS_WHG, HG_WIDTH, D_MODEL, 0, r, 0, D_MODEL, 0, 1.f}; r -= I_HG;
        if (r < I_ATT) return ConvJob{w_att, ws + WS_WATT, ATT_OUT, D_MODEL, 0, r, 0, D_MODEL, 0, 1.f}; r -= I_ATT;
        if (r < I_OUT) return ConvJob{w_out, ws + WS_WOUT, D_MODEL, D_MODEL, 0, r, 0, D_MODEL, 1, 64.f}; r -= I_OUT;
        const int which = r / (NEXP1 * I_E); r -= which * (NEXP1 * I_E);
        const int e = r / I_E, ri = r % I_E; const int es = gu8 ? 1 : 2;
        if (which == 0) return ConvJob{(e < N_EXPERTS) ? w_eg + (size_t)e * D_MODEL * EXPERT_FF : w_sg, ws + (moe8 ? WS_WGU8 : WS_WGU) + (size_t)e * 1024 * D_MODEL * es, D_MODEL, EXPERT_FF, 2, ri, 0, EXPERT_FF, gu8 ? 1 : 0, 64.f};
        if (which == 1) return ConvJob{(e < N_EXPERTS) ? w_eu + (size_t)e * D_MODEL * EXPERT_FF : w_su, ws + (moe8 ? WS_WGU8 : WS_WGU) + (size_t)e * 1024 * D_MODEL * es, D_MODEL, EXPERT_FF, 3, ri, 0, EXPERT_FF, gu8 ? 1 : 0, 64.f};
        return ConvJob{(e < N_EXPERTS) ? w_ed + (size_t)e * EXPERT_FF * D_MODEL : w_sd, ws + (moe8 ? WS_WDN8 : WS_WDN) + (size_t)e * D_MODEL * EXPERT_FF, EXPERT_FF, D_MODEL, 0, ri, 0, D_MODEL, 1, 64.f};
    };
    constexpr int N_NONEXP = I_IN + I_INF + I_HG + I_ATT + I_OUT, NB16 = I_INF + I_HG + I_ATT;
    if (gu8) {
        constexpr int NF8 = NITEMS - NB16, NF8_NONEXP = I_IN + I_OUT;
        const int q_lo = (part == 2) ? NF8_NONEXP : 0, q_end = (part == 1) ? NF8_NONEXP : NF8, q_hi = q_end - tail;
        if (ctr != nullptr) {
            LAS unsigned* qw = (LAS unsigned*)(F.lds + LDS_TAB + 1536);
            for (;;) {
                if (tid == 0) *qw = __hip_atomic_fetch_add(ctr, 1u, RLX_AGENT);
                LDS_BARRIER();
                const int qd = q_hi + __builtin_amdgcn_readfirstlane((int)*qw);
                LDS_BARRIER();
                if (qd >= q_end) break;
                const ConvJob j = decode(qd < I_IN ? qd : qd + NB16); f32x4 v[16]; conv8_load(j, tid, v); conv8_store(j, tid, v); }
            return;
        }
        int q = q_lo + F.bid;
        if (q < q_hi) {
            f32x4 va[16], vb[16];
            conv8_load(decode(q < I_IN ? q : q + NB16), tid, va);
            for (;;) {
                const int q1 = q + F.G; const bool m1 = q1 < q_hi;
                if (m1) conv8_load(decode(q1 < I_IN ? q1 : q1 + NB16), tid, vb);
                conv8_store(decode(q < I_IN ? q : q + NB16), tid, va);
                if (!m1) break;
                const int q2 = q1 + F.G; const bool m2 = q2 < q_hi;
                if (m2) conv8_load(decode(q2 < I_IN ? q2 : q2 + NB16), tid, va);
                conv8_store(decode(q1 < I_IN ? q1 : q1 + NB16), tid, vb);
                if (!m2) break;
                q = q2; }
        }
        if (part != 2) {
            for (int it = I_IN + (F.G - 1 - F.bid); it < I_IN + NB16; it += F.G) { const ConvJob j = decode(it); f32x4 v[16];
                conv_load(j, tid, v); conv_to_lds(j, tid, v, TL); LDS_BARRIER(); conv_from_lds(j, tid, TL); LDS_BARRIER(); }
        }
    } else {
    const int it_lo = (part == 2) ? N_NONEXP : 0, it_hi = (part == 1) ? N_NONEXP : NITEMS;
    if (it_lo + F.bid < it_hi) {
        f32x4 va[16]; int it = it_lo + F.bid; ConvJob jc = decode(it);
        conv_load(jc, tid, va);
        for (;;) { const int itn = it + F.G; const bool more = itn < it_hi;
            conv_to_lds(jc, tid, va, TL);
            LDS_BARRIER();
            ConvJob jn = jc; if (more) { jn = decode(itn); conv_load(jn, tid, va); }
            conv_from_lds(jc, tid, TL);
            LDS_BARRIER();
            if (!more) break;
            jc = jn; it = itn; }
    }
    }
    if (layer == 0 && part != 2) {
        const GAS f32x4* x4 = (const GAS f32x4*)GIN(0); GAS u32x2* xb = (GAS u32x2*)(ws + WS_XB); GAS unsigned* xb8 = (GAS unsigned*)(ws + WS_XB8);
        for (size_t i = (size_t)F.bid * 512 + tid; i < (size_t)T * D_MODEL / 4; i += (size_t)F.G * 512) { const f32x4 v = x4[i]; u32x2 o; o.x = pk2(v[0], v[1]); o.y = pk2(v[2], v[3]); xb[i] = o;
            int w8 = __builtin_amdgcn_cvt_pk_fp8_f32(v[0], v[1], 0, false); w8 = __builtin_amdgcn_cvt_pk_fp8_f32(v[2], v[3], w8, true); xb8[i] = (unsigned)w8; }
        const GAS int* pos = (const GAS int*)GIN(1); GAS f32x2* rt = (GAS f32x2*)(ws + WS_ROPE);
        for (int i = F.bid * 512 + tid; i < T * 64; i += F.G * 512) { const int tk = i >> 6, fi = i & 63;
            const double inv = exp2(-(double)fi * (13.287712379549449 / 64.0));
            const double ang = (double)pos[tk] * inv; const double red = ang - rint(ang * 0.15915494309189535) * 6.283185307179586;
            const float rf = (float)red; rt[i] = (f32x2){cosf(rf), sinf(rf)}; }
        const GAS float* lbl = GIN(3); GAS float* lb = (GAS float*)(ws + WS_LB);
        for (int c = F.bid * 512 + tid; c < HG_WIDTH; c += F.G * 512) {
            float mx = -1e30f; for (int l = 0; l < DEPTH; ++l) mx = fmaxf(mx, lbl[l * HG_WIDTH + c]);
            float den = 0.f; for (int l = 0; l < DEPTH; ++l) den += expf(lbl[l * HG_WIDTH + c] - mx);
            float cum = 0.f, c0 = 0.f; for (int l = 0; l < DEPTH; ++l) { cum += expf(lbl[l * HG_WIDTH + c] - mx) / den; if (l == 0) c0 = cum; lb[l * HG_WIDTH + c] = cum - c0; }
        }
    }
}

constexpr int TROW = 272;
struct H1Regs { float lf[16]; u32x4 v[2]; };
__device__ __forceinline__ void h1_load(Frame& F, int chunk, int tid, H1Regs& R) {
    const GAS bf16_t* H = (const GAS bf16_t*)(F.ws + WS_H); const GAS _Float16* LF = (const GAS _Float16*)(F.ws + WS_LF);
    const int bh = chunk >> 5, n = chunk & 31, b = bh >> 3, head = bh & 7, tok0 = b * SEQ + n * 64, kk = tid & 127, part = tid >> 7;
    const GAS _Float16* p = LF + HOFF(head * 128, tok0 + part * 16) + kk;
#pragma unroll
    for (int j = 0; j < 16; ++j) R.lf[j] = (float)p[(size_t)j * 128];
#pragma unroll
    for (int j = 0; j < 2; ++j) { const int c = tid + 512 * j, row = c >> 4, ch = c & 15;
        R.v[j] = *(const GAS u32x4*)(H + HOFF(C_HI + head * 128, tok0 + row) + ch * 8); }
}
__device__ __forceinline__ void h1_item(Frame& F, int chunk, int tid, const H1Regs& R) {
    GAS float* UT = (GAS float*)(F.ws + WS_UT); GAS float* DEC = (GAS float*)(F.ws + WS_DEC);
    LAS unsigned char* KT = F.lds; LAS unsigned char* VT = F.lds + 17408; LAS float* TOT = (LAS float*)(F.lds + 34816);
    const int lane = tid & 63, w = __builtin_amdgcn_readfirstlane(tid >> 6);
    const int kk = tid & 127, part = tid >> 7, g = lane >> 4, i = lane & 15;
    float lf[16], cum[16];
#pragma unroll
    for (int j = 0; j < 16; ++j) lf[j] = R.lf[j];
#pragma unroll
    for (int j = 0; j < 2; ++j) { const int c = tid + 512 * j, row = c >> 4, ch = c & 15; *(LAS u32x4*)(VT + row * TROW + ch * 16) = R.v[j]; }
    float run = 0.f;
#pragma unroll
    for (int j = 0; j < 16; ++j) { run += lf[j]; cum[j] = run; }
    TOT[part * 128 + kk] = run;
    LDS_BARRIER();
    float off = 0.f, end = 0.f;
#pragma unroll
    for (int p = 0; p < 4; ++p) { const float t = TOT[p * 128 + kk]; if (p < part) off += t; end += t; }
#pragma unroll
    for (int j = 0; j < 16; ++j) { const float c = cum[j] + off; const float kt = (1.0f - __expf(lf[j])) * __expf(end - c);
        *(LAS unsigned short*)(KT + (part * 16 + j) * TROW + kk * 2) = (unsigned short)cvt_pk_bf16(kt, 0.f); }
    if (part == 0) DEC[(size_t)chunk * 128 + kk] = __expf(end);
    LDS_BARRIER();
    const unsigned ktb = (unsigned)(size_t)KT, vtb = (unsigned)(size_t)VT;
    const int q = i >> 2, p4 = i & 3;
    bf16x8 af[2];
#pragma unroll
    for (int ks = 0; ks < 2; ++ks) { const s16x4 lo = tr_read(ktb + (32 * ks + 8 * g + q) * TROW + (16 * w + 4 * p4) * 2), hi = tr_read(ktb + (32 * ks + 8 * g + 4 + q) * TROW + (16 * w + 4 * p4) * 2);
        af[ks] = (bf16x8){lo[0], lo[1], lo[2], lo[3], hi[0], hi[1], hi[2], hi[3]}; }
    f32x4 uacc[8];
#pragma unroll
    for (int vb = 0; vb < 8; ++vb) uacc[vb] = (f32x4){0.f, 0.f, 0.f, 0.f};
#pragma unroll
    for (int ks = 0; ks < 2; ++ks) { s16x4 lo[8], hi[8];
        tr_read8<32>(lo, vtb + (32 * ks + 8 * g + q) * TROW + 8 * p4); tr_read8<32>(hi, vtb + (32 * ks + 8 * g + 4 + q) * TROW + 8 * p4);
#pragma unroll
        for (int vb = 0; vb < 8; ++vb) uacc[vb] = mfma16(af[ks], TRCAT(lo[vb], hi[vb]), uacc[vb]); }
#pragma unroll
    for (int vb = 0; vb < 8; ++vb) { u32x2 wv; wv.x = pk2(uacc[vb][0], uacc[vb][1]); wv.y = pk2(uacc[vb][2], uacc[vb][3]);
        *(GAS u32x2*)((GAS bf16_t*)UT + (size_t)chunk * 16384 + (16 * vb + i) * 128 + 16 * w + 4 * g) = wv; }
    LDS_BARRIER();
}

struct AttKV { u32x4 k[8], v[8]; };
__device__ __forceinline__ void attn_kv_load(Frame& F, int it, int tid, AttKV& R) {
    const GAS bf16_t* H = (const GAS bf16_t*)(F.ws + WS_H);
    const int b = it / 192, rem = it % 192, h = rem >> 4, j = rem & 15, grp = h >> 2, dsh = 2 * grp, d = 1 << dsh, r = j & (d - 1), qb = j >> dsh;
    const int lbase = 128 * (qb - 1);
    const GAS bf16_t* HbK = H + HOFF(C_AK + h * 128, b * SEQ); const GAS bf16_t* HbV = H + HOFF(C_AV + h * 128, b * SEQ);
#pragma unroll
    for (int jj = 0; jj < 8; ++jj) { if (qb == 0 && jj < 4) continue;
        const int c = tid + 512 * jj, row = c >> 4, ch = c & 15; int l = lbase + row; l = l < 0 ? 0 : l; const size_t tok = (size_t)(l * d + r);
        R.k[jj] = *(const GAS u32x4*)(HbK + tok * 128 + ch * 8); R.v[jj] = *(const GAS u32x4*)(HbV + tok * 128 + ch * 8); }
}
__device__ __forceinline__ void attn_item(Frame& F, int it, AttKV& R, int it_next) {
    GAS bf16_t* H = (GAS bf16_t*)(F.ws + WS_H); GAS float* LSE = (GAS float*)(F.ws + WS_LSE);
    const int b = it / 192, rem = it % 192, h = rem >> 4, j = rem & 15, grp = h >> 2, dsh = 2 * grp, d = 1 << dsh, r = j & (d - 1), qb = j >> dsh;
    const int lbase = 128 * (qb - 1);
    GAS bf16_t* HbQ = H + HOFF(C_AQ + h * 128, b * SEQ); GAS bf16_t* HbK = H + HOFF(C_AK + h * 128, b * SEQ); GAS bf16_t* HbV = H + HOFF(C_AV + h * 128, b * SEQ);
    LAS unsigned char* KT = F.lds; LAS unsigned char* VT = F.lds + 256 * TROW;
    PHASE_IDS();
    const int g = lane >> 4, i = lane & 15;
    const int jb0 = (qb == 0) ? (8 - w) : 0;
#pragma unroll
    for (int jj = 0; jj < 8; ++jj) { if (qb == 0 && jj < 4) continue;
        const int c = tid + 512 * jj, row = c >> 4, ch = c & 15;
        *(LAS u32x4*)(KT + row * TROW + ch * 16) = R.k[jj]; *(LAS u32x4*)(VT + row * TROW + ch * 16) = R.v[jj]; }
    const size_t tokq = (size_t)((128 * qb + 16 * w + i) * d + r);
    bf16x8 qf[4];
#pragma unroll
    for (int ks = 0; ks < 4; ++ks) qf[ks] = *(const GAS bf16x8*)(HbQ + tokq * 128 + 32 * ks + 8 * g);
    if (it_next >= 0) attn_kv_load(F, it_next, tid, R);
    LDS_BARRIER();
    f32x4 s[9];
#pragma unroll
    for (int jb = 0; jb < 9; ++jb) { f32x4 a4 = {0.f, 0.f, 0.f, 0.f};
        if (jb >= jb0) {
#pragma unroll
            for (int ks = 0; ks < 4; ++ks) { const bf16x8 a = *(const LAS bf16x8*)(KT + (16 * (w + jb) + i) * TROW + (32 * ks + 8 * g) * 2); a4 = mfma16(a, qf[ks], a4); } }
        s[jb] = a4; }
    float mx = -1e30f;
#pragma unroll
    for (int jb = 0; jb < 9; ++jb)
#pragma unroll
        for (int rg = 0; rg < 4; ++rg) { const int kin = 4 * g + rg, dist = 128 - 16 * jb + i - kin, lk = lbase + 16 * (w + jb) + kin;
            const bool valid = ((unsigned)dist <= 128u) && (lk >= 0) && (jb >= jb0);
            const float v = valid ? s[jb][rg] : -INFINITY; s[jb][rg] = v; mx = fmaxf(mx, v); }
    mx = fmaxf(mx, __shfl_xor(mx, 16)); mx = fmaxf(mx, __shfl_xor(mx, 32));
    float den = 0.f;
#pragma unroll
    for (int jb = 0; jb < 9; ++jb)
#pragma unroll
        for (int rg = 0; rg < 4; ++rg) { const float p = __expf(s[jb][rg] - mx); s[jb][rg] = p; den += p; }
    den += __shfl_xor(den, 16); den += __shfl_xor(den, 32);
    f32x4 o[8];
#pragma unroll
    for (int db = 0; db < 8; ++db) o[db] = (f32x4){0.f, 0.f, 0.f, 0.f};
    const unsigned vtb = (unsigned)(size_t)VT; const int q = i >> 2, p4 = i & 3;
#pragma unroll
    for (int kp = 0; kp < 5; ++kp) {
        bf16x8 pb; { const unsigned a0 = cvt_pk_bf16(s[2 * kp][0], s[2 * kp][1]), a1 = cvt_pk_bf16(s[2 * kp][2], s[2 * kp][3]);
            unsigned b0 = 0u, b1 = 0u; if (kp < 4) { b0 = cvt_pk_bf16(s[2 * kp + 1][0], s[2 * kp + 1][1]); b1 = cvt_pk_bf16(s[2 * kp + 1][2], s[2 * kp + 1][3]); }
            const u32x4 t4 = {a0, a1, b0, b1}; pb = __builtin_bit_cast(bf16x8, t4); }
        if (2 * kp + 1 < jb0) continue;
        int r0 = 16 * (w + 2 * kp) + 4 * g + q; const int r1 = (kp < 4) ? r0 + 16 : r0;
        if (2 * kp < jb0) r0 = r1;
        s16x4 lo[8], hi[8];
        tr_read8<32>(lo, vtb + r0 * TROW + 8 * p4); tr_read8<32>(hi, vtb + r1 * TROW + 8 * p4);
#pragma unroll
        for (int db = 0; db < 8; ++db) o[db] = mfma16(TRCAT(lo[db], hi[db]), pb, o[db]);
    }
    const float rden = fdiv(1.0f, den);
#pragma unroll
    for (int db = 0; db < 8; ++db) { u32x2 wv; wv.x = cvt_pk_bf16(o[db][0] * rden, o[db][1] * rden); wv.y = cvt_pk_bf16(o[db][2] * rden, o[db][3] * rden);
        *(GAS u32x2*)(HbQ + tokq * 128 + 16 * db + 4 * g) = wv; }
    if (g == 0) LSE[(size_t)h * T + (size_t)b * SEQ + tokq] = mx + __logf(den);
    LDS_BARRIER();
}

__device__ __forceinline__ void scan_item(Frame& F, int item) {
    const GAS float* UT = (const GAS float*)(F.ws + WS_UT); const GAS float* DEC = (const GAS float*)(F.ws + WS_DEC); GAS bf16_t* SPT = (GAS bf16_t*)(F.ws + WS_SPT);
    PHASE_IDS();
    const int bh = item >> 2, q4 = item & 3, vv = q4 * 32 + (tid >> 4), kk0 = (tid & 15) * 8;
    f32x4 s0 = {0.f, 0.f, 0.f, 0.f}, s1 = {0.f, 0.f, 0.f, 0.f};
#pragma unroll 16
    for (int n = 0; n < 32; ++n) { const size_t chunk = (size_t)bh * 32 + n; const size_t eo = chunk * 16384 + (size_t)vv * 128 + kk0;
        const u32x4 ub = *(const GAS u32x4*)((const GAS bf16_t*)UT + eo); const f32x4 u0 = {bflo(ub.x), bfhi(ub.x), bflo(ub.y), bfhi(ub.y)}, u1 = {bflo(ub.z), bfhi(ub.z), bflo(ub.w), bfhi(ub.w)}, d0 = *(const GAS f32x4*)(DEC + chunk * 128 + kk0), d1 = *(const GAS f32x4*)(DEC + chunk * 128 + kk0 + 4);
        u32x4 wv; wv.x = cvt_pk_bf16(s0[0], s0[1]); wv.y = cvt_pk_bf16(s0[2], s0[3]); wv.z = cvt_pk_bf16(s1[0], s1[1]); wv.w = cvt_pk_bf16(s1[2], s1[3]);
        *(GAS u32x4*)(SPT + eo) = wv;
        s0 = d0 * s0 + u0; s1 = d1 * s1 + u1; }
}
__device__ __forceinline__ void attn_merge(Frame& F) {
    const GAS bf16_t* H = (const GAS bf16_t*)(F.ws + WS_H); const GAS float* LSE = (const GAS float*)(F.ws + WS_LSE); GAS bf16_t* ATTO = (GAS bf16_t*)(F.ws + WS_ATTO);
    PHASE_IDS();
    const int gw = F.bid * 8 + w, NGW = F.G * 8, hg = lane >> 4, d0 = (lane & 15) * 8;
    for (int t = gw; t < T; t += NGW) {
        const float l0 = LSE[(size_t)hg * T + t], l1 = LSE[(size_t)(4 + hg) * T + t], l2 = LSE[(size_t)(8 + hg) * T + t];
        const float mx = fmaxf(l0, fmaxf(l1, l2)); float w0 = __expf(l0 - mx), w1 = __expf(l1 - mx), w2 = __expf(l2 - mx); const float rs = fdiv(1.0f, w0 + w1 + w2); w0 *= rs; w1 *= rs; w2 *= rs;
        const GAS bf16_t* base = H + HOFF(C_AQ + hg * 128, t) + d0;
        const u32x4 a = *(const GAS u32x4*)base, bq = *(const GAS u32x4*)(base + (size_t)4 * T * 128), c = *(const GAS u32x4*)(base + (size_t)8 * T * 128);
        u32x4 wv;
        wv.x = cvt_pk_bf16(w0 * bflo(a.x) + w1 * bflo(bq.x) + w2 * bflo(c.x), w0 * bfhi(a.x) + w1 * bfhi(bq.x) + w2 * bfhi(c.x));
        wv.y = cvt_pk_bf16(w0 * bflo(a.y) + w1 * bflo(bq.y) + w2 * bflo(c.y), w0 * bfhi(a.y) + w1 * bfhi(bq.y) + w2 * bfhi(c.y));
        wv.z = cvt_pk_bf16(w0 * bflo(a.z) + w1 * bflo(bq.z) + w2 * bflo(c.z), w0 * bfhi(a.z) + w1 * bfhi(bq.z) + w2 * bfhi(c.z));
        wv.w = cvt_pk_bf16(w0 * bflo(a.w) + w1 * bflo(bq.w) + w2 * bflo(c.w), w0 * bfhi(a.w) + w1 * bfhi(bq.w) + w2 * bfhi(c.w));
        *(GAS u32x4*)(ATTO + (size_t)t * ATT_OUT + hg * 128 + d0) = wv;
    }
}

struct H3Regs { float lf[16]; unsigned short q[16]; u32x4 v[2]; u32x4 sp[4]; };
__device__ __forceinline__ void h3_load(Frame& F, int chunk, int tid, H3Regs& R) {
    const GAS bf16_t* H = (const GAS bf16_t*)(F.ws + WS_H); const GAS _Float16* LF = (const GAS _Float16*)(F.ws + WS_LF); const GAS bf16_t* SPT = (const GAS bf16_t*)(F.ws + WS_SPT);
    const int bh = chunk >> 5, n = chunk & 31, b = bh >> 3, head = bh & 7, tok0 = b * SEQ + n * 64, kk = tid & 127, part = tid >> 7;
    const GAS _Float16* p = LF + HOFF(head * 128, tok0 + part * 16) + kk; const GAS bf16_t* pq = H + HOFF(C_HQ + head * 128, tok0 + part * 16) + kk;
#pragma unroll
    for (int j = 0; j < 16; ++j) { R.lf[j] = (float)p[(size_t)j * 128]; R.q[j] = pq[(size_t)j * 128]; }
#pragma unroll
    for (int j = 0; j < 2; ++j) { const int c = tid + 512 * j, row = c >> 4, ch = c & 15; R.v[j] = *(const GAS u32x4*)(H + HOFF(C_HI + head * 128, tok0 + row) + ch * 8); }
#pragma unroll
    for (int j = 0; j < 4; ++j) { const int c = tid + 512 * j, row = c >> 4, ch = c & 15; R.sp[j] = *(const GAS u32x4*)(SPT + (size_t)chunk * 16384 + row * 128 + ch * 8); }
}
__device__ __forceinline__ void h3_item(Frame& F, int chunk, const GAS float* normg, int tid, const H3Regs& R) {
    const GAS bf16_t* H = (const GAS bf16_t*)(F.ws + WS_H); GAS bf16_t* HGO = (GAS bf16_t*)(F.ws + WS_HGO);
    const int bh = chunk >> 5, n = chunk & 31, b = bh >> 3, head = bh & 7, tok0 = b * SEQ + n * 64;
    LAS unsigned char* QT = F.lds; LAS unsigned char* QH = F.lds + 17408; LAS unsigned char* KH = F.lds + 34816; LAS unsigned char* VT = F.lds + 52224; LAS unsigned char* SP = F.lds + 69632;
    LAS float* TOT = (LAS float*)(F.lds + 104448); LAS float* RS = (LAS float*)(F.lds + 106496);
    const int lane = tid & 63, w = __builtin_amdgcn_readfirstlane(tid >> 6);
    const int kk = tid & 127, part = tid >> 7, g = lane >> 4, i = lane & 15;
    const int tb = w & 3, vh = w >> 2;
    const size_t tok = (size_t)(tok0 + 16 * tb + i);
    f32x4 ngv[4]; u32x2 gtv[4];
#pragma unroll
    for (int vb = 0; vb < 4; ++vb) { const int vv = 16 * (4 * vh + vb) + 4 * g; ngv[vb] = *(const GAS f32x4*)(normg + head * 128 + vv); gtv[vb] = *(const GAS u32x2*)(H + HOFF(C_HGATE + head * 128, tok) + vv); }
    float lf[16], cum[16], qv[16];
#pragma unroll
    for (int j = 0; j < 16; ++j) { lf[j] = R.lf[j]; qv[j] = bf2f(R.q[j]); }
#pragma unroll
    for (int j = 0; j < 2; ++j) { const int c = tid + 512 * j, row = c >> 4, ch = c & 15; *(LAS u32x4*)(VT + row * TROW + ch * 16) = R.v[j]; }
#pragma unroll
    for (int j = 0; j < 4; ++j) { const int c = tid + 512 * j, row = c >> 4, ch = c & 15; *(LAS u32x4*)(SP + row * TROW + ch * 16) = R.sp[j]; }
    float run = 0.f;
#pragma unroll
    for (int j = 0; j < 16; ++j) { run += lf[j]; cum[j] = run; }
    TOT[part * 128 + kk] = run;
    LDS_BARRIER();
    float off = 0.f;
#pragma unroll
    for (int p = 0; p < 4; ++p) { const float t = TOT[p * 128 + kk]; if (p < part) off += t; }
    const float cmid = TOT[kk] + TOT[128 + kk];
#pragma unroll
    for (int j = 0; j < 16; ++j) { const float c = cum[j] + off; const int t = part * 16 + j; const float kq = 1.0f - __expf(lf[j]);
        const unsigned w01 = cvt_pk_bf16(qv[j] * __expf(c), qv[j] * __expf(fminf(c - cmid, 60.f)));
        *(LAS unsigned short*)(QT + t * TROW + kk * 2) = (unsigned short)w01;
        *(LAS unsigned short*)(QH + t * TROW + kk * 2) = (unsigned short)(w01 >> 16);
        *(LAS unsigned short*)(KH + t * TROW + kk * 2) = (unsigned short)cvt_pk_bf16(kq * __expf(fminf(cmid - c, 60.f)), 0.f); }
    LDS_BARRIER();
    f32x4 at[4];
#pragma unroll
    for (int sb = 0; sb < 4; ++sb) { f32x4 a4 = {0.f, 0.f, 0.f, 0.f};
        if (sb <= tb) {
#pragma unroll
            for (int ks = 0; ks < 4; ++ks) { const bf16x8 a = *(const LAS bf16x8*)(KH + (16 * sb + i) * TROW + (32 * ks + 8 * g) * 2), bq = *(const LAS bf16x8*)(QH + (16 * tb + i) * TROW + (32 * ks + 8 * g) * 2);
                a4 = mfma16(a, bq, a4); }
            if (sb == tb) {
#pragma unroll
                for (int rg = 0; rg < 4; ++rg) a4[rg] = (4 * g + rg <= i) ? a4[rg] : 0.f; }
        }
        at[sb] = a4; }
    bf16x8 pb[2];
#pragma unroll
    for (int kp = 0; kp < 2; ++kp) { const u32x4 t4 = {pk2(at[2 * kp][0], at[2 * kp][1]), pk2(at[2 * kp][2], at[2 * kp][3]), pk2(at[2 * kp + 1][0], at[2 * kp + 1][1]), pk2(at[2 * kp + 1][2], at[2 * kp + 1][3])};
        pb[kp] = __builtin_bit_cast(bf16x8, t4); }
    const unsigned vtb = (unsigned)(size_t)VT; const int q = i >> 2, p4 = i & 3;
    f32x4 o[4]; float ss = 0.f;
    s16x4 vlo[2][4], vhi[2][4];
#pragma unroll
    for (int kp = 0; kp < 2; ++kp) tr_read4x2<32>(vlo[kp], vhi[kp], vtb + (32 * kp + 4 * g + q) * TROW + (64 * vh + 4 * p4) * 2, vtb + (32 * kp + 16 + 4 * g + q) * TROW + (64 * vh + 4 * p4) * 2);
#pragma unroll
    for (int vb = 0; vb < 4; ++vb) { const int vblk = 4 * vh + vb; f32x4 acc = {0.f, 0.f, 0.f, 0.f};
#pragma unroll
        for (int ks = 0; ks < 4; ++ks) { const bf16x8 a = *(const LAS bf16x8*)(SP + (16 * vblk + i) * TROW + (32 * ks + 8 * g) * 2), bq = *(const LAS bf16x8*)(QT + (16 * tb + i) * TROW + (32 * ks + 8 * g) * 2);
            acc = mfma16(a, bq, acc); }
#pragma unroll
        for (int kp = 0; kp < 2; ++kp) acc = mfma16(TRCAT(vlo[kp][vb], vhi[kp][vb]), pb[kp], acc);
        o[vb] = acc; ss += (acc[0] * acc[0] + acc[1] * acc[1]) + (acc[2] * acc[2] + acc[3] * acc[3]); }
    ss += __shfl_xor(ss, 16); ss += __shfl_xor(ss, 32);
    if (g == 0) RS[vh * 64 + 16 * tb + i] = ss;
    LDS_BARRIER();
    const float tot = RS[16 * tb + i] + RS[64 + 16 * tb + i];
    const float rinv = rsqrtf(tot * (1.0f / 128.0f) + NORM_EPS);
#pragma unroll
    for (int vb = 0; vb < 4; ++vb) { const int vv = 16 * (4 * vh + vb) + 4 * g;
        const f32x4 ng = ngv[vb]; const u32x2 gt = gtv[vb];
        u32x2 wv; wv.x = cvt_pk_bf16(o[vb][0] * rinv * ng[0] * bflo(gt.x), o[vb][1] * rinv * ng[1] * bfhi(gt.x)); wv.y = cvt_pk_bf16(o[vb][2] * rinv * ng[2] * bflo(gt.y), o[vb][3] * rinv * ng[3] * bfhi(gt.y));
        *(GAS u32x2*)(HGO + tok * HG_WIDTH + head * 128 + vv) = wv; }
    LDS_BARRIER();
}

template <bool X8>
__device__ __forceinline__ void ln_router_phase(Frame& F, int layer) {
    PHASE_ARGS();
    const GAS bf16_t* R = (const GAS bf16_t*)(F.ws + WS_R); GAS bf16_t* X1B = (GAS bf16_t*)(F.ws + WS_X1B); GAS unsigned char* X1B8 = F.ws + WS_X1B8;
    const GAS float* g1 = GIN(8) + (size_t)layer * D_MODEL; const GAS float* b1 = GIN(9) + (size_t)layer * D_MODEL;
    const GAS float* wrt = GIN(10) + (size_t)layer * D_MODEL * N_EXPERTS; const GAS float* rbias = GIN(11) + (size_t)layer * N_EXPERTS;
    GAS int* PE = (GAS int*)(F.ws + WS_PE); GAS int* PP = (GAS int*)(F.ws + WS_PP); GAS float* PG = (GAS float*)(F.ws + WS_PG); GAS int* RM = (GAS int*)(F.ws + WS_RM);
    GAS unsigned* cnt = F.ctl + CW_CNT + layer * 64;
    constexpr int XROW = 528, WROW = 144;
    LAS unsigned char* XSb = F.lds; LAS unsigned char* WSb = F.lds + 64 * XROW; LAS float* PART = (LAS float*)F.lds; LAS float* LG = (LAS float*)(F.lds + 32768);
    LAS int* LCNT = (LAS int*)(F.lds + 49152); LAS int* BASE = (LAS int*)(F.lds + 49408); LAS int* PEL = (LAS int*)(F.lds + 49664); LAS int* PLL = (LAS int*)(F.lds + 51712);
    PHASE_IDS();
    const int g = lane >> 4, i = lane & 15;
    for (int bt = F.bid; bt < T / 64; bt += F.G) {
        const int tok0 = bt * 64;
#pragma unroll 1
        for (int pr = 0; pr < 4; ++pr) {
            f32x4 ys[2][4][2];
#pragma unroll
            for (int tt = 0; tt < 2; ++tt) { const size_t token = (size_t)(tok0 + 8 * w + 2 * pr + tt);
                const GAS u32x4* rp = (const GAS u32x4*)(R + token * D_MODEL) + lane;
#pragma unroll
                for (int j = 0; j < 4; ++j) { const u32x4 r = rp[64 * j]; ys[tt][j][0] = (f32x4){bflo(r.x), bfhi(r.x), bflo(r.y), bfhi(r.y)}; ys[tt][j][1] = (f32x4){bflo(r.z), bfhi(r.z), bflo(r.w), bfhi(r.w)}; } }
#pragma unroll
            for (int tt = 0; tt < 2; ++tt) { const size_t token = (size_t)(tok0 + 8 * w + 2 * pr + tt); float s = 0.f;
#pragma unroll
                for (int j = 0; j < 4; ++j)
#pragma unroll
                    for (int h = 0; h < 2; ++h) s += (ys[tt][j][h][0] + ys[tt][j][h][1]) + (ys[tt][j][h][2] + ys[tt][j][h][3]);
                const float mean = wave_sum(s) * (1.0f / D_MODEL); float s2 = 0.f;
#pragma unroll
                for (int j = 0; j < 4; ++j)
#pragma unroll
                    for (int h = 0; h < 2; ++h) { ys[tt][j][h] = ys[tt][j][h] - mean; s2 += (ys[tt][j][h][0] * ys[tt][j][h][0] + ys[tt][j][h][1] * ys[tt][j][h][1]) + (ys[tt][j][h][2] * ys[tt][j][h][2] + ys[tt][j][h][3] * ys[tt][j][h][3]); }
                const float rstd = rsqrtf(wave_sum(s2) * (1.0f / D_MODEL) + LN_EPS);
#pragma unroll
                for (int j = 0; j < 4; ++j) { const int c = 8 * lane + 512 * j;
                    const f32x4 y0 = ys[tt][j][0] * rstd * *(const GAS f32x4*)(g1 + c) + *(const GAS f32x4*)(b1 + c), y1 = ys[tt][j][1] * rstd * *(const GAS f32x4*)(g1 + c + 4) + *(const GAS f32x4*)(b1 + c + 4);
                    u32x4 o; o.x = cvt_pk_bf16(y0[0], y0[1]); o.y = cvt_pk_bf16(y0[2], y0[3]); o.z = cvt_pk_bf16(y1[0], y1[1]); o.w = cvt_pk_bf16(y1[2], y1[3]);
                    *(GAS u32x4*)(X1B + token * D_MODEL + c) = o;
                    if constexpr (X8) { u32x2 w8; int q8 = __builtin_amdgcn_cvt_pk_fp8_f32(y0[0], y0[1], 0, false); q8 = __builtin_amdgcn_cvt_pk_fp8_f32(y0[2], y0[3], q8, true); w8.x = (unsigned)q8;
                        q8 = __builtin_amdgcn_cvt_pk_fp8_f32(y1[0], y1[1], 0, false); q8 = __builtin_amdgcn_cvt_pk_fp8_f32(y1[2], y1[3], q8, true); w8.y = (unsigned)q8;
                        *(GAS u32x2*)(X1B8 + token * D_MODEL + c) = w8; } }
            }
        }
        VM_WAIT(); __syncthreads();
        f32x4 dacc[4];
#pragma unroll
        for (int nb = 0; nb < 4; ++nb) dacc[nb] = (f32x4){0.f, 0.f, 0.f, 0.f};
        const int tt4 = w & 3, kh = w >> 2;
        u32x4 xr[4];
#pragma unroll
        for (int j = 0; j < 4; ++j) { const int idx = tid + 512 * j, row = idx >> 5, c8 = idx & 31; xr[j] = *(const GAS u32x4*)(X1B + (size_t)(tok0 + row) * D_MODEL + 8 * c8); }
#pragma unroll 1
        for (int ke = 0; ke < 8; ++ke) { const int k1 = 256 * (ke + 1);
#pragma unroll
            for (int j = 0; j < 4; ++j) { const int idx = tid + 512 * j, row = idx >> 5, c8 = idx & 31; *(LAS u32x4*)(XSb + row * XROW + c8 * 16) = xr[j]; }
#pragma unroll
            for (int j = 0; j < 8; ++j) { const int idx = tid + 512 * j, row = idx >> 4, c4 = idx & 15; const f32x4 v = *(const GAS f32x4*)(wrt + (size_t)(k1 - 256 + row) * N_EXPERTS + 4 * c4);
                u32x2 o; o.x = cvt_pk_bf16(v[0], v[1]); o.y = cvt_pk_bf16(v[2], v[3]); *(LAS u32x2*)(WSb + row * WROW + c4 * 8) = o; }
            LDS_BARRIER();
            if (ke < 7) {
#pragma unroll
                for (int j = 0; j < 4; ++j) { const int idx = tid + 512 * j, row = idx >> 5, c8 = idx & 31; xr[j] = *(const GAS u32x4*)(X1B + (size_t)(tok0 + row) * D_MODEL + k1 + 8 * c8); }
            }
            { const unsigned wsb = (unsigned)(size_t)WSb; const int q = i >> 2, p4 = i & 3;
#pragma unroll
              for (int ks = 0; ks < 4; ++ks) { const int kk0 = 128 * kh + 32 * ks;
                const bf16x8 a = *(const LAS bf16x8*)(XSb + (tt4 * 16 + i) * XROW + (kk0 + 8 * g) * 2);
                s16x4 lo4[4], hi4[4];
                tr_read4x2<32>(lo4, hi4, wsb + (kk0 + 8 * g + q) * WROW + 8 * p4, wsb + (kk0 + 8 * g + 4 + q) * WROW + 8 * p4);
#pragma unroll
                for (int nb = 0; nb < 4; ++nb) dacc[nb] = mfma16(a, TRCAT(lo4[nb], hi4[nb]), dacc[nb]); } }
            LDS_BARRIER();
        }
#pragma unroll
        for (int nb = 0; nb < 4; ++nb)
#pragma unroll
            for (int rg = 0; rg < 4; ++rg) PART[(kh * 64 + tt4 * 16 + 4 * g + rg) * 64 + 16 * nb + i] = dacc[nb][rg];
        __syncthreads();
        { const f32x4 a0 = *(const LAS f32x4*)(PART + tid * 8), a1 = *(const LAS f32x4*)(PART + tid * 8 + 4), c0 = *(const LAS f32x4*)(PART + 4096 + tid * 8), c1 = *(const LAS f32x4*)(PART + 4096 + tid * 8 + 4);
          __syncthreads();
          *(LAS f32x4*)(LG + tid * 8) = a0 + c0; *(LAS f32x4*)(LG + tid * 8 + 4) = a1 + c1; }
        if (tid < 64) { RM[(size_t)N_EXPERTS * T + tok0 + tid] = tok0 + tid; LCNT[tid] = 0; }
        __syncthreads();
#pragma unroll 1
        for (int tt = 0; tt < 8; ++tt) { const int tk = 8 * w + tt, token = tok0 + tk, e = lane;
            const float sc = 1.0f / (1.0f + expf(-LG[tk * 64 + e])); const float sel = sc + rbias[e];
            const float m1 = max8_dpp(sel);
            const unsigned long long bal = __ballot(sel == m1) & (0xFFull << (8 * (e >> 3)));
            const int first = __builtin_ctzll(bal);
            const float v2 = max8_dpp((e == first) ? -INFINITY : sel);
            const float gs = m1 + v2; int grank = 0;
#pragma unroll
            for (int gp = 0; gp < 8; ++gp) { const float o = __builtin_bit_cast(float, __builtin_amdgcn_readlane(__builtin_bit_cast(int, gs), 8 * gp)); grank += (o > gs || (o == gs && gp < (e >> 3))) ? 1 : 0; }
            const bool gsel = grank < TOPK_GROUPS; const float sel2 = gsel ? sel : -INFINITY; int rank = 0;
            const unsigned long long gbal = __ballot(gsel);
#pragma unroll 1
            for (int gp = 0; gp < 8; ++gp) { if (((gbal >> (8 * gp)) & 1ull) == 0ull) continue;
#pragma unroll
                for (int q = 0; q < 8; ++q) { const int ep = 8 * gp + q; const float o = __builtin_bit_cast(float, __builtin_amdgcn_readlane(__builtin_bit_cast(int, sel2), ep)); rank += (o > sel2 || (o == sel2 && ep < e)) ? 1 : 0; } }
            const bool chosen = gsel && rank < TOP_K;
            float wsum = 0.f; { unsigned long long cb = __ballot(chosen);
                while (cb) { const int l = __builtin_ctzll(cb); wsum += __builtin_bit_cast(float, __builtin_amdgcn_readlane(__builtin_bit_cast(int, sc), l)); cb &= cb - 1ull; } }
            if (chosen) { const int lpos = __hip_atomic_fetch_add(LCNT + e, 1, __ATOMIC_RELAXED, __HIP_MEMORY_SCOPE_WORKGROUP);
                PEL[tk * 8 + rank] = e; PLL[tk * 8 + rank] = lpos;
                PE[(size_t)token * 8 + rank] = e; PG[(size_t)token * 8 + rank] = sc / wsum * ROUTED_SCALE; }
        }
        __syncthreads();
        if (tid < 64) BASE[tid] = (int)__hip_atomic_fetch_add(cnt + tid, (unsigned)LCNT[tid], __ATOMIC_RELAXED, __HIP_MEMORY_SCOPE_AGENT);
        __syncthreads();
        { const int e = PEL[tid], pos = BASE[e] + PLL[tid], token = tok0 + (tid >> 3);
          PP[(size_t)token * 8 + (tid & 7)] = pos; RM[(size_t)e * T + pos] = token; }
        __syncthreads();
    }
}

__device__ __forceinline__ void build_toff(Frame& F, int layer) {
    LAS int* toff = (LAS int*)(F.lds + LDS_TAB);
    if (threadIdx.x < 64) {
        const GAS unsigned* cnt = F.ctl + CW_CNT + layer * 64; const int e = (int)threadIdx.x;
        const int tiles = ((int)__hip_atomic_load(cnt + e, RLX_AGENT) + 255) >> 8; int incl = tiles;
#pragma unroll
        for (int o = 1; o < 64; o <<= 1) { const int up = __shfl_up(incl, o); if (e >= o) incl += up; }
        toff[e] = incl - tiles;
        if (e == 63) { toff[N_EXPERTS] = incl; toff[NEXP1] = incl + T / 256; } }
    __syncthreads();
}

template <bool Y8, bool LAST>
__device__ __forceinline__ void combine_ln2_phase(Frame& F, int layer) {
    PHASE_ARGS(); GAS float* OUT = (GAS float*)(GAS float*)ap->out;
    const GAS bf16_t* Y = (const GAS bf16_t*)(F.ws + WS_Y); const GAS bf16_t* X1B = (const GAS bf16_t*)(F.ws + WS_X1B); GAS bf16_t* XB = (GAS bf16_t*)(F.ws + WS_XB); GAS unsigned char* XB8 = F.ws + WS_XB8;
    const GAS float* g2 = GIN(18) + (size_t)layer * D_MODEL; const GAS float* b2 = GIN(19) + (size_t)layer * D_MODEL;
    const GAS int* PE = (const GAS int*)(F.ws + WS_PE); const GAS int* PP = (const GAS int*)(F.ws + WS_PP); const GAS float* PG = (const GAS float*)(F.ws + WS_PG);
    const LAS int* toff = (const LAS int*)(F.lds + LDS_TAB);
    PHASE_IDS();
    const int gw = F.bid * 8 + w, NGW = F.G * 8;
    for (int tb = gw; tb < T; tb += 8 * NGW) {
        int myrow = 0; float mygate = 0.f;
        { const int tl = tb + (lane >> 3) * NGW; if (tl < T) { const int e = PE[(size_t)tl * 8 + (lane & 7)]; myrow = toff[e] * 256 + PP[(size_t)tl * 8 + (lane & 7)]; mygate = PG[(size_t)tl * 8 + (lane & 7)]; } }
#pragma unroll 1
      for (int tj = 0; tj < 8; ++tj) { const int t = tb + tj * NGW; if (t >= T) break;
        f32x4 a[4][2];
#pragma unroll
        for (int j = 0; j < 4; ++j) { a[j][0] = (f32x4){0.f, 0.f, 0.f, 0.f}; a[j][1] = (f32x4){0.f, 0.f, 0.f, 0.f}; }
#pragma unroll
        for (int k = 0; k < 9; ++k) { size_t row; float gt;
            if (k < 8) { row = (size_t)__shfl(myrow, tj * 8 + k); gt = __shfl(mygate, tj * 8 + k); }
            else { row = (size_t)toff[N_EXPERTS] * 256 + t; gt = 1.0f; }
            if constexpr (Y8) {
                const GAS u32x2* yp = (const GAS u32x2*)((const GAS unsigned char*)Y + row * D_MODEL) + lane;
#pragma unroll
                for (int j = 0; j < 4; ++j) { const u32x2 y = yp[64 * j];
                    const f32x2 p0 = __builtin_amdgcn_cvt_pk_f32_fp8((int)y.x, false), p1 = __builtin_amdgcn_cvt_pk_f32_fp8((int)y.x, true), p2 = __builtin_amdgcn_cvt_pk_f32_fp8((int)y.y, false), p3 = __builtin_amdgcn_cvt_pk_f32_fp8((int)y.y, true);
                    a[j][0] += (f32x4){p0[0], p0[1], p1[0], p1[1]} * gt; a[j][1] += (f32x4){p2[0], p2[1], p3[0], p3[1]} * gt; }
            } else {
            const GAS u32x4* yp = (const GAS u32x4*)(Y + row * D_MODEL) + lane;
#pragma unroll
            for (int j = 0; j < 4; ++j) { const u32x4 y = yp[64 * j];
                a[j][0] += (f32x4){bflo(y.x), bfhi(y.x), bflo(y.y), bfhi(y.y)} * gt; a[j][1] += (f32x4){bflo(y.z), bfhi(y.z), bflo(y.w), bfhi(y.w)} * gt; } } }
        float s = 0.f;
#pragma unroll
        for (int j = 0; j < 4; ++j) { const u32x4 xv = *(const GAS u32x4*)(X1B + (size_t)t * D_MODEL + 8 * lane + 512 * j);
            a[j][0] += (f32x4){bflo(xv.x), bfhi(xv.x), bflo(xv.y), bfhi(xv.y)} * DN_ALPHA; a[j][1] += (f32x4){bflo(xv.z), bfhi(xv.z), bflo(xv.w), bfhi(xv.w)} * DN_ALPHA;
            s += (a[j][0][0] + a[j][0][1]) + (a[j][0][2] + a[j][0][3]) + (a[j][1][0] + a[j][1][1]) + (a[j][1][2] + a[j][1][3]); }
        const float mean = wave_sum(s) * (1.0f / D_MODEL); float s2 = 0.f;
#pragma unroll
        for (int j = 0; j < 4; ++j) { a[j][0] = a[j][0] - mean; a[j][1] = a[j][1] - mean;
            s2 += (a[j][0][0] * a[j][0][0] + a[j][0][1] * a[j][0][1]) + (a[j][0][2] * a[j][0][2] + a[j][0][3] * a[j][0][3]) + (a[j][1][0] * a[j][1][0] + a[j][1][1] * a[j][1][1]) + (a[j][1][2] * a[j][1][2] + a[j][1][3] * a[j][1][3]); }
        const float rstd = rsqrtf(wave_sum(s2) * (1.0f / D_MODEL) + LN_EPS);
#pragma unroll
        for (int j = 0; j < 4; ++j) { const int c = 8 * lane + 512 * j;
            const f32x4 o0 = a[j][0] * rstd * *(const GAS f32x4*)(g2 + c) + *(const GAS f32x4*)(b2 + c), o1 = a[j][1] * rstd * *(const GAS f32x4*)(g2 + c + 4) + *(const GAS f32x4*)(b2 + c + 4);
            if constexpr (LAST) { *(GAS f32x4*)(OUT + (size_t)t * D_MODEL + c) = o0; *(GAS f32x4*)(OUT + (size_t)t * D_MODEL + c + 4) = o1; }
            else {
            u32x4 wv; wv.x = cvt_pk_bf16(o0[0], o0[1]); wv.y = cvt_pk_bf16(o0[2], o0[3]); wv.z = cvt_pk_bf16(o1[0], o1[1]); wv.w = cvt_pk_bf16(o1[2], o1[3]);
            *(GAS u32x4*)(XB + (size_t)t * D_MODEL + c) = wv;
            u32x2 w8; { int q = __builtin_amdgcn_cvt_pk_fp8_f32(o0[0], o0[1], 0, false); q = __builtin_amdgcn_cvt_pk_fp8_f32(o0[2], o0[3], q, true); w8.x = (unsigned)q;
                        q = __builtin_amdgcn_cvt_pk_fp8_f32(o1[0], o1[1], 0, false); q = __builtin_amdgcn_cvt_pk_fp8_f32(o1[2], o1[3], q, true); w8.y = (unsigned)q; }
            *(GAS u32x2*)(XB8 + (size_t)t * D_MODEL + c) = w8; } }
      }
    }
}

constexpr int PH_PER_LAYER = 11, N_PHASES = DEPTH * PH_PER_LAYER;
constexpr int CONV_TAIL = 2048;
constexpr bool GU8_ALL = true;
#ifndef PH_MASK
#define PH_MASK 0x7ff
#endif
#define IN(k) (((PH_MASK >> ((k) % PH_PER_LAYER)) & 1) && lo <= (k) && (k) < hi)
#ifndef PROBE_MASK
#define PROBE_MASK 0
#endif
#ifndef PROBE_AMP
#define PROBE_AMP 4
#endif
constexpr int LDS_STAMP = LDS_TAB + 1024;
#define SEAM(k) do { if (IN(k) && IN((k) + 1)) xcd_barrier(bar); \
    if (PROBE_MASK != 0 && threadIdx.x == 0) ((LAS unsigned long long*)(F0.lds + LDS_STAMP))[(k) + 1] = __builtin_amdgcn_s_memrealtime(); } while (0)
#define PHASE_FRAME() Frame F = F0; asm volatile("" : "+s"(F.ws), "+s"(F.ctl), "+s"(F.G), "+s"(F.bid), "+s"(F.lds)); \
    F.ws = (GAS unsigned char*)(GAS unsigned char*)F.ws; F.ctl = (GAS unsigned*)(GAS unsigned*)F.ctl;     \
    GAS unsigned char* ws = F.ws; (void)ws
template <int layer>
__device__ __forceinline__ void run_layer(const Frame& F0, const XcdBarrier& bar, const int lo, const int hi) {
        const int pb = layer * PH_PER_LAYER;
        constexpr bool GU8 = (layer == DEPTH - 1) || GU8_ALL;
        constexpr bool MOE8 = (layer == DEPTH - 1);
        if constexpr (layer == 0) { if (IN(pb + 0)) { PHASE_FRAME(); p0_convert(F, layer, GU8, MOE8, 1); } }
        SEAM(pb + 0);
        if (IN(pb + 1)) { PHASE_FRAME();
            EpiIn E{(GAS bf16_t*)(ws + WS_H), (GAS _Float16*)(ws + WS_LF), (const GAS float*)(ws + WS_LB) + layer * HG_WIDTH, (const GAS f32x4*)(ws + WS_ROPE)};
            DenseSched Sa{(const GAS char*)(ws + WS_XB), (const GAS char*)(ws + WS_WINF) - (size_t)C_HF * (D_MODEL * 2), D_MODEL * 2, D_MODEL * 2, D_MODEL / 64, T / 256, HG_WIDTH / 256, F.G, F.bid, 0, C_HF / 256};
            pg8::gemm_phase<EpiIn, DenseSched, false, false, true>(F.lds, Sa, E);
            DenseSched Sb{(const GAS char*)(ws + WS_XB8), (const GAS char*)(ws + WS_WIN), D_MODEL, D_MODEL, D_MODEL / 128, T / 256, (IN_WIDTH - HG_WIDTH) / 256, F.G, F.bid, C_HF / 256, HG_WIDTH / 256};
            if constexpr (layer == 0) {
                const long ntile = (long)Sb.nM * Sb.nN; const int nun = (int)((ntile - F.bid + F.G - 1) / F.G);
                const int ks = __builtin_amdgcn_readfirstlane(((F.bid & 7) * (nun + 1)) >> 3);
#pragma unroll 1
                for (int part = 0; part < 2; ++part) {
                    pg8::RangeSched<DenseSched> RS{Sb, part == 0 ? 0 : ks, part == 0 ? ks : (1 << 30)};
                    pg8::gemm_phase<EpiIn, pg8::RangeSched<DenseSched>, false, true, true>(F.lds, RS, E);
                    if (part == 0) p0_convert(F, layer, GU8, MOE8, 2, CONV_TAIL);
                }
                p0_convert(F, layer, GU8, MOE8, 2, CONV_TAIL, F.ctl + CW_CQ);
            } else pg8::gemm_phase<EpiIn, DenseSched, false, true, true>(F.lds, Sb, E);
        }
        SEAM(pb + 1);
        if (IN(pb + 2)) { PHASE_FRAME();
            { PHASE_IDS(); H1Regs ra, rb; int it = F.bid;
              if (it < NCHUNK * HG_HEADS) h1_load(F, it, tid, ra);
              for (; it < NCHUNK * HG_HEADS; it += F.G) { const int itn = it + F.G; if (itn < NCHUNK * HG_HEADS) h1_load(F, itn, tid, rb); h1_item(F, it, tid, ra); ra = rb; } }
            { constexpr int NAI = BATCH * ATT_HEADS * 16; const int nb = F.G >> 3, x = F.bid & 7, lb = F.bid >> 3;
              PHASE_IDS(); AttKV R;
              if ((F.G & 7) == 0 && NAI % 8 == 0) {
                  auto item_of = [&](int k) { const int hh = k >> 4, jj = ((k & 15) + hh) & 15; return x * (NAI / 8) + hh * 16 + jj; };
                  int k = lb; if (k < NAI / 8) attn_kv_load(F, item_of(k), tid, R);
                  for (; k < NAI / 8; k += nb) attn_item(F, item_of(k), R, (k + nb < NAI / 8) ? item_of(k + nb) : -1); }
              else { int it = F.bid; if (it < NAI) attn_kv_load(F, it, tid, R);
                  for (; it < NAI; it += F.G) attn_item(F, it, R, (it + F.G < NAI) ? it + F.G : -1); } }
        }
        SEAM(pb + 2);
        if (IN(pb + 3)) { PHASE_FRAME();
            for (int it = F.bid; it < BATCH * HG_HEADS * 4; it += F.G) scan_item(F, it);
            attn_merge(F);
        }
        SEAM(pb + 3);
        if (IN(pb + 4)) { PHASE_FRAME();
            PHASE_ARGS(); const GAS float* normg = GIN(4) + (size_t)layer * HG_WIDTH;
            { PHASE_IDS(); H3Regs ra, rb; int it = F.bid;
              if (it < NCHUNK * HG_HEADS) h3_load(F, it, tid, ra);
              for (; it < NCHUNK * HG_HEADS; it += F.G) { const int itn = it + F.G; if (itn < NCHUNK * HG_HEADS) h3_load(F, itn, tid, rb); h3_item(F, it, normg, tid, ra); ra = rb; } }
        }
        SEAM(pb + 4);
        if (IN(pb + 5)) { PHASE_FRAME();
            MergeSched S{(const GAS char*)(ws + WS_HGO), (const GAS char*)(ws + WS_WHG), (const GAS char*)(ws + WS_ATTO), (const GAS char*)(ws + WS_WATT), T / 256, D_MODEL / 256, F.G, F.bid};
            EpiMerge E{(const GAS bf16_t*)(ws + WS_H), (GAS bf16_t*)(ws + WS_MRG)};
            pg8::gemm_phase<EpiMerge, MergeSched, false>(F.lds, S, E);
        }
        SEAM(pb + 5);
        if (IN(pb + 6)) { PHASE_FRAME();
            DenseSched S{(const GAS char*)(ws + WS_MRG), (const GAS char*)(ws + WS_WOUT), D_MODEL, D_MODEL, D_MODEL / 128, T / 256, D_MODEL / 256, F.G, F.bid, 1 << 30, 0};
            PHASE_ARGS(); EpiResid E{(const GAS bf16_t*)(ws + WS_XB), (GAS bf16_t*)(ws + WS_R)};
            pg8::gemm_phase<EpiResid, DenseSched, false, true, true>(F.lds, S, E);
        }
        SEAM(pb + 6);
        if (IN(pb + 7)) { PHASE_FRAME(); ln_router_phase<GU8>(F, layer); }
        SEAM(pb + 7);
        if (IN(pb + 8)) { PHASE_FRAME();
            build_toff(F, layer);
            {
                typedef MoeSched<4, true, GU8 ? 1 : 2> SchedT;
                SchedT S{(const LAS int*)(F.lds + LDS_TAB), F.ctl + CW_CNT + layer * 64, (const GAS char*)(ws + (GU8 ? WS_X1B8 : WS_X1B)), (const GAS char*)(ws + (MOE8 ? WS_WGU8 : WS_WGU)), (const GAS int*)(ws + WS_RM), F.G, F.bid, (const LAS int*)(F.lds + LDS_EPI), (const LAS int*)(F.lds + LDS_TAB + 512)}; S.build_units((LAS int*)(F.lds + LDS_TAB + 512));
                EpiGateUp<true> E{(GAS bf16_t*)(ws + WS_HID)};
                if constexpr (layer + 1 < DEPTH) {
                    int nun = 0; { const LAS int* ut = (const LAS int*)(F.lds + LDS_TAB + 512); for (int i = 0; i < 32; ++i) nun += ut[i * 4 + 3]; }
                    const int ks = __builtin_amdgcn_readfirstlane(((F.bid & 7) * (nun + 1)) >> 3);
#pragma unroll 1
                    for (int part = 0; part < 2; ++part) {
                        pg8::RangeSched<SchedT> RS{S, part == 0 ? 0 : ks, part == 0 ? ks : (1 << 30)};
                        pg8::gemm_phase<EpiGateUp<true>, pg8::RangeSched<SchedT>, true, GU8>(F.lds, RS, E);
                        if (part == 0) p0_convert(F, layer + 1, (layer + 1 == DEPTH - 1) || GU8_ALL, layer + 1 == DEPTH - 1, 0, CONV_TAIL);
                    }
                    p0_convert(F, layer + 1, (layer + 1 == DEPTH - 1) || GU8_ALL, layer + 1 == DEPTH - 1, 0, CONV_TAIL, F.ctl + CW_CQ + 64);
                } else pg8::gemm_phase<EpiGateUp<true>, SchedT, true, GU8>(F.lds, S, E);
            }
        }
        SEAM(pb + 8);
        if (IN(pb + 9)) { PHASE_FRAME();
            build_toff(F, layer);
            {
                EpiDown<true> E{(GAS bf16_t*)(ws + WS_Y)};
                MoeSched<8, false, 1> S{(const LAS int*)(F.lds + LDS_TAB), F.ctl + CW_CNT + layer * 64, (const GAS char*)(ws + WS_HID), (const GAS char*)(ws + (MOE8 ? WS_WDN8 : WS_WDN)), nullptr, F.G, F.bid, nullptr, (const LAS int*)(F.lds + LDS_TAB + 512)}; S.build_units((LAS int*)(F.lds + LDS_TAB + 512));
                pg8::gemm_phase<EpiDown<true>, MoeSched<8, false, 1>, false, true, true>(F.lds, S, E);
            }
        }
        SEAM(pb + 9);
        if (IN(pb + 10)) { PHASE_FRAME(); build_toff(F, layer); combine_ln2_phase<true, layer == DEPTH - 1>(F, layer); }
        if constexpr (layer == DEPTH - 1) { SEAM(pb + 10); } else { if (PROBE_MASK != 0 && threadIdx.x == 0) ((LAS unsigned long long*)(F0.lds + LDS_STAMP))[pb + 11] = __builtin_amdgcn_s_memrealtime(); }
}
#undef IN
#undef SEAM
__global__ void __launch_bounds__(512, 2) kfwd(Args args) {
    extern __shared__ __attribute__((aligned(16))) unsigned char lds_raw[];
    Frame F0;
    F0.lds = (LAS unsigned char*)lds_raw;
    F0.G = gridDim.x; F0.bid = blockIdx.x; F0.ws = (GAS unsigned char*)args.ws; F0.ctl = (GAS unsigned*)(args.ws + WS_CTL);
    for (int u = threadIdx.x; u < (LDS_BYTES - LDS_TAB) / 4; u += 512) ((LAS unsigned*)(F0.lds + LDS_TAB))[u] = 0u;
    __syncthreads();
    XcdBarrier bar = xcd_barrier_post((unsigned*)(F0.ctl + CW_BAR), (volatile LAS unsigned*)(F0.lds + LDS_MISC));
    const int lo = args.ph_lo, hi = args.ph_hi;
    if (PROBE_MASK != 0 && threadIdx.x == 0) ((LAS unsigned long long*)(F0.lds + LDS_STAMP))[0] = __builtin_amdgcn_s_memrealtime();
    run_layer<0>(F0, bar, lo, hi);
    run_layer<1>(F0, bar, lo, hi);
    if (PROBE_MASK != 0 && blockIdx.x == 0 && threadIdx.x == 0) {
        const LAS unsigned long long* ts = (const LAS unsigned long long*)(F0.lds + LDS_STAMP); unsigned long long tot = 0;
        for (int k = 0; k < N_PHASES; ++k) if ((PROBE_MASK >> (k % PH_PER_LAYER)) & 1) tot += ts[k + 1] - ts[k];
        const unsigned long long t0 = __builtin_amdgcn_s_memrealtime(), lim = tot * PROBE_AMP < 4000000ull ? tot * PROBE_AMP : 4000000ull;
        while (__builtin_amdgcn_s_memrealtime() - t0 < lim) __builtin_amdgcn_s_sleep(32);
    }
}

extern "C" void kernel_launch(void* const* d_in, const int* in_sizes, int n_in, void* d_out, int out_size, void* d_ws, size_t ws_size, hipStream_t stream) {
    static int grid = 0;
    if (grid == 0) {
        if (n_in != 20 || out_size != T * D_MODEL || ws_size < WS_END) { fprintf(stderr, "kernel_launch: unexpected shapes (n_in %d, out %d, ws %zu < %zu)\n", n_in, out_size, ws_size, (size_t)WS_END); grid = -1; return; }
        int dev = 0, cus = 0, per_cu = 0;
        if (hipGetDevice(&dev) != hipSuccess || hipDeviceGetAttribute(&cus, hipDeviceAttributeMultiprocessorCount, dev) != hipSuccess) { grid = -1; return; }
        if (hipFuncSetAttribute((const void*)kfwd, hipFuncAttributeMaxDynamicSharedMemorySize, LDS_BYTES) != hipSuccess) { fprintf(stderr, "kernel_launch: hipFuncSetAttribute failed\n"); grid = -1; return; }
        if (hipOccupancyMaxActiveBlocksPerMultiprocessor(&per_cu, (const void*)kfwd, 512, LDS_BYTES) != hipSuccess || per_cu < 1) fprintf(stderr, "kernel_launch: occupancy query says %d\n", per_cu);
        (void)hipGetLastError();
        grid = cus;
    }
    if (grid < 0) return;
    if (hipMemsetAsync((char*)d_ws + WS_CTL, 0, CTL_ZERO_BYTES, stream) != hipSuccess) return;
    Args a{};
    for (int i = 0; i < 20; ++i) a.in[i] = (const float*)d_in[i];
    a.out = (float*)d_out; a.ws = (unsigned char*)d_ws;
#if MK_LAUNCH_PER_PHASE
    for (int p = 0; p < N_PHASES; ++p) { a.ph_lo = p; a.ph_hi = p + 1; hipLaunchKernelGGL(kfwd, dim3(grid), dim3(512), LDS_BYTES, stream, a); }
#else
    a.ph_lo = 0; a.ph_hi = N_PHASES; hipLaunchKernelGGL(kfwd, dim3(grid), dim3(512), LDS_BYTES, stream, a);
#endif
}
```
